# Optimizing an MI355X kernel written in HIP

```python
import jax
import jax.numpy as jnp
from jax import lax
import numpy as np

D_MODEL = 1024
BATCH = 4
SEQ = 4096
DEPTH = 1

N_HEADS = 8
HEAD_DIM = 64
ATTN_WIDTH = N_HEADS * HEAD_DIM
MOBA_BLOCK = 256
MOBA_TOPK = 3
Q_CHUNK = 32
SGU_CHUNK = 128
SGU_GROUPS = 8
SGU_WIDTH = D_MODEL // 2
SGU_GROUP_DIM = SGU_WIDTH // SGU_GROUPS
N_BRANCHES = 2
IN_WIDTH = 3 * ATTN_WIDTH + 2 * SGU_WIDTH + N_BRANCHES * D_MODEL
N_EXPERTS = 32
EXPERT_TOPK = 4
D_EXPERT = D_MODEL
SWIGLU_LIMIT = 7.0
SWIGLU_ALPHA = 1.702
ROW_BLOCK = 128
NORM_EPS = 1e-5

kernel_name = "hybrid_moba_gmlp_moe_layer"


def rms_norm(x, g):
    xf = x.astype(jnp.float32)
    y = xf * lax.rsqrt(jnp.mean(xf * xf, axis=-1, keepdims=True) + NORM_EPS)
    return (y * g.astype(jnp.float32)).astype(x.dtype)


def layer_norm(x, g, b):
    xf = x.astype(jnp.float32)
    mu = jnp.mean(xf, axis=-1, keepdims=True)
    var = jnp.mean(jnp.square(xf - mu), axis=-1, keepdims=True)
    y = (xf - mu) * lax.rsqrt(var + NORM_EPS) * g.astype(jnp.float32) + b.astype(jnp.float32)
    return y.astype(x.dtype)


def alibi_slopes(n_heads):
    return 2.0 ** (-8.0 * jnp.arange(1, n_heads + 1, dtype=jnp.float32) / n_heads)


def moba_attention(q, k, v):
    b, s, h, dh = q.shape
    nb = -(-s // MOBA_BLOCK)
    s_pad = nb * MOBA_BLOCK
    pad = [(0, 0), (0, s_pad - s), (0, 0), (0, 0)]
    q, k, v = [jnp.pad(t, pad).transpose(0, 2, 1, 3) for t in (q, k, v)]
    k_blk = k.reshape(b, h, nb, MOBA_BLOCK, dh)
    v_blk = v.reshape(b, h, nb, MOBA_BLOCK, dh)
    k_mean = jnp.mean(k_blk.astype(jnp.float32), axis=3)
    pos = jnp.arange(s_pad, dtype=jnp.int32)
    q_blk_id = pos // MOBA_BLOCK
    gate = jnp.einsum('bhtd,bhnd->bhtn', q.astype(jnp.float32), k_mean)
    past = jnp.arange(nb, dtype=jnp.int32)[None, :] < q_blk_id[:, None]
    gate = jnp.where(past, gate, -jnp.inf)
    n_sel = min(MOBA_TOPK, nb)
    _, sel_idx = lax.top_k(gate, n_sel)
    sel_valid = jnp.arange(n_sel, dtype=jnp.int32)[None, :] < q_blk_id[:, None]

    n_chunks = s_pad // Q_CHUNK
    slopes = alibi_slopes(h)
    scale = dh ** -0.5
    q_c = q.reshape(b, h, n_chunks, Q_CHUNK, dh).transpose(2, 0, 1, 3, 4)
    idx_c = sel_idx.reshape(b, h, n_chunks, Q_CHUNK, n_sel).transpose(2, 0, 1, 3, 4)
    valid_c = sel_valid.reshape(n_chunks, Q_CHUNK, n_sel)
    b_ix = jnp.arange(b)[:, None, None, None]
    h_ix = jnp.arange(h)[None, :, None, None]
    offs = jnp.arange(MOBA_BLOCK, dtype=jnp.int32)

    def one_chunk(args):
        c, qc, ic, vc = args
        t = c * Q_CHUNK + jnp.arange(Q_CHUNK, dtype=jnp.int32)
        own = (c * Q_CHUNK) // MOBA_BLOCK
        k_sel = k_blk[b_ix, h_ix, ic]
        v_sel = v_blk[b_ix, h_ix, ic]
        k_own = lax.dynamic_index_in_dim(k_blk, own, axis=2, keepdims=False)
        v_own = lax.dynamic_index_in_dim(v_blk, own, axis=2, keepdims=False)
        s_sel = jnp.einsum('bhqd,bhqnld->bhqnl', qc, k_sel, preferred_element_type=jnp.float32) * scale
        s_own = jnp.einsum('bhqd,bhld->bhql', qc, k_own, preferred_element_type=jnp.float32) * scale
        sel_pos = ic[..., None] * MOBA_BLOCK + offs
        own_pos = own * MOBA_BLOCK + offs
        s_sel = s_sel - slopes[:, None, None, None] * (t[:, None, None] - sel_pos).astype(jnp.float32)
        s_sel = jnp.where(vc[None, None, :, :, None], s_sel, -jnp.inf)
        s_own = s_own - slopes[:, None, None] * (t[:, None] - own_pos[None, :]).astype(jnp.float32)
        s_own = jnp.where(own_pos[None, :] <= t[:, None], s_own, -jnp.inf)
        scores = jnp.concatenate([s_sel.reshape(b, h, Q_CHUNK, n_sel * MOBA_BLOCK), s_own], axis=-1)
        p = jax.nn.softmax(scores, axis=-1).astype(v.dtype)
        p_sel = p[..., :n_sel * MOBA_BLOCK].reshape(b, h, Q_CHUNK, n_sel, MOBA_BLOCK)
        p_own = p[..., n_sel * MOBA_BLOCK:]
        return (jnp.einsum('bhqnl,bhqnld->bhqd', p_sel, v_sel)
                + jnp.einsum('bhql,bhld->bhqd', p_own, v_own))

    out = lax.map(one_chunk, (jnp.arange(n_chunks, dtype=jnp.int32), q_c, idx_c, valid_c))
    out = out.transpose(1, 0, 3, 2, 4).reshape(b, s_pad, h * dh)
    return out[:, :s]


def spatial_gating(z, ln_g, ln_b, w_s, b_s):
    u, vv = jnp.split(z, 2, axis=-1)
    vv = layer_norm(vv, ln_g, ln_b)
    b, s, _ = vv.shape
    nc = s // SGU_CHUNK
    vv = vv.reshape(b, nc, SGU_CHUNK, SGU_GROUPS, SGU_GROUP_DIM)
    causal = jnp.tril(jnp.ones((SGU_CHUNK, SGU_CHUNK), dtype=bool))
    w = jnp.where(causal[None], w_s, jnp.zeros_like(w_s))
    mixed = jnp.einsum('gts,bcsgd->bctgd', w, vv) + b_s.T[None, None, :, :, None]
    return u * mixed.reshape(b, s, SGU_WIDTH)


def clamped_swiglu(gu):
    gate, up = gu[..., 0::2], gu[..., 1::2]
    gate = jnp.minimum(gate, SWIGLU_LIMIT)
    up = jnp.clip(up, -SWIGLU_LIMIT, SWIGLU_LIMIT)
    return gate * jax.nn.sigmoid(SWIGLU_ALPHA * gate) * (up + 1.0)


def moe_ffn(x, w_router, b_router, w_gate_up, b_gate_up, w_down, b_down):
    b, s, d = x.shape
    n_tok = b * s
    xt = x.reshape(n_tok, d)
    logits = (xt @ w_router + b_router).astype(jnp.float32)
    top_val, top_idx = lax.top_k(logits, EXPERT_TOPK)
    top_w = jax.nn.softmax(top_val, axis=-1)
    n_assign = n_tok * EXPERT_TOPK
    flat_e = top_idx.reshape(n_assign).astype(jnp.int32)
    flat_tok = jnp.repeat(jnp.arange(n_tok, dtype=jnp.int32), EXPERT_TOPK)
    flat_w = top_w.reshape(n_assign)
    order = jnp.argsort(flat_e)
    e_sorted = flat_e[order]
    counts = jnp.bincount(flat_e, length=N_EXPERTS).astype(jnp.int32)
    padded = (counts + ROW_BLOCK - 1) // ROW_BLOCK * ROW_BLOCK
    pad_end = jnp.cumsum(padded)
    pad_start = pad_end - padded
    grp_start = jnp.cumsum(counts) - counts
    dest = pad_start[e_sorted] + jnp.arange(n_assign, dtype=jnp.int32) - grp_start[e_sorted]
    n_blocks = -(-(n_assign + N_EXPERTS * (ROW_BLOCK - 1)) // ROW_BLOCK)
    n_rows = n_blocks * ROW_BLOCK
    row_tok = jnp.zeros((n_rows,), jnp.int32).at[dest].set(flat_tok[order])
    row_w = jnp.zeros((n_rows,), jnp.float32).at[dest].set(flat_w[order])
    block_start = jnp.arange(n_blocks, dtype=jnp.int32) * ROW_BLOCK
    block_expert = jnp.minimum(jnp.searchsorted(pad_end, block_start, side='right'), N_EXPERTS - 1)
    x_rows = xt[row_tok].reshape(n_blocks, ROW_BLOCK, d)

    def expert_block(args):
        e, xb = args
        hid = clamped_swiglu(xb @ w_gate_up[e] + b_gate_up[e])
        return hid @ w_down[e] + b_down[e]

    y_rows = lax.map(expert_block, (block_expert, x_rows)).reshape(n_rows, d)
    out = jax.ops.segment_sum(y_rows.astype(jnp.float32) * row_w[:, None], row_tok, num_segments=n_tok)
    return out.astype(x.dtype).reshape(b, s, d)


def setup_inputs(seed: int = 0) -> dict:
    key = jax.random.key(seed)
    ks = jax.random.split(key, 20)
    f32 = jnp.float32
    nrm = lambda k, shape, fan_in: jax.random.normal(k, shape, f32) * (fan_in ** -0.5)
    L = DEPTH
    return {
        "x": jax.random.normal(ks[0], (BATCH, SEQ, D_MODEL), f32),
        "mix_norm_g": 1.0 + 0.05 * jax.random.normal(ks[1], (L, D_MODEL), f32),
        "w_in": nrm(ks[2], (L, D_MODEL, IN_WIDTH), D_MODEL),
        "w_attn_out": nrm(ks[3], (L, ATTN_WIDTH, D_MODEL), ATTN_WIDTH),
        "sgu_ln_g": 1.0 + 0.05 * jax.random.normal(ks[4], (L, SGU_WIDTH), f32),
        "sgu_ln_b": 0.01 * jax.random.normal(ks[5], (L, SGU_WIDTH), f32),
        "w_spatial": nrm(ks[6], (L, SGU_GROUPS, SGU_CHUNK, SGU_CHUNK), SGU_CHUNK),
        "b_spatial": 1.0 + 0.01 * jax.random.normal(ks[7], (L, SGU_GROUPS, SGU_CHUNK), f32),
        "w_sgu_out": nrm(ks[8], (L, SGU_WIDTH, D_MODEL), SGU_WIDTH),
        "w_mix_out": nrm(ks[9], (L, D_MODEL, D_MODEL), D_MODEL),
        "ffn_norm_g": 1.0 + 0.05 * jax.random.normal(ks[10], (L, D_MODEL), f32),
        "w_router": nrm(ks[11], (L, D_MODEL, N_EXPERTS), D_MODEL),
        "b_router": 0.01 * jax.random.normal(ks[12], (L, N_EXPERTS), f32),
        "w_gate_up": nrm(ks[13], (L, N_EXPERTS, D_MODEL, 2 * D_EXPERT), D_MODEL),
        "b_gate_up": 0.01 * jax.random.normal(ks[14], (L, N_EXPERTS, 2 * D_EXPERT), f32),
        "w_down": nrm(ks[15], (L, N_EXPERTS, D_EXPERT, D_MODEL), D_EXPERT),
        "b_down": 0.01 * jax.random.normal(ks[16], (L, N_EXPERTS, D_MODEL), f32),
        "final_norm_g": 1.0 + 0.05 * jax.random.normal(ks[17], (D_MODEL,), f32),
    }


def reference(x, mix_norm_g, w_in, w_attn_out, sgu_ln_g, sgu_ln_b, w_spatial, b_spatial, w_sgu_out,
              w_mix_out, ffn_norm_g, w_router, b_router, w_gate_up, b_gate_up, w_down, b_down,
              final_norm_g):
    b, s, _ = x.shape
    h = x
    splits = [ATTN_WIDTH, 2 * ATTN_WIDTH, 3 * ATTN_WIDTH, 3 * ATTN_WIDTH + 2 * SGU_WIDTH]
    for layer in range(DEPTH):
        xn = rms_norm(h, mix_norm_g[layer])
        proj = xn @ w_in[layer]
        q, k, v, z, gates = jnp.split(proj, splits, axis=-1)
        q = q.reshape(b, s, N_HEADS, HEAD_DIM)
        k = k.reshape(b, s, N_HEADS, HEAD_DIM)
        v = v.reshape(b, s, N_HEADS, HEAD_DIM)
        y_attn = moba_attention(q, k, v) @ w_attn_out[layer]
        y_sgu = spatial_gating(jax.nn.gelu(z, approximate=False), sgu_ln_g[layer], sgu_ln_b[layer],
                               w_spatial[layer], b_spatial[layer]) @ w_sgu_out[layer]
        g_attn, g_sgu = jnp.split(jax.nn.sigmoid(gates), 2, axis=-1)
        h = h + (g_attn * y_attn + g_sgu * y_sgu) @ w_mix_out[layer]
        h = h + moe_ffn(rms_norm(h, ffn_norm_g[layer]), w_router[layer], b_router[layer],
                        w_gate_up[layer], b_gate_up[layer], w_down[layer], b_down[layer])
    return rms_norm(h, final_norm_g)
```

```cpp
#include <hip/hip_runtime.h>
#include <hip/hip_bf16.h>
#include <cstdio>
#include <cstdint>
#ifndef SGU_REP
#define SGU_REP 1
#endif

typedef unsigned short bf16;
typedef short bf16x8 __attribute__((ext_vector_type(8)));
typedef float f32x4 __attribute__((ext_vector_type(4)));
typedef unsigned u32x4 __attribute__((ext_vector_type(4)));
typedef unsigned u32x2 __attribute__((ext_vector_type(2)));

constexpr int T = 16384, D = 1024, SEQ = 4096, NBATCH = 4, NH = 8, HD = 64, AW = 512, SW = 512, NIN = 4608;
constexpr int NE = 32, TOPK = 4, DE = 1024, MB = 256  , NBLK = SEQ / MB  ;
constexpr int NROWS_PAD = 73728;
constexpr float EPS = 1e-5f;
constexpr float C2 = 0.125f * 1.4426950408889634f;
constexpr float LOG2E = 1.4426950408889634f;

constexpr size_t MiB = 1u << 20;
constexpr size_t WS_CTL = 0, CTL_ZERO_BYTES = 1 * MiB;
constexpr size_t WS_WIN = 2 * MiB, WS_WA = 12 * MiB, WS_WS = 13 * MiB, WS_WM = 14 * MiB, WS_WR = 16 * MiB;
constexpr size_t WS_WGU = 32 * MiB, WS_WD = 160 * MiB, WS_XN = 224 * MiB;
constexpr size_t WS_Q = 256 * MiB, WS_K = 272 * MiB, WS_V = 288 * MiB, WS_U = 304 * MiB, WS_VV = 320 * MiB, WS_O = 336 * MiB, WS_SG = 352 * MiB;
constexpr size_t WS_GA = 368 * MiB, WS_GS = 400 * MiB, WS_MG = 432 * MiB, WS_H1 = 464 * MiB, WS_H1B = 528 * MiB;
constexpr size_t WS_LIST = 560 * MiB, WS_TOKSLOT = 562 * MiB, WS_TOKW = 563 * MiB, WS_RSTD2 = 564 * MiB, WS_STATS = 565 * MiB, WS_RLIST = 566 * MiB, WS_HIST = 568 * MiB;
constexpr size_t WS_HID = 576 * MiB, WS_Y = 720 * MiB, WS_END = 864 * MiB;
constexpr int CW_TMO = 0, CW_CODE = 1, CW_BAR = 4096  , CW_CNT = 32768  , CW_KM = 65536  ;

struct Ptrs {
    const float *x, *mix_g, *w_in, *w_attn_out, *ln_g, *ln_b, *w_sp, *b_sp, *w_sgu_out, *w_mix_out, *ffn_g, *w_router, *b_router, *w_gu, *b_gu, *w_down, *b_down, *fin_g;
    float* out; unsigned char* ws;
};

__device__ __forceinline__ unsigned f2bf(float f) { unsigned u = __builtin_bit_cast(unsigned, f); return (u + 0x7fffu + ((u >> 16) & 1u)) >> 16; }
__device__ __forceinline__ float bf2f(unsigned h) { return __builtin_bit_cast(float, (h & 0xffffu) << 16); }
__device__ __forceinline__ float wave_sum(float v) {
#pragma unroll
    for (int o = 1; o < 64; o <<= 1) v += __shfl_xor(v, o);
    return v;
}
__device__ __forceinline__ float wave_max(float v) {
#pragma unroll
    for (int o = 1; o < 64; o <<= 1) v = fmaxf(v, __shfl_xor(v, o));
    return v;
}
__device__ __forceinline__ float gelu_erf(float v) { return 0.5f * v * (1.f + erff(v * 0.70710678118654752f)); }
__device__ __forceinline__ float sigmoidf(float v) { return 1.f / (1.f + __expf(-v)); }
__device__ __forceinline__ float swiglu(float g, float u) {
    g = fminf(g, 7.f); u = fminf(fmaxf(u, -7.f), 7.f);
    return g * (1.f / (1.f + __expf(-1.702f * g))) * (u + 1.f);
}

__global__ __launch_bounds__(256) void n_cvtT(const float* W, bf16* WT, int K, int N, const float* kscale) {
    __shared__ float t[32][33];
    const size_t boff = (size_t)blockIdx.z * K * N; W += boff; WT += boff;
    const int k0 = blockIdx.y * 32, n0 = blockIdx.x * 32, tx = threadIdx.x & 31, ty = threadIdx.x >> 5;
    for (int i = ty; i < 32; i += 8) t[i][tx] = W[(size_t)(k0 + i) * N + n0 + tx] * (kscale ? kscale[k0 + i] : 1.f);
    __syncthreads();
    for (int i = ty; i < 32; i += 8) WT[(size_t)(n0 + i) * K + k0 + tx] = (bf16)f2bf(t[tx][i]);
}
__global__ void n_cvt_router(const float* w, const float* g, bf16* hi, bf16* lo) {
    const int i = blockIdx.x * blockDim.x + threadIdx.x; if (i >= NE * D) return;
    const int e = i / D, k = i % D; const float v = w[(size_t)k * NE + e] * g[k];
    const unsigned h = f2bf(v); hi[i] = (bf16)h; lo[i] = (bf16)f2bf(v - bf2f(h));
}
__global__ __launch_bounds__(256) void n_rmsnorm(const float* x, const float* g, bf16* xn) {
    const int row = blockIdx.x * 4 + (threadIdx.x >> 6), lane = threadIdx.x & 63;
    const f32x4* xr = (const f32x4*)(x + (size_t)row * D) + lane; f32x4 v[4]; float s = 0.f;
#pragma unroll
    for (int j = 0; j < 4; ++j) { v[j] = xr[64 * j]; s += v[j].x * v[j].x + v[j].y * v[j].y + v[j].z * v[j].z + v[j].w * v[j].w; }
    const float rstd = 1.f / sqrtf(wave_sum(s) * (1.f / D) + EPS);
#pragma unroll
    for (int j = 0; j < 4; ++j) { const f32x4 gg = ((const f32x4*)g)[lane + 64 * j];
        u32x2 o; o.x = f2bf(v[j].x * rstd * gg.x) | (f2bf(v[j].y * rstd * gg.y) << 16); o.y = f2bf(v[j].z * rstd * gg.z) | (f2bf(v[j].w * rstd * gg.w) << 16);
        *((u32x2*)(xn + (size_t)row * D) + lane + 64 * j) = o; }
}

__device__ __forceinline__ void wave_gemm64(const bf16* a0, const bf16* a1, const bf16* a2, const bf16* a3, const bf16* b0, const bf16* b1, const bf16* b2, const bf16* b3, int K, f32x4 (&acc)[4][4]) {
    for (int k = 0; k < K; k += 32) {
        bf16x8 a[4], b[4];
        a[0] = *(const bf16x8*)(a0 + k); a[1] = *(const bf16x8*)(a1 + k); a[2] = *(const bf16x8*)(a2 + k); a[3] = *(const bf16x8*)(a3 + k);
        b[0] = *(const bf16x8*)(b0 + k); b[1] = *(const bf16x8*)(b1 + k); b[2] = *(const bf16x8*)(b2 + k); b[3] = *(const bf16x8*)(b3 + k);
#pragma unroll
        for (int mi = 0; mi < 4; ++mi)
#pragma unroll
            for (int ni = 0; ni < 4; ++ni) acc[mi][ni] = __builtin_amdgcn_mfma_f32_16x16x32_bf16(a[mi], b[ni], acc[mi][ni], 0, 0, 0);
    }
}
#define ZERO_ACC(acc) _Pragma("unroll") for (int _a = 0; _a < 4; ++_a) _Pragma("unroll") for (int _b = 0; _b < 4; ++_b) acc[_a][_b] = (f32x4){0.f, 0.f, 0.f, 0.f}

enum { EPI_IN = 0, EPI_MG1 = 1, EPI_MG2 = 2, EPI_H1 = 3 };
template <int MODE>
__global__ __launch_bounds__(256) void n_gemm(const bf16* A, int lda, const bf16* Bt, int ldb, int K, Ptrs P) {
    const int lane = threadIdx.x & 63, w = threadIdx.x >> 6, wy = w >> 1, wx = w & 1;
    const int row0 = blockIdx.y * 128 + wy * 64, col0 = blockIdx.x * 128 + wx * 64;
    const int lr = lane & 15, lq = lane >> 4;
    const bf16* ap = A + (size_t)(row0 + lr) * lda + 8 * lq; const bf16* bp = Bt + (size_t)(col0 + lr) * ldb + 8 * lq;
    f32x4 acc[4][4]; ZERO_ACC(acc);
    wave_gemm64(ap, ap + 16 * (size_t)lda, ap + 32 * (size_t)lda, ap + 48 * (size_t)lda, bp, bp + 16 * (size_t)ldb, bp + 32 * (size_t)ldb, bp + 48 * (size_t)ldb, K, acc);
    unsigned char* ws = P.ws;
#pragma unroll
    for (int mi = 0; mi < 4; ++mi)
#pragma unroll
        for (int ni = 0; ni < 4; ++ni)
#pragma unroll
            for (int j = 0; j < 4; ++j) {
                const int row = row0 + 16 * mi + lq * 4 + j, col = col0 + 16 * ni + lr; const float v = acc[mi][ni][j];
                if (MODE == EPI_IN) {
                    if (col < 512) ((bf16*)(ws + WS_Q))[(size_t)row * 512 + col] = (bf16)f2bf(v * C2);
                    else if (col < 1024) ((bf16*)(ws + WS_K))[(size_t)row * 512 + col - 512] = (bf16)f2bf(v);
                    else if (col < 1536) ((bf16*)(ws + WS_V))[(size_t)row * 512 + col - 1024] = (bf16)f2bf(v);
                    else if (col < 2048) ((bf16*)(ws + WS_U))[(size_t)row * 512 + col - 1536] = (bf16)f2bf(gelu_erf(v));
                    else if (col < 2560) ((bf16*)(ws + WS_VV))[(size_t)row * 512 + col - 2048] = (bf16)f2bf(gelu_erf(v));
                    else if (col < 3584) ((bf16*)(ws + WS_GA))[(size_t)row * 1024 + col - 2560] = (bf16)f2bf(sigmoidf(v));
                    else ((bf16*)(ws + WS_GS))[(size_t)row * 1024 + col - 3584] = (bf16)f2bf(sigmoidf(v));
                } else if (MODE == EPI_MG1) {
                    const size_t o = (size_t)row * 1024 + col; ((bf16*)(ws + WS_MG))[o] = (bf16)f2bf(v * bf2f(((const bf16*)(ws + WS_GA))[o]));
                } else if (MODE == EPI_MG2) {
                    const size_t o = (size_t)row * 1024 + col; bf16* mg = (bf16*)(ws + WS_MG); mg[o] = (bf16)f2bf(bf2f(mg[o]) + v * bf2f(((const bf16*)(ws + WS_GS))[o]));
                } else {
                    const size_t o = (size_t)row * 1024 + col; const float h = P.x[o] + v; ((float*)(ws + WS_H1))[o] = h; ((bf16*)(ws + WS_H1B))[o] = (bf16)f2bf(h);
                }
            }
}
__global__ void n_kmean(const bf16* Kb, float* KM) {
    const int i = blockIdx.x * blockDim.x + threadIdx.x; if (i >= NBATCH * NBLK * AW) return;
    const int c = i % AW, bb = i / AW; float s = 0.f;
    for (int r = 0; r < MB; ++r) s += bf2f(Kb[(size_t)(bb * MB + r) * AW + c]);
    KM[i] = s * (1.f / MB);
}
__global__ __launch_bounds__(256) void n_attn(const bf16* Q, const bf16* Kb, const bf16* Vb, const float* KM, bf16* O) {
    __shared__ float qs[4][64];
    const int lane = threadIdx.x & 63, w = threadIdx.x >> 6, gw = blockIdx.x * 4 + w, tok = gw >> 3, h = gw & 7;
    const int b = tok / SEQ, t = tok % SEQ, blk = t / MB;
    const float qd = bf2f(Q[(size_t)tok * AW + h * HD + lane]);
    qs[w][lane] = qd; __syncthreads();
    float g[16];
#pragma unroll
    for (int j = 0; j < 16; ++j) { float p = (j < blk) ? qd * KM[(size_t)(b * NBLK + j) * AW + h * HD + lane] : 0.f; p = wave_sum(p); g[j] = (j < blk) ? p : -INFINITY; }
    int sel[4];
#pragma unroll
    for (int s = 0; s < 3; ++s) { int best = -1; float bv = -INFINITY;
#pragma unroll
        for (int j = 0; j < 16; ++j) if (g[j] > bv) { bv = g[j]; best = j; }
#pragma unroll
        for (int j = 0; j < 16; ++j) if (j == best) g[j] = -INFINITY;
        sel[s] = best; }
    sel[3] = blk;
    const float slope2 = exp2f(-(float)(h + 1)) * LOG2E;
    float sc[16];
#pragma unroll
    for (int s = 0; s < 4; ++s) {
        const int kb = sel[s];
#pragma unroll
        for (int c = 0; c < 4; ++c) {
            float v = -INFINITY;
            if (kb >= 0) { const int key = kb * MB + c * 64 + lane;
                if (key <= t) { const bf16* kr = Kb + (size_t)(b * SEQ + key) * AW + h * HD; float a = 0.f;
                    for (int d8 = 0; d8 < 8; ++d8) { const u32x4 kk = *(const u32x4*)(kr + d8 * 8);
#pragma unroll
                        for (int e = 0; e < 4; ++e) { a += qs[w][d8 * 8 + 2 * e] * bf2f(kk[e] & 0xffffu) + qs[w][d8 * 8 + 2 * e + 1] * bf2f(kk[e] >> 16); } }
                    v = a + slope2 * (float)(key - t); } }
            sc[s * 4 + c] = v; }
    }
    float m = sc[0];
#pragma unroll
    for (int i = 1; i < 16; ++i) m = fmaxf(m, sc[i]);
    m = wave_max(m); float l = 0.f;
#pragma unroll
    for (int i = 0; i < 16; ++i) { sc[i] = (sc[i] == -INFINITY) ? 0.f : exp2f(sc[i] - m); l += sc[i]; }
    l = wave_sum(l); float o = 0.f;
#pragma unroll
    for (int s = 0; s < 4; ++s) { const int kb = sel[s]; if (kb < 0) continue;
#pragma unroll
        for (int c = 0; c < 4; ++c) { const int key0 = kb * MB + c * 64; if (key0 > t) continue;
            const bf16* vr = Vb + (size_t)(b * SEQ + key0) * AW + h * HD + lane;
            for (int kl = 0; kl < 64; ++kl) { const float p = __shfl(sc[s * 4 + c], kl); o += p * bf2f(vr[(size_t)kl * AW]); } } }
    O[(size_t)tok * AW + h * HD + lane] = (bf16)f2bf(o / l);
}
__global__ __launch_bounds__(256) void n_sgu_stats(const bf16* VV, float* stats) {
    const int row = blockIdx.x * 4 + (threadIdx.x >> 6), lane = threadIdx.x & 63;
    const u32x4 r = *((const u32x4*)(VV + (size_t)row * SW) + lane); float v[8];
#pragma unroll
    for (int e = 0; e < 4; ++e) { v[2 * e] = bf2f(r[e] & 0xffffu); v[2 * e + 1] = bf2f(r[e] >> 16); }
    float s = 0.f;
#pragma unroll
    for (int e = 0; e < 8; ++e) s += v[e];
    const float mu = wave_sum(s) * (1.f / SW); float q = 0.f;
#pragma unroll
    for (int e = 0; e < 8; ++e) q += (v[e] - mu) * (v[e] - mu);
    const float rstd = 1.f / sqrtf(wave_sum(q) * (1.f / SW) + EPS);
    if (lane == 0) { stats[2 * row] = mu; stats[2 * row + 1] = rstd; }
}
__global__ __launch_bounds__(256) void n_sgu(const bf16* U, const bf16* VV, const float* stats, Ptrs P, bf16* SG) {
    const int i = blockIdx.x * 256 + threadIdx.x, tok = i / SW, c = i % SW, g = c / 64, tl = tok % 128, s0 = tok - tl;
    const float lg = P.ln_g[c], lb = P.ln_b[c]; const float* wr = P.w_sp + ((size_t)g * 128 + tl) * 128; float a = 0.f;
    for (int s = 0; s <= tl; ++s) { const float vn = (bf2f(VV[(size_t)(s0 + s) * SW + c]) - stats[2 * (s0 + s)]) * stats[2 * (s0 + s) + 1] * lg + lb; a += wr[s] * vn; }
    SG[i] = (bf16)f2bf(bf2f(U[i]) * (a + P.b_sp[g * 128 + tl]));
}
__global__ __launch_bounds__(256) void n_router(Ptrs P) {
    unsigned char* ws = P.ws; const int tok = blockIdx.x * 4 + (threadIdx.x >> 6), lane = threadIdx.x & 63;
    const f32x4* hr = (const f32x4*)((const float*)(ws + WS_H1) + (size_t)tok * D) + lane; f32x4 v[4]; float s = 0.f;
#pragma unroll
    for (int j = 0; j < 4; ++j) { v[j] = hr[64 * j]; s += v[j].x * v[j].x + v[j].y * v[j].y + v[j].z * v[j].z + v[j].w * v[j].w; }
    const float rstd = 1.f / sqrtf(wave_sum(s) * (1.f / D) + EPS);
#pragma unroll
    for (int j = 0; j < 4; ++j) { const f32x4 gg = ((const f32x4*)P.ffn_g)[lane + 64 * j]; v[j] = v[j] * gg; }
    float lg[32];
#pragma unroll
    for (int e = 0; e < 32; ++e) { float a = 0.f;
#pragma unroll
        for (int j = 0; j < 4; ++j) { const float* wr = P.w_router + (size_t)(4 * lane + 256 * j) * NE + e; a += v[j].x * wr[0] + v[j].y * wr[NE] + v[j].z * wr[2 * NE] + v[j].w * wr[3 * NE]; }
        lg[e] = wave_sum(a) * rstd + P.b_router[e]; }
    int idx[4]; float val[4];
#pragma unroll
    for (int k = 0; k < 4; ++k) { int best = 0; float bv = -INFINITY;
#pragma unroll
        for (int e = 0; e < 32; ++e) if (lg[e] > bv) { bv = lg[e]; best = e; }
#pragma unroll
        for (int e = 0; e < 32; ++e) if (e == best) lg[e] = -INFINITY;
        idx[k] = best; val[k] = bv; }
    float den = 0.f, pw[4];
#pragma unroll
    for (int k = 0; k < 4; ++k) { pw[k] = __expf(val[k] - val[0]); den += pw[k]; }
    if (lane == 0) {
        unsigned* ctl = (unsigned*)(ws + WS_CTL); int* list = (int*)(ws + WS_LIST); unsigned* slot = (unsigned*)(ws + WS_TOKSLOT); float* tw = (float*)(ws + WS_TOKW);
#pragma unroll
        for (int k = 0; k < 4; ++k) { const unsigned pos = atomicAdd(ctl + CW_CNT + 64 * idx[k], 1u); list[(size_t)idx[k] * T + pos] = tok;
            slot[tok * 4 + k] = (unsigned)idx[k] | (pos << 8); tw[tok * 4 + k] = pw[k] / den; }
        ((float*)(ws + WS_RSTD2))[tok] = rstd;
        for (int k = 0; k < 4; ++k) { const unsigned s2 = slot[tok * 4 + k]; ((float*)(ws + WS_RLIST))[(size_t)(s2 & 0xff) * T + (s2 >> 8)] = rstd; }
    }
}
__device__ __forceinline__ bool tile_lookup(const unsigned* ctl, int mt, int& e, int& lt, int& cnt) {
    int base = 0;
    for (int i = 0; i < NE; ++i) { const int c = (int)ctl[CW_CNT + 64 * i], nt = (c + 255) >> 8; if (mt < base + nt) { e = i; lt = mt - base; cnt = c; return true; } base += nt; }
    return false;
}
__device__ __forceinline__ int expert_rowbase(const unsigned* ctl, int e) { int base = 0; for (int i = 0; i < e; ++i) base += ((int)ctl[CW_CNT + 64 * i] + 255) >> 8; return base * 256; }
__global__ __launch_bounds__(256) void n_moe_gu(Ptrs P) {
    unsigned char* ws = P.ws; const unsigned* ctl = (const unsigned*)(ws + WS_CTL);
    const int lane = threadIdx.x & 63, w = threadIdx.x >> 6, wy = w >> 1, wx = w & 1, lr = lane & 15, lq = lane >> 4;
    const int mt = blockIdx.y >> 1; int e, lt, cnt; if (!tile_lookup(ctl, mt, e, lt, cnt)) return;
    const int* list = (const int*)(ws + WS_LIST) + (size_t)e * T; const bf16* A = (const bf16*)(ws + WS_H1B); const bf16* Bt = (const bf16*)(ws + WS_WGU) + (size_t)e * 2048 * D;
    const int prow0 = lt * 256 + (blockIdx.y & 1) * 128 + wy * 64;
    const int j0 = blockIdx.x * 128 + wx * 64;
    const bf16* ap[4];
#pragma unroll
    for (int i = 0; i < 4; ++i) { const int pos = prow0 + 16 * i + lr; const int tok = list[pos < cnt ? pos : lt * 256]; ap[i] = A + (size_t)tok * D + 8 * lq; }
    const bf16* bg = Bt + (size_t)(2 * (j0 + lr)) * D + 8 * lq; const bf16* bu = bg + D;
    f32x4 accg[4][4], accu[4][4]; ZERO_ACC(accg); ZERO_ACC(accu);
    wave_gemm64(ap[0], ap[1], ap[2], ap[3], bg, bg + 32 * (size_t)D, bg + 64 * (size_t)D, bg + 96 * (size_t)D, D, accg);
    wave_gemm64(ap[0], ap[1], ap[2], ap[3], bu, bu + 32 * (size_t)D, bu + 64 * (size_t)D, bu + 96 * (size_t)D, D, accu);
    const float* rs = (const float*)(ws + WS_RSTD2); const float* bgu = P.b_gu + (size_t)e * 2048; bf16* HID = (bf16*)(ws + WS_HID);
#pragma unroll
    for (int mi = 0; mi < 4; ++mi)
#pragma unroll
        for (int j = 0; j < 4; ++j) { const int pos = prow0 + 16 * mi + lq * 4 + j; const int tok = list[pos < cnt ? pos : lt * 256]; const float r = rs[tok];
            const size_t orow = (size_t)mt * 256 + (blockIdx.y & 1) * 128 + wy * 64 + 16 * mi + lq * 4 + j;
#pragma unroll
            for (int ni = 0; ni < 4; ++ni) { const int jc = j0 + 16 * ni + lr; HID[orow * DE + jc] = (bf16)f2bf(swiglu(accg[mi][ni][j] * r + bgu[2 * jc], accu[mi][ni][j] * r + bgu[2 * jc + 1])); } }
}
__global__ __launch_bounds__(256) void n_moe_down(Ptrs P) {
    unsigned char* ws = P.ws; const unsigned* ctl = (const unsigned*)(ws + WS_CTL);
    const int lane = threadIdx.x & 63, w = threadIdx.x >> 6, wy = w >> 1, wx = w & 1, lr = lane & 15, lq = lane >> 4;
    const int mt = blockIdx.y >> 1; int e, lt, cnt; if (!tile_lookup(ctl, mt, e, lt, cnt)) return;
    const int row0 = blockIdx.y * 128 + wy * 64, col0 = blockIdx.x * 128 + wx * 64;
    const bf16* ap = (const bf16*)(ws + WS_HID) + (size_t)(row0 + lr) * DE + 8 * lq; const bf16* bp = (const bf16*)(ws + WS_WD) + ((size_t)e * D + col0 + lr) * DE + 8 * lq;
    f32x4 acc[4][4]; ZERO_ACC(acc);
    wave_gemm64(ap, ap + 16 * (size_t)DE, ap + 32 * (size_t)DE, ap + 48 * (size_t)DE, bp, bp + 16 * (size_t)DE, bp + 32 * (size_t)DE, bp + 48 * (size_t)DE, DE, acc);
    bf16* Y = (bf16*)(ws + WS_Y); const float* bd = P.b_down + (size_t)e * D;
#pragma unroll
    for (int mi = 0; mi < 4; ++mi)
#pragma unroll
        for (int ni = 0; ni < 4; ++ni)
#pragma unroll
            for (int j = 0; j < 4; ++j) { const int row = row0 + 16 * mi + lq * 4 + j, col = col0 + 16 * ni + lr; Y[(size_t)row * D + col] = (bf16)f2bf(acc[mi][ni][j] + bd[col]); }
}
__global__ __launch_bounds__(256) void n_combine(Ptrs P) {
    unsigned char* ws = P.ws; const unsigned* ctl = (const unsigned*)(ws + WS_CTL);
    const int tok = blockIdx.x * 4 + (threadIdx.x >> 6), lane = threadIdx.x & 63;
    const f32x4* hr = (const f32x4*)((const float*)(ws + WS_H1) + (size_t)tok * D) + lane; f32x4 v[4];
#pragma unroll
    for (int j = 0; j < 4; ++j) v[j] = hr[64 * j];
    const unsigned* slot = (const unsigned*)(ws + WS_TOKSLOT) + tok * 4; const float* tw = (const float*)(ws + WS_TOKW) + tok * 4; const bf16* Y = (const bf16*)(ws + WS_Y);
    for (int k = 0; k < 4; ++k) { const unsigned s = slot[k]; const int e = s & 0xff, pos = s >> 8; const float wgt = tw[k];
        const bf16* yr = Y + (size_t)(expert_rowbase(ctl, e) + pos) * D;
#pragma unroll
        for (int j = 0; j < 4; ++j) { const u32x2 y = *((const u32x2*)yr + lane + 64 * j);
            v[j].x += wgt * bf2f(y.x & 0xffffu); v[j].y += wgt * bf2f(y.x >> 16); v[j].z += wgt * bf2f(y.y & 0xffffu); v[j].w += wgt * bf2f(y.y >> 16); } }
    float s = 0.f;
#pragma unroll
    for (int j = 0; j < 4; ++j) s += v[j].x * v[j].x + v[j].y * v[j].y + v[j].z * v[j].z + v[j].w * v[j].w;
    const float rstd = 1.f / sqrtf(wave_sum(s) * (1.f / D) + EPS);
#pragma unroll
    for (int j = 0; j < 4; ++j) { const f32x4 gg = ((const f32x4*)P.fin_g)[lane + 64 * j]; *((f32x4*)(P.out + (size_t)tok * D) + lane + 64 * j) = v[j] * rstd * gg; }
}

#define GAS __attribute__((address_space(1)))
#define LAS __attribute__((address_space(3)))
typedef float f32x2 __attribute__((ext_vector_type(2)));
typedef float f32x16 __attribute__((ext_vector_type(16)));
constexpr int NWAVES = 8;
constexpr int RING_BYTES = 131072;
constexpr int LX_BAR = RING_BYTES, LX_TBASE = RING_BYTES + 64, LX_TILEE = RING_BYTES + 256, LX_ROWBASE = RING_BYTES + 2048, LX_MISC = RING_BYTES + 4096;
constexpr int LDS_BYTES = 147456;

typedef __bf16 bf16x2_t __attribute__((ext_vector_type(2)));
__device__ __forceinline__ unsigned cvt_pk_bf16(float lo, float hi) { const f32x2 v = {lo, hi}; const bf16x2_t b = __builtin_convertvector(v, bf16x2_t); return __builtin_bit_cast(unsigned, b); }
__device__ __forceinline__ f32x2 gelu_pk(f32x2 v) {
    const f32x2 av = __builtin_elementwise_abs(v), d = av * 0.2316418882f + 1.0f;
    f32x2 t; t.x = __builtin_amdgcn_rcpf(d.x); t.y = __builtin_amdgcn_rcpf(d.y);
    f32x2 q = t * 0.5307027145f + (-0.7265760135f); q = q * t + 0.7107068705f; q = q * t + (-0.142248368f); q = q * t + 0.127414796f; q = q * t;
    const f32x2 s = (v * v) * (-0.72134752044f);
    f32x2 e; e.x = __builtin_amdgcn_exp2f(s.x); e.y = __builtin_amdgcn_exp2f(s.y);
    const f32x2 m = v * (q * e), r = v - m;
    f32x2 o; o.x = v.x < 0.f ? m.x : r.x; o.y = v.y < 0.f ? m.y : r.y; return o;
}
__device__ __forceinline__ float fast_sigmoid(float v) { return __builtin_amdgcn_rcpf(1.f + __builtin_amdgcn_exp2f(-LOG2E * v)); }
__device__ __forceinline__ float fast_swiglu(float g, float u) {
    g = fminf(g, 7.f); u = fminf(fmaxf(u, -7.f), 7.f);
    return g * __builtin_amdgcn_rcpf(1.f + __builtin_amdgcn_exp2f(-1.702f * LOG2E * g)) * (u + 1.f);
}

#define XB_TMO      128
#define XB_XCNT(j)  (256  + 64 * (j))
#define XB_XSUB(j)  (1280 + 64 * (j))
#define XB_XGEN(j)  (2304 + 64 * (j))
#define XB_TOP      3328
#define XB_TOPGEN   3392
#define XCD_BAR_WORDS 3456
#define XB_SPIN_CAP (1u << 18)
__device__ __forceinline__ unsigned xb_ld(unsigned* p)              { return __hip_atomic_load(p, __ATOMIC_RELAXED, __HIP_MEMORY_SCOPE_AGENT); }
__device__ __forceinline__ unsigned xb_add(unsigned* p, unsigned v) { return __hip_atomic_fetch_add(p, v, __ATOMIC_RELAXED, __HIP_MEMORY_SCOPE_AGENT); }
__device__ __forceinline__ unsigned xb_xcc_id() { return (unsigned)__builtin_amdgcn_s_getreg((3 << 11) | 20) & 0xFu; }
#define XB_SPIN(cond, bar) do { unsigned _sp = 0; while (cond) { __builtin_amdgcn_s_sleep(1); \
    if ((++_sp & 255u) == 0u) { if (xb_ld(&(bar)[XB_TMO])) break; if (_sp > XB_SPIN_CAP) { atomicAdd(&(bar)[XB_TMO], 1u); break; } } } } while (0)
struct XcdBarrier { unsigned* bar; unsigned x; volatile LAS unsigned* st; };
__device__ __forceinline__ XcdBarrier xcd_barrier_post(unsigned* bar, volatile LAS unsigned* st) {
    XcdBarrier b; b.bar = bar; b.x = xb_xcc_id(); b.st = st;
    if (threadIdx.x == 0) (void)xb_add(&bar[XB_XCNT(b.x)], 1u);
    return b;
}
__device__ __forceinline__ void xcd_barrier_complete(unsigned* bar, unsigned x, unsigned& nloc, unsigned& nx) {
    const unsigned G = gridDim.x * gridDim.y * gridDim.z;
    unsigned sum, cnt, mine, sp = 0u;
    for (;;) {
        sum = 0u; cnt = 0u; mine = 0u;
#pragma unroll
        for (unsigned j = 0; j < 16; ++j) { const unsigned c = xb_ld(&bar[XB_XCNT(j)]); sum += c; cnt += (c > 0u) ? 1u : 0u; mine = (j == x) ? c : mine; }
        if (sum == G) break;
        __builtin_amdgcn_s_sleep(1);
        if ((++sp & 255u) == 0u) { if (xb_ld(&bar[XB_TMO])) break; if (sp > XB_SPIN_CAP) { atomicAdd(&bar[XB_TMO], 1u); break; } }
    }
    nloc = mine > 0u ? mine : 1u; nx = cnt > 0u ? cnt : 1u;
}
__device__ __forceinline__ void xcd_barrier(const XcdBarrier& b) {
    asm volatile("s_waitcnt vmcnt(0)" ::: "memory");
    __syncthreads();
    if (threadIdx.x == 0) {
        unsigned* bar = b.bar;
        __builtin_amdgcn_s_waitcnt(0);
        unsigned nloc = b.st[0], nx = b.st[1];
        if (nloc == 0u) { xcd_barrier_complete(bar, b.x, nloc, nx); b.st[0] = nloc; b.st[1] = nx; }
        const unsigned old = xb_add(&bar[XB_XSUB(b.x)], 1u);
        const unsigned gen = old / nloc;
        if (old + 1u == (gen + 1u) * nloc) {
            __builtin_amdgcn_fence(__ATOMIC_RELEASE, "agent");
            asm volatile("s_waitcnt vmcnt(0)" ::: "memory");
            const unsigned og = xb_add(&bar[XB_TOP], 1u);
            const unsigned tg = og / nx;
            if (og + 1u == (tg + 1u) * nx) xb_add(&bar[XB_TOPGEN], 1u);
            else XB_SPIN(xb_ld(&bar[XB_TOPGEN]) == tg, bar);
            __builtin_amdgcn_fence(__ATOMIC_ACQUIRE, "agent");
            xb_add(&bar[XB_XGEN(b.x)], 1u);
            asm volatile("s_waitcnt vmcnt(0)" ::: "memory");
        } else {
            XB_SPIN(xb_ld(&bar[XB_XGEN(b.x)]) == gen, bar);
            __builtin_amdgcn_fence(__ATOMIC_ACQUIRE, "agent");
            asm volatile("s_waitcnt vmcnt(0)" ::: "memory");
        }
    }
    __syncthreads();
}

namespace pg8 {
constexpr int BM = 256, BK = 64, HALF = 128, HTB = HALF * BK * 2, STAGE_BYTES = 8 * HTB, NXCD = 8, WGM = 8;
__host__ __device__ __forceinline__ int lds_byte(int r, int c) { const int st = (r >> 4) * 2 + (c >> 5), rr = r & 15, cc = c & 31, ob = rr * 64 + cc * 2; return st * 1024 + (ob ^ (((ob >> 9) & 1) << 5)); }
__host__ __device__ __forceinline__ void stage_rc(int b, int& R, int& C) { const int st = b / 1024, sb = b % 1024, swz = sb ^ (((sb >> 9) & 1) << 5); R = (st >> 1) * 16 + swz / 64; C = (st & 1) * 32 + (swz % 64) / 2; }
__host__ __device__ __forceinline__ int perm32(int rho) { const int n = rho >> 4, i = rho & 15; return 8 * (i >> 2) + 4 * n + (i & 3); }

struct Unit { int pm, pn, e, lt, cnt; };

__device__ __forceinline__ void order_map(int L, int nM, int nN, int& pm, int& pn) {
    const int nwg = nM * nN; int wgid = L; { const int q = nwg / NXCD, r = nwg % NXCD, xcd = wgid % NXCD, off = wgid / NXCD; wgid = (xcd < r ? xcd * (q + 1) : r * (q + 1) + (xcd - r) * q) + off; }
    const int nig = WGM * nN, gid = wgid / nig, fm = gid * WGM, gsz = (nM - fm) < WGM ? (nM - fm) : WGM;
    pm = fm + ((wgid % nig) % gsz); pn = (wgid % nig) / gsz;
}

template <class Epi, class Sched, bool ALIGN_EPI>
__device__ __forceinline__ void gemm_phase(LAS unsigned char* lds, const int K, const unsigned ldb, const Sched& S, const Epi& E) {
    const int tid = threadIdx.x, wid = __builtin_amdgcn_readfirstlane(tid >> 6), lane = tid & 63, wr = wid >> 2, wc = wid & 3, fr = lane & 15, fq = lane >> 4;
    const int nt = K / BK;
    int R[2], C[2]; unsigned voffB[2];
#pragma unroll
    for (int i = 0; i < 2; ++i) { stage_rc(tid * 16 + i * 8192, R[i], C[i]); const int Rb = (R[i] & ~31) + perm32(R[i] & 31); voffB[i] = (unsigned)(Rb * (int)ldb + C[i]) * 2u; }
    const unsigned kstep = (unsigned)(BK * 2);
    const size_t hstepB = (size_t)HALF * ldb * 2;
    const unsigned ldsw = (unsigned)wid * 1024u;
    const int aoff = lds_byte(wr * 64 + fr, fq * 8), boff = lds_byte(wc * 32 + fr, fq * 8);
#define PG8_SA(b, h) (((b) * 2 + (h)) * HTB)
#define PG8_SB(b, h) ((4 + (b) * 2 + (h)) * HTB)
#define PG8_STAGE(bufoff, gbase, voff) do { _Pragma("unroll") for (int _i = 0; _i < 2; ++_i) \
        __builtin_amdgcn_global_load_lds((const unsigned*)((const char*)(gbase) + (voff)[_i]), (LAS unsigned*)(lds + (bufoff) + ldsw + _i * 8192), 16, 0, 0); } while (0)
#define PG8_LDA(dst, b, h) do { _Pragma("unroll") for (int m = 0; m < 4; ++m) _Pragma("unroll") for (int k = 0; k < 2; ++k) dst[m][k] = *(const LAS bf16x8*)(lds + PG8_SA(b, h) + aoff + m * 2048 + k * 1024); } while (0)
#define PG8_LDB(dst, b, h) do { _Pragma("unroll") for (int n = 0; n < 2; ++n) _Pragma("unroll") for (int k = 0; k < 2; ++k) dst[n][k] = *(const LAS bf16x8*)(lds + PG8_SB(b, h) + boff + n * 2048 + k * 1024); } while (0)
#define PG8_MMA(ai, bj, At, Bt) do { __builtin_amdgcn_s_setprio(1); _Pragma("unroll") for (int m = 0; m < 4; ++m) _Pragma("unroll") for (int n = 0; n < 2; ++n) _Pragma("unroll") for (int k = 0; k < 2; ++k) \
        acc[ai][bj][m][n] = __builtin_amdgcn_mfma_f32_16x16x32_bf16(Bt[n][k], At[m][k], acc[ai][bj][m][n], 0, 0, 0); __builtin_amdgcn_s_setprio(0); } while (0)
#define PG8_WAIT_V(n) asm volatile("s_waitcnt vmcnt(" #n ")" ::: "memory")
#define PG8_WAIT_L(n) asm volatile("s_waitcnt lgkmcnt(" #n ")" ::: "memory")
#define PG8_BAR __builtin_amdgcn_s_barrier()
#define PG8_SCHED __builtin_amdgcn_sched_barrier(0)
#define PG8_PIN4(v) asm volatile("" : "+v"(v[0][0]), "+v"(v[0][1]), "+v"(v[1][0]), "+v"(v[1][1]))
    Unit cur, nxt; int ui = 0;
    if (!S.next(0, cur)) return;
    f32x4 acc[2][2][4][2];
#pragma unroll
    for (int a = 0; a < 2; ++a)
#pragma unroll
        for (int b = 0; b < 2; ++b)
#pragma unroll
            for (int m = 0; m < 4; ++m)
#pragma unroll
                for (int n = 0; n < 2; ++n) acc[a][b][m][n] = (f32x4){0.f, 0.f, 0.f, 0.f};
    bf16x8 At[4][2], B0[2][2], B1[2][2];
    unsigned cvo[2][2], nvo[2][2];
    S.a_off(cur, R, C, cvo);
    if (Sched::GATHER) { PG8_PIN4(cvo); }
    const char* const Ab = S.a_base();
    const char* cB = S.b_ptr(cur);
    PG8_STAGE(PG8_SB(0, 0), cB, voffB); PG8_STAGE(PG8_SB(0, 1), cB + hstepB, voffB); PG8_STAGE(PG8_SA(0, 0), Ab, cvo[0]); PG8_STAGE(PG8_SA(0, 1), Ab, cvo[1]);
    if (wr == 1) PG8_BAR;
    PG8_WAIT_V(2); PG8_BAR;
    PG8_STAGE(PG8_SB(1, 0), cB + kstep, voffB); PG8_STAGE(PG8_SA(1, 0), Ab + kstep, cvo[0]); PG8_STAGE(PG8_SB(1, 1), cB + hstepB + kstep, voffB);
    PG8_WAIT_V(6); PG8_BAR;
    for (;;) {
        const bool has_next = S.next(ui + 1, nxt);
        if (has_next) { S.a_off(nxt, R, C, nvo); } else { nvo[0][0] = cvo[0][0]; nvo[0][1] = cvo[0][1]; nvo[1][0] = cvo[1][0]; nvo[1][1] = cvo[1][1]; }
        if (Sched::GATHER) { PG8_PIN4(nvo); }
        const char* nB = has_next ? S.b_ptr(nxt) : cB;
        for (int t = 0; t < nt; t += 2) {
            const bool last = (t == nt - 2);
            const char* a1 = Ab + (size_t)(t + 1) * kstep;
            const char* a2 = last ? Ab : Ab + (size_t)(t + 2) * kstep; const char* b2 = last ? nB : cB + (size_t)(t + 2) * kstep;
            const char* a3 = a2 + kstep; const char* b3 = b2 + kstep;
            unsigned v2[2][2];
#pragma unroll
            for (int h = 0; h < 2; ++h)
#pragma unroll
                for (int i = 0; i < 2; ++i) v2[h][i] = last ? nvo[h][i] : cvo[h][i];
            PG8_LDB(B0, 0, 0); PG8_LDB(B1, 0, 1); PG8_SCHED; PG8_LDA(At, 0, 0); PG8_STAGE(PG8_SA(1, 1), a1, cvo[1]);
            PG8_WAIT_V(8); PG8_WAIT_L(0); PG8_BAR; PG8_MMA(0, 0, At, B0); PG8_MMA(0, 1, At, B1); PG8_BAR; PG8_SCHED;
            PG8_LDA(At, 0, 1); PG8_STAGE(PG8_SB(0, 0), b2, voffB); PG8_STAGE(PG8_SB(0, 1), b2 + hstepB, voffB); PG8_STAGE(PG8_SA(0, 0), a2, v2[0]);
            PG8_WAIT_V(8); PG8_WAIT_L(0); PG8_BAR; PG8_MMA(1, 0, At, B0); PG8_MMA(1, 1, At, B1); PG8_BAR; PG8_SCHED;
            PG8_LDB(B0, 1, 0); PG8_LDB(B1, 1, 1); PG8_SCHED; PG8_LDA(At, 1, 0); PG8_STAGE(PG8_SA(0, 1), a2, v2[1]);
            PG8_WAIT_V(8); PG8_WAIT_L(0); PG8_BAR; PG8_MMA(0, 0, At, B0); PG8_MMA(0, 1, At, B1); PG8_BAR; PG8_SCHED;
            PG8_LDA(At, 1, 1); PG8_STAGE(PG8_SB(1, 0), b3, voffB); PG8_STAGE(PG8_SB(1, 1), b3 + hstepB, voffB); PG8_STAGE(PG8_SA(1, 0), a3, v2[0]);
            PG8_WAIT_V(8); PG8_WAIT_L(0); PG8_BAR; PG8_MMA(1, 0, At, B0); PG8_MMA(1, 1, At, B1); PG8_BAR; PG8_SCHED;
        }
        if constexpr (ALIGN_EPI) { if (wr == 0) PG8_BAR; }
        E(acc, cur, wr, wc, fr, fq);
        if (!has_next) break;
#pragma unroll
        for (int a = 0; a < 2; ++a)
#pragma unroll
            for (int b = 0; b < 2; ++b)
#pragma unroll
                for (int m = 0; m < 4; ++m)
#pragma unroll
                    for (int n = 0; n < 2; ++n) acc[a][b][m][n] = (f32x4){0.f, 0.f, 0.f, 0.f};
        cur = nxt; cB = nB; ++ui;
#pragma unroll
        for (int h = 0; h < 2; ++h)
#pragma unroll
            for (int i = 0; i < 2; ++i) cvo[h][i] = nvo[h][i];
        if constexpr (ALIGN_EPI) { if (wr == 1) PG8_BAR; }
    }
    PG8_WAIT_V(0);
    if constexpr (!ALIGN_EPI) { if (wr == 0) PG8_BAR; }
    PG8_BAR;
#undef PG8_SA
#undef PG8_SB
#undef PG8_STAGE
#undef PG8_LDA
#undef PG8_LDB
#undef PG8_MMA
#undef PG8_WAIT_V
#undef PG8_WAIT_L
#undef PG8_BAR
#undef PG8_SCHED
#undef PG8_PIN4
}
}

struct DenseSched {
    static constexpr bool GATHER = false;
    const char* A; const char* Bt; int lda, ldb, nM, nN, G, c;
    __device__ __forceinline__ bool next(int i, pg8::Unit& u) const { const int L = i * G + c; if (L >= nM * nN) return false; pg8::order_map(L, nM, nN, u.pm, u.pn); u.e = 0; u.lt = 0; u.cnt = 0; return true; }
    __device__ __forceinline__ void a_off(const pg8::Unit& u, const int (&R)[2], const int (&C)[2], unsigned (&vo)[2][2]) const {
#pragma unroll
        for (int h = 0; h < 2; ++h)
#pragma unroll
            for (int i = 0; i < 2; ++i) vo[h][i] = (unsigned)((u.pm * 256 + 128 * h + R[i]) * lda + C[i]) * 2u; }
    __device__ __forceinline__ const char* a_base() const { return A; }
    __device__ __forceinline__ const char* b_ptr(const pg8::Unit& u) const { return Bt + (size_t)u.pn * 256 * ldb * 2; }
};
struct MergeSched {
    static constexpr bool GATHER = false;
    const char* A; const char* Bt; int G, c;
    __device__ __forceinline__ bool next(int i, pg8::Unit& u) const { const int v = i & 1, L = (i >> 1) * G + c; if (L >= 256 || i >= 2 * ((256 + G - 1) / G)) return false; pg8::order_map(L, 64, 4, u.pm, u.pn); u.e = v; u.lt = 0; u.cnt = 0; return true; }
    __device__ __forceinline__ void a_off(const pg8::Unit& u, const int (&R)[2], const int (&C)[2], unsigned (&vo)[2][2]) const {
#pragma unroll
        for (int h = 0; h < 2; ++h)
#pragma unroll
            for (int i = 0; i < 2; ++i) vo[h][i] = (unsigned)u.e * (unsigned)(WS_SG - WS_O) + (unsigned)((u.pm * 256 + 128 * h + R[i]) * 512 + C[i]) * 2u; }
    __device__ __forceinline__ const char* a_base() const { return A; }
    __device__ __forceinline__ const char* b_ptr(const pg8::Unit& u) const { return Bt + (size_t)u.e * (WS_WS - WS_WA) + (size_t)u.pn * 256 * 512 * 2; }
};
template <bool GU>
struct MoeSched {
    static constexpr bool GATHER = GU;
    const char* A; const char* Bt; const int* list; const LAS int* tbase; const LAS int* tile_e; const unsigned* cnt; int nN, G, c;
    __device__ __forceinline__ bool next(int i, pg8::Unit& u) const {
        const int nM = tbase[NE]; const int L = i * G + c; if (L >= nM * nN) return false;
        pg8::order_map(L, nM, nN, u.pm, u.pn); u.e = tile_e[u.pm]; u.lt = u.pm - tbase[u.e]; u.cnt = (int)cnt[CW_CNT + 64 * u.e]; return true; }
    __device__ __forceinline__ void a_off(const pg8::Unit& u, const int (&R)[2], const int (&C)[2], unsigned (&vo)[2][2]) const {
#pragma unroll
        for (int h = 0; h < 2; ++h)
#pragma unroll
            for (int i = 0; i < 2; ++i) {
                if (GU) { const int pos = u.lt * 256 + 128 * h + R[i]; const int tok = list[(size_t)u.e * T + (pos < u.cnt ? pos : u.lt * 256)]; vo[h][i] = (unsigned)(tok * D + C[i]) * 2u; }
                else vo[h][i] = (unsigned)((u.pm * 256 + 128 * h + R[i]) * DE + C[i]) * 2u; } }
    __device__ __forceinline__ const char* a_base() const { return A; }
    __device__ __forceinline__ const char* b_ptr(const pg8::Unit& u) const { return Bt + ((size_t)u.e * nN + u.pn) * 256 * 1024 * 2; }
};

#ifndef KM_ATOMICS
#define KM_ATOMICS 1
#endif
struct EpiIn {
    unsigned char* ws; float* km;
    template <int ACT>
    __device__ __forceinline__ void store(const f32x4 (&acc)[2][2][4][2], bf16* base, int ldc, int row0, int col0, float sc) const {
#pragma unroll
        for (int ai = 0; ai < 2; ++ai)
#pragma unroll
            for (int m = 0; m < 4; ++m) { bf16* rowp = base + (size_t)(row0 + ai * 128 + m * 16) * ldc + col0;
#pragma unroll
                for (int bj = 0; bj < 2; ++bj) { f32x4 v0 = acc[ai][bj][m][0], v1 = acc[ai][bj][m][1];
                    if (ACT == 0) { v0 = v0 * sc; v1 = v1 * sc; }
                    if (ACT == 1) { const f32x2 a = gelu_pk((f32x2){v0[0], v0[1]}), b = gelu_pk((f32x2){v0[2], v0[3]}), c = gelu_pk((f32x2){v1[0], v1[1]}), d = gelu_pk((f32x2){v1[2], v1[3]});
                        v0 = (f32x4){a.x, a.y, b.x, b.y}; v1 = (f32x4){c.x, c.y, d.x, d.y}; }
                    if (ACT == 2) {
#pragma unroll
                        for (int j = 0; j < 4; ++j) { v0[j] = fast_sigmoid(v0[j]); v1[j] = fast_sigmoid(v1[j]); } }
                    u32x4 w; w.x = cvt_pk_bf16(v0[0], v0[1]); w.y = cvt_pk_bf16(v0[2], v0[3]); w.z = cvt_pk_bf16(v1[0], v1[1]); w.w = cvt_pk_bf16(v1[2], v1[3]);
                    *(u32x4*)(rowp + bj * 128) = w; } }
    }
    __device__ __forceinline__ void operator()(const f32x4 (&acc)[2][2][4][2], const pg8::Unit& u, int wr, int wc, int fr, int fq) const {
        const int pn = u.pn, row0 = u.pm * 256 + wr * 64 + fr;
        if (pn < 10) {
            const int kind = pn >> 1, col0 = (pn & 1) * 256 + wc * 32 + 8 * fq; bf16* base = (bf16*)(ws + WS_Q + (size_t)kind * 16 * MiB);
            if (kind == 0) store<0>(acc, base, 512, row0, col0, C2);
            else if (kind < 3) store<0>(acc, base, 512, row0, col0, 1.f);
            else store<1>(acc, base, 512, row0, col0, 1.f);
            if (KM_ATOMICS && kind == 1) {
#pragma unroll
                for (int bj = 0; bj < 2; ++bj)
#pragma unroll
                    for (int n = 0; n < 2; ++n) { f32x4 s = (f32x4){0.f, 0.f, 0.f, 0.f};
#pragma unroll
                        for (int ai = 0; ai < 2; ++ai)
#pragma unroll
                            for (int m = 0; m < 4; ++m) s = s + acc[ai][bj][m][n];
#pragma unroll
                        for (int j = 0; j < 4; ++j) { float t = s[j]; t += __shfl_xor(t, 1); t += __shfl_xor(t, 2); t += __shfl_xor(t, 4); t += __shfl_xor(t, 8); s[j] = t; }
                        if (fr == 0) { float* dst = km + (size_t)u.pm * 512 + col0 + bj * 128 + 4 * n;
#pragma unroll
                            for (int j = 0; j < 4; ++j) unsafeAtomicAdd(dst + j, s[j] * (1.f / 256.f)); } }
            }
        } else {
            const int gsel = (pn - 10) >> 2, col0 = ((pn - 10) & 3) * 256 + wc * 32 + 8 * fq; bf16* base = (bf16*)(ws + (gsel ? WS_GS : WS_GA));
            store<2>(acc, base, 1024, row0, col0, 1.f);
        }
    }
};
struct EpiMerge {
    unsigned char* ws;
    __device__ __forceinline__ void operator()(const f32x4 (&acc)[2][2][4][2], const pg8::Unit& u, int wr, int wc, int fr, int fq) const {
        const int row0 = u.pm * 256 + wr * 64 + fr, col0 = u.pn * 256 + wc * 32 + 8 * fq;
        const bf16* gate = (const bf16*)(ws + (u.e ? WS_GS : WS_GA)); bf16* mg = (bf16*)(ws + WS_MG);
#pragma unroll
        for (int ai = 0; ai < 2; ++ai)
#pragma unroll
            for (int m = 0; m < 4; ++m) { const size_t ro = (size_t)(row0 + ai * 128 + m * 16) * 1024 + col0;
#pragma unroll
                for (int bj = 0; bj < 2; ++bj) { const u32x4 g = *(const u32x4*)(gate + ro + bj * 128); f32x4 v0 = acc[ai][bj][m][0], v1 = acc[ai][bj][m][1];
                    v0[0] *= bf2f(g.x & 0xffffu); v0[1] *= bf2f(g.x >> 16); v0[2] *= bf2f(g.y & 0xffffu); v0[3] *= bf2f(g.y >> 16);
                    v1[0] *= bf2f(g.z & 0xffffu); v1[1] *= bf2f(g.z >> 16); v1[2] *= bf2f(g.w & 0xffffu); v1[3] *= bf2f(g.w >> 16);
                    if (u.e) { const u32x4 p = *(const u32x4*)(mg + ro + bj * 128);
                        v0[0] += bf2f(p.x & 0xffffu); v0[1] += bf2f(p.x >> 16); v0[2] += bf2f(p.y & 0xffffu); v0[3] += bf2f(p.y >> 16);
                        v1[0] += bf2f(p.z & 0xffffu); v1[1] += bf2f(p.z >> 16); v1[2] += bf2f(p.w & 0xffffu); v1[3] += bf2f(p.w >> 16); }
                    u32x4 w; w.x = cvt_pk_bf16(v0[0], v0[1]); w.y = cvt_pk_bf16(v0[2], v0[3]); w.z = cvt_pk_bf16(v1[0], v1[1]); w.w = cvt_pk_bf16(v1[2], v1[3]);
                    *(u32x4*)(mg + ro + bj * 128) = w; } }
    }
};
struct EpiH1 {
    const float* x; float* h1; bf16* h1b;
    __device__ __forceinline__ void operator()(const f32x4 (&acc)[2][2][4][2], const pg8::Unit& u, int wr, int wc, int fr, int fq) const {
        const int row0 = u.pm * 256 + wr * 64 + fr, col0 = u.pn * 256 + wc * 32 + 8 * fq;
#pragma unroll
        for (int ai = 0; ai < 2; ++ai)
#pragma unroll
            for (int m = 0; m < 4; ++m) { const size_t ro = (size_t)(row0 + ai * 128 + m * 16) * 1024 + col0;
#pragma unroll
                for (int bj = 0; bj < 2; ++bj) { const f32x4 x0 = *(const f32x4*)(x + ro + bj * 128), x1 = *(const f32x4*)(x + ro + bj * 128 + 4);
                    const f32x4 v0 = acc[ai][bj][m][0] + x0, v1 = acc[ai][bj][m][1] + x1;
                    *(f32x4*)(h1 + ro + bj * 128) = v0; *(f32x4*)(h1 + ro + bj * 128 + 4) = v1;
                    u32x4 w; w.x = cvt_pk_bf16(v0[0], v0[1]); w.y = cvt_pk_bf16(v0[2], v0[3]); w.z = cvt_pk_bf16(v1[0], v1[1]); w.w = cvt_pk_bf16(v1[2], v1[3]);
                    *(u32x4*)(h1b + ro + bj * 128) = w; } }
    }
};
struct EpiGu {
    const float* rlist; const float* bgu; bf16* hid;
    __device__ __forceinline__ void operator()(const f32x4 (&acc)[2][2][4][2], const pg8::Unit& u, int wr, int wc, int fr, int fq) const {
        const int lrow0 = wr * 64 + fr, col0 = u.pn * 256 + wc * 32 + 8 * fq; const float* bb = bgu + (size_t)u.e * 2048 + col0;
        f32x4 b0[2], b1[2];
#pragma unroll
        for (int bj = 0; bj < 2; ++bj) { b0[bj] = *(const f32x4*)(bb + bj * 128); b1[bj] = *(const f32x4*)(bb + bj * 128 + 4); }
#pragma unroll
        for (int ai = 0; ai < 2; ++ai)
#pragma unroll
            for (int m = 0; m < 4; ++m) { const int lr = lrow0 + ai * 128 + m * 16, pos = u.lt * 256 + lr; const float r = pos < u.cnt ? rlist[(size_t)u.e * T + pos] : 0.f;
                bf16* rowp = hid + (size_t)(u.pm * 256 + lr) * DE + (col0 >> 1);
#pragma unroll
                for (int bj = 0; bj < 2; ++bj) { const f32x4 v0 = acc[ai][bj][m][0] * r + b0[bj], v1 = acc[ai][bj][m][1] * r + b1[bj];
                    u32x2 w; w.x = cvt_pk_bf16(fast_swiglu(v0[0], v0[1]), fast_swiglu(v0[2], v0[3])); w.y = cvt_pk_bf16(fast_swiglu(v1[0], v1[1]), fast_swiglu(v1[2], v1[3]));
                    *(u32x2*)(rowp + bj * 64) = w; } }
    }
};
struct EpiDown {
    const float* bd; bf16* y;
    __device__ __forceinline__ void operator()(const f32x4 (&acc)[2][2][4][2], const pg8::Unit& u, int wr, int wc, int fr, int fq) const {
        const int lrow0 = wr * 64 + fr, col0 = u.pn * 256 + wc * 32 + 8 * fq; const float* bb = bd + (size_t)u.e * D + col0;
        f32x4 b0[2], b1[2];
#pragma unroll
        for (int bj = 0; bj < 2; ++bj) { b0[bj] = *(const f32x4*)(bb + bj * 128); b1[bj] = *(const f32x4*)(bb + bj * 128 + 4); }
#pragma unroll
        for (int ai = 0; ai < 2; ++ai)
#pragma unroll
            for (int m = 0; m < 4; ++m) { bf16* rowp = y + (size_t)(u.pm * 256 + lrow0 + ai * 128 + m * 16) * D + col0;
#pragma unroll
                for (int bj = 0; bj < 2; ++bj) { const f32x4 v0 = acc[ai][bj][m][0] + b0[bj], v1 = acc[ai][bj][m][1] + b1[bj];
                    u32x4 w; w.x = cvt_pk_bf16(v0[0], v0[1]); w.y = cvt_pk_bf16(v0[2], v0[3]); w.z = cvt_pk_bf16(v1[0], v1[1]); w.w = cvt_pk_bf16(v1[2], v1[3]);
                    *(u32x4*)(rowp + bj * 128) = w; } }
    }
};

namespace attn_body {
using bf16=__hip_bfloat16;
using bf16x8=__attribute__((ext_vector_type(8)))short;
using s16x4=__attribute__((ext_vector_type(4)))short;
using f32x16=__attribute__((ext_vector_type(16)))float;
using u32x4=__attribute__((ext_vector_type(4)))unsigned;
constexpr int BATCH=4,NHEAD=8,SEQ=4096,D=64,DM=NHEAD*D;
constexpr int NW=8,QBLK=32,QB=QBLK*NW,KVBLK=64,NQB=SEQ/QB;
__device__ __forceinline__ int crow(int r,int hi){return (r&3)+8*(r>>2)+4*hi;}
#define SBAR() __builtin_amdgcn_sched_barrier(0)
__device__ __forceinline__ void cmask(f32x16&p0,f32x16&p1,int jb,int qrel,int hi){
  const float NEG=-INFINITY; int kb=64*jb+4*hi;
  #pragma unroll
  for(int r=0;r<16;++r){int kv=kb+(r&3)+8*(r>>2); if(kv>qrel)p0[r]=NEG; if(kv+32>qrel)p1[r]=NEG;}
}
constexpr int NSLOT=3, SLOTB=8192;
constexpr int LDS_K=0, LDS_V=NSLOT*SLOTB, LDS_WS=2*NSLOT*SLOTB, LDS_OST=LDS_WS+NW*64*4, LDS_BYTES=LDS_OST+NW*4096;
constexpr int LDS_GATE=LDS_OST;
__device__ __forceinline__ void glds16(const void*gsrc,unsigned lds_dst){unsigned keep;
  asm volatile("s_mov_b32 %0, m0\n\ts_mov_b32 m0, %2\n\ts_nop 0\n\tglobal_load_lds_dwordx4 %1, off\n\ts_mov_b32 m0, %0":"=&s"(keep):"v"(gsrc),"s"(lds_dst):"memory");}
typedef float f32x2_t __attribute__((ext_vector_type(2))); typedef __bf16 bf16x2_t __attribute__((ext_vector_type(2)));
__device__ __forceinline__ unsigned cvtpk_s(float lo,float hi){f32x2_t v={lo,hi};bf16x2_t b=__builtin_convertvector(v,bf16x2_t);return __builtin_bit_cast(unsigned,b);}
#define WAIT_BAR(N) asm volatile("s_waitcnt vmcnt(" #N ") lgkmcnt(0)\n\ts_barrier":::"memory")
__device__ __forceinline__ float max3f(float a,float b,float c){return __builtin_fmaxf(__builtin_fmaxf(a,b),c);}
typedef __attribute__((address_space(3))) const char* lds_cptr;
typedef short v4i16_t __attribute__((ext_vector_type(4)));
__device__ __forceinline__ void kload8(bf16x8*kf,lds_cptr kp){
  kf[0]=*(const __attribute__((address_space(3))) bf16x8*)(kp);      kf[1]=*(const __attribute__((address_space(3))) bf16x8*)(kp+512);
  kf[2]=*(const __attribute__((address_space(3))) bf16x8*)(kp+2048); kf[3]=*(const __attribute__((address_space(3))) bf16x8*)(kp+2560);
  kf[4]=*(const __attribute__((address_space(3))) bf16x8*)(kp+4096); kf[5]=*(const __attribute__((address_space(3))) bf16x8*)(kp+4608);
  kf[6]=*(const __attribute__((address_space(3))) bf16x8*)(kp+6144); kf[7]=*(const __attribute__((address_space(3))) bf16x8*)(kp+6656);
}
__device__ __forceinline__ void kload2(bf16x8*kf,lds_cptr kp,int j){ kf[2*j]=*(const __attribute__((address_space(3))) bf16x8*)(kp+j*2048); kf[2*j+1]=*(const __attribute__((address_space(3))) bf16x8*)(kp+j*2048+512); }
__device__ __forceinline__ s16x4 vtr(lds_cptr p){ return __builtin_bit_cast(s16x4,__builtin_amdgcn_ds_read_tr16_b64_v4i16((__attribute__((address_space(3))) v4i16_t*)p)); }
__device__ __forceinline__ float rowmax(const f32x16&p0,const f32x16&p1){
  float a=max3f(p0[0],p0[1],p1[0]),b=max3f(p0[2],p0[3],p1[1]);a=max3f(a,p1[2],p1[3]);
  #pragma unroll
  for(int r=4;r<16;r+=4){a=max3f(a,p0[r],p0[r+1]);b=max3f(b,p0[r+2],p0[r+3]);a=max3f(a,p1[r],p1[r+1]);b=max3f(b,p1[r+2],p1[r+3]);}
  const float m=__builtin_fmaxf(a,b);
  auto rr=__builtin_amdgcn_permlane32_swap(__float_as_uint(m),__float_as_uint(m),false,false);
  return __builtin_fmaxf(__uint_as_float(rr[0]),__uint_as_float(rr[1]));
}
__device__ __forceinline__ void pv(f32x16*o,int vb,bf16x8 pa0,bf16x8 pa1,bf16x8 pa2,bf16x8 pa3){
  #pragma unroll
  for(int d0=0;d0<2;++d0){s16x4 lo[4],hi[4];
    #pragma unroll
    for(int ks=0;ks<4;++ks){
      asm volatile("ds_read_b64_tr_b16 %0,%1 offset:%c2":"=&v"(lo[ks]):"v"(vb),"i"(d0*4096+ks*1024):"memory");
      asm volatile("ds_read_b64_tr_b16 %0,%1 offset:%c2":"=&v"(hi[ks]):"v"(vb),"i"(d0*4096+ks*1024+512):"memory");}
    asm volatile("s_waitcnt lgkmcnt(0)":::"memory");SBAR();
    #define PK(k) (bf16x8){lo[k][0],lo[k][1],lo[k][2],lo[k][3],hi[k][0],hi[k][1],hi[k][2],hi[k][3]}
    o[d0]=__builtin_amdgcn_mfma_f32_32x32x16_bf16(pa0,PK(0),o[d0],0,0,0);
    o[d0]=__builtin_amdgcn_mfma_f32_32x32x16_bf16(pa1,PK(1),o[d0],0,0,0);
    o[d0]=__builtin_amdgcn_mfma_f32_32x32x16_bf16(pa2,PK(2),o[d0],0,0,0);
    o[d0]=__builtin_amdgcn_mfma_f32_32x32x16_bf16(pa3,PK(3),o[d0],0,0,0);
    #undef PK
  }
}
constexpr float MASKED=-1.0e30f, LOWREF=-1000.f;
template<int THRL> __device__ __forceinline__ void attn_unit(int b,int h,int qb,const bf16*Q,const bf16*__restrict__ K,const bf16*__restrict__ V,const float*__restrict__ KM,bf16*O,char*shm){
  int tid=threadIdx.x; asm volatile("":"+v"(tid));
  const int lane=tid&63,r32=lane&31,hi=lane>>5; const int wid=__builtin_amdgcn_readfirstlane(tid>>6);
  const long rowbase=(long)b*SEQ; const int q0=qb*QB;
  const bf16*Qw=Q+(rowbase+q0+wid*QBLK)*DM+h*D;
  const bf16*Kh=K+rowbase*DM+h*D,*Vh=V+rowbase*DM+h*D;
  const unsigned lds0=(unsigned)(uintptr_t)shm;
  __attribute__((address_space(3))) float*wsf=(__attribute__((address_space(3))) float*)((__attribute__((address_space(3))) char*)shm+LDS_WS)+wid*64;
  const bf16*ksrc=Kh+(long)lane*DM+wid*8;
  const bf16*vsrc=Vh+(long)(16*(wid&3)+(lane>>2))*DM+(wid>>2)*32+(lane&3)*8;
  const unsigned kdst=lds0+LDS_K+wid*1024, vdst=lds0+LDS_V+wid*1024;
  #define DMA_K(t,slot) glds16(ksrc+(long)(t)*KVBLK*DM,(unsigned)__builtin_amdgcn_readfirstlane(kdst+(slot)))
  #define DMA_V(t,slot) glds16(vsrc+(long)(t)*KVBLK*DM,(unsigned)__builtin_amdgcn_readfirstlane(vdst+(slot)))
  const int vb0=(int)(lds0+LDS_V)+((lane>>4)&1)*32+(lane&3)*8+(4*hi+((lane&15)>>2))*64;
  bf16x8 kf[8];
  const lds_cptr shm3=(lds_cptr)shm; const lds_cptr kp0=shm3+LDS_K+hi*1024+r32*16; const lds_cptr vp0=shm3+LDS_V+((lane>>4)&1)*32+(lane&3)*8+(4*hi+((lane&15)>>2))*64;
  const int NT=(q0+QB)/KVBLK;
  DMA_K(0,0);DMA_V(0,0);DMA_K(1,SLOTB);
  bf16x8 qr[4];
  #pragma unroll
  for(int d0=0;d0<4;++d0)qr[d0]=*reinterpret_cast<const bf16x8*>(&Qw[(long)r32*DM+d0*16+hi*8]);
  { const int row=tid>>4, dg=tid&15, j=row&15; f32x4 m4=(f32x4){0.f,0.f,0.f,0.f};
    if(j<qb) m4=*(const f32x4*)(KM+((long)(b*NQB+j))*DM+h*D+4*dg);
    unsigned w0,w1; { const unsigned h0=cvtpk_s(m4[0],m4[1]),h1=cvtpk_s(m4[2],m4[3]);
      if(row<16){w0=h0;w1=h1;} else { w0=cvtpk_s(m4[0]-__uint_as_float(h0<<16),m4[1]-__uint_as_float(h0&0xffff0000u)); w1=cvtpk_s(m4[2]-__uint_as_float(h1<<16),m4[3]-__uint_as_float(h1&0xffff0000u)); } }
    typedef unsigned u32x2_t __attribute__((ext_vector_type(2)));
    *(__attribute__((address_space(3))) u32x2_t*)(shm3+LDS_GATE+(dg>>1)*512+row*16+(dg&1)*8)=(u32x2_t){w0,w1}; }
  float mhat=0.f,l_reg=0.f;
  const int qrel=wid*QBLK+r32;
  const float sl2=exp2f(-(float)(h+1))*1.4426950408889634f;
  const float cb0=sl2*(float)(4*hi-(q0+qrel));
  #define CMASK(P0,P1,t) do{int jb_=(t)-(NT-4); if(jb_>=0)cmask(P0,P1,jb_,qrel,hi);}while(0)
  #define CINIT(C0,C1,t) do{ const bool s_=((selmask>>((t)>>2))&1u)!=0u; const float bt_=s_?(cb0+sl2*(float)(64*(t))-mhat):MASKED; \
      _Pragma("unroll") for(int r=0;r<16;++r){ const float kc_=(float)((r&3)+8*(r>>2)); C0[r]=__builtin_fmaf(sl2,kc_,bt_); C1[r]=__builtin_fmaf(sl2,kc_+32.f,bt_);} }while(0)
  bool resc=false;
  #define START(P0,P1) do{ const float rm=rowmax(P0,P1); resc=false; \
    { const float dl=__builtin_fmaxf(rm,LOWREF); mhat+=dl; \
      _Pragma("unroll") for(int r=0;r<16;++r){P0[r]-=dl;P1[r]-=dl;} } \
    _Pragma("unroll") for(int r=0;r<16;++r)P0[r]=__builtin_amdgcn_exp2f(P0[r]); }while(0)
  #define RESC() do{ if(resc){ asm volatile("s_waitcnt lgkmcnt(0)":::"memory"); \
      _Pragma("unroll") for(int d_=0;d_<2;++d_) _Pragma("unroll") for(int r=0;r<16;++r)o[d_][r]*=wsf[crow(r,hi)]; } }while(0)
  f32x16 pA0,pA1,pB0,pB1;
  int sl_prev=0,sl_cur=0,sl_next=SLOTB;
  #define ROT() do{sl_prev=sl_cur;sl_cur=sl_next;sl_next=(sl_next==(NSLOT-1)*SLOTB)?0:sl_next+SLOTB;}while(0)
  DMA_K(2,2*SLOTB);
  WAIT_BAR(3);
  unsigned selmask=1u<<qb;
  if(qb>0){
    f32x16 g=f32x16{};
    #pragma unroll
    for(int d0=0;d0<4;++d0){ const bf16x8 a=*(const __attribute__((address_space(3))) bf16x8*)(shm3+LDS_GATE+(2*d0+hi)*512+r32*16); g=__builtin_amdgcn_mfma_f32_32x32x16_bf16(a,qr[d0],g,0,0,0); }
    float gl[8],gp[8];
    #pragma unroll
    for(int i=0;i<4;++i){ gl[i]=g[i]+g[8+i]; gl[4+i]=g[4+i]+g[12+i]; }
    #pragma unroll
    for(int i=0;i<8;++i) gp[i]=__shfl_xor(gl[i],32);
    float gv[16];
    #pragma unroll
    for(int j=0;j<16;++j){ const int half=(j>>2)&1, i=(j&3)+4*(j>>3); const float v=(half==hi)?gl[i]:gp[i]; gv[j]=(j<qb)?v:-INFINITY; }
    #pragma unroll
    for(int s=0;s<3;++s){ int best=-1; float bv=-INFINITY;
      #pragma unroll
      for(int j=0;j<16;++j) if(gv[j]>bv){bv=gv[j];best=j;}
      #pragma unroll
      for(int j=0;j<16;++j) if(j==best) gv[j]=-INFINITY;
      if(best>=0) selmask|=1u<<best; }
  }
  f32x16 o[2];o[0]=f32x16{};o[1]=f32x16{}; asm volatile("":"+v"(o[0]),"+v"(o[1]));
  { const lds_cptr kp=kp0; kload8(kf,kp); }
  CINIT(pA0,pA1,0);
  #pragma unroll
  for(int d0=0;d0<4;++d0){ pA0=__builtin_amdgcn_mfma_f32_32x32x16_bf16(kf[2*d0],qr[d0],pA0,0,0,0); pA1=__builtin_amdgcn_mfma_f32_32x32x16_bf16(kf[2*d0+1],qr[d0],pA1,0,0,0); }
  CMASK(pA0,pA1,0);
  START(pA0,pA1);
  _Pragma("unroll") for(int r=0;r<16;++r)pA1[r]=__builtin_amdgcn_exp2f(pA1[r]);
  WAIT_BAR(0);
  DMA_K(3,0);DMA_V(1,SLOTB);
  ROT();
  kload8(kf,kp0+sl_cur);
  WAIT_BAR(2);
  s16x4 vlo[8],vhi[8]; u32x4 pw0,pw1,pw2,pw3;
  #define PKW(P,B) cvtpk_s(P[B],P[B+1])
  #define PAF(k) __builtin_bit_cast(bf16x8,pw##k)
  #define VFR(i) (bf16x8){vlo[i][0],vlo[i][1],vlo[i][2],vlo[i][3],vhi[i][0],vhi[i][1],vhi[i][2],vhi[i][3]}
  #define PIN(x) asm volatile("":"+v"(x))
  #define MX3(a,b,c) __builtin_fmaxf(__builtin_fmaxf((a),(b)),(c))
  #define GAPA(MF,A0,A1,A2,A3,W0,W1,PW) do{ MF; sacc+=A0; sacc+=A1; sacc+=A2; sacc+=A3; PIN(sacc); W0; W1; PIN(PW); SBAR(); }while(0)
  #define EX(v) __builtin_amdgcn_exp2f(v)
  #define GAPB(MF,X,B) do{ MF; X[B]=EX(X[B]); X[B+1]=EX(X[B+1]); X[B+2]=EX(X[B+2]); X[B+3]=EX(X[B+3]); PIN(X); SBAR(); }while(0)
  #define VRD(i) do{ vlo[i]=vtr(vp_+(((i)>>2)*4096+((i)&3)*1024)); vhi[i]=vtr(vp_+(((i)>>2)*4096+((i)&3)*1024+512)); }while(0)
  #define KRD(G,j) do{ if(G){ kload2(kf,kp0+sl_next,j); SBAR(); } }while(0)
  #define STEP(C0,C1,P0,P1,t,GK,GV,GL) do{ SBAR(); \
    const lds_cptr vp_=vp0+sl_prev; \
    CINIT(C0,C1,t); SBAR(); \
    VRD(0); SBAR(); float sacc=(P0[0]+P0[1]); \
    GAPA(C0=__builtin_amdgcn_mfma_f32_32x32x16_bf16(kf[0],qr[0],C0,0,0,0), P0[2],P0[3],P0[4],P0[5],     pw0[0]=PKW(P0,0), pw0[1]=PKW(P0,2), pw0); \
    VRD(4); SBAR(); GAPA(C1=__builtin_amdgcn_mfma_f32_32x32x16_bf16(kf[1],qr[0],C1,0,0,0), P0[6],P0[7],P0[8],P0[9],     pw0[2]=PKW(P0,4), pw0[3]=PKW(P0,6), pw0); \
    VRD(1); SBAR(); GAPA(C0=__builtin_amdgcn_mfma_f32_32x32x16_bf16(kf[2],qr[1],C0,0,0,0),   P0[10],P0[11],P0[12],P0[13], pw1[0]=PKW(P0,8), pw1[1]=PKW(P0,10), pw1); \
    VRD(5); SBAR(); GAPA(C1=__builtin_amdgcn_mfma_f32_32x32x16_bf16(kf[3],qr[1],C1,0,0,0),   P0[14],P0[15],P1[0],P1[1],   pw1[2]=PKW(P0,12),pw1[3]=PKW(P0,14), pw1); \
    VRD(2); SBAR(); GAPA(C0=__builtin_amdgcn_mfma_f32_32x32x16_bf16(kf[4],qr[2],C0,0,0,0),   P1[2],P1[3],P1[4],P1[5],     pw2[0]=PKW(P1,0), pw2[1]=PKW(P1,2), pw2); \
    VRD(6); SBAR(); GAPA(C1=__builtin_amdgcn_mfma_f32_32x32x16_bf16(kf[5],qr[2],C1,0,0,0),   P1[6],P1[7],P1[8],P1[9],     pw2[2]=PKW(P1,4), pw2[3]=PKW(P1,6), pw2); \
    VRD(3); SBAR(); GAPA(C0=__builtin_amdgcn_mfma_f32_32x32x16_bf16(kf[6],qr[3],C0,0,0,0),   P1[10],P1[11],P1[12],P1[13], pw3[0]=PKW(P1,8), pw3[1]=PKW(P1,10), pw3); \
    VRD(7); SBAR(); GAPA(C1=__builtin_amdgcn_mfma_f32_32x32x16_bf16(kf[7],qr[3],C1,0,0,0),   P1[14],P1[15],0.f,0.f,       pw3[2]=PKW(P1,12),pw3[3]=PKW(P1,14), pw3); \
    l_reg+=sacc; \
    if(GK){DMA_K((t)+3,sl_cur);} if(GV){DMA_V((t)+1,sl_next);} \
    CMASK(C0,C1,t); \
    { float a=MX3(C0[0],C0[1],C1[0]),b=MX3(C0[2],C0[3],C1[1]); a=MX3(a,C1[2],C1[3]); \
      _Pragma("unroll") for(int r=4;r<16;r+=4){a=MX3(a,C0[r],C0[r+1]);b=MX3(b,C0[r+2],C0[r+3]);a=MX3(a,C1[r],C1[r+1]);b=MX3(b,C1[r+2],C1[r+3]);} \
      float rm=__builtin_fmaxf(a,b); { auto rr=__builtin_amdgcn_permlane32_swap(__float_as_uint(rm),__float_as_uint(rm),false,false); rm=__builtin_fmaxf(__uint_as_float(rr[0]),__uint_as_float(rr[1])); } \
      resc=false; \
      if(__builtin_expect(__any(rm>(float)THRL),0)){ const float dl=__builtin_fmaxf(rm,0.f); mhat+=dl; \
        _Pragma("unroll") for(int r=0;r<16;++r){C0[r]-=dl;C1[r]-=dl;} \
        const float f=__builtin_amdgcn_exp2f(-dl); l_reg*=f; if(hi==0)wsf[r32]=f; resc=true; } } \
    SBAR(); \
    GAPB(o[0]=__builtin_amdgcn_mfma_f32_32x32x16_bf16(PAF(0),VFR(0),o[0],0,0,0), C0,0); \
    GAPB(o[1]=__builtin_amdgcn_mfma_f32_32x32x16_bf16(PAF(0),VFR(4),o[1],0,0,0), C0,4); \
    KRD(GL,0); GAPB(o[0]=__builtin_amdgcn_mfma_f32_32x32x16_bf16(PAF(1),VFR(1),o[0],0,0,0), C0,8); \
    KRD(GL,1); GAPB(o[1]=__builtin_amdgcn_mfma_f32_32x32x16_bf16(PAF(1),VFR(5),o[1],0,0,0), C0,12); \
    KRD(GL,2); GAPB(o[0]=__builtin_amdgcn_mfma_f32_32x32x16_bf16(PAF(2),VFR(2),o[0],0,0,0), C1,0); \
    KRD(GL,3); GAPB(o[1]=__builtin_amdgcn_mfma_f32_32x32x16_bf16(PAF(2),VFR(6),o[1],0,0,0), C1,4); \
    GAPB(o[0]=__builtin_amdgcn_mfma_f32_32x32x16_bf16(PAF(3),VFR(3),o[0],0,0,0), C1,8); \
    GAPB(o[1]=__builtin_amdgcn_mfma_f32_32x32x16_bf16(PAF(3),VFR(7),o[1],0,0,0), C1,12); \
    }while(0)
  int t=1;
  #undef CMASK
  #define CMASK(P0,P1,t) do{}while(0)
  for(;t+5<NT;t+=2){
    STEP(pB0,pB1,pA0,pA1,t,true,true,true);     WAIT_BAR(2); RESC(); ROT();
    STEP(pA0,pA1,pB0,pB1,t+1,true,true,true);   WAIT_BAR(2); RESC(); ROT();
  }
  #undef CMASK
  #define CMASK(P0,P1,t) do{int jb_=(t)-(NT-4); if(jb_>=0)cmask(P0,P1,jb_,qrel,hi);}while(0)
  #define ENDW(tt) do{ if((tt)+3<NT){WAIT_BAR(2);} else if((tt)+2<NT){WAIT_BAR(1);} else {WAIT_BAR(0);} }while(0)
  for(;t+1<NT;t+=2){
    STEP(pB0,pB1,pA0,pA1,t,(t+3<NT),(t+1<NT),(t+1<NT));       ENDW(t);   RESC(); ROT();
    STEP(pA0,pA1,pB0,pB1,t+1,(t+4<NT),(t+2<NT),(t+2<NT));     ENDW(t+1); RESC(); ROT();
  }
  STEP(pB0,pB1,pA0,pA1,NT-1,false,false,false); RESC();
  { float sacc=pB0[0]+pB0[1]; _Pragma("unroll") for(int r=2;r<16;++r)sacc+=pB0[r]; _Pragma("unroll") for(int r=0;r<16;++r)sacc+=pB1[r]; l_reg+=sacc;
    pw0=(u32x4){PKW(pB0,0),PKW(pB0,2),PKW(pB0,4),PKW(pB0,6)};pw1=(u32x4){PKW(pB0,8),PKW(pB0,10),PKW(pB0,12),PKW(pB0,14)};pw2=(u32x4){PKW(pB1,0),PKW(pB1,2),PKW(pB1,4),PKW(pB1,6)};pw3=(u32x4){PKW(pB1,8),PKW(pB1,10),PKW(pB1,12),PKW(pB1,14)};
    SBAR(); pv(o,vb0+sl_cur,PAF(0),PAF(1),PAF(2),PAF(3)); }
  #undef PKW
  #undef PAF
  #undef VFR
  #undef PIN
  #undef MX3
  #undef GAPA
  #undef GAPB
  #undef EX
  #undef VRD
  #undef KRD
  #undef STEP
  #undef ENDW
  {auto rr=__builtin_amdgcn_permlane32_swap(__float_as_uint(l_reg),__float_as_uint(l_reg),false,false);l_reg=__uint_as_float(rr[0])+__uint_as_float(rr[1]);}
  if(hi==0)wsf[32+r32]=l_reg;asm volatile("s_waitcnt lgkmcnt(0)":::"memory");
  float rli[16];
  #pragma unroll
  for(int r=0;r<16;++r)rli[r]=__builtin_amdgcn_rcpf(wsf[32+crow(r,hi)]);
  int lane2=lane; asm volatile("":"+v"(lane2));
  bf16*Ow=O+(rowbase+q0+wid*QBLK)*DM+h*D;
  { __attribute__((address_space(3))) unsigned short*stg=(__attribute__((address_space(3))) unsigned short*)((__attribute__((address_space(3))) char*)shm+LDS_OST)+wid*2048;
    #pragma unroll
    for(int r=0;r<16;++r){const int orow=crow(r,hi);
      #pragma unroll
      for(int d0=0;d0<2;++d0)stg[orow*64+d0*32+r32]=(unsigned short)(cvtpk_s(o[d0][r]*rli[r],0.f)&0xffffu);}
    asm volatile("s_waitcnt lgkmcnt(0)":::"memory");
    #pragma unroll
    for(int i=0;i<4;++i){const int row=i*8+(lane2>>3),ch=lane2&7; const u32x4 v=*(const __attribute__((address_space(3))) u32x4*)(stg+row*64+ch*8); *(u32x4*)(Ow+(long)row*DM+ch*8)=v;} }
  asm volatile("s_waitcnt lgkmcnt(0)\n\ts_barrier":::"memory");
  #undef DMA_K
  #undef DMA_V
  #undef CMASK
  #undef CINIT
  #undef START
  #undef RESC
  #undef ROT
}
constexpr int ATTN_LDS_BYTES=LDS_BYTES;
#undef SBAR
#undef WAIT_BAR
}

struct Frame { LAS unsigned char* lds; int tid, lane, wave, vcu, G; };
#define LDS_WAIT() asm volatile("s_waitcnt lgkmcnt(0)" ::: "memory")

struct P0Item { const float* W; bf16* WT; const float* ks; int K, N, k0, n0; };
__device__ __forceinline__ P0Item p0_decode(const Ptrs& P, int it) {
    constexpr int I_IN = (D / 64) * (NIN / 32), I_A = (AW / 64) * (D / 32), I_M = (D / 64) * (D / 32), I_GU = (D / 64) * (2 * DE / 32), I_D = (DE / 64) * (D / 32);
    unsigned char* ws = P.ws; P0Item q; int r = it;
    if (r < I_IN) { q.W = P.w_in; q.WT = (bf16*)(ws + WS_WIN); q.ks = nullptr; q.K = D; q.N = NIN; }
    else if ((r -= I_IN) < I_A) { q.W = P.w_attn_out; q.WT = (bf16*)(ws + WS_WA); q.ks = nullptr; q.K = AW; q.N = D; }
    else if ((r -= I_A) < I_A) { q.W = P.w_sgu_out; q.WT = (bf16*)(ws + WS_WS); q.ks = nullptr; q.K = SW; q.N = D; }
    else if ((r -= I_A) < I_M) { q.W = P.w_mix_out; q.WT = (bf16*)(ws + WS_WM); q.ks = nullptr; q.K = D; q.N = D; }
    else if ((r -= I_M) < NE * I_GU) { const int e = r / I_GU; r -= e * I_GU; q.W = P.w_gu + (size_t)e * D * 2 * DE; q.WT = (bf16*)(ws + WS_WGU) + (size_t)e * D * 2 * DE; q.ks = P.ffn_g; q.K = D; q.N = 2 * DE; }
    else { r -= NE * I_GU; const int e = r / I_D; r -= e * I_D; q.W = P.w_down + (size_t)e * DE * D; q.WT = (bf16*)(ws + WS_WD) + (size_t)e * DE * D; q.ks = nullptr; q.K = DE; q.N = D; }
    const int nblk = q.N / 32; q.k0 = 64 * (r / nblk); q.n0 = 32 * (r % nblk); return q;
}
__device__ __forceinline__ void p0_load(const P0Item& q, int lane, f32x4 (&buf)[8]) {
    const float* src = q.W + (size_t)(q.k0 + (lane >> 3)) * q.N + q.n0 + 4 * (lane & 7);
#pragma unroll
    for (int i = 0; i < 8; ++i) buf[i] = *(const GAS f32x4*)(src + (size_t)(8 * i) * q.N);
}
__device__ __forceinline__ void p0_store(const P0Item& q, int lane, const f32x4 (&buf)[8], LAS float* scr) {
#pragma unroll
    for (int i = 0; i < 8; ++i) { const int kk = (lane >> 3) + 8 * i; const float sc = q.ks ? q.ks[q.k0 + kk] : 1.f; LAS float* d = scr + kk * 33 + 4 * (lane & 7);
        d[0] = buf[i][0] * sc; d[1] = buf[i][1] * sc; d[2] = buf[i][2] * sc; d[3] = buf[i][3] * sc; }
    LDS_WAIT(); asm volatile("" ::: "memory");
    const int c = lane & 7;
#pragma unroll
    for (int j = 0; j < 4; ++j) { const int n = (lane >> 3) + 8 * j; const LAS float* s = scr + (8 * c) * 33 + n;
        u32x4 o; o.x = cvt_pk_bf16(s[0 * 33], s[1 * 33]); o.y = cvt_pk_bf16(s[2 * 33], s[3 * 33]); o.z = cvt_pk_bf16(s[4 * 33], s[5 * 33]); o.w = cvt_pk_bf16(s[6 * 33], s[7 * 33]);
        *(GAS u32x4*)(q.WT + (size_t)(q.n0 + n) * q.K + q.k0 + 8 * c) = o; }
    LDS_WAIT(); asm volatile("" ::: "memory");
}
__device__ __forceinline__ void p0_prologue(Frame& F, const Ptrs& P) {
    unsigned char* ws = P.ws;
    LAS float* scr = (LAS float*)(F.lds + F.wave * 16384);
    const int gw = F.vcu * NWAVES + F.wave, NGW = F.G * NWAVES;
    constexpr int I_IN = (D / 64) * (NIN / 32), I_A = (AW / 64) * (D / 32), I_M = (D / 64) * (D / 32), I_GU = (D / 64) * (2 * DE / 32), I_D = (DE / 64) * (D / 32);
    constexpr int NITEMS = I_IN + 2 * I_A + I_M + NE * I_GU + NE * I_D;
    if (gw < NITEMS) {
        P0Item cur = p0_decode(P, gw); f32x4 bufA[8], bufB[8]; p0_load(cur, F.lane, bufA);
        for (int it = gw;;) {
            const int nit = it + NGW; const bool has = nit < NITEMS; P0Item nxt = cur;
            if (has) { nxt = p0_decode(P, nit); p0_load(nxt, F.lane, bufB); }
            p0_store(cur, F.lane, bufA, scr);
            if (!has) break;
            cur = nxt; it = nit;
#pragma unroll
            for (int i = 0; i < 8; ++i) bufA[i] = bufB[i];
        }
    }
    for (int i = (F.vcu * NWAVES + F.wave) * 64 + F.lane; i < NE * D; i += NGW * 64) { const int e = i / D, k = i % D; const float v = P.w_router[(size_t)k * NE + e] * P.ffn_g[k];
        const unsigned h = f2bf(v); ((bf16*)(ws + WS_WR))[i] = (bf16)h; ((bf16*)(ws + WS_WR))[NE * D + i] = (bf16)f2bf(v - bf2f(h)); }
    f32x4 gg[4];
#pragma unroll
    for (int j = 0; j < 4; ++j) gg[j] = ((const f32x4*)P.mix_g)[F.lane + 64 * j];
    for (int row = gw; row < T; row += 2 * NGW) {
        const int row2 = row + NGW; const bool two = row2 < T;
        const GAS f32x4* xr = (const GAS f32x4*)(P.x + (size_t)row * D) + F.lane; const GAS f32x4* xr2 = (const GAS f32x4*)(P.x + (size_t)(two ? row2 : row) * D) + F.lane;
        f32x4 v[4], u[4]; float s = 0.f, s2 = 0.f;
#pragma unroll
        for (int j = 0; j < 4; ++j) { v[j] = xr[64 * j]; u[j] = xr2[64 * j]; }
#pragma unroll
        for (int j = 0; j < 4; ++j) { s += (v[j].x * v[j].x + v[j].y * v[j].y) + (v[j].z * v[j].z + v[j].w * v[j].w); s2 += (u[j].x * u[j].x + u[j].y * u[j].y) + (u[j].z * u[j].z + u[j].w * u[j].w); }
        const float rstd = 1.f / sqrtf(wave_sum(s) * (1.f / D) + EPS), rstd2 = 1.f / sqrtf(wave_sum(s2) * (1.f / D) + EPS);
#pragma unroll
        for (int j = 0; j < 4; ++j) { u32x2 o; o.x = cvt_pk_bf16(v[j].x * rstd * gg[j].x, v[j].y * rstd * gg[j].y); o.y = cvt_pk_bf16(v[j].z * rstd * gg[j].z, v[j].w * rstd * gg[j].w);
            *((GAS u32x2*)(ws + WS_XN + (size_t)row * D * 2) + F.lane + 64 * j) = o; }
        if (two) {
#pragma unroll
            for (int j = 0; j < 4; ++j) { u32x2 o; o.x = cvt_pk_bf16(u[j].x * rstd2 * gg[j].x, u[j].y * rstd2 * gg[j].y); o.y = cvt_pk_bf16(u[j].z * rstd2 * gg[j].z, u[j].w * rstd2 * gg[j].w);
                *((GAS u32x2*)(ws + WS_XN + (size_t)row2 * D * 2) + F.lane + 64 * j) = o; } }
    }
}
__device__ __forceinline__ void moe_tables(Frame& F, const unsigned* ctl) {
    LAS int* tbase = (LAS int*)(F.lds + LX_TBASE); LAS int* tile_e = (LAS int*)(F.lds + LX_TILEE);
    if (F.tid < 64) { const int c = F.tid < NE ? (int)ctl[CW_CNT + 64 * F.tid] : 0; const int n = (c + 255) >> 8; int incl = n;
#pragma unroll
        for (int o = 1; o < 64; o <<= 1) { const int t = __shfl_up(incl, o); if (F.lane >= o) incl += t; }
        if (F.tid <= NE) tbase[F.tid] = incl - n;
    }
    __syncthreads();
    for (int mt = F.tid; mt < NROWS_PAD / 256; mt += NWAVES * 64) { int e = 0;
        for (int i = 0; i < NE; ++i) if (mt >= tbase[i + 1]) e = i + 1;
        tile_e[mt] = e < NE ? e : NE - 1; }
    __syncthreads();
}


__device__ __forceinline__ void p5_router(Frame& F, const Ptrs& P) {
    unsigned char* ws = P.ws; unsigned* ctl = (unsigned*)(ws + WS_CTL);
    LAS float* red = (LAS float*)F.lds;
    LAS unsigned* lcnt = (LAS unsigned*)(F.lds + 36864);
    LAS unsigned* lbase = lcnt + 32;
    const int w = F.wave, lane = F.lane, gI = w & 1, kq = w >> 1, r32 = lane & 31, hi = lane >> 5;
    const bf16* WR = (const bf16*)(ws + WS_WR);
    for (int grp = blockIdx.x; grp < T / 64; grp += F.G) {
        if (F.tid < 64) lcnt[F.tid] = 0u;
        const int tok = grp * 64 + gI * 32 + r32;
        const float* xr = (const float*)(ws + WS_H1) + (size_t)tok * D + kq * 256 + 8 * hi;
        const bf16* whi = WR + (size_t)r32 * D + kq * 256 + 8 * hi; const bf16* wlo = whi + NE * D;
        f32x16 c = {}; float ss = 0.f;
#pragma unroll 4
        for (int s = 0; s < 16; ++s) {
            const f32x4 x0 = *(const f32x4*)(xr + 16 * s), x1 = *(const f32x4*)(xr + 16 * s + 4);
            ss += (x0[0] * x0[0] + x0[1] * x0[1]) + (x0[2] * x0[2] + x0[3] * x0[3]) + (x1[0] * x1[0] + x1[1] * x1[1]) + (x1[2] * x1[2] + x1[3] * x1[3]);
            u32x4 hw, lw;
            { const unsigned h = cvt_pk_bf16(x0[0], x0[1]); hw[0] = h; lw[0] = cvt_pk_bf16(x0[0] - __uint_as_float(h << 16), x0[1] - __uint_as_float(h & 0xffff0000u)); }
            { const unsigned h = cvt_pk_bf16(x0[2], x0[3]); hw[1] = h; lw[1] = cvt_pk_bf16(x0[2] - __uint_as_float(h << 16), x0[3] - __uint_as_float(h & 0xffff0000u)); }
            { const unsigned h = cvt_pk_bf16(x1[0], x1[1]); hw[2] = h; lw[2] = cvt_pk_bf16(x1[0] - __uint_as_float(h << 16), x1[1] - __uint_as_float(h & 0xffff0000u)); }
            { const unsigned h = cvt_pk_bf16(x1[2], x1[3]); hw[3] = h; lw[3] = cvt_pk_bf16(x1[2] - __uint_as_float(h << 16), x1[3] - __uint_as_float(h & 0xffff0000u)); }
            const bf16x8 xh = __builtin_bit_cast(bf16x8, hw), xl = __builtin_bit_cast(bf16x8, lw);
            const bf16x8 ah = *(const bf16x8*)(whi + 16 * s), al = *(const bf16x8*)(wlo + 16 * s);
            c = __builtin_amdgcn_mfma_f32_32x32x16_bf16(ah, xh, c, 0, 0, 0);
            c = __builtin_amdgcn_mfma_f32_32x32x16_bf16(ah, xl, c, 0, 0, 0);
            c = __builtin_amdgcn_mfma_f32_32x32x16_bf16(al, xh, c, 0, 0, 0);
        }
#pragma unroll
        for (int r = 0; r < 16; ++r) red[(w * 17 + r) * 64 + lane] = c[r];
        red[(w * 17 + 16) * 64 + lane] = ss;
        __syncthreads();
        int idx[4]; unsigned lpos[4]; float pw[4]; float rstd = 0.f;
        if (kq == 0) {
            float lg[16], pl[16]; float ssum = 0.f;
#pragma unroll
            for (int r = 0; r < 16; ++r) lg[r] = 0.f;
#pragma unroll
            for (int q = 0; q < 4; ++q) {
#pragma unroll
                for (int r = 0; r < 16; ++r) lg[r] += red[((w + 2 * q) * 17 + r) * 64 + lane];
                ssum += red[((w + 2 * q) * 17 + 16) * 64 + lane]; }
            ssum += __shfl_xor(ssum, 32);
            rstd = 1.f / sqrtf(ssum * (1.f / D) + EPS);
#pragma unroll
            for (int r = 0; r < 16; ++r) { lg[r] = lg[r] * rstd + P.b_router[(r & 3) + 8 * (r >> 2) + 4 * hi]; pl[r] = __shfl_xor(lg[r], 32); }
            float v[32];
#pragma unroll
            for (int e = 0; e < 32; ++e) { const int half = (e >> 2) & 1, r = (e & 3) + 4 * (e >> 3); v[e] = (half == hi) ? lg[r] : pl[r]; }
            float val[4];
#pragma unroll
            for (int k = 0; k < 4; ++k) { int best = 0; float bv = -INFINITY;
#pragma unroll
                for (int e = 0; e < 32; ++e) if (v[e] > bv) { bv = v[e]; best = e; }
#pragma unroll
                for (int e = 0; e < 32; ++e) if (e == best) v[e] = -INFINITY;
                idx[k] = best; val[k] = bv; }
            float den = 0.f;
#pragma unroll
            for (int k = 0; k < 4; ++k) { pw[k] = __expf(val[k] - val[0]); den += pw[k]; }
            const float rden = 1.f / den;
#pragma unroll
            for (int k = 0; k < 4; ++k) { pw[k] *= rden; lpos[k] = 0u; if (hi == 0) lpos[k] = atomicAdd((unsigned*)&lcnt[idx[k]], 1u); }
        }
        __syncthreads();
        if (F.tid < NE) ((unsigned*)(ws + WS_HIST))[grp * NE + F.tid] = lcnt[F.tid];
        if (kq == 0 && hi == 0) {
            unsigned* slot = (unsigned*)(ws + WS_TOKSLOT); float* tw = (float*)(ws + WS_TOKW);
#pragma unroll
            for (int k = 0; k < 4; ++k) { slot[tok * 4 + k] = (unsigned)idx[k] | (lpos[k] << 8); tw[tok * 4 + k] = pw[k]; }
            ((float*)(ws + WS_RSTD2))[tok] = rstd;
        }
        __syncthreads();
    }
}
__device__ __forceinline__ void p5b_lists(Frame& F, const Ptrs& P) {
    unsigned char* ws = P.ws; unsigned* ctl = (unsigned*)(ws + WS_CTL); const unsigned* hist = (const unsigned*)(ws + WS_HIST);
    LAS unsigned* part = (LAS unsigned*)F.lds;
    LAS unsigned* lbase = part + 512;
    for (int grp = blockIdx.x; grp < T / 64; grp += F.G) {
        { const int e = F.tid & 31, pt = F.tid >> 5; unsigned s = 0u;
#pragma unroll
          for (int i = 0; i < 16; ++i) { const int g2 = pt * 16 + i; const unsigned v = hist[g2 * NE + e]; s += (g2 < grp) ? v : 0u; }
          part[pt * 32 + e] = s; }
        __syncthreads();
        if (F.tid < NE) { unsigned s = 0u;
#pragma unroll
            for (int i = 0; i < 16; ++i) s += part[i * 32 + F.tid];
            lbase[F.tid] = s;
            if (grp == T / 64 - 1) ctl[CW_CNT + 64 * F.tid] = s + hist[grp * NE + F.tid]; }
        __syncthreads();
        if (F.tid < 256) { const int tok = grp * 64 + (F.tid >> 2); unsigned* slot = (unsigned*)(ws + WS_TOKSLOT) + tok * 4 + (F.tid & 3);
            const unsigned sv = *slot; const unsigned e = sv & 0xffu, pos = lbase[e] + (sv >> 8);
            *slot = e | (pos << 8); ((int*)(ws + WS_LIST))[(size_t)e * T + pos] = tok; ((float*)(ws + WS_RLIST))[(size_t)e * T + pos] = ((const float*)(ws + WS_RSTD2))[tok]; }
        __syncthreads();
    }
}
__device__ __forceinline__ void p8_combine(Frame& F, const Ptrs& P) {
    unsigned char* ws = P.ws; const LAS int* tbase = (const LAS int*)(F.lds + LX_TBASE);
    const int gw = F.vcu * NWAVES + F.wave, NGW = F.G * NWAVES, lane = F.lane;
    const bf16* Y = (const bf16*)(ws + WS_Y); const unsigned* slot = (const unsigned*)(ws + WS_TOKSLOT); const float* tw = (const float*)(ws + WS_TOKW);
    f32x4 gg[4];
#pragma unroll
    for (int j = 0; j < 2; ++j) { gg[2 * j] = *(const f32x4*)(P.fin_g + 8 * lane + 512 * j); gg[2 * j + 1] = *(const f32x4*)(P.fin_g + 8 * lane + 512 * j + 4); }
    for (int tok = gw; tok < T; tok += NGW) {
        const float* hr = (const float*)(ws + WS_H1) + (size_t)tok * D + 8 * lane; f32x4 v[4];
#pragma unroll
        for (int j = 0; j < 2; ++j) { v[2 * j] = *(const f32x4*)(hr + 512 * j); v[2 * j + 1] = *(const f32x4*)(hr + 512 * j + 4); }
        const u32x4 sl = *(const u32x4*)(slot + tok * 4); const f32x4 wv = *(const f32x4*)(tw + tok * 4);
        u32x4 y[4][2];
#pragma unroll
        for (int k = 0; k < 4; ++k) { const int e = sl[k] & 0xff, pos = sl[k] >> 8; const bf16* yr = Y + (size_t)(tbase[e] * 256 + pos) * D + 8 * lane; y[k][0] = *(const u32x4*)yr; y[k][1] = *(const u32x4*)(yr + 512); }
#pragma unroll
        for (int k = 0; k < 4; ++k)
#pragma unroll
            for (int j = 0; j < 2; ++j) { const u32x4 q = y[k][j]; const float wk = wv[k];
                v[2 * j][0] += wk * bf2f(q.x & 0xffffu); v[2 * j][1] += wk * bf2f(q.x >> 16); v[2 * j][2] += wk * bf2f(q.y & 0xffffu); v[2 * j][3] += wk * bf2f(q.y >> 16);
                v[2 * j + 1][0] += wk * bf2f(q.z & 0xffffu); v[2 * j + 1][1] += wk * bf2f(q.z >> 16); v[2 * j + 1][2] += wk * bf2f(q.w & 0xffffu); v[2 * j + 1][3] += wk * bf2f(q.w >> 16); }
        float s = 0.f;
#pragma unroll
        for (int j = 0; j < 4; ++j) s += (v[j][0] * v[j][0] + v[j][1] * v[j][1]) + (v[j][2] * v[j][2] + v[j][3] * v[j][3]);
        const float rstd = 1.f / sqrtf(wave_sum(s) * (1.f / D) + EPS);
        float* orow = P.out + (size_t)tok * D + 8 * lane;
#pragma unroll
        for (int j = 0; j < 2; ++j) { *(f32x4*)(orow + 512 * j) = v[2 * j] * rstd * gg[2 * j]; *(f32x4*)(orow + 512 * j + 4) = v[2 * j + 1] * rstd * gg[2 * j + 1]; }
    }
}

constexpr int SGU_PITCH = 136;
__device__ __forceinline__ void sgu_unit(Frame& F, const Ptrs& P, int hu) {
    unsigned char* ws = P.ws; const int b = hu >> 6, c = (hu >> 1) & 31, gh = hu & 1, tok0 = b * SEQ + c * 128, ch0 = 256 * gh;
    const bf16* VV = (const bf16*)(ws + WS_VV); const bf16* U = (const bf16*)(ws + WS_U); bf16* SG = (bf16*)(ws + WS_SG);
    LAS bf16* vnT = (LAS bf16*)F.lds; LAS f32x2* st = (LAS f32x2*)(F.lds + 256 * SGU_PITCH * 2);
    int tid = F.tid; asm volatile("" : "+v"(tid));
    const int w = __builtin_amdgcn_readfirstlane(tid >> 6), lane = tid & 63;
    for (int rr = 0; rr < 16; ++rr) { const int row = 16 * w + rr; const u32x4 r = *((const u32x4*)(VV + (size_t)(tok0 + row) * SW) + lane); float v[8];
#pragma unroll
        for (int e = 0; e < 4; ++e) { v[2 * e] = bf2f(r[e] & 0xffffu); v[2 * e + 1] = bf2f(r[e] >> 16); }
        float s = ((v[0] + v[1]) + (v[2] + v[3])) + ((v[4] + v[5]) + (v[6] + v[7]));
        const float mu = wave_sum(s) * (1.f / SW); float q = 0.f;
#pragma unroll
        for (int e = 0; e < 8; ++e) q += (v[e] - mu) * (v[e] - mu);
        const float rstd = 1.f / sqrtf(wave_sum(q) * (1.f / SW) + EPS);
        if (lane == 0) st[row] = (f32x2){mu, rstd}; }
    __syncthreads();
#pragma unroll 2
    for (int i = 0; i < 8; ++i) { const int item = tid + 512 * i, s = item & 127, chunk = item >> 7; const int cc = ch0 + 8 * chunk;
        const u32x4 r = *(const u32x4*)(VV + (size_t)(tok0 + s) * SW + cc); const f32x2 ms = st[s];
        const f32x4 g0 = *(const f32x4*)(P.ln_g + cc), g1 = *(const f32x4*)(P.ln_g + cc + 4), b0 = *(const f32x4*)(P.ln_b + cc), b1 = *(const f32x4*)(P.ln_b + cc + 4);
        float v[8];
#pragma unroll
        for (int e = 0; e < 4; ++e) { v[2 * e] = bf2f(r[e] & 0xffffu); v[2 * e + 1] = bf2f(r[e] >> 16); }
#pragma unroll
        for (int e = 0; e < 8; ++e) { const float gg = e < 4 ? g0[e] : g1[e - 4], bb = e < 4 ? b0[e] : b1[e - 4]; vnT[(8 * chunk + e) * SGU_PITCH + s] = (bf16)f2bf((v[e] - ms.x) * ms.y * gg + bb); } }
    __syncthreads();
    const int gl = w >> 1, th = w & 1, g = 4 * gh + gl, r32 = lane & 31, hi = lane >> 5;
    f32x16 acc[2][2];
#pragma unroll
    for (int dt = 0; dt < 2; ++dt)
#pragma unroll
        for (int tt = 0; tt < 2; ++tt) acc[dt][tt] = f32x16{};
    const float* Wg = P.w_sp + (size_t)g * 128 * 128;
#pragma unroll
    for (int tt = 0; tt < 2; ++tt) { const int t0 = 64 * th + 32 * tt, t = t0 + r32, nst = (t0 + 32) / 16;
        for (int ks = 0; ks < nst; ++ks) { const int s0 = 16 * ks + 8 * hi;
            const f32x4 w0 = *(const f32x4*)(Wg + (size_t)t * 128 + s0), w1 = *(const f32x4*)(Wg + (size_t)t * 128 + s0 + 4);
            u32x4 bw;
            bw[0] = cvt_pk_bf16(s0 + 0 <= t ? w0[0] : 0.f, s0 + 1 <= t ? w0[1] : 0.f); bw[1] = cvt_pk_bf16(s0 + 2 <= t ? w0[2] : 0.f, s0 + 3 <= t ? w0[3] : 0.f);
            bw[2] = cvt_pk_bf16(s0 + 4 <= t ? w1[0] : 0.f, s0 + 5 <= t ? w1[1] : 0.f); bw[3] = cvt_pk_bf16(s0 + 6 <= t ? w1[2] : 0.f, s0 + 7 <= t ? w1[3] : 0.f);
            const bf16x8 bfr = __builtin_bit_cast(bf16x8, bw);
#pragma unroll
            for (int dt = 0; dt < 2; ++dt) { const bf16x8 a = *(const LAS bf16x8*)(vnT + (64 * gl + 32 * dt + r32) * SGU_PITCH + s0);
                acc[dt][tt] = __builtin_amdgcn_mfma_f32_32x32x16_bf16(a, bfr, acc[dt][tt], 0, 0, 0); } } }
#pragma unroll
    for (int tt = 0; tt < 2; ++tt) { const int t = 64 * th + 32 * tt + r32; const size_t tok = (size_t)(tok0 + t); const float bias = P.b_sp[g * 128 + t];
#pragma unroll
        for (int dt = 0; dt < 2; ++dt)
#pragma unroll
            for (int q = 0; q < 4; ++q) { const int cch = g * 64 + 32 * dt + 8 * q + 4 * hi; const u32x2 uu = *(const u32x2*)(U + tok * SW + cch);
                const float o0 = bf2f(uu.x & 0xffffu) * (acc[dt][tt][4 * q] + bias), o1 = bf2f(uu.x >> 16) * (acc[dt][tt][4 * q + 1] + bias), o2 = bf2f(uu.y & 0xffffu) * (acc[dt][tt][4 * q + 2] + bias), o3 = bf2f(uu.y >> 16) * (acc[dt][tt][4 * q + 3] + bias);
                u32x2 ov; ov.x = cvt_pk_bf16(o0, o1); ov.y = cvt_pk_bf16(o2, o3); *(u32x2*)(SG + tok * SW + cch) = ov; } }
    __syncthreads();
}
__device__ __forceinline__ void p2_mixer(Frame& F, const Ptrs& P, char* lds_generic, int nrep) {
    unsigned char* ws = P.ws;
    const attn_body::bf16* Q = (const attn_body::bf16*)(ws + WS_Q); const attn_body::bf16* K = (const attn_body::bf16*)(ws + WS_K); const attn_body::bf16* V = (const attn_body::bf16*)(ws + WS_V);
    const float* KM = (const float*)(ws + WS_CTL) + CW_KM; attn_body::bf16* O = (attn_body::bf16*)(ws + WS_O);
    for (int p = F.vcu; p < NBATCH * NH * 8; p += F.G) { const int bh = p >> 3, s = p & 7;
        for (int r = 0; r < 2 * nrep; ++r)
            attn_body::attn_unit<8>(bh / NH, bh % NH, (r & 1) ? 15 - s : s, Q, K, V, KM, O, lds_generic); }
    for (int hu = F.vcu; hu < NBATCH * 32 * 2; hu += F.G) for (int r = 0; r < SGU_REP; ++r) sgu_unit(F, P, hu);
}

struct Args { Ptrs P; int ph_lo, ph_hi, li, pad; };
__global__ void __launch_bounds__(NWAVES * 64, 2) fwd(Args args) {
    extern __shared__ __attribute__((aligned(16))) unsigned char lds_raw[];
    Frame F; F.lds = (LAS unsigned char*)lds_raw; F.tid = threadIdx.x; F.lane = F.tid & 63; F.wave = __builtin_amdgcn_readfirstlane(F.tid >> 6);
    F.G = gridDim.x; { const int bx = blockIdx.x; F.vcu = (F.G % 8 == 0) ? (bx % 8) * (F.G / 8) + bx / 8 : bx; }
    const Ptrs& P = args.P; unsigned char* ws = P.ws; unsigned* ctl = (unsigned*)(ws + WS_CTL);
    if (F.tid < 4) ((LAS unsigned*)(F.lds + LX_BAR))[F.tid] = 0u;
    __syncthreads();
    XcdBarrier bar = xcd_barrier_post(ctl + CW_BAR + args.li * XCD_BAR_WORDS, (volatile LAS unsigned*)(F.lds + LX_BAR));
    const int lo = args.ph_lo, hi = args.ph_hi;
#define IN(k) (lo <= (k) && (k) < hi)
#ifndef REP_PHASE
#define REP_PHASE -1
#endif
#define REPS(k) (((k) == REP_PHASE) ? 2 : 1)
#define SEAM(k) do { if (IN(k) && IN((k) + 1)) xcd_barrier(bar); } while (0)

    if (IN(0)) _Pragma("unroll") for (int rep_ = 0; rep_ < REPS(0); ++rep_) { p0_prologue(F, P); if (rep_ + 1 < REPS(0)) xcd_barrier(bar); else SEAM(0); }
    if (IN(1)) _Pragma("unroll") for (int rep_ = 0; rep_ < REPS(1); ++rep_) {
        DenseSched S{(const char*)(ws + WS_XN), (const char*)(ws + WS_WIN), D, D, T / 256, NIN / 256, F.G, (int)blockIdx.x};
        EpiIn E{ws, (float*)(ws + WS_CTL) + CW_KM};
        pg8::gemm_phase<EpiIn, DenseSched, true>(F.lds, D, D, S, E);
        if (rep_ + 1 < REPS(1)) xcd_barrier(bar); else SEAM(1);
    }
    if (IN(2)) _Pragma("unroll") for (int rep_ = 0; rep_ < REPS(2); ++rep_) { p2_mixer(F, P, (char*)lds_raw, args.pad); if (rep_ + 1 < REPS(2)) xcd_barrier(bar); else SEAM(2); }
    if (IN(3)) _Pragma("unroll") for (int rep_ = 0; rep_ < REPS(3); ++rep_) {
        MergeSched S{(const char*)(ws + WS_O), (const char*)(ws + WS_WA), F.G, (int)blockIdx.x};
        EpiMerge E{ws};
        pg8::gemm_phase<EpiMerge, MergeSched, true>(F.lds, AW, AW, S, E);
        if (rep_ + 1 < REPS(3)) xcd_barrier(bar); else SEAM(3);
    }
    if (IN(4)) _Pragma("unroll") for (int rep_ = 0; rep_ < REPS(4); ++rep_) {
        DenseSched S{(const char*)(ws + WS_MG), (const char*)(ws + WS_WM), D, D, T / 256, D / 256, F.G, (int)blockIdx.x};
        EpiH1 E{P.x, (float*)(ws + WS_H1), (bf16*)(ws + WS_H1B)};
        pg8::gemm_phase<EpiH1, DenseSched, true>(F.lds, D, D, S, E);
        if (rep_ + 1 < REPS(4)) xcd_barrier(bar); else SEAM(4);
    }
    if (IN(5)) { p5_router(F, P); xcd_barrier(bar); p5b_lists(F, P); SEAM(5); }
    if (IN(6)) _Pragma("unroll") for (int rep_ = 0; rep_ < REPS(6); ++rep_) {
        moe_tables(F, ctl);
        MoeSched<true> S{(const char*)(ws + WS_H1B), (const char*)(ws + WS_WGU), (const int*)(ws + WS_LIST), (const LAS int*)(F.lds + LX_TBASE), (const LAS int*)(F.lds + LX_TILEE), ctl, 8, F.G, (int)blockIdx.x};
        EpiGu E{(const float*)(ws + WS_RLIST), P.b_gu, (bf16*)(ws + WS_HID)};
        pg8::gemm_phase<EpiGu, MoeSched<true>, true>(F.lds, D, D, S, E);
        if (rep_ + 1 < REPS(6)) xcd_barrier(bar); else SEAM(6);
    }
    if (IN(7)) _Pragma("unroll") for (int rep_ = 0; rep_ < REPS(7); ++rep_) {
        moe_tables(F, ctl);
        MoeSched<false> S{(const char*)(ws + WS_HID), (const char*)(ws + WS_WD), nullptr, (const LAS int*)(F.lds + LX_TBASE), (const LAS int*)(F.lds + LX_TILEE), ctl, 4, F.G, (int)blockIdx.x};
        EpiDown E{P.b_down, (bf16*)(ws + WS_Y)};
        pg8::gemm_phase<EpiDown, MoeSched<false>, true>(F.lds, DE, DE, S, E);
        if (rep_ + 1 < REPS(7)) xcd_barrier(bar); else SEAM(7);
    }
    if (IN(8)) _Pragma("unroll") for (int rep_ = 0; rep_ < REPS(8); ++rep_) { moe_tables(F, ctl); p8_combine(F, P); if (rep_ + 1 < REPS(8)) xcd_barrier(bar); }
#undef IN
#undef SEAM
}

#ifndef ATTN_REP
#define ATTN_REP 1
#endif
#ifndef REDO_MASK
#define REDO_MASK 0x000
#endif
#ifndef OPT_MASK
#define OPT_MASK 0x1FF
#endif
static void naive_phase(int k, const Ptrs& P, hipStream_t stream) {
    unsigned char* ws = P.ws;
    switch (k) {
    case 0:
        n_cvtT<<<dim3(NIN / 32, D / 32, 1), 256, 0, stream>>>(P.w_in, (bf16*)(ws + WS_WIN), D, NIN, nullptr);
        n_cvtT<<<dim3(D / 32, AW / 32, 1), 256, 0, stream>>>(P.w_attn_out, (bf16*)(ws + WS_WA), AW, D, nullptr);
        n_cvtT<<<dim3(D / 32, SW / 32, 1), 256, 0, stream>>>(P.w_sgu_out, (bf16*)(ws + WS_WS), SW, D, nullptr);
        n_cvtT<<<dim3(D / 32, D / 32, 1), 256, 0, stream>>>(P.w_mix_out, (bf16*)(ws + WS_WM), D, D, nullptr);
        n_cvtT<<<dim3(2 * DE / 32, D / 32, NE), 256, 0, stream>>>(P.w_gu, (bf16*)(ws + WS_WGU), D, 2 * DE, P.ffn_g);
        n_cvtT<<<dim3(D / 32, DE / 32, NE), 256, 0, stream>>>(P.w_down, (bf16*)(ws + WS_WD), DE, D, nullptr);
        n_cvt_router<<<NE * D / 256, 256, 0, stream>>>(P.w_router, P.ffn_g, (bf16*)(ws + WS_WR), (bf16*)(ws + WS_WR) + NE * D);
        n_rmsnorm<<<T / 4, 256, 0, stream>>>(P.x, P.mix_g, (bf16*)(ws + WS_XN));
        break;
    case 1:
        n_gemm<EPI_IN><<<dim3(NIN / 128, T / 128), 256, 0, stream>>>((const bf16*)(ws + WS_XN), D, (const bf16*)(ws + WS_WIN), D, D, P);
        n_kmean<<<NBATCH * NBLK * AW / 256, 256, 0, stream>>>((const bf16*)(ws + WS_K), (float*)(ws + WS_CTL) + CW_KM);
        break;
    case 2:
        n_attn<<<T * NH / 4, 256, 0, stream>>>((const bf16*)(ws + WS_Q), (const bf16*)(ws + WS_K), (const bf16*)(ws + WS_V), (const float*)(ws + WS_CTL) + CW_KM, (bf16*)(ws + WS_O));
        n_sgu_stats<<<T / 4, 256, 0, stream>>>((const bf16*)(ws + WS_VV), (float*)(ws + WS_STATS));
        n_sgu<<<T * SW / 256, 256, 0, stream>>>((const bf16*)(ws + WS_U), (const bf16*)(ws + WS_VV), (const float*)(ws + WS_STATS), P, (bf16*)(ws + WS_SG));
        break;
    case 3:
        n_gemm<EPI_MG1><<<dim3(D / 128, T / 128), 256, 0, stream>>>((const bf16*)(ws + WS_O), AW, (const bf16*)(ws + WS_WA), AW, AW, P);
        n_gemm<EPI_MG2><<<dim3(D / 128, T / 128), 256, 0, stream>>>((const bf16*)(ws + WS_SG), SW, (const bf16*)(ws + WS_WS), SW, SW, P);
        break;
    case 4: n_gemm<EPI_H1><<<dim3(D / 128, T / 128), 256, 0, stream>>>((const bf16*)(ws + WS_MG), D, (const bf16*)(ws + WS_WM), D, D, P); break;
    case 5: n_router<<<T / 4, 256, 0, stream>>>(P); break;
    case 6: n_moe_gu<<<dim3(DE / 128, NROWS_PAD / 128), 256, 0, stream>>>(P); break;
    case 7: n_moe_down<<<dim3(D / 128, NROWS_PAD / 128), 256, 0, stream>>>(P); break;
    default: n_combine<<<T / 4, 256, 0, stream>>>(P); break;
    }
}
extern "C" void kernel_launch(void* const* d_in, const int* in_sizes, int n_in, void* d_out, int out_size, void* d_ws, size_t ws_size, hipStream_t stream) {
    static int grid = 0;
    if (grid == 0) {
        if (n_in != 18 || in_sizes[0] != T * D || out_size != T * D || ws_size < WS_END) { fprintf(stderr, "kernel_launch: unexpected shapes (n_in %d, in0 %d, out %d, ws %zu)\n", n_in, n_in > 0 ? in_sizes[0] : -1, out_size, ws_size); grid = -1; return; }
        int dev = 0, cus = 0, per_cu = 0;
        if (hipGetDevice(&dev) != hipSuccess || hipDeviceGetAttribute(&cus, hipDeviceAttributeMultiprocessorCount, dev) != hipSuccess) { grid = -1; return; }
        if (hipFuncSetAttribute((const void*)fwd, hipFuncAttributeMaxDynamicSharedMemorySize, LDS_BYTES) != hipSuccess) { fprintf(stderr, "kernel_launch: hipFuncSetAttribute failed\n"); grid = -1; return; }
        if (hipOccupancyMaxActiveBlocksPerMultiprocessor(&per_cu, (const void*)fwd, NWAVES * 64, LDS_BYTES) != hipSuccess || per_cu < 1) fprintf(stderr, "kernel_launch: occupancy query says %d\n", per_cu);
        (void)hipGetLastError();
        grid = cus;
    }
    if (grid < 0) return;
    Ptrs P{};
    const float** pf = (const float**)&P;
    for (int i = 0; i < 18; ++i) pf[i] = (const float*)d_in[i];
    P.out = (float*)d_out; P.ws = (unsigned char*)d_ws;
    (void)hipMemsetAsync((unsigned char*)d_ws + WS_CTL, 0, CTL_ZERO_BYTES, stream);
    int li = 0;
    for (int k = 0; k < 9;) {
        if (!((OPT_MASK >> k) & 1)) { naive_phase(k, P, stream); ++k; continue; }
        int hi = k; while (hi < 9 && ((OPT_MASK >> hi) & 1)) ++hi;
        Args a{}; a.P = P; a.ph_lo = k; a.ph_hi = hi; a.li = li++; a.pad = ATTN_REP;
        hipLaunchKernelGGL(fwd, dim3(grid), dim3(NWAVES * 64), LDS_BYTES, stream, a);
        for (int q = k; q < hi; ++q) if ((REDO_MASK >> q) & 1) naive_phase(q, P, stream);
        k = hi;
    }
}
```

```cpp
#include <hip/hip_runtime.h>
#include <hip/hip_bf16.h>
#include <cstdio>
#include <cstdint>
#ifndef SGU_REP
#define SGU_REP 1
#ifndef EPI_PROBE
#define EPI_PROBE 0
#endif
#define EPI_PREF 1
#endif
#ifndef Y_F8
#define Y_F8 1
#endif
#ifndef GATE_U8
#define GATE_U8 1
#endif
#ifndef H1_BF16
#define H1_BF16 1
#endif
#ifndef WGM_IN
#define WGM_IN 2
#endif
#ifndef WGM_MID
#define WGM_MID 2
#endif
#ifndef WGM_GU
#define WGM_GU 2
#endif
#ifndef WGM_DN
#define WGM_DN 2
#endif
#ifndef P3_FUSED
#define P3_FUSED 1
#endif
#ifndef IN_I8
#define IN_I8 1
#endif
#define IN_BF_TILES 2
#ifndef MOE_F8
#define MOE_F8 1
#endif
#ifndef MOE_I8
#define MOE_I8 1
#endif
#ifndef PROBE_K
#define PROBE_K -1
#endif

typedef unsigned short bf16;
typedef short bf16x8 __attribute__((ext_vector_type(8)));
typedef float f32x4 __attribute__((ext_vector_type(4)));
typedef unsigned u32x4 __attribute__((ext_vector_type(4)));
typedef unsigned u32x2 __attribute__((ext_vector_type(2)));
typedef int i32x4 __attribute__((ext_vector_type(4)));
typedef int i32x8 __attribute__((ext_vector_type(8)));
typedef int i32x8a __attribute__((ext_vector_type(8), aligned(16)));

constexpr int T = 16384, D = 1024, SEQ = 4096, NBATCH = 4, NH = 8, HD = 64, AW = 512, SW = 512, NIN = 4608;
constexpr int NE = 32, TOPK = 4, DE = 1024, MB = 256  , NBLK = SEQ / MB  ;
constexpr int NROWS_PAD = 73728;
constexpr float EPS = 1e-5f;
constexpr float C2 = 0.125f * 1.4426950408889634f;
constexpr float LOG2E = 1.4426950408889634f;

constexpr size_t MiB = 1u << 20;
constexpr size_t WS_CTL = 0, CTL_ZERO_BYTES = 1 * MiB;
constexpr size_t WS_WIN = 2 * MiB, WS_WA = 12 * MiB, WS_WS = 13 * MiB, WS_WM = 14 * MiB, WS_WR = 16 * MiB;
constexpr size_t WS_WGU = 32 * MiB, WS_WD = 160 * MiB, WS_XN = 224 * MiB;
constexpr size_t WS_Q = 256 * MiB, WS_K = 272 * MiB, WS_V = 288 * MiB, WS_U = 304 * MiB, WS_VV = 320 * MiB, WS_O = 336 * MiB, WS_SG = 352 * MiB;
constexpr size_t WS_GA = 368 * MiB, WS_GS = 400 * MiB, WS_MG = 432 * MiB, WS_H1 = 464 * MiB, WS_H1B = 528 * MiB;
constexpr size_t WS_LIST = 560 * MiB, WS_TOKSLOT = 562 * MiB, WS_TOKW = 563 * MiB, WS_RSTD2 = 564 * MiB, WS_STATS = 565 * MiB, WS_RLIST = 566 * MiB, WS_HIST = 568 * MiB;
constexpr size_t WS_HID = 576 * MiB, WS_Y = 720 * MiB, WS_H1Q = 864 * MiB  , WS_SB = 569 * MiB  ,
    WS_SBIN = WS_SB + 256 * 1024  , WS_SXN = WS_SB + 320 * 1024  , WS_WSP = WS_SB + 384 * 1024  , WS_XNQ = 880 * MiB  , WS_WINQ = 896 * MiB  , WS_END = 900 * MiB;
constexpr int CW_TMO = 0, CW_CODE = 1, CW_BAR = 4096  , CW_CNT = 32768  , CW_KM = 65536  ;

struct Ptrs {
    const float *x, *mix_g, *w_in, *w_attn_out, *ln_g, *ln_b, *w_sp, *b_sp, *w_sgu_out, *w_mix_out, *ffn_g, *w_router, *b_router, *w_gu, *b_gu, *w_down, *b_down, *fin_g;
    float* out; unsigned char* ws;
};

__device__ __forceinline__ unsigned f2bf(float f) { unsigned u = __builtin_bit_cast(unsigned, f); return (u + 0x7fffu + ((u >> 16) & 1u)) >> 16; }
__device__ __forceinline__ float bf2f(unsigned h) { return __builtin_bit_cast(float, (h & 0xffffu) << 16); }
__device__ __forceinline__ float wave_sum(float v) {
#pragma unroll
    for (int o = 1; o < 64; o <<= 1) v += __shfl_xor(v, o);
    return v;
}
__device__ __forceinline__ float wave_max(float v) {
#pragma unroll
    for (int o = 1; o < 64; o <<= 1) v = fmaxf(v, __shfl_xor(v, o));
    return v;
}
__device__ __forceinline__ float gelu_erf(float v) { return 0.5f * v * (1.f + erff(v * 0.70710678118654752f)); }
__device__ __forceinline__ float sigmoidf(float v) { return 1.f / (1.f + __expf(-v)); }
__device__ __forceinline__ float swiglu(float g, float u) {
    g = fminf(g, 7.f); u = fminf(fmaxf(u, -7.f), 7.f);
    return g * (1.f / (1.f + __expf(-1.702f * g))) * (u + 1.f);
}

__global__ __launch_bounds__(256) void n_cvtT(const float* W, bf16* WT, int K, int N, const float* kscale) {
    __shared__ float t[32][33];
    const size_t boff = (size_t)blockIdx.z * K * N; W += boff; WT += boff;
    const int k0 = blockIdx.y * 32, n0 = blockIdx.x * 32, tx = threadIdx.x & 31, ty = threadIdx.x >> 5;
    for (int i = ty; i < 32; i += 8) t[i][tx] = W[(size_t)(k0 + i) * N + n0 + tx] * (kscale ? kscale[k0 + i] : 1.f);
    __syncthreads();
    for (int i = ty; i < 32; i += 8) WT[(size_t)(n0 + i) * K + k0 + tx] = (bf16)f2bf(t[tx][i]);
}
__global__ void n_cvt_router(const float* w, const float* g, bf16* hi, bf16* lo) {
    const int i = blockIdx.x * blockDim.x + threadIdx.x; if (i >= NE * D) return;
    const int e = i / D, k = i % D; const float v = w[(size_t)k * NE + e] * g[k];
    const unsigned h = f2bf(v); hi[i] = (bf16)h; lo[i] = (bf16)f2bf(v - bf2f(h));
}
__global__ __launch_bounds__(256) void n_rmsnorm(const float* x, const float* g, bf16* xn) {
    const int row = blockIdx.x * 4 + (threadIdx.x >> 6), lane = threadIdx.x & 63;
    const f32x4* xr = (const f32x4*)(x + (size_t)row * D) + lane; f32x4 v[4]; float s = 0.f;
#pragma unroll
    for (int j = 0; j < 4; ++j) { v[j] = xr[64 * j]; s += v[j].x * v[j].x + v[j].y * v[j].y + v[j].z * v[j].z + v[j].w * v[j].w; }
    const float rstd = 1.f / sqrtf(wave_sum(s) * (1.f / D) + EPS);
#pragma unroll
    for (int j = 0; j < 4; ++j) { const f32x4 gg = ((const f32x4*)g)[lane + 64 * j];
        u32x2 o; o.x = f2bf(v[j].x * rstd * gg.x) | (f2bf(v[j].y * rstd * gg.y) << 16); o.y = f2bf(v[j].z * rstd * gg.z) | (f2bf(v[j].w * rstd * gg.w) << 16);
        *((u32x2*)(xn + (size_t)row * D) + lane + 64 * j) = o; }
}

__device__ __forceinline__ void wave_gemm64(const bf16* a0, const bf16* a1, const bf16* a2, const bf16* a3, const bf16* b0, const bf16* b1, const bf16* b2, const bf16* b3, int K, f32x4 (&acc)[4][4]) {
    for (int k = 0; k < K; k += 32) {
        bf16x8 a[4], b[4];
        a[0] = *(const bf16x8*)(a0 + k); a[1] = *(const bf16x8*)(a1 + k); a[2] = *(const bf16x8*)(a2 + k); a[3] = *(const bf16x8*)(a3 + k);
        b[0] = *(const bf16x8*)(b0 + k); b[1] = *(const bf16x8*)(b1 + k); b[2] = *(const bf16x8*)(b2 + k); b[3] = *(const bf16x8*)(b3 + k);
#pragma unroll
        for (int mi = 0; mi < 4; ++mi)
#pragma unroll
            for (int ni = 0; ni < 4; ++ni) acc[mi][ni] = __builtin_amdgcn_mfma_f32_16x16x32_bf16(a[mi], b[ni], acc[mi][ni], 0, 0, 0);
    }
}
#define ZERO_ACC(acc) _Pragma("unroll") for (int _a = 0; _a < 4; ++_a) _Pragma("unroll") for (int _b = 0; _b < 4; ++_b) acc[_a][_b] = (f32x4){0.f, 0.f, 0.f, 0.f}

enum { EPI_IN = 0, EPI_MG1 = 1, EPI_MG2 = 2, EPI_H1 = 3 };
template <int MODE>
__global__ __launch_bounds__(256) void n_gemm(const bf16* A, int lda, const bf16* Bt, int ldb, int K, Ptrs P) {
    const int lane = threadIdx.x & 63, w = threadIdx.x >> 6, wy = w >> 1, wx = w & 1;
    const int row0 = blockIdx.y * 128 + wy * 64, col0 = blockIdx.x * 128 + wx * 64;
    const int lr = lane & 15, lq = lane >> 4;
    const bf16* ap = A + (size_t)(row0 + lr) * lda + 8 * lq; const bf16* bp = Bt + (size_t)(col0 + lr) * ldb + 8 * lq;
    f32x4 acc[4][4]; ZERO_ACC(acc);
    wave_gemm64(ap, ap + 16 * (size_t)lda, ap + 32 * (size_t)lda, ap + 48 * (size_t)lda, bp, bp + 16 * (size_t)ldb, bp + 32 * (size_t)ldb, bp + 48 * (size_t)ldb, K, acc);
    unsigned char* ws = P.ws;
#pragma unroll
    for (int mi = 0; mi < 4; ++mi)
#pragma unroll
        for (int ni = 0; ni < 4; ++ni)
#pragma unroll
            for (int j = 0; j < 4; ++j) {
                const int row = row0 + 16 * mi + lq * 4 + j, col = col0 + 16 * ni + lr; const float v = acc[mi][ni][j];
                if (MODE == EPI_IN) {
                    if (col < 512) ((bf16*)(ws + WS_Q))[(size_t)row * 512 + col] = (bf16)f2bf(v * C2);
                    else if (col < 1024) ((bf16*)(ws + WS_K))[(size_t)row * 512 + col - 512] = (bf16)f2bf(v);
                    else if (col < 1536) ((bf16*)(ws + WS_V))[(size_t)row * 512 + col - 1024] = (bf16)f2bf(v);
                    else if (col < 2048) ((bf16*)(ws + WS_U))[(size_t)row * 512 + col - 1536] = (bf16)f2bf(gelu_erf(v));
                    else if (col < 2560) ((bf16*)(ws + WS_VV))[(size_t)row * 512 + col - 2048] = (bf16)f2bf(gelu_erf(v));
                    else if (col < 3584) ((bf16*)(ws + WS_GA))[(size_t)row * 1024 + col - 2560] = (bf16)f2bf(sigmoidf(v));
                    else ((bf16*)(ws + WS_GS))[(size_t)row * 1024 + col - 3584] = (bf16)f2bf(sigmoidf(v));
                } else if (MODE == EPI_MG1) {
                    const size_t o = (size_t)row * 1024 + col; ((bf16*)(ws + WS_MG))[o] = (bf16)f2bf(v * bf2f(((const bf16*)(ws + WS_GA))[o]));
                } else if (MODE == EPI_MG2) {
                    const size_t o = (size_t)row * 1024 + col; bf16* mg = (bf16*)(ws + WS_MG); mg[o] = (bf16)f2bf(bf2f(mg[o]) + v * bf2f(((const bf16*)(ws + WS_GS))[o]));
                } else {
                    const size_t o = (size_t)row * 1024 + col; const float h = P.x[o] + v; ((float*)(ws + WS_H1))[o] = h; ((bf16*)(ws + WS_H1B))[o] = (bf16)f2bf(h);
                }
            }
}
__global__ void n_kmean(const bf16* Kb, float* KM) {
    const int i = blockIdx.x * blockDim.x + threadIdx.x; if (i >= NBATCH * NBLK * AW) return;
    const int c = i % AW, bb = i / AW; float s = 0.f;
    for (int r = 0; r < MB; ++r) s += bf2f(Kb[(size_t)(bb * MB + r) * AW + c]);
    KM[i] = s * (1.f / MB);
}
__global__ __launch_bounds__(256) void n_attn(const bf16* Q, const bf16* Kb, const bf16* Vb, const float* KM, bf16* O) {
    __shared__ float qs[4][64];
    const int lane = threadIdx.x & 63, w = threadIdx.x >> 6, gw = blockIdx.x * 4 + w, tok = gw >> 3, h = gw & 7;
    const int b = tok / SEQ, t = tok % SEQ, blk = t / MB;
    const float qd = bf2f(Q[(size_t)tok * AW + h * HD + lane]);
    qs[w][lane] = qd; __syncthreads();
    float g[16];
#pragma unroll
    for (int j = 0; j < 16; ++j) { float p = (j < blk) ? qd * KM[(size_t)(b * NBLK + j) * AW + h * HD + lane] : 0.f; p = wave_sum(p); g[j] = (j < blk) ? p : -INFINITY; }
    int sel[4];
#pragma unroll
    for (int s = 0; s < 3; ++s) { int best = -1; float bv = -INFINITY;
#pragma unroll
        for (int j = 0; j < 16; ++j) if (g[j] > bv) { bv = g[j]; best = j; }
#pragma unroll
        for (int j = 0; j < 16; ++j) if (j == best) g[j] = -INFINITY;
        sel[s] = best; }
    sel[3] = blk;
    const float slope2 = exp2f(-(float)(h + 1)) * LOG2E;
    float sc[16];
#pragma unroll
    for (int s = 0; s < 4; ++s) {
        const int kb = sel[s];
#pragma unroll
        for (int c = 0; c < 4; ++c) {
            float v = -INFINITY;
            if (kb >= 0) { const int key = kb * MB + c * 64 + lane;
                if (key <= t) { const bf16* kr = Kb + (size_t)(b * SEQ + key) * AW + h * HD; float a = 0.f;
                    for (int d8 = 0; d8 < 8; ++d8) { const u32x4 kk = *(const u32x4*)(kr + d8 * 8);
#pragma unroll
                        for (int e = 0; e < 4; ++e) { a += qs[w][d8 * 8 + 2 * e] * bf2f(kk[e] & 0xffffu) + qs[w][d8 * 8 + 2 * e + 1] * bf2f(kk[e] >> 16); } }
                    v = a + slope2 * (float)(key - t); } }
            sc[s * 4 + c] = v; }
    }
    float m = sc[0];
#pragma unroll
    for (int i = 1; i < 16; ++i) m = fmaxf(m, sc[i]);
    m = wave_max(m); float l = 0.f;
#pragma unroll
    for (int i = 0; i < 16; ++i) { sc[i] = (sc[i] == -INFINITY) ? 0.f : exp2f(sc[i] - m); l += sc[i]; }
    l = wave_sum(l); float o = 0.f;
#pragma unroll
    for (int s = 0; s < 4; ++s) { const int kb = sel[s]; if (kb < 0) continue;
#pragma unroll
        for (int c = 0; c < 4; ++c) { const int key0 = kb * MB + c * 64; if (key0 > t) continue;
            const bf16* vr = Vb + (size_t)(b * SEQ + key0) * AW + h * HD + lane;
            for (int kl = 0; kl < 64; ++kl) { const float p = __shfl(sc[s * 4 + c], kl); o += p * bf2f(vr[(size_t)kl * AW]); } } }
    O[(size_t)tok * AW + h * HD + lane] = (bf16)f2bf(o / l);
}
__global__ __launch_bounds__(256) void n_sgu_stats(const bf16* VV, float* stats) {
    const int row = blockIdx.x * 4 + (threadIdx.x >> 6), lane = threadIdx.x & 63;
    const u32x4 r = *((const u32x4*)(VV + (size_t)row * SW) + lane); float v[8];
#pragma unroll
    for (int e = 0; e < 4; ++e) { v[2 * e] = bf2f(r[e] & 0xffffu); v[2 * e + 1] = bf2f(r[e] >> 16); }
    float s = 0.f;
#pragma unroll
    for (int e = 0; e < 8; ++e) s += v[e];
    const float mu = wave_sum(s) * (1.f / SW); float q = 0.f;
#pragma unroll
    for (int e = 0; e < 8; ++e) q += (v[e] - mu) * (v[e] - mu);
    const float rstd = 1.f / sqrtf(wave_sum(q) * (1.f / SW) + EPS);
    if (lane == 0) { stats[2 * row] = mu; stats[2 * row + 1] = rstd; }
}
__global__ __launch_bounds__(256) void n_sgu(const bf16* U, const bf16* VV, const float* stats, Ptrs P, bf16* SG) {
    const int i = blockIdx.x * 256 + threadIdx.x, tok = i / SW, c = i % SW, g = c / 64, tl = tok % 128, s0 = tok - tl;
    const float lg = P.ln_g[c], lb = P.ln_b[c]; const float* wr = P.w_sp + ((size_t)g * 128 + tl) * 128; float a = 0.f;
    for (int s = 0; s <= tl; ++s) { const float vn = (bf2f(VV[(size_t)(s0 + s) * SW + c]) - stats[2 * (s0 + s)]) * stats[2 * (s0 + s) + 1] * lg + lb; a += wr[s] * vn; }
    SG[i] = (bf16)f2bf(bf2f(U[i]) * (a + P.b_sp[g * 128 + tl]));
}
__global__ __launch_bounds__(256) void n_router(Ptrs P) {
    unsigned char* ws = P.ws; const int tok = blockIdx.x * 4 + (threadIdx.x >> 6), lane = threadIdx.x & 63;
    const f32x4* hr = (const f32x4*)((const float*)(ws + WS_H1) + (size_t)tok * D) + lane; f32x4 v[4]; float s = 0.f;
#pragma unroll
    for (int j = 0; j < 4; ++j) { v[j] = hr[64 * j]; s += v[j].x * v[j].x + v[j].y * v[j].y + v[j].z * v[j].z + v[j].w * v[j].w; }
    const float rstd = 1.f / sqrtf(wave_sum(s) * (1.f / D) + EPS);
#pragma unroll
    for (int j = 0; j < 4; ++j) { const f32x4 gg = ((const f32x4*)P.ffn_g)[lane + 64 * j]; v[j] = v[j] * gg; }
    float lg[32];
#pragma unroll
    for (int e = 0; e < 32; ++e) { float a = 0.f;
#pragma unroll
        for (int j = 0; j < 4; ++j) { const float* wr = P.w_router + (size_t)(4 * lane + 256 * j) * NE + e; a += v[j].x * wr[0] + v[j].y * wr[NE] + v[j].z * wr[2 * NE] + v[j].w * wr[3 * NE]; }
        lg[e] = wave_sum(a) * rstd + P.b_router[e]; }
    int idx[4]; float val[4];
#pragma unroll
    for (int k = 0; k < 4; ++k) { int best = 0; float bv = -INFINITY;
#pragma unroll
        for (int e = 0; e < 32; ++e) if (lg[e] > bv) { bv = lg[e]; best = e; }
#pragma unroll
        for (int e = 0; e < 32; ++e) if (e == best) lg[e] = -INFINITY;
        idx[k] = best; val[k] = bv; }
    float den = 0.f, pw[4];
#pragma unroll
    for (int k = 0; k < 4; ++k) { pw[k] = __expf(val[k] - val[0]); den += pw[k]; }
    if (lane == 0) {
        unsigned* ctl = (unsigned*)(ws + WS_CTL); int* list = (int*)(ws + WS_LIST); unsigned* slot = (unsigned*)(ws + WS_TOKSLOT); float* tw = (float*)(ws + WS_TOKW);
#pragma unroll
        for (int k = 0; k < 4; ++k) { const unsigned pos = atomicAdd(ctl + CW_CNT + 64 * idx[k], 1u); list[(size_t)idx[k] * T + pos] = tok;
            slot[tok * 4 + k] = (unsigned)idx[k] | (pos << 8); tw[tok * 4 + k] = pw[k] / den; }
        ((float*)(ws + WS_RSTD2))[tok] = rstd;
        for (int k = 0; k < 4; ++k) { const unsigned s2 = slot[tok * 4 + k]; ((float*)(ws + WS_RLIST))[(size_t)(s2 & 0xff) * T + (s2 >> 8)] = rstd; }
    }
}
__device__ __forceinline__ bool tile_lookup(const unsigned* ctl, int mt, int& e, int& lt, int& cnt) {
    int base = 0;
    for (int i = 0; i < NE; ++i) { const int c = (int)ctl[CW_CNT + 64 * i], nt = (c + 255) >> 8; if (mt < base + nt) { e = i; lt = mt - base; cnt = c; return true; } base += nt; }
    return false;
}
__device__ __forceinline__ int expert_rowbase(const unsigned* ctl, int e) { int base = 0; for (int i = 0; i < e; ++i) base += ((int)ctl[CW_CNT + 64 * i] + 255) >> 8; return base * 256; }
__global__ __launch_bounds__(256) void n_moe_gu(Ptrs P) {
    unsigned char* ws = P.ws; const unsigned* ctl = (const unsigned*)(ws + WS_CTL);
    const int lane = threadIdx.x & 63, w = threadIdx.x >> 6, wy = w >> 1, wx = w & 1, lr = lane & 15, lq = lane >> 4;
    const int mt = blockIdx.y >> 1; int e, lt, cnt; if (!tile_lookup(ctl, mt, e, lt, cnt)) return;
    const int* list = (const int*)(ws + WS_LIST) + (size_t)e * T; const bf16* A = (const bf16*)(ws + WS_H1B); const bf16* Bt = (const bf16*)(ws + WS_WGU) + (size_t)e * 2048 * D;
    const int prow0 = lt * 256 + (blockIdx.y & 1) * 128 + wy * 64;
    const int j0 = blockIdx.x * 128 + wx * 64;
    const bf16* ap[4];
#pragma unroll
    for (int i = 0; i < 4; ++i) { const int pos = prow0 + 16 * i + lr; const int tok = list[pos < cnt ? pos : lt * 256]; ap[i] = A + (size_t)tok * D + 8 * lq; }
    const bf16* bg = Bt + (size_t)(2 * (j0 + lr)) * D + 8 * lq; const bf16* bu = bg + D;
    f32x4 accg[4][4], accu[4][4]; ZERO_ACC(accg); ZERO_ACC(accu);
    wave_gemm64(ap[0], ap[1], ap[2], ap[3], bg, bg + 32 * (size_t)D, bg + 64 * (size_t)D, bg + 96 * (size_t)D, D, accg);
    wave_gemm64(ap[0], ap[1], ap[2], ap[3], bu, bu + 32 * (size_t)D, bu + 64 * (size_t)D, bu + 96 * (size_t)D, D, accu);
    const float* rs = (const float*)(ws + WS_RSTD2); const float* bgu = P.b_gu + (size_t)e * 2048; bf16* HID = (bf16*)(ws + WS_HID);
#pragma unroll
    for (int mi = 0; mi < 4; ++mi)
#pragma unroll
        for (int j = 0; j < 4; ++j) { const int pos = prow0 + 16 * mi + lq * 4 + j; const int tok = list[pos < cnt ? pos : lt * 256]; const float r = rs[tok];
            const size_t orow = (size_t)mt * 256 + (blockIdx.y & 1) * 128 + wy * 64 + 16 * mi + lq * 4 + j;
#pragma unroll
            for (int ni = 0; ni < 4; ++ni) { const int jc = j0 + 16 * ni + lr; HID[orow * DE + jc] = (bf16)f2bf(swiglu(accg[mi][ni][j] * r + bgu[2 * jc], accu[mi][ni][j] * r + bgu[2 * jc + 1])); } }
}
__global__ __launch_bounds__(256) void n_moe_down(Ptrs P) {
    unsigned char* ws = P.ws; const unsigned* ctl = (const unsigned*)(ws + WS_CTL);
    const int lane = threadIdx.x & 63, w = threadIdx.x >> 6, wy = w >> 1, wx = w & 1, lr = lane & 15, lq = lane >> 4;
    const int mt = blockIdx.y >> 1; int e, lt, cnt; if (!tile_lookup(ctl, mt, e, lt, cnt)) return;
    const int row0 = blockIdx.y * 128 + wy * 64, col0 = blockIdx.x * 128 + wx * 64;
    const bf16* ap = (const bf16*)(ws + WS_HID) + (size_t)(row0 + lr) * DE + 8 * lq; const bf16* bp = (const bf16*)(ws + WS_WD) + ((size_t)e * D + col0 + lr) * DE + 8 * lq;
    f32x4 acc[4][4]; ZERO_ACC(acc);
    wave_gemm64(ap, ap + 16 * (size_t)DE, ap + 32 * (size_t)DE, ap + 48 * (size_t)DE, bp, bp + 16 * (size_t)DE, bp + 32 * (size_t)DE, bp + 48 * (size_t)DE, DE, acc);
    bf16* Y = (bf16*)(ws + WS_Y); const float* bd = P.b_down + (size_t)e * D;
#pragma unroll
    for (int mi = 0; mi < 4; ++mi)
#pragma unroll
        for (int ni = 0; ni < 4; ++ni)
#pragma unroll
            for (int j = 0; j < 4; ++j) { const int row = row0 + 16 * mi + lq * 4 + j, col = col0 + 16 * ni + lr; Y[(size_t)row * D + col] = (bf16)f2bf(acc[mi][ni][j] + bd[col]); }
}
__global__ __launch_bounds__(256) void n_combine(Ptrs P) {
    unsigned char* ws = P.ws; const unsigned* ctl = (const unsigned*)(ws + WS_CTL);
    const int tok = blockIdx.x * 4 + (threadIdx.x >> 6), lane = threadIdx.x & 63;
    const f32x4* hr = (const f32x4*)((const float*)(ws + WS_H1) + (size_t)tok * D) + lane; f32x4 v[4];
#pragma unroll
    for (int j = 0; j < 4; ++j) v[j] = hr[64 * j];
    const unsigned* slot = (const unsigned*)(ws + WS_TOKSLOT) + tok * 4; const float* tw = (const float*)(ws + WS_TOKW) + tok * 4; const bf16* Y = (const bf16*)(ws + WS_Y);
    for (int k = 0; k < 4; ++k) { const unsigned s = slot[k]; const int e = s & 0xff, pos = s >> 8; const float wgt = tw[k];
        const bf16* yr = Y + (size_t)(expert_rowbase(ctl, e) + pos) * D;
#pragma unroll
        for (int j = 0; j < 4; ++j) { const u32x2 y = *((const u32x2*)yr + lane + 64 * j);
            v[j].x += wgt * bf2f(y.x & 0xffffu); v[j].y += wgt * bf2f(y.x >> 16); v[j].z += wgt * bf2f(y.y & 0xffffu); v[j].w += wgt * bf2f(y.y >> 16); } }
    float s = 0.f;
#pragma unroll
    for (int j = 0; j < 4; ++j) s += v[j].x * v[j].x + v[j].y * v[j].y + v[j].z * v[j].z + v[j].w * v[j].w;
    const float rstd = 1.f / sqrtf(wave_sum(s) * (1.f / D) + EPS);
#pragma unroll
    for (int j = 0; j < 4; ++j) { const f32x4 gg = ((const f32x4*)P.fin_g)[lane + 64 * j]; *((f32x4*)(P.out + (size_t)tok * D) + lane + 64 * j) = v[j] * rstd * gg; }
}

#define GAS __attribute__((address_space(1)))
#define LAS __attribute__((address_space(3)))
typedef float f32x2 __attribute__((ext_vector_type(2)));
typedef float f32x16 __attribute__((ext_vector_type(16)));
constexpr int NWAVES = 8;
constexpr int RING_BYTES = 131072;
constexpr int LX_BAR = RING_BYTES, LX_TBASE = RING_BYTES + 64, LX_TILEE = RING_BYTES + 256, LX_ROWBASE = RING_BYTES + 2048, LX_MISC = RING_BYTES + 4096;
constexpr int LDS_BYTES = 147456;
constexpr int LX_EPI = RING_BYTES + 8192;

typedef __bf16 bf16x2_t __attribute__((ext_vector_type(2)));
__device__ __forceinline__ unsigned cvt_pk_bf16(float lo, float hi) { const f32x2 v = {lo, hi}; const bf16x2_t b = __builtin_convertvector(v, bf16x2_t); return __builtin_bit_cast(unsigned, b); }
__device__ __forceinline__ f32x2 gelu_pk(f32x2 v) {
    const f32x2 av = __builtin_elementwise_abs(v), d = av * 0.2316418882f + 1.0f;
    f32x2 t; t.x = __builtin_amdgcn_rcpf(d.x); t.y = __builtin_amdgcn_rcpf(d.y);
    f32x2 q = t * 0.5307027145f + (-0.7265760135f); q = q * t + 0.7107068705f; q = q * t + (-0.142248368f); q = q * t + 0.127414796f; q = q * t;
    const f32x2 s = (v * v) * (-0.72134752044f);
    f32x2 e; e.x = __builtin_amdgcn_exp2f(s.x); e.y = __builtin_amdgcn_exp2f(s.y);
    const f32x2 m = v * (q * e), r = v - m;
    f32x2 o; o.x = v.x < 0.f ? m.x : r.x; o.y = v.y < 0.f ? m.y : r.y; return o;
}
__device__ __forceinline__ float fast_sigmoid(float v) { return __builtin_amdgcn_rcpf(1.f + __builtin_amdgcn_exp2f(-LOG2E * v)); }
__device__ __forceinline__ float fast_swiglu(float g, float u) {
    g = fminf(g, 7.f); u = fminf(fmaxf(u, -7.f), 7.f);
    return g * __builtin_amdgcn_rcpf(1.f + __builtin_amdgcn_exp2f(-1.702f * LOG2E * g)) * (u + 1.f);
}

__device__ __forceinline__ float folded_swiglu(float t, float w) {
    constexpr float CC = -1.702f * LOG2E;
    t = __builtin_fmaxf(t, 7.f * CC); w = __builtin_amdgcn_fmed3f(w, 8.f / CC, -6.f / CC);
    return t * __builtin_amdgcn_rcpf(1.f + __builtin_amdgcn_exp2f(t)) * w;
}

#define XB_TMO      128
#define XB_XCNT(j)  (256  + 64 * (j))
#define XB_XSUB(j)  (1280 + 64 * (j))
#define XB_XGEN(j)  (2304 + 64 * (j))
#define XB_TOP      3328
#define XB_TOPGEN   3392
#define XCD_BAR_WORDS 3456
#define XB_SPIN_CAP (1u << 18)
__device__ __forceinline__ unsigned xb_ld(unsigned* p)              { return __hip_atomic_load(p, __ATOMIC_RELAXED, __HIP_MEMORY_SCOPE_AGENT); }
__device__ __forceinline__ unsigned xb_add(unsigned* p, unsigned v) { return __hip_atomic_fetch_add(p, v, __ATOMIC_RELAXED, __HIP_MEMORY_SCOPE_AGENT); }
__device__ __forceinline__ unsigned xb_xcc_id() { return (unsigned)__builtin_amdgcn_s_getreg((3 << 11) | 20) & 0xFu; }
#define XB_SPIN(cond, bar) do { unsigned _sp = 0; while (cond) { __builtin_amdgcn_s_sleep(1); \
    if ((++_sp & 255u) == 0u) { if (xb_ld(&(bar)[XB_TMO])) break; if (_sp > XB_SPIN_CAP) { atomicAdd(&(bar)[XB_TMO], 1u); break; } } } } while (0)
struct XcdBarrier { unsigned* bar; unsigned x; volatile LAS unsigned* st; };
__device__ __forceinline__ XcdBarrier xcd_barrier_post(unsigned* bar, volatile LAS unsigned* st) {
    XcdBarrier b; b.bar = bar; b.x = xb_xcc_id(); b.st = st;
    if (threadIdx.x == 0) (void)xb_add(&bar[XB_XCNT(b.x)], 1u);
    return b;
}
__device__ __forceinline__ void xcd_barrier_complete(unsigned* bar, unsigned x, unsigned& nloc, unsigned& nx) {
    const unsigned G = gridDim.x * gridDim.y * gridDim.z;
    unsigned sum, cnt, mine, sp = 0u;
    for (;;) {
        sum = 0u; cnt = 0u; mine = 0u;
#pragma unroll
        for (unsigned j = 0; j < 16; ++j) { const unsigned c = xb_ld(&bar[XB_XCNT(j)]); sum += c; cnt += (c > 0u) ? 1u : 0u; mine = (j == x) ? c : mine; }
        if (sum == G) break;
        __builtin_amdgcn_s_sleep(1);
        if ((++sp & 255u) == 0u) { if (xb_ld(&bar[XB_TMO])) break; if (sp > XB_SPIN_CAP) { atomicAdd(&bar[XB_TMO], 1u); break; } }
    }
    nloc = mine > 0u ? mine : 1u; nx = cnt > 0u ? cnt : 1u;
}
__device__ __forceinline__ void xcd_barrier(const XcdBarrier& b) {
    asm volatile("s_waitcnt vmcnt(0)" ::: "memory");
    __syncthreads();
    if (threadIdx.x == 0) {
        unsigned* bar = b.bar;
        __builtin_amdgcn_s_waitcnt(0);
        unsigned nloc = b.st[0], nx = b.st[1];
        if (nloc == 0u) { xcd_barrier_complete(bar, b.x, nloc, nx); b.st[0] = nloc; b.st[1] = nx; }
        const unsigned old = xb_add(&bar[XB_XSUB(b.x)], 1u);
        const unsigned gen = old / nloc;
        if (old + 1u == (gen + 1u) * nloc) {
            __builtin_amdgcn_fence(__ATOMIC_RELEASE, "agent");
            asm volatile("s_waitcnt vmcnt(0)" ::: "memory");
            const unsigned og = xb_add(&bar[XB_TOP], 1u);
            const unsigned tg = og / nx;
            if (og + 1u == (tg + 1u) * nx) xb_add(&bar[XB_TOPGEN], 1u);
            else XB_SPIN(xb_ld(&bar[XB_TOPGEN]) == tg, bar);
            __builtin_amdgcn_fence(__ATOMIC_ACQUIRE, "agent");
            xb_add(&bar[XB_XGEN(b.x)], 1u);
            asm volatile("s_waitcnt vmcnt(0)" ::: "memory");
        } else {
            XB_SPIN(xb_ld(&bar[XB_XGEN(b.x)]) == gen, bar);
            __builtin_amdgcn_fence(__ATOMIC_ACQUIRE, "agent");
            asm volatile("s_waitcnt vmcnt(0)" ::: "memory");
        }
    }
    __syncthreads();
}

namespace pg8 {
constexpr int BM = 256, BK = 64, HALF = 128, HTB = HALF * BK * 2, STAGE_BYTES = 8 * HTB, NXCD = 8;
__host__ __device__ __forceinline__ int lds_byte(int r, int c) { const int st = (r >> 4) * 2 + (c >> 5), rr = r & 15, cc = c & 31, ob = rr * 64 + cc * 2; return st * 1024 + (ob ^ (((ob >> 9) & 1) << 5)); }
__host__ __device__ __forceinline__ void stage_rc(int b, int& R, int& C) { const int st = b / 1024, sb = b % 1024, swz = sb ^ (((sb >> 9) & 1) << 5); R = (st >> 1) * 16 + swz / 64; C = (st & 1) * 32 + (swz % 64) / 2; }
__host__ __device__ __forceinline__ int perm32(int rho) { const int n = rho >> 4, i = rho & 15; return 8 * (i >> 2) + 4 * n + (i & 3); }

struct Unit { int pm, pn, e, lt, cnt, par; };

__device__ __forceinline__ void order_map(int L, int nM, int nN, int& pm, int& pn, int WGM) {
    const int nwg = nM * nN; int wgid = L; { const int q = nwg / NXCD, r = nwg % NXCD, xcd = wgid % NXCD, off = wgid / NXCD; wgid = (xcd < r ? xcd * (q + 1) : r * (q + 1) + (xcd - r) * q) + off; }
    const int nig = WGM * nN, gid = wgid / nig, fm = gid * WGM, gsz = (nM - fm) < WGM ? (nM - fm) : WGM;
    pm = fm + ((wgid % nig) % gsz); pn = (wgid % nig) / gsz;
}

template <class Epi, class Sched, bool ALIGN_EPI>
__device__ __forceinline__ void gemm_phase(LAS unsigned char* lds, const int K, const unsigned ldb, const Sched& S, const Epi& E) {
    const int tid = threadIdx.x, wid = __builtin_amdgcn_readfirstlane(tid >> 6), lane = tid & 63, wr = wid >> 2, wc = wid & 3, fr = lane & 15, fq = lane >> 4;
    const int nt = K / BK;
    int R[2], C[2]; unsigned voffB[2];
#pragma unroll
    for (int i = 0; i < 2; ++i) { stage_rc(tid * 16 + i * 8192, R[i], C[i]); const int Rb = (R[i] & ~31) + perm32(R[i] & 31); voffB[i] = (unsigned)(Rb * (int)ldb + C[i]) * 2u; }
    const unsigned kstep = (unsigned)(BK * 2);
    const size_t hstepB = (size_t)HALF * ldb * 2;
    const unsigned ldsw = (unsigned)wid * 1024u;
    constexpr int MODE = Epi::MODE; constexpr int KST = 1024;
    const int c8 = fq * 8;
    const int aoff = lds_byte(wr * 64 + fr, c8), boff = lds_byte(wc * 32 + fr, c8);
#define PG8_SA(b, h) (((b) * 2 + (h)) * HTB)
#define PG8_SB(b, h) ((4 + (b) * 2 + (h)) * HTB)
#define PG8_STAGE(bufoff, gbase, voff) do { _Pragma("unroll") for (int _i = 0; _i < 2; ++_i) \
        __builtin_amdgcn_global_load_lds((const unsigned*)((const char*)(gbase) + (voff)[_i]), (LAS unsigned*)(lds + (bufoff) + ldsw + _i * 8192), 16, 0, 0); } while (0)
#define PG8_LD32(p) __builtin_shufflevector(*(const LAS i32x4*)(p), *(const LAS i32x4*)((p) + KST), 0, 1, 2, 3, 4, 5, 6, 7)
#define PG8_LDA(dst, b, h) do { if constexpr (MODE == 2) { _Pragma("unroll") for (int m = 0; m < 4; ++m) dst##8[m] = PG8_LD32(lds + PG8_SA(b, h) + aoff + m * 2048); } \
        else { _Pragma("unroll") for (int m = 0; m < 4; ++m) _Pragma("unroll") for (int k = 0; k < 2; ++k) dst[m][k] = *(const LAS bf16x8*)(lds + PG8_SA(b, h) + aoff + m * 2048 + k * KST); } } while (0)
#define PG8_LDB(dst, b, h) do { if constexpr (MODE == 2) { _Pragma("unroll") for (int n = 0; n < 2; ++n) dst##8[n] = PG8_LD32(lds + PG8_SB(b, h) + boff + n * 2048); } \
        else { _Pragma("unroll") for (int n = 0; n < 2; ++n) _Pragma("unroll") for (int k = 0; k < 2; ++k) dst[n][k] = *(const LAS bf16x8*)(lds + PG8_SB(b, h) + boff + n * 2048 + k * KST); } } while (0)
#define PG8_CAT(x) __builtin_shufflevector(__builtin_bit_cast(i32x4, x[0]), __builtin_bit_cast(i32x4, x[1]), 0, 1, 2, 3, 4, 5, 6, 7)
#define PG8_MMA(ai, bj, At, Bt) do { __builtin_amdgcn_s_setprio(1); _Pragma("unroll") for (int m = 0; m < 4; ++m) _Pragma("unroll") for (int n = 0; n < 2; ++n) { \
        if constexpr (MODE == 2) asm volatile("v_mfma_scale_f32_16x16x128_f8f6f4 %0, %1, %2, %0, %3, %3 op_sel_hi:[0,0,0]" : "+v"(acc[ai][bj][m][n]) : "v"(Bt##8[n]), "v"(At##8[m]), "v"(one_scale)); \
        else { _Pragma("unroll") for (int k = 0; k < 2; ++k) { if constexpr (MODE == 1) acc[ai][bj][m][n] = __builtin_amdgcn_mfma_i32_16x16x64_i8(__builtin_bit_cast(i32x4, Bt[n][k]), __builtin_bit_cast(i32x4, At[m][k]), acc[ai][bj][m][n], 0, 0, 0); \
          else acc[ai][bj][m][n] = __builtin_amdgcn_mfma_f32_16x16x32_bf16(Bt[n][k], At[m][k], acc[ai][bj][m][n], 0, 0, 0); } } } __builtin_amdgcn_s_setprio(0); } while (0)
#define PG8_WAIT_V(n) asm volatile("s_waitcnt vmcnt(" #n ")" ::: "memory")
#define PG8_WAIT_L(n) asm volatile("s_waitcnt lgkmcnt(" #n ")" ::: "memory")
#define PG8_BAR __builtin_amdgcn_s_barrier()
#define PG8_SCHED __builtin_amdgcn_sched_barrier(0)
#define PG8_PIN4(v) asm volatile("" : "+v"(v[0][0]), "+v"(v[0][1]), "+v"(v[1][0]), "+v"(v[1][1]))
    Unit cur, nxt; int ui = 0;
    if (!S.next(0, cur)) return;
    typedef typename Epi::acc_t acc_t;
    acc_t acc[2][2][4][2];
#pragma unroll
    for (int a = 0; a < 2; ++a)
#pragma unroll
        for (int b = 0; b < 2; ++b)
#pragma unroll
            for (int m = 0; m < 4; ++m)
#pragma unroll
                for (int n = 0; n < 2; ++n) acc[a][b][m][n] = acc_t{};
    bf16x8 At[4][2], B0[2][2], B1[2][2]; i32x8 At8[4], B08[2], B18[2];
    unsigned one_scale = 0x7f7f7f7fu; if constexpr (MODE == 2) asm volatile("" : "+v"(one_scale));
    unsigned cvo[2][2], nvo[2][2];
    const char* const Ab = S.a_base();
    const char* cA = Ab;
    if constexpr (Sched::GATHER) { S.a_off(cur, R, C, cvo); PG8_PIN4(cvo); } else { S.lane_off(R, C, cvo); cA = Ab + S.a_ubase(cur); }
    const char* cB = S.b_ptr(cur);
    cur.par = 0;
    if constexpr (Epi::PREF) { if (wid == 0) E.pref(lds + LX_EPI, cur, lane); }
    PG8_STAGE(PG8_SB(0, 0), cB, voffB); PG8_STAGE(PG8_SB(0, 1), cB + hstepB, voffB); PG8_STAGE(PG8_SA(0, 0), cA, cvo[0]); PG8_STAGE(PG8_SA(0, 1), cA, cvo[1]);
    if (wr == 1) PG8_BAR;
    PG8_WAIT_V(2); PG8_BAR;
    PG8_STAGE(PG8_SB(1, 0), cB + kstep, voffB); PG8_STAGE(PG8_SA(1, 0), cA + kstep, cvo[0]); PG8_STAGE(PG8_SB(1, 1), cB + hstepB + kstep, voffB);
    PG8_WAIT_V(6); PG8_BAR;
    for (;;) {
        const bool has_next = S.next(ui + 1, nxt);
        const char* nA = cA;
        if constexpr (Sched::GATHER) {
            if (has_next) { S.a_off(nxt, R, C, nvo); } else { nvo[0][0] = cvo[0][0]; nvo[0][1] = cvo[0][1]; nvo[1][0] = cvo[1][0]; nvo[1][1] = cvo[1][1]; }
            PG8_PIN4(nvo);
        } else { if (has_next) nA = Ab + S.a_ubase(nxt); }
        const char* nB = has_next ? S.b_ptr(nxt) : cB;
        if constexpr (Epi::PREF) { if (ui > 0 && wid == 0) E.pref(lds + LX_EPI + cur.par * 3072, cur, lane); }
#pragma nounroll
        for (int t = 0; t < nt; t += 2) {
            const bool last = (t == nt - 2);
            if constexpr (Epi::MIDK) { if (t == nt / 2) E.mid(acc, cur, wr, wc, fr, fq); }
            const char* a1 = cA + (size_t)(t + 1) * kstep;
            const char* a2 = last ? nA : cA + (size_t)(t + 2) * kstep; const char* b2 = last ? nB : cB + (size_t)(t + 2) * kstep;
            const char* a3 = a2 + kstep; const char* b3 = b2 + kstep;
            unsigned v2[2][2];
#pragma unroll
            for (int h = 0; h < 2; ++h)
#pragma unroll
                for (int i = 0; i < 2; ++i) v2[h][i] = (Sched::GATHER && last) ? nvo[h][i] : cvo[h][i];
            PG8_LDB(B0, 0, 0); PG8_LDB(B1, 0, 1); PG8_SCHED; PG8_LDA(At, 0, 0); PG8_STAGE(PG8_SA(1, 1), a1, cvo[1]);
            PG8_WAIT_V(8); PG8_WAIT_L(0); PG8_BAR; PG8_MMA(0, 0, At, B0); PG8_MMA(0, 1, At, B1); PG8_BAR; PG8_SCHED;
            PG8_LDA(At, 0, 1); PG8_STAGE(PG8_SB(0, 0), b2, voffB); PG8_STAGE(PG8_SB(0, 1), b2 + hstepB, voffB); PG8_STAGE(PG8_SA(0, 0), a2, v2[0]);
            PG8_WAIT_V(8); PG8_WAIT_L(0); PG8_BAR; PG8_MMA(1, 0, At, B0); PG8_MMA(1, 1, At, B1); PG8_BAR; PG8_SCHED;
            PG8_LDB(B0, 1, 0); PG8_LDB(B1, 1, 1); PG8_SCHED; PG8_LDA(At, 1, 0); PG8_STAGE(PG8_SA(0, 1), a2, v2[1]);
            PG8_WAIT_V(8); PG8_WAIT_L(0); PG8_BAR; PG8_MMA(0, 0, At, B0); PG8_MMA(0, 1, At, B1); PG8_BAR; PG8_SCHED;
            PG8_LDA(At, 1, 1); PG8_STAGE(PG8_SB(1, 0), b3, voffB); PG8_STAGE(PG8_SB(1, 1), b3 + hstepB, voffB); PG8_STAGE(PG8_SA(1, 0), a3, v2[0]);
            PG8_WAIT_V(8); PG8_WAIT_L(0); PG8_BAR; PG8_MMA(1, 0, At, B0); PG8_MMA(1, 1, At, B1); PG8_BAR; PG8_SCHED;
        }
        if constexpr (ALIGN_EPI) { if (wr == 0) PG8_BAR; }
        if constexpr (MODE == 2) asm volatile("s_nop 15\n\ts_nop 15" ::: "memory");
        E(acc, cur, wr, wc, fr, fq);
        if constexpr (EPI_PROBE == 6 && Epi::MODE == 1 && Sched::GATHER) { asm volatile("" ::: "memory"); E(acc, cur, wr, wc, fr, fq); }
        if constexpr (EPI_PROBE == 7 && Epi::MODE == 2) { asm volatile("" ::: "memory"); E(acc, cur, wr, wc, fr, fq); }
        if (!has_next) break;
#pragma unroll
        for (int a = 0; a < 2; ++a)
#pragma unroll
            for (int b = 0; b < 2; ++b)
#pragma unroll
                for (int m = 0; m < 4; ++m)
#pragma unroll
                    for (int n = 0; n < 2; ++n) acc[a][b][m][n] = acc_t{};
        cur = nxt; cB = nB; cA = nA; ++ui; cur.par = ui & 1;
        if constexpr (Sched::GATHER) {
#pragma unroll
        for (int h = 0; h < 2; ++h)
#pragma unroll
            for (int i = 0; i < 2; ++i) cvo[h][i] = nvo[h][i]; }
        if constexpr (ALIGN_EPI) { if (wr == 1) PG8_BAR; }
    }
    PG8_WAIT_V(0);
    if constexpr (!ALIGN_EPI) { if (wr == 0) PG8_BAR; }
    PG8_BAR;
#undef PG8_SA
#undef PG8_SB
#undef PG8_STAGE
#undef PG8_LDA
#undef PG8_LD32
#undef PG8_LDB
#undef PG8_MMA
#undef PG8_CAT
#undef PG8_WAIT_V
#undef PG8_WAIT_L
#undef PG8_BAR
#undef PG8_SCHED
#undef PG8_PIN4
}
}

struct DenseSched {
    static constexpr bool GATHER = false;
    const char* A; const char* Bt; int lda, ldb, nM, nN, G, c, wgm;
    __device__ __forceinline__ bool next(int i, pg8::Unit& u) const { const int L = i * G + c; if (L >= nM * nN) return false; pg8::order_map(L, nM, nN, u.pm, u.pn, wgm); u.e = 0; u.lt = 0; u.cnt = 0; return true; }
    __device__ __forceinline__ void a_off(const pg8::Unit& u, const int (&R)[2], const int (&C)[2], unsigned (&vo)[2][2]) const {
#pragma unroll
        for (int h = 0; h < 2; ++h)
#pragma unroll
            for (int i = 0; i < 2; ++i) vo[h][i] = (unsigned)((u.pm * 256 + 128 * h + R[i]) * lda + C[i]) * 2u; }
    __device__ __forceinline__ void lane_off(const int (&R)[2], const int (&C)[2], unsigned (&vo)[2][2]) const {
#pragma unroll
        for (int h = 0; h < 2; ++h)
#pragma unroll
            for (int i = 0; i < 2; ++i) vo[h][i] = (unsigned)((128 * h + R[i]) * lda + C[i]) * 2u; }
    __device__ __forceinline__ size_t a_ubase(const pg8::Unit& u) const { return (size_t)u.pm * 256 * lda * 2; }
    __device__ __forceinline__ const char* a_base() const { return A; }
    __device__ __forceinline__ const char* b_ptr(const pg8::Unit& u) const { return Bt + (size_t)u.pn * 256 * ldb * 2; }
};
struct BalSched {
    static constexpr bool GATHER = false;
    const char* A; const char* Bt; int lda, ldb, nM, nN, G, c, nbf;
    __device__ __forceinline__ bool next(int i, pg8::Unit& u) const {
        int L;
        if (G == 256 && nbf == 128 && nM * nN == 1024) { if (c < 128) { if (i >= 3) return false; L = 128 * i + c; } else { if (i >= 5) return false; L = 384 + 128 * i + (c - 128); } }
        else { L = i * G + c; if (L >= nM * nN) return false; }
        pg8::order_map(L, nM, nN, u.pm, u.pn, WGM_IN); u.e = 0; u.lt = 0; u.cnt = 0; return true; }
    __device__ __forceinline__ void a_off(const pg8::Unit&, const int (&)[2], const int (&)[2], unsigned (&)[2][2]) const {}
    __device__ __forceinline__ void lane_off(const int (&R)[2], const int (&C)[2], unsigned (&vo)[2][2]) const {
#pragma unroll
        for (int h = 0; h < 2; ++h)
#pragma unroll
            for (int i = 0; i < 2; ++i) vo[h][i] = (unsigned)((128 * h + R[i]) * lda + C[i]) * 2u; }
    __device__ __forceinline__ size_t a_ubase(const pg8::Unit& u) const { return (size_t)u.pm * 256 * lda * 2; }
    __device__ __forceinline__ const char* a_base() const { return A; }
    __device__ __forceinline__ const char* b_ptr(const pg8::Unit& u) const { return Bt + (size_t)u.pn * 256 * ldb * 2; }
};
struct MergeSched {
    static constexpr bool GATHER = false;
    const char* A; const char* Bt; int G, c;
    __device__ __forceinline__ bool next(int i, pg8::Unit& u) const { const int v = i & 1, L = (i >> 1) * G + c; if (L >= 256 || i >= 2 * ((256 + G - 1) / G)) return false; pg8::order_map(L, 64, 4, u.pm, u.pn, WGM_MID); u.e = v; u.lt = 0; u.cnt = 0; return true; }
    __device__ __forceinline__ void a_off(const pg8::Unit& u, const int (&R)[2], const int (&C)[2], unsigned (&vo)[2][2]) const {
#pragma unroll
        for (int h = 0; h < 2; ++h)
#pragma unroll
            for (int i = 0; i < 2; ++i) vo[h][i] = (unsigned)u.e * (unsigned)(WS_SG - WS_O) + (unsigned)((u.pm * 256 + 128 * h + R[i]) * 512 + C[i]) * 2u; }
    __device__ __forceinline__ void lane_off(const int (&R)[2], const int (&C)[2], unsigned (&vo)[2][2]) const {
#pragma unroll
        for (int h = 0; h < 2; ++h)
#pragma unroll
            for (int i = 0; i < 2; ++i) vo[h][i] = (unsigned)((128 * h + R[i]) * 512 + C[i]) * 2u; }
    __device__ __forceinline__ size_t a_ubase(const pg8::Unit& u) const { return (size_t)u.e * (WS_SG - WS_O) + (size_t)u.pm * 256 * 512 * 2; }
    __device__ __forceinline__ const char* a_base() const { return A; }
    __device__ __forceinline__ const char* b_ptr(const pg8::Unit& u) const { return Bt + (size_t)u.e * (WS_WS - WS_WA) + (size_t)u.pn * 256 * 512 * 2; }
};
template <bool GU>
struct MoeSched {
    static constexpr bool GATHER = GU;
    const char* A; const char* Bt; const int* list; const LAS int* tbase; const LAS int* tile_e; const unsigned* cnt; int nN, G, c, ldk;
    __device__ __forceinline__ bool next(int i, pg8::Unit& u) const {
        const int nM = tbase[NE]; const int L = i * G + c; if (L >= nM * nN) return false;
        pg8::order_map(L, nM, nN, u.pm, u.pn, GU ? WGM_GU : WGM_DN); u.e = tile_e[u.pm]; u.lt = u.pm - tbase[u.e]; u.cnt = (int)cnt[CW_CNT + 64 * u.e]; return true; }
    __device__ __forceinline__ void a_off(const pg8::Unit& u, const int (&R)[2], const int (&C)[2], unsigned (&vo)[2][2]) const {
#pragma unroll
        for (int h = 0; h < 2; ++h)
#pragma unroll
            for (int i = 0; i < 2; ++i) {
                if (GU) { const int pos = u.lt * 256 + 128 * h + R[i]; const int tok = list[(size_t)u.e * T + (pos < u.cnt ? pos : u.lt * 256)]; vo[h][i] = (unsigned)(tok * ldk + C[i]) * 2u; }
                else vo[h][i] = (unsigned)((u.pm * 256 + 128 * h + R[i]) * ldk + C[i]) * 2u; } }
    __device__ __forceinline__ void lane_off(const int (&R)[2], const int (&C)[2], unsigned (&vo)[2][2]) const {
#pragma unroll
        for (int h = 0; h < 2; ++h)
#pragma unroll
            for (int i = 0; i < 2; ++i) vo[h][i] = (unsigned)((128 * h + R[i]) * ldk + C[i]) * 2u; }
    __device__ __forceinline__ size_t a_ubase(const pg8::Unit& u) const { return (size_t)u.pm * 256 * ldk * 2; }
    __device__ __forceinline__ const char* a_base() const { return A; }
    __device__ __forceinline__ const char* b_ptr(const pg8::Unit& u) const { return Bt + ((size_t)u.e * nN + u.pn) * 256 * ldk * 2; }
};

#ifndef KM_ATOMICS
#define KM_ATOMICS 1
#endif
struct EpiIn {
    typedef f32x4 acc_t; static constexpr int MODE = 0;
    static constexpr bool MIDK = false; static constexpr bool PREF = false;
    unsigned char* ws; float* km;
    template <int ACT>
    __device__ __forceinline__ void store(const f32x4 (&acc)[2][2][4][2], bf16* base, int ldc, int row0, int col0, float sc) const {
#pragma unroll
        for (int ai = 0; ai < 2; ++ai)
#pragma unroll
            for (int m = 0; m < 4; ++m) { bf16* rowp = base + (size_t)(row0 + ai * 128 + m * 16) * ldc + col0;
#pragma unroll
                for (int bj = 0; bj < 2; ++bj) { f32x4 v0 = acc[ai][bj][m][0], v1 = acc[ai][bj][m][1];
                    if (ACT == 0) { v0 = v0 * sc; v1 = v1 * sc; }
                    if (ACT == 1) { const f32x2 a = gelu_pk((f32x2){v0[0], v0[1]}), b = gelu_pk((f32x2){v0[2], v0[3]}), c = gelu_pk((f32x2){v1[0], v1[1]}), d = gelu_pk((f32x2){v1[2], v1[3]});
                        v0 = (f32x4){a.x, a.y, b.x, b.y}; v1 = (f32x4){c.x, c.y, d.x, d.y}; }
                    if (ACT == 2) {
#pragma unroll
                        for (int j = 0; j < 4; ++j) { v0[j] = fast_sigmoid(v0[j]); v1[j] = fast_sigmoid(v1[j]); } }
                    u32x4 w; w.x = cvt_pk_bf16(v0[0], v0[1]); w.y = cvt_pk_bf16(v0[2], v0[3]); w.z = cvt_pk_bf16(v1[0], v1[1]); w.w = cvt_pk_bf16(v1[2], v1[3]);
                    *(u32x4*)(rowp + bj * 128) = w; } }
    }
    __device__ __forceinline__ void operator()(const f32x4 (&acc)[2][2][4][2], const pg8::Unit& u, int wr, int wc, int fr, int fq) const {
        const int pn = u.pn, row0 = u.pm * 256 + wr * 64 + fr;
        if (pn < 10) {
            const int kind = pn >> 1, col0 = (pn & 1) * 256 + wc * 32 + 8 * fq; bf16* base = (bf16*)(ws + WS_Q + (size_t)kind * 16 * MiB);
            if (kind == 0) store<0>(acc, base, 512, row0, col0, C2);
            else if (kind < 3) store<0>(acc, base, 512, row0, col0, 1.f);
            else store<1>(acc, base, 512, row0, col0, 1.f);
            if (KM_ATOMICS && kind == 1) {
#pragma unroll
                for (int bj = 0; bj < 2; ++bj)
#pragma unroll
                    for (int n = 0; n < 2; ++n) { f32x4 s = (f32x4){0.f, 0.f, 0.f, 0.f};
#pragma unroll
                        for (int ai = 0; ai < 2; ++ai)
#pragma unroll
                            for (int m = 0; m < 4; ++m) s = s + acc[ai][bj][m][n];
#pragma unroll
                        for (int j = 0; j < 4; ++j) { float t = s[j]; t += __shfl_xor(t, 1); t += __shfl_xor(t, 2); t += __shfl_xor(t, 4); t += __shfl_xor(t, 8); s[j] = t; }
                        if (fr == 0) { float* dst = km + (size_t)u.pm * 512 + col0 + bj * 128 + 4 * n;
#pragma unroll
                            for (int j = 0; j < 4; ++j) unsafeAtomicAdd(dst + j, s[j] * (1.f / 256.f)); } }
            }
        } else {
            const int gsel = (pn - 10) >> 2, col0 = ((pn - 10) & 3) * 256 + wc * 32 + 8 * fq; bf16* base = (bf16*)(ws + (gsel ? WS_GS : WS_GA));
            store<2>(acc, base, 1024, row0, col0, 1.f);
        }
    }
};
struct EpiInQ {
    typedef i32x4 acc_t; static constexpr int MODE = 1;
    static constexpr bool MIDK = false; static constexpr bool PREF = EPI_PREF != 0;
    unsigned char* ws; const float* sxn; const float* sbin; float* km; LAS unsigned char* lds;
    __device__ __forceinline__ void pref(LAS unsigned char* buf, const pg8::Unit& u, int lane) const {
        __builtin_amdgcn_global_load_lds((const unsigned*)(sbin + u.pn * 256 + 4 * lane), (LAS unsigned*)buf, 16, 0, 0);
        __builtin_amdgcn_global_load_lds((const unsigned*)(sxn + u.pm * 256 + 4 * lane), (LAS unsigned*)(buf + 1024), 16, 0, 0);
    }
    __device__ __forceinline__ f32x4 ldsc(const float* sbp, const LAS float* esb, int off) const { if constexpr (PREF) return *(const LAS f32x4*)(esb + off); else return *(const f32x4*)(sbp + off); }
    __device__ __forceinline__ float ldsr(int row, const LAS float* esr, int off) const { if constexpr (PREF) return esr[off]; else return sxn[row]; }
    template <int ACT>
    __device__ __forceinline__ void store(const i32x4 (&acc)[2][2][4][2], bf16* base, int ldc, int row0, int col0, const float* sbp, const LAS float* esb, const LAS float* esr) const {
        f32x4 s0[2], s1[2];
#pragma unroll
        for (int bj = 0; bj < 2; ++bj) { s0[bj] = ldsc(sbp, esb, bj * 128); s1[bj] = ldsc(sbp, esb, bj * 128 + 4); }
#pragma unroll
        for (int ai = 0; ai < 2; ++ai)
#pragma unroll
            for (int m = 0; m < 4; ++m) { const int row = row0 + ai * 128 + m * 16; const float sa = ldsr(row, esr, ai * 128 + m * 16); bf16* rowp = base + (size_t)row * ldc + col0;
#pragma unroll
                for (int bj = 0; bj < 2; ++bj) { f32x4 v0 = __builtin_convertvector(acc[ai][bj][m][0], f32x4) * (s0[bj] * sa), v1 = __builtin_convertvector(acc[ai][bj][m][1], f32x4) * (s1[bj] * sa);
                    if (ACT == 1) { const f32x2 a = gelu_pk((f32x2){v0[0], v0[1]}), b = gelu_pk((f32x2){v0[2], v0[3]}), c = gelu_pk((f32x2){v1[0], v1[1]}), d = gelu_pk((f32x2){v1[2], v1[3]});
                        v0 = (f32x4){a.x, a.y, b.x, b.y}; v1 = (f32x4){c.x, c.y, d.x, d.y}; }
                    if (ACT == 2) {
#pragma unroll
                        for (int j = 0; j < 4; ++j) { v0[j] = fast_sigmoid(v0[j]); v1[j] = fast_sigmoid(v1[j]); } }
                    u32x4 w; w.x = cvt_pk_bf16(v0[0], v0[1]); w.y = cvt_pk_bf16(v0[2], v0[3]); w.z = cvt_pk_bf16(v1[0], v1[1]); w.w = cvt_pk_bf16(v1[2], v1[3]);
                    *(u32x4*)(rowp + bj * 128) = w; } }
    }
    __device__ __forceinline__ void operator()(const i32x4 (&acc)[2][2][4][2], const pg8::Unit& u, int wr, int wc, int fr, int fq) const {
        const int pn = u.pn + IN_BF_TILES, row0 = u.pm * 256 + wr * 64 + fr; const float* sbp = sbin + u.pn * 256 + wc * 32 + 8 * fq;
        const LAS float* esb = (const LAS float*)(lds + LX_EPI + u.par * 3072) + wc * 32 + 8 * fq; const LAS float* esr = (const LAS float*)(lds + LX_EPI + u.par * 3072) + 256 + wr * 64 + fr;
        if (pn < 10) { const int kind = pn >> 1, col0 = (pn & 1) * 256 + wc * 32 + 8 * fq; bf16* base = (bf16*)(ws + WS_Q + (size_t)kind * 16 * MiB);
            if (kind <= 2) store<0>(acc, base, 512, row0, col0, sbp, esb, esr); else store<1>(acc, base, 512, row0, col0, sbp, esb, esr);
            if (KM_ATOMICS && kind == 1) {
                float sa[2][4];
#pragma unroll
                for (int ai = 0; ai < 2; ++ai)
#pragma unroll
                    for (int m = 0; m < 4; ++m) sa[ai][m] = ldsr(row0 + ai * 128 + m * 16, esr, ai * 128 + m * 16);
#pragma unroll
                for (int bj = 0; bj < 2; ++bj)
#pragma unroll
                    for (int n = 0; n < 2; ++n) { f32x4 s = (f32x4){0.f, 0.f, 0.f, 0.f};
#pragma unroll
                        for (int ai = 0; ai < 2; ++ai)
#pragma unroll
                            for (int m = 0; m < 4; ++m) s = s + __builtin_convertvector(acc[ai][bj][m][n], f32x4) * sa[ai][m];
                        s = s * ldsc(sbp, esb, bj * 128 + 4 * n);
#pragma unroll
                        for (int j = 0; j < 4; ++j) { float t = s[j]; t += __shfl_xor(t, 1); t += __shfl_xor(t, 2); t += __shfl_xor(t, 4); t += __shfl_xor(t, 8); s[j] = t; }
                        if (fr == 0) { float* dst = km + (size_t)u.pm * 512 + col0 + bj * 128 + 4 * n;
#pragma unroll
                            for (int j = 0; j < 4; ++j) unsafeAtomicAdd(dst + j, s[j] * (1.f / 256.f)); } }
            }
        } else { const int gsel = (pn - 10) >> 2, col0 = ((pn - 10) & 3) * 256 + wc * 32 + 8 * fq; bf16* base = (bf16*)(ws + (gsel ? WS_GS : WS_GA));
#if GATE_U8
            { f32x4 s0[2], s1[2];
#pragma unroll
              for (int bj = 0; bj < 2; ++bj) { s0[bj] = ldsc(sbp, esb, bj * 128); s1[bj] = ldsc(sbp, esb, bj * 128 + 4); }
#pragma unroll
              for (int ai = 0; ai < 2; ++ai)
#pragma unroll
                for (int m = 0; m < 4; ++m) { const int row = row0 + ai * 128 + m * 16; const float sa = ldsr(row, esr, ai * 128 + m * 16); unsigned char* rowp = (unsigned char*)base + (size_t)row * 1024 + col0;
#pragma unroll
                    for (int bj = 0; bj < 2; ++bj) { const f32x4 v0 = __builtin_convertvector(acc[ai][bj][m][0], f32x4) * (s0[bj] * sa), v1 = __builtin_convertvector(acc[ai][bj][m][1], f32x4) * (s1[bj] * sa); unsigned q[8];
#pragma unroll
                        for (int j = 0; j < 4; ++j) { q[j] = (unsigned)(int)fmaxf(__builtin_rintf(fast_sigmoid(v0[j]) * 255.f), 1.f); q[4 + j] = (unsigned)(int)fmaxf(__builtin_rintf(fast_sigmoid(v1[j]) * 255.f), 1.f); }
                        u32x2 w; w.x = q[0] | (q[1] << 8) | (q[2] << 16) | (q[3] << 24); w.y = q[4] | (q[5] << 8) | (q[6] << 16) | (q[7] << 24);
                        *(u32x2*)(rowp + bj * 128) = w; } } }
#else
            store<2>(acc, base, 1024, row0, col0, sbp, esb, esr);
#endif
        }
    }
};
struct EpiMerge {
    typedef f32x4 acc_t; static constexpr int MODE = 0;
    static constexpr bool MIDK = false; static constexpr bool PREF = false;
    unsigned char* ws;
    __device__ __forceinline__ void operator()(const f32x4 (&acc)[2][2][4][2], const pg8::Unit& u, int wr, int wc, int fr, int fq) const {
        const int row0 = u.pm * 256 + wr * 64 + fr, col0 = u.pn * 256 + wc * 32 + 8 * fq;
        const bf16* gate = (const bf16*)(ws + (u.e ? WS_GS : WS_GA)); bf16* mg = (bf16*)(ws + WS_MG);
#pragma unroll
        for (int ai = 0; ai < 2; ++ai)
#pragma unroll
            for (int m = 0; m < 4; ++m) { const size_t ro = (size_t)(row0 + ai * 128 + m * 16) * 1024 + col0;
#pragma unroll
                for (int bj = 0; bj < 2; ++bj) { const u32x4 g = *(const u32x4*)(gate + ro + bj * 128); f32x4 v0 = acc[ai][bj][m][0], v1 = acc[ai][bj][m][1];
                    v0[0] *= bf2f(g.x & 0xffffu); v0[1] *= bf2f(g.x >> 16); v0[2] *= bf2f(g.y & 0xffffu); v0[3] *= bf2f(g.y >> 16);
                    v1[0] *= bf2f(g.z & 0xffffu); v1[1] *= bf2f(g.z >> 16); v1[2] *= bf2f(g.w & 0xffffu); v1[3] *= bf2f(g.w >> 16);
                    if (u.e) { const u32x4 p = *(const u32x4*)(mg + ro + bj * 128);
                        v0[0] += bf2f(p.x & 0xffffu); v0[1] += bf2f(p.x >> 16); v0[2] += bf2f(p.y & 0xffffu); v0[3] += bf2f(p.y >> 16);
                        v1[0] += bf2f(p.z & 0xffffu); v1[1] += bf2f(p.z >> 16); v1[2] += bf2f(p.w & 0xffffu); v1[3] += bf2f(p.w >> 16); }
                    u32x4 w; w.x = cvt_pk_bf16(v0[0], v0[1]); w.y = cvt_pk_bf16(v0[2], v0[3]); w.z = cvt_pk_bf16(v1[0], v1[1]); w.w = cvt_pk_bf16(v1[2], v1[3]);
                    *(u32x4*)(mg + ro + bj * 128) = w; } }
    }
};
struct EpiMergeF {
    typedef f32x4 acc_t; static constexpr int MODE = 0; static constexpr bool MIDK = true; static constexpr bool PREF = false;
    unsigned char* ws;
    __device__ __forceinline__ void mid(f32x4 (&acc)[2][2][4][2], const pg8::Unit& u, int wr, int wc, int fr, int fq) const {
        asm volatile("" : "+v"(fr), "+v"(fq));
        const int row0 = u.pm * 256 + wr * 64 + fr, col0 = u.pn * 256 + wc * 32 + 8 * fq; const bf16* ga = (const bf16*)(ws + WS_GA); const bf16* gs = (const bf16*)(ws + WS_GS);
#pragma unroll
        for (int ai = 0; ai < 2; ++ai)
#pragma unroll
            for (int m = 0; m < 4; ++m) { const size_t ro = (size_t)(row0 + ai * 128 + m * 16) * 1024 + col0;
#pragma unroll
                for (int bj = 0; bj < 2; ++bj) {
#if GATE_U8
                    const u32x2 a = *(const u32x2*)((const unsigned char*)ga + ro + bj * 128), b = *(const u32x2*)((const unsigned char*)gs + ro + bj * 128);
#pragma unroll
                    for (int j = 0; j < 8; ++j) { const float r = (float)((a[j >> 2] >> (8 * (j & 3))) & 0xffu) * __builtin_amdgcn_rcpf((float)((b[j >> 2] >> (8 * (j & 3))) & 0xffu)); acc[ai][bj][m][j >> 2][j & 3] *= r; }
#else
                    const u32x4 a = *(const u32x4*)(ga + ro + bj * 128), b = *(const u32x4*)(gs + ro + bj * 128);
#pragma unroll
                    for (int j = 0; j < 4; ++j) { const float rl = bf2f(a[j] & 0xffffu) * __builtin_amdgcn_rcpf(bf2f(b[j] & 0xffffu)), rh = bf2f(a[j] >> 16) * __builtin_amdgcn_rcpf(bf2f(b[j] >> 16));
                        acc[ai][bj][m][j >> 1][2 * (j & 1)] *= rl; acc[ai][bj][m][j >> 1][2 * (j & 1) + 1] *= rh; }
#endif
                }
                if (m == 3) asm volatile("" ::: "memory"); }
    }
    __device__ __forceinline__ void operator()(const f32x4 (&acc)[2][2][4][2], const pg8::Unit& u, int wr, int wc, int fr, int fq) const {
        const int row0 = u.pm * 256 + wr * 64 + fr, col0 = u.pn * 256 + wc * 32 + 8 * fq; const bf16* gs = (const bf16*)(ws + WS_GS); bf16* mg = (bf16*)(ws + WS_MG);
#if GATE_U8
        u32x2 gq[2][4][2];
#pragma unroll
        for (int ai = 0; ai < 2; ++ai)
#pragma unroll
            for (int m = 0; m < 4; ++m)
#pragma unroll
                for (int bj = 0; bj < 2; ++bj) gq[ai][m][bj] = *(const u32x2*)((const unsigned char*)gs + (size_t)(row0 + ai * 128 + m * 16) * 1024 + col0 + bj * 128);
#endif
#pragma unroll
        for (int ai = 0; ai < 2; ++ai)
#pragma unroll
            for (int m = 0; m < 4; ++m) { const size_t ro = (size_t)(row0 + ai * 128 + m * 16) * 1024 + col0;
#pragma unroll
                for (int bj = 0; bj < 2; ++bj) { f32x4 v0 = acc[ai][bj][m][0], v1 = acc[ai][bj][m][1];
#if GATE_U8
                    const u32x2 g = gq[ai][m][bj];
#pragma unroll
                    for (int j = 0; j < 4; ++j) { v0[j] *= (float)((g.x >> (8 * j)) & 0xffu) * (1.f / 255.f); v1[j] *= (float)((g.y >> (8 * j)) & 0xffu) * (1.f / 255.f); }
#else
                    const u32x4 g = *(const u32x4*)(gs + ro + bj * 128);
                    v0[0] *= bf2f(g.x & 0xffffu); v0[1] *= bf2f(g.x >> 16); v0[2] *= bf2f(g.y & 0xffffu); v0[3] *= bf2f(g.y >> 16);
                    v1[0] *= bf2f(g.z & 0xffffu); v1[1] *= bf2f(g.z >> 16); v1[2] *= bf2f(g.w & 0xffffu); v1[3] *= bf2f(g.w >> 16);
#endif
                    u32x4 w; w.x = cvt_pk_bf16(v0[0], v0[1]); w.y = cvt_pk_bf16(v0[2], v0[3]); w.z = cvt_pk_bf16(v1[0], v1[1]); w.w = cvt_pk_bf16(v1[2], v1[3]);
                    *(u32x4*)(mg + ro + bj * 128) = w; } }
    }
};
struct EpiH1 {
    typedef f32x4 acc_t; static constexpr int MODE = 0;
    static constexpr bool MIDK = false; static constexpr bool PREF = false;
    const float* x; float* h1; bf16* h1b;
    __device__ __forceinline__ void operator()(const f32x4 (&acc)[2][2][4][2], const pg8::Unit& u, int wr, int wc, int fr, int fq) const {
        const int row0 = u.pm * 256 + wr * 64 + fr, col0 = u.pn * 256 + wc * 32 + 8 * fq;
        f32x4 xq[4][2][2];
#pragma unroll
        for (int g = 0; g < 4; ++g)
#pragma unroll
            for (int bj = 0; bj < 2; ++bj) { const size_t ro = (size_t)(row0 + (g >> 2) * 128 + (g & 3) * 16) * 1024 + col0;
                xq[g][bj][0] = __builtin_nontemporal_load((const f32x4*)(x + ro + bj * 128)); xq[g][bj][1] = __builtin_nontemporal_load((const f32x4*)(x + ro + bj * 128 + 4)); }
#pragma unroll
        for (int ai = 0; ai < 2; ++ai)
#pragma unroll
            for (int m = 0; m < 4; ++m) { const size_t ro = (size_t)(row0 + ai * 128 + m * 16) * 1024 + col0; const int g = ai * 4 + m;
                f32x4 xc[2][2];
#pragma unroll
                for (int bj = 0; bj < 2; ++bj) { xc[bj][0] = xq[g & 3][bj][0]; xc[bj][1] = xq[g & 3][bj][1]; }
                if (g + 4 < 8) {
#pragma unroll
                    for (int bj = 0; bj < 2; ++bj) { const size_t rn = (size_t)(row0 + ((g + 4) >> 2) * 128 + ((g + 4) & 3) * 16) * 1024 + col0;
                        xq[g & 3][bj][0] = __builtin_nontemporal_load((const f32x4*)(x + rn + bj * 128)); xq[g & 3][bj][1] = __builtin_nontemporal_load((const f32x4*)(x + rn + bj * 128 + 4)); } }
#pragma unroll
                for (int bj = 0; bj < 2; ++bj) { const f32x4 x0 = xc[bj][0], x1 = xc[bj][1];
                    const f32x4 v0 = acc[ai][bj][m][0] + x0, v1 = acc[ai][bj][m][1] + x1;
                    if (!H1_BF16) { *(f32x4*)(h1 + ro + bj * 128) = v0; *(f32x4*)(h1 + ro + bj * 128 + 4) = v1; }
                    if (!MOE_I8 || H1_BF16) { u32x4 w; w.x = cvt_pk_bf16(v0[0], v0[1]); w.y = cvt_pk_bf16(v0[2], v0[3]); w.z = cvt_pk_bf16(v1[0], v1[1]); w.w = cvt_pk_bf16(v1[2], v1[3]);
                        *(u32x4*)(h1b + ro + bj * 128) = w; } } }
    }
};
struct EpiGu {
    typedef f32x4 acc_t; static constexpr int MODE = 0;
    static constexpr bool MIDK = false; static constexpr bool PREF = false;
    const float* rlist; const float* bgu; bf16* hid;
    __device__ __forceinline__ void operator()(const f32x4 (&acc)[2][2][4][2], const pg8::Unit& u, int wr, int wc, int fr, int fq) const {
        const int lrow0 = wr * 64 + fr, col0 = u.pn * 256 + wc * 32 + 8 * fq; const float* bb = bgu + (size_t)u.e * 2048 + col0;
        f32x4 b0[2], b1[2];
#pragma unroll
        for (int bj = 0; bj < 2; ++bj) { b0[bj] = *(const f32x4*)(bb + bj * 128); b1[bj] = *(const f32x4*)(bb + bj * 128 + 4); }
#pragma unroll
        for (int ai = 0; ai < 2; ++ai)
#pragma unroll
            for (int m = 0; m < 4; ++m) { const int lr = lrow0 + ai * 128 + m * 16, pos = u.lt * 256 + lr; const float r = pos < u.cnt ? rlist[(size_t)u.e * T + pos] : 0.f;
                bf16* rowp = hid + (size_t)(u.pm * 256 + lr) * DE + (col0 >> 1);
#pragma unroll
                for (int bj = 0; bj < 2; ++bj) { const f32x4 v0 = acc[ai][bj][m][0] * r + b0[bj], v1 = acc[ai][bj][m][1] * r + b1[bj];
                    u32x2 w; w.x = cvt_pk_bf16(fast_swiglu(v0[0], v0[1]), fast_swiglu(v0[2], v0[3])); w.y = cvt_pk_bf16(fast_swiglu(v1[0], v1[1]), fast_swiglu(v1[2], v1[3]));
                    *(u32x2*)(rowp + bj * 64) = w; } }
    }
};
struct EpiGuQ {
    typedef i32x4 acc_t; static constexpr int MODE = 1;
    static constexpr bool MIDK = false; static constexpr bool PREF = EPI_PREF != 0;
    const float* rlist; const float* sb; const float* bgu; bf16* hid; LAS unsigned char* lds;
    __device__ __forceinline__ void pref(LAS unsigned char* buf, const pg8::Unit& u, int lane) const {
        __builtin_amdgcn_global_load_lds((const unsigned*)(bgu + (size_t)u.e * 2048 + u.pn * 256 + 4 * lane), (LAS unsigned*)buf, 16, 0, 0);
        __builtin_amdgcn_global_load_lds((const unsigned*)(sb + (size_t)u.e * 2048 + u.pn * 256 + 4 * lane), (LAS unsigned*)(buf + 1024), 16, 0, 0);
        __builtin_amdgcn_global_load_lds((const unsigned*)(rlist + (size_t)u.e * T + u.lt * 256 + 4 * lane), (LAS unsigned*)(buf + 2048), 16, 0, 0);
    }
    __device__ __forceinline__ void operator()(const i32x4 (&acc)[2][2][4][2], const pg8::Unit& u, int wr, int wc, int fr, int fq) const {
        const int lrow0 = wr * 64 + fr, col0 = u.pn * 256 + wc * 32 + 8 * fq; const float* bb = bgu + (size_t)u.e * 2048 + col0; const float* ss = sb + (size_t)u.e * 2048 + col0;
        const LAS float* eb = (const LAS float*)(lds + LX_EPI + u.par * 3072) + wc * 32 + 8 * fq; (void)eb;
        f32x4 b0[2], b1[2], s0[2], s1[2];
#pragma unroll
        for (int bj = 0; bj < 2; ++bj) {
            if constexpr (PREF) { b0[bj] = *(const LAS f32x4*)(eb + bj * 128); b1[bj] = *(const LAS f32x4*)(eb + bj * 128 + 4); s0[bj] = *(const LAS f32x4*)(eb + 256 + bj * 128); s1[bj] = *(const LAS f32x4*)(eb + 256 + bj * 128 + 4); }
            else { b0[bj] = *(const f32x4*)(bb + bj * 128); b1[bj] = *(const f32x4*)(bb + bj * 128 + 4); s0[bj] = *(const f32x4*)(ss + bj * 128); s1[bj] = *(const f32x4*)(ss + bj * 128 + 4); } }
        const LAS float* er = (const LAS float*)(lds + LX_EPI + u.par * 3072) + 512; (void)er;
#if MOE_F8
        { constexpr float CC = -1.702f * LOG2E, IC = 1.f / CC; const f32x4 cm = (f32x4){CC, IC, CC, IC}, ca = (f32x4){0.f, IC, 0.f, IC};
#pragma unroll
          for (int bj = 0; bj < 2; ++bj) { s0[bj] = s0[bj] * cm; s1[bj] = s1[bj] * cm; b0[bj] = b0[bj] * cm + ca; b1[bj] = b1[bj] * cm + ca; } }
#endif
#pragma unroll
        for (int ai = 0; ai < 2; ++ai)
#pragma unroll
            for (int m = 0; m < 4; ++m) { const int lr = lrow0 + ai * 128 + m * 16, pos = u.lt * 256 + lr; float r;
                if constexpr (PREF) { const float rv = er[lr]; r = pos < u.cnt ? rv : 0.f; } else r = pos < u.cnt ? rlist[(size_t)u.e * T + pos] : 0.f;
                bf16* rowp = hid + (size_t)(u.pm * 256 + lr) * DE + (col0 >> 1);
#pragma unroll
                for (int bj = 0; bj < 2; ++bj) { const f32x4 v0 = __builtin_convertvector(acc[ai][bj][m][0], f32x4) * (s0[bj] * r) + b0[bj], v1 = __builtin_convertvector(acc[ai][bj][m][1], f32x4) * (s1[bj] * r) + b1[bj];
#if MOE_F8
                    unsigned w = 0u; w = __builtin_amdgcn_cvt_pk_fp8_f32(folded_swiglu(v0[0], v0[1]), folded_swiglu(v0[2], v0[3]), w, false); w = __builtin_amdgcn_cvt_pk_fp8_f32(folded_swiglu(v1[0], v1[1]), folded_swiglu(v1[2], v1[3]), w, true);
                    *(unsigned*)((unsigned char*)hid + (size_t)(u.pm * 256 + lr) * DE + (col0 >> 1) + bj * 64) = w; (void)rowp;
#else
                    u32x2 w; w.x = cvt_pk_bf16(fast_swiglu(v0[0], v0[1]), fast_swiglu(v0[2], v0[3])); w.y = cvt_pk_bf16(fast_swiglu(v1[0], v1[1]), fast_swiglu(v1[2], v1[3]));
                    *(u32x2*)(rowp + bj * 64) = w;
#endif
                } }
    }
};
struct EpiDown {
    typedef f32x4 acc_t; static constexpr int MODE = MOE_F8 ? 2 : 0;
    static constexpr bool MIDK = false; static constexpr bool PREF = EPI_PREF != 0;
    const float* bd; bf16* y; LAS unsigned char* lds;
    __device__ __forceinline__ void pref(LAS unsigned char* buf, const pg8::Unit& u, int lane) const {
        __builtin_amdgcn_global_load_lds((const unsigned*)(bd + (size_t)u.e * D + u.pn * 256 + 4 * lane), (LAS unsigned*)buf, 16, 0, 0);
    }
    __device__ __forceinline__ void operator()(const f32x4 (&acc)[2][2][4][2], const pg8::Unit& u, int wr, int wc, int fr, int fq) const {
        const int lrow0 = wr * 64 + fr, col0 = u.pn * 256 + wc * 32 + 8 * fq; const float* bb = bd + (size_t)u.e * D + col0;
        const LAS float* eb = (const LAS float*)(lds + LX_EPI + u.par * 3072) + wc * 32 + 8 * fq; (void)eb;
        f32x4 b0[2], b1[2];
#pragma unroll
        for (int bj = 0; bj < 2; ++bj) {
            if constexpr (PREF) { b0[bj] = *(const LAS f32x4*)(eb + bj * 128); b1[bj] = *(const LAS f32x4*)(eb + bj * 128 + 4); }
            else { b0[bj] = *(const f32x4*)(bb + bj * 128); b1[bj] = *(const f32x4*)(bb + bj * 128 + 4); } }
#pragma unroll
        for (int ai = 0; ai < 2; ++ai)
#pragma unroll
            for (int m = 0; m < 4; ++m) { bf16* rowp = y + (size_t)(u.pm * 256 + lrow0 + ai * 128 + m * 16) * D + col0;
#pragma unroll
                for (int bj = 0; bj < 2; ++bj) { constexpr float ws_ = MOE_F8 ? (1.f / 32.f) : 1.f; const f32x4 v0 = acc[ai][bj][m][0] * ws_ + b0[bj], v1 = acc[ai][bj][m][1] * ws_ + b1[bj];
#if Y_F8
                    u32x2 w; unsigned t = 0u; t = __builtin_amdgcn_cvt_pk_fp8_f32(v0[0], v0[1], t, false); t = __builtin_amdgcn_cvt_pk_fp8_f32(v0[2], v0[3], t, true); w.x = t;
                    t = 0u; t = __builtin_amdgcn_cvt_pk_fp8_f32(v1[0], v1[1], t, false); t = __builtin_amdgcn_cvt_pk_fp8_f32(v1[2], v1[3], t, true); w.y = t;
                    *(u32x2*)((unsigned char*)y + (size_t)(u.pm * 256 + lrow0 + ai * 128 + m * 16) * D + col0 + bj * 128) = w; (void)rowp;
#else
                    u32x4 w; w.x = cvt_pk_bf16(v0[0], v0[1]); w.y = cvt_pk_bf16(v0[2], v0[3]); w.z = cvt_pk_bf16(v1[0], v1[1]); w.w = cvt_pk_bf16(v1[2], v1[3]);
                    *(u32x4*)(rowp + bj * 128) = w;
#endif
                } }
    }
};

namespace attn_body {
using bf16=__hip_bfloat16;
using bf16x8=__attribute__((ext_vector_type(8)))short;
using s16x4=__attribute__((ext_vector_type(4)))short;
using f32x16=__attribute__((ext_vector_type(16)))float;
using u32x4=__attribute__((ext_vector_type(4)))unsigned;
constexpr int BATCH=4,NHEAD=8,SEQ=4096,D=64,DM=NHEAD*D;
constexpr int NW=8,QBLK=32,QB=QBLK*NW,KVBLK=64,NQB=SEQ/QB;
__device__ __forceinline__ int crow(int r,int hi){return (r&3)+8*(r>>2)+4*hi;}
#define SBAR() __builtin_amdgcn_sched_barrier(0)
__device__ __forceinline__ void cmask(f32x16&p0,f32x16&p1,int jb,int qrel,int hi){
  const float NEG=-INFINITY; int kb=64*jb+4*hi;
  #pragma unroll
  for(int r=0;r<16;++r){int kv=kb+(r&3)+8*(r>>2); if(kv>qrel)p0[r]=NEG; if(kv+32>qrel)p1[r]=NEG;}
}
constexpr int NSLOT=3, SLOTB=8192;
constexpr int LDS_K=0, LDS_V=NSLOT*SLOTB, LDS_WS=2*NSLOT*SLOTB, LDS_OST=LDS_WS+NW*64*4, LDS_BYTES=LDS_OST+NW*4096;
constexpr int LDS_GATE=LDS_OST;
__device__ __forceinline__ void glds16(const void*gsrc,unsigned lds_dst){unsigned keep;
  asm volatile("s_mov_b32 %0, m0\n\ts_mov_b32 m0, %2\n\ts_nop 0\n\tglobal_load_lds_dwordx4 %1, off\n\ts_mov_b32 m0, %0":"=&s"(keep):"v"(gsrc),"s"(lds_dst):"memory");}
typedef float f32x2_t __attribute__((ext_vector_type(2))); typedef __bf16 bf16x2_t __attribute__((ext_vector_type(2)));
__device__ __forceinline__ unsigned cvtpk_s(float lo,float hi){f32x2_t v={lo,hi};bf16x2_t b=__builtin_convertvector(v,bf16x2_t);return __builtin_bit_cast(unsigned,b);}
#define WAIT_BAR(N) asm volatile("s_waitcnt vmcnt(" #N ") lgkmcnt(0)\n\ts_barrier":::"memory")
__device__ __forceinline__ float max3f(float a,float b,float c){return __builtin_fmaxf(__builtin_fmaxf(a,b),c);}
typedef __attribute__((address_space(3))) const char* lds_cptr;
typedef short v4i16_t __attribute__((ext_vector_type(4)));
__device__ __forceinline__ void kload8(bf16x8*kf,lds_cptr kp){
  kf[0]=*(const __attribute__((address_space(3))) bf16x8*)(kp);      kf[1]=*(const __attribute__((address_space(3))) bf16x8*)(kp+512);
  kf[2]=*(const __attribute__((address_space(3))) bf16x8*)(kp+2048); kf[3]=*(const __attribute__((address_space(3))) bf16x8*)(kp+2560);
  kf[4]=*(const __attribute__((address_space(3))) bf16x8*)(kp+4096); kf[5]=*(const __attribute__((address_space(3))) bf16x8*)(kp+4608);
  kf[6]=*(const __attribute__((address_space(3))) bf16x8*)(kp+6144); kf[7]=*(const __attribute__((address_space(3))) bf16x8*)(kp+6656);
}
__device__ __forceinline__ void kload2(bf16x8*kf,lds_cptr kp,int j){ kf[2*j]=*(const __attribute__((address_space(3))) bf16x8*)(kp+j*2048); kf[2*j+1]=*(const __attribute__((address_space(3))) bf16x8*)(kp+j*2048+512); }
__device__ __forceinline__ s16x4 vtr(lds_cptr p){ return __builtin_bit_cast(s16x4,__builtin_amdgcn_ds_read_tr16_b64_v4i16((__attribute__((address_space(3))) v4i16_t*)p)); }
__device__ __forceinline__ float rowmax(const f32x16&p0,const f32x16&p1){
  float a=max3f(p0[0],p0[1],p1[0]),b=max3f(p0[2],p0[3],p1[1]);a=max3f(a,p1[2],p1[3]);
  #pragma unroll
  for(int r=4;r<16;r+=4){a=max3f(a,p0[r],p0[r+1]);b=max3f(b,p0[r+2],p0[r+3]);a=max3f(a,p1[r],p1[r+1]);b=max3f(b,p1[r+2],p1[r+3]);}
  const float m=__builtin_fmaxf(a,b);
  auto rr=__builtin_amdgcn_permlane32_swap(__float_as_uint(m),__float_as_uint(m),false,false);
  return __builtin_fmaxf(__uint_as_float(rr[0]),__uint_as_float(rr[1]));
}
__device__ __forceinline__ void pv(f32x16*o,int vb,bf16x8 pa0,bf16x8 pa1,bf16x8 pa2,bf16x8 pa3){
  #pragma unroll
  for(int d0=0;d0<2;++d0){s16x4 lo[4],hi[4];
    #pragma unroll
    for(int ks=0;ks<4;++ks){
      asm volatile("ds_read_b64_tr_b16 %0,%1 offset:%c2":"=&v"(lo[ks]):"v"(vb),"i"(d0*4096+ks*1024):"memory");
      asm volatile("ds_read_b64_tr_b16 %0,%1 offset:%c2":"=&v"(hi[ks]):"v"(vb),"i"(d0*4096+ks*1024+512):"memory");}
    asm volatile("s_waitcnt lgkmcnt(0)":::"memory");SBAR();
    #define PK(k) (bf16x8){lo[k][0],lo[k][1],lo[k][2],lo[k][3],hi[k][0],hi[k][1],hi[k][2],hi[k][3]}
    o[d0]=__builtin_amdgcn_mfma_f32_32x32x16_bf16(pa0,PK(0),o[d0],0,0,0);
    o[d0]=__builtin_amdgcn_mfma_f32_32x32x16_bf16(pa1,PK(1),o[d0],0,0,0);
    o[d0]=__builtin_amdgcn_mfma_f32_32x32x16_bf16(pa2,PK(2),o[d0],0,0,0);
    o[d0]=__builtin_amdgcn_mfma_f32_32x32x16_bf16(pa3,PK(3),o[d0],0,0,0);
    #undef PK
  }
}
constexpr float MASKED=-1.0e30f, LOWREF=-1000.f;
template<int THRL> __device__ __forceinline__ void attn_unit(int b,int h,int qb,const bf16*Q,const bf16*__restrict__ K,const bf16*__restrict__ V,const float*__restrict__ KM,bf16*O,char*shm){
  int tid=threadIdx.x; asm volatile("":"+v"(tid));
  const int lane=tid&63,r32=lane&31,hi=lane>>5; const int wid=__builtin_amdgcn_readfirstlane(tid>>6);
  const long rowbase=(long)b*SEQ; const int q0=qb*QB;
  const bf16*Qw=Q+(rowbase+q0+wid*QBLK)*DM+h*D;
  const bf16*Kh=K+rowbase*DM+h*D,*Vh=V+rowbase*DM+h*D;
  const unsigned lds0=(unsigned)(uintptr_t)shm;
  __attribute__((address_space(3))) float*wsf=(__attribute__((address_space(3))) float*)((__attribute__((address_space(3))) char*)shm+LDS_WS)+wid*64;
  const bf16*ksrc=Kh+(long)lane*DM+wid*8;
  const bf16*vsrc=Vh+(long)(16*(wid&3)+(lane>>2))*DM+(wid>>2)*32+(lane&3)*8;
  const unsigned kdst=lds0+LDS_K+wid*1024, vdst=lds0+LDS_V+wid*1024;
  #define DMA_K(t,slot) glds16(ksrc+(long)(t)*KVBLK*DM,(unsigned)__builtin_amdgcn_readfirstlane(kdst+(slot)))
  #define DMA_V(t,slot) glds16(vsrc+(long)(t)*KVBLK*DM,(unsigned)__builtin_amdgcn_readfirstlane(vdst+(slot)))
  const int vb0=(int)(lds0+LDS_V)+((lane>>4)&1)*32+(lane&3)*8+(4*hi+((lane&15)>>2))*64;
  bf16x8 kf[8];
  const lds_cptr shm3=(lds_cptr)shm; const lds_cptr kp0=shm3+LDS_K+hi*1024+r32*16; const lds_cptr vp0=shm3+LDS_V+((lane>>4)&1)*32+(lane&3)*8+(4*hi+((lane&15)>>2))*64;
  const int NT=(q0+QB)/KVBLK;
  DMA_K(0,0);DMA_V(0,0);DMA_K(1,SLOTB);
  bf16x8 qr[4];
  #pragma unroll
  for(int d0=0;d0<4;++d0)qr[d0]=*reinterpret_cast<const bf16x8*>(&Qw[(long)r32*DM+d0*16+hi*8]);
  { const int row=tid>>4, dg=tid&15, j=row&15; f32x4 m4=(f32x4){0.f,0.f,0.f,0.f};
    if(j<qb) m4=*(const f32x4*)(KM+((long)(b*NQB+j))*DM+h*D+4*dg);
    unsigned w0,w1; { const unsigned h0=cvtpk_s(m4[0],m4[1]),h1=cvtpk_s(m4[2],m4[3]);
      if(row<16){w0=h0;w1=h1;} else { w0=cvtpk_s(m4[0]-__uint_as_float(h0<<16),m4[1]-__uint_as_float(h0&0xffff0000u)); w1=cvtpk_s(m4[2]-__uint_as_float(h1<<16),m4[3]-__uint_as_float(h1&0xffff0000u)); } }
    typedef unsigned u32x2_t __attribute__((ext_vector_type(2)));
    *(__attribute__((address_space(3))) u32x2_t*)(shm3+LDS_GATE+(dg>>1)*512+row*16+(dg&1)*8)=(u32x2_t){w0,w1}; }
  float mhat=0.f,l_reg=0.f;
  const int qrel=wid*QBLK+r32;
  const float sl2=exp2f(-(float)(h+1))*1.4426950408889634f;
  const float cb0=sl2*(float)(4*hi-(q0+qrel));
  #define CMASK(P0,P1,t) do{int jb_=(t)-(NT-4); if(jb_>=0)cmask(P0,P1,jb_,qrel,hi);}while(0)
  #define CINIT(C0,C1,t) do{ const bool s_=((selmask>>((t)>>2))&1u)!=0u; const float bt_=s_?(cb0+sl2*(float)(64*(t))-mhat):MASKED; \
      _Pragma("unroll") for(int r=0;r<16;++r){ const float kc_=(float)((r&3)+8*(r>>2)); C0[r]=__builtin_fmaf(sl2,kc_,bt_); C1[r]=__builtin_fmaf(sl2,kc_+32.f,bt_);} }while(0)
  bool resc=false;
  #define START(P0,P1) do{ const float rm=rowmax(P0,P1); resc=false; \
    { const float dl=__builtin_fmaxf(rm,LOWREF); mhat+=dl; \
      _Pragma("unroll") for(int r=0;r<16;++r){P0[r]-=dl;P1[r]-=dl;} } \
    _Pragma("unroll") for(int r=0;r<16;++r)P0[r]=__builtin_amdgcn_exp2f(P0[r]); }while(0)
  #define RESC() do{ if(resc){ asm volatile("s_waitcnt lgkmcnt(0)":::"memory"); \
      _Pragma("unroll") for(int d_=0;d_<2;++d_) _Pragma("unroll") for(int r=0;r<16;++r)o[d_][r]*=wsf[crow(r,hi)]; } }while(0)
  f32x16 pA0,pA1,pB0,pB1;
  int sl_prev=0,sl_cur=0,sl_next=SLOTB;
  #define ROT() do{sl_prev=sl_cur;sl_cur=sl_next;sl_next=(sl_next==(NSLOT-1)*SLOTB)?0:sl_next+SLOTB;}while(0)
  DMA_K(2,2*SLOTB);
  WAIT_BAR(3);
  unsigned selmask=1u<<qb;
  if(qb>0){
    f32x16 g=f32x16{};
    #pragma unroll
    for(int d0=0;d0<4;++d0){ const bf16x8 a=*(const __attribute__((address_space(3))) bf16x8*)(shm3+LDS_GATE+(2*d0+hi)*512+r32*16); g=__builtin_amdgcn_mfma_f32_32x32x16_bf16(a,qr[d0],g,0,0,0); }
    float gl[8],gp[8];
    #pragma unroll
    for(int i=0;i<4;++i){ gl[i]=g[i]+g[8+i]; gl[4+i]=g[4+i]+g[12+i]; }
    #pragma unroll
    for(int i=0;i<8;++i) gp[i]=__shfl_xor(gl[i],32);
    float gv[16];
    #pragma unroll
    for(int j=0;j<16;++j){ const int half=(j>>2)&1, i=(j&3)+4*(j>>3); const float v=(half==hi)?gl[i]:gp[i]; gv[j]=(j<qb)?v:-INFINITY; }
    #pragma unroll
    for(int s=0;s<3;++s){ int best=-1; float bv=-INFINITY;
      #pragma unroll
      for(int j=0;j<16;++j) if(gv[j]>bv){bv=gv[j];best=j;}
      #pragma unroll
      for(int j=0;j<16;++j) if(j==best) gv[j]=-INFINITY;
      if(best>=0) selmask|=1u<<best; }
  }
  f32x16 o[2];o[0]=f32x16{};o[1]=f32x16{}; asm volatile("":"+v"(o[0]),"+v"(o[1]));
  { const lds_cptr kp=kp0; kload8(kf,kp); }
  CINIT(pA0,pA1,0);
  #pragma unroll
  for(int d0=0;d0<4;++d0){ pA0=__builtin_amdgcn_mfma_f32_32x32x16_bf16(kf[2*d0],qr[d0],pA0,0,0,0); pA1=__builtin_amdgcn_mfma_f32_32x32x16_bf16(kf[2*d0+1],qr[d0],pA1,0,0,0); }
  CMASK(pA0,pA1,0);
  START(pA0,pA1);
  _Pragma("unroll") for(int r=0;r<16;++r)pA1[r]=__builtin_amdgcn_exp2f(pA1[r]);
  WAIT_BAR(0);
  DMA_K(3,0);DMA_V(1,SLOTB);
  ROT();
  kload8(kf,kp0+sl_cur);
  WAIT_BAR(2);
  s16x4 vlo[8],vhi[8]; u32x4 pw0,pw1,pw2,pw3;
  #define PKW(P,B) cvtpk_s(P[B],P[B+1])
  #define PAF(k) __builtin_bit_cast(bf16x8,pw##k)
  #define VFR(i) (bf16x8){vlo[i][0],vlo[i][1],vlo[i][2],vlo[i][3],vhi[i][0],vhi[i][1],vhi[i][2],vhi[i][3]}
  #define PIN(x) asm volatile("":"+v"(x))
  #define MX3(a,b,c) __builtin_fmaxf(__builtin_fmaxf((a),(b)),(c))
  #define GAPA(MF,A0,A1,A2,A3,W0,W1,PW) do{ MF; sacc+=A0; sacc+=A1; sacc+=A2; sacc+=A3; PIN(sacc); W0; W1; PIN(PW); SBAR(); }while(0)
  #define EX(v) __builtin_amdgcn_exp2f(v)
  #define KCF(r) ((float)(((r)&3)+8*((r)>>2)))
  #define GAPB(MF,X,B,N0,N1,R) do{ MF; X[B]=EX(X[B]); X[B+1]=EX(X[B+1]); X[B+2]=EX(X[B+2]); X[B+3]=EX(X[B+3]); PIN(X); \
    N0[R]=__builtin_fmaf(sl2,KCF(R),btn_); N0[R+1]=__builtin_fmaf(sl2,KCF(R+1),btn_); N1[R]=__builtin_fmaf(sl2,KCF(R)+32.f,btn_); N1[R+1]=__builtin_fmaf(sl2,KCF(R+1)+32.f,btn_); SBAR(); }while(0)
  #define VRD(i) do{ vlo[i]=vtr(vp_+(((i)>>2)*4096+((i)&3)*1024)); vhi[i]=vtr(vp_+(((i)>>2)*4096+((i)&3)*1024+512)); }while(0)
  #define KRD(G,j) do{ if(G){ kload2(kf,kp0+sl_next,j); SBAR(); } }while(0)
  #define STEP(C0,C1,P0,P1,t,GK,GV,GL) do{ SBAR(); \
    const lds_cptr vp_=vp0+sl_prev; \
    VRD(0); SBAR(); float sacc=(P0[0]+P0[1]); \
    GAPA(C0=__builtin_amdgcn_mfma_f32_32x32x16_bf16(kf[0],qr[0],C0,0,0,0), P0[2],P0[3],P0[4],P0[5],     pw0[0]=PKW(P0,0), pw0[1]=PKW(P0,2), pw0); \
    VRD(4); SBAR(); GAPA(C1=__builtin_amdgcn_mfma_f32_32x32x16_bf16(kf[1],qr[0],C1,0,0,0), P0[6],P0[7],P0[8],P0[9],     pw0[2]=PKW(P0,4), pw0[3]=PKW(P0,6), pw0); \
    VRD(1); SBAR(); GAPA(C0=__builtin_amdgcn_mfma_f32_32x32x16_bf16(kf[2],qr[1],C0,0,0,0),   P0[10],P0[11],P0[12],P0[13], pw1[0]=PKW(P0,8), pw1[1]=PKW(P0,10), pw1); \
    VRD(5); SBAR(); GAPA(C1=__builtin_amdgcn_mfma_f32_32x32x16_bf16(kf[3],qr[1],C1,0,0,0),   P0[14],P0[15],P1[0],P1[1],   pw1[2]=PKW(P0,12),pw1[3]=PKW(P0,14), pw1); \
    VRD(2); SBAR(); GAPA(C0=__builtin_amdgcn_mfma_f32_32x32x16_bf16(kf[4],qr[2],C0,0,0,0),   P1[2],P1[3],P1[4],P1[5],     pw2[0]=PKW(P1,0), pw2[1]=PKW(P1,2), pw2); \
    VRD(6); SBAR(); GAPA(C1=__builtin_amdgcn_mfma_f32_32x32x16_bf16(kf[5],qr[2],C1,0,0,0),   P1[6],P1[7],P1[8],P1[9],     pw2[2]=PKW(P1,4), pw2[3]=PKW(P1,6), pw2); \
    VRD(3); SBAR(); GAPA(C0=__builtin_amdgcn_mfma_f32_32x32x16_bf16(kf[6],qr[3],C0,0,0,0),   P1[10],P1[11],P1[12],P1[13], pw3[0]=PKW(P1,8), pw3[1]=PKW(P1,10), pw3); \
    VRD(7); SBAR(); GAPA(C1=__builtin_amdgcn_mfma_f32_32x32x16_bf16(kf[7],qr[3],C1,0,0,0),   P1[14],P1[15],0.f,0.f,       pw3[2]=PKW(P1,12),pw3[3]=PKW(P1,14), pw3); \
    l_reg+=sacc; \
    if(GK){DMA_K((t)+3,sl_cur);} if(GV){DMA_V((t)+1,sl_next);} \
    CMASK(C0,C1,t); \
    { float a=MX3(C0[0],C0[1],C1[0]),b=MX3(C0[2],C0[3],C1[1]); a=MX3(a,C1[2],C1[3]); \
      _Pragma("unroll") for(int r=4;r<16;r+=4){a=MX3(a,C0[r],C0[r+1]);b=MX3(b,C0[r+2],C0[r+3]);a=MX3(a,C1[r],C1[r+1]);b=MX3(b,C1[r+2],C1[r+3]);} \
      float rm=__builtin_fmaxf(a,b); { auto rr=__builtin_amdgcn_permlane32_swap(__float_as_uint(rm),__float_as_uint(rm),false,false); rm=__builtin_fmaxf(__uint_as_float(rr[0]),__uint_as_float(rr[1])); } \
      resc=false; \
      if(__builtin_expect(__any(rm>(float)THRL),0)){ const float dl=__builtin_fmaxf(rm,0.f); mhat+=dl; \
        _Pragma("unroll") for(int r=0;r<16;++r){C0[r]-=dl;C1[r]-=dl;} \
        const float f=__builtin_amdgcn_exp2f(-dl); l_reg*=f; if(hi==0)wsf[r32]=f; resc=true; } } \
    const float btn_=(((selmask>>(((t)+1)>>2))&1u)!=0u)?(cb0+sl2*(float)(64*((t)+1))-mhat):MASKED; \
    SBAR(); \
    GAPB(o[0]=__builtin_amdgcn_mfma_f32_32x32x16_bf16(PAF(0),VFR(0),o[0],0,0,0), C0,0, P0,P1,0); \
    GAPB(o[1]=__builtin_amdgcn_mfma_f32_32x32x16_bf16(PAF(0),VFR(4),o[1],0,0,0), C0,4, P0,P1,2); \
    KRD(GL,0); GAPB(o[0]=__builtin_amdgcn_mfma_f32_32x32x16_bf16(PAF(1),VFR(1),o[0],0,0,0), C0,8, P0,P1,4); \
    KRD(GL,1); GAPB(o[1]=__builtin_amdgcn_mfma_f32_32x32x16_bf16(PAF(1),VFR(5),o[1],0,0,0), C0,12, P0,P1,6); \
    KRD(GL,2); GAPB(o[0]=__builtin_amdgcn_mfma_f32_32x32x16_bf16(PAF(2),VFR(2),o[0],0,0,0), C1,0, P0,P1,8); \
    KRD(GL,3); GAPB(o[1]=__builtin_amdgcn_mfma_f32_32x32x16_bf16(PAF(2),VFR(6),o[1],0,0,0), C1,4, P0,P1,10); \
    GAPB(o[0]=__builtin_amdgcn_mfma_f32_32x32x16_bf16(PAF(3),VFR(3),o[0],0,0,0), C1,8, P0,P1,12); \
    GAPB(o[1]=__builtin_amdgcn_mfma_f32_32x32x16_bf16(PAF(3),VFR(7),o[1],0,0,0), C1,12, P0,P1,14); \
    }while(0)
  CINIT(pB0,pB1,1);
  int t=1;
  #undef CMASK
  #define CMASK(P0,P1,t) do{}while(0)
  for(;t+5<NT;t+=2){
    STEP(pB0,pB1,pA0,pA1,t,true,true,true);     WAIT_BAR(2); RESC(); ROT();
    STEP(pA0,pA1,pB0,pB1,t+1,true,true,true);   WAIT_BAR(2); RESC(); ROT();
  }
  #undef CMASK
  #define CMASK(P0,P1,t) do{int jb_=(t)-(NT-4); if(jb_>=0)cmask(P0,P1,jb_,qrel,hi);}while(0)
  #define ENDW(tt) do{ if((tt)+3<NT){WAIT_BAR(2);} else if((tt)+2<NT){WAIT_BAR(1);} else {WAIT_BAR(0);} }while(0)
  for(;t+1<NT;t+=2){
    STEP(pB0,pB1,pA0,pA1,t,(t+3<NT),(t+1<NT),(t+1<NT));       ENDW(t);   RESC(); ROT();
    STEP(pA0,pA1,pB0,pB1,t+1,(t+4<NT),(t+2<NT),(t+2<NT));     ENDW(t+1); RESC(); ROT();
  }
  STEP(pB0,pB1,pA0,pA1,NT-1,false,false,false); RESC();
  { float sacc=pB0[0]+pB0[1]; _Pragma("unroll") for(int r=2;r<16;++r)sacc+=pB0[r]; _Pragma("unroll") for(int r=0;r<16;++r)sacc+=pB1[r]; l_reg+=sacc;
    pw0=(u32x4){PKW(pB0,0),PKW(pB0,2),PKW(pB0,4),PKW(pB0,6)};pw1=(u32x4){PKW(pB0,8),PKW(pB0,10),PKW(pB0,12),PKW(pB0,14)};pw2=(u32x4){PKW(pB1,0),PKW(pB1,2),PKW(pB1,4),PKW(pB1,6)};pw3=(u32x4){PKW(pB1,8),PKW(pB1,10),PKW(pB1,12),PKW(pB1,14)};
    SBAR(); pv(o,vb0+sl_cur,PAF(0),PAF(1),PAF(2),PAF(3)); }
  #undef PKW
  #undef PAF
  #undef VFR
  #undef PIN
  #undef MX3
  #undef GAPA
  #undef GAPB
  #undef KCF
  #undef EX
  #undef VRD
  #undef KRD
  #undef STEP
  #undef ENDW
  {auto rr=__builtin_amdgcn_permlane32_swap(__float_as_uint(l_reg),__float_as_uint(l_reg),false,false);l_reg=__uint_as_float(rr[0])+__uint_as_float(rr[1]);}
  if(hi==0)wsf[32+r32]=l_reg;asm volatile("s_waitcnt lgkmcnt(0)":::"memory");
  float rli[16];
  #pragma unroll
  for(int r=0;r<16;++r)rli[r]=__builtin_amdgcn_rcpf(wsf[32+crow(r,hi)]);
  int lane2=lane; asm volatile("":"+v"(lane2));
  constexpr int OP=P3_FUSED?2*DM:DM;
  bf16*Ow=O+(rowbase+q0+wid*QBLK)*OP+h*D;
  { __attribute__((address_space(3))) unsigned short*stg=(__attribute__((address_space(3))) unsigned short*)((__attribute__((address_space(3))) char*)shm+LDS_OST)+wid*2048;
    #pragma unroll
    for(int r=0;r<16;++r){const int orow=crow(r,hi);
      #pragma unroll
      for(int d0=0;d0<2;++d0)stg[orow*64+d0*32+r32]=(unsigned short)(cvtpk_s(o[d0][r]*rli[r],0.f)&0xffffu);}
    asm volatile("s_waitcnt lgkmcnt(0)":::"memory");
    #pragma unroll
    for(int i=0;i<4;++i){const int row=i*8+(lane2>>3),ch=lane2&7; const u32x4 v=*(const __attribute__((address_space(3))) u32x4*)(stg+row*64+ch*8); *(u32x4*)(Ow+(long)row*OP+ch*8)=v;} }
  asm volatile("s_waitcnt lgkmcnt(0)\n\ts_barrier":::"memory");
  #undef DMA_K
  #undef DMA_V
  #undef CMASK
  #undef CINIT
  #undef START
  #undef RESC
  #undef ROT
}
constexpr int ATTN_LDS_BYTES=LDS_BYTES;
#undef SBAR
#undef WAIT_BAR
}

struct Frame { LAS unsigned char* lds; int tid, lane, wave, vcu, G; };
#define LDS_WAIT() asm volatile("s_waitcnt lgkmcnt(0)" ::: "memory")

struct P0Item { const float* W; bf16* WT; const float* ks; int K, N, k0, n0, f8, nblk, pitch; };
__device__ __forceinline__ P0Item p0_decode(const Ptrs& P, int it) {
    constexpr int I_IN = (D / 64) * ((IN_I8 ? 256 * IN_BF_TILES : NIN) / 32), I_A = (AW / 64) * (D / 32), I_M = (D / 64) * (D / 32), I_GU = (D / 64) * (2 * DE / 32), I_D = (DE / 64) * (D / 32);
    unsigned char* ws = P.ws; P0Item q; int r = it; q.f8 = 0; q.nblk = 0; q.pitch = 0;
    if (r < I_IN) { q.W = P.w_in; q.WT = (bf16*)(ws + WS_WIN); q.ks = nullptr; q.K = D; q.N = NIN; q.nblk = (IN_I8 ? 256 * IN_BF_TILES : NIN) / 32; }
    else if ((r -= I_IN) < I_A) { q.W = P.w_attn_out; q.WT = (bf16*)(ws + WS_WA); q.ks = nullptr; q.K = AW; q.N = D; q.pitch = P3_FUSED ? 1024 : 0; }
    else if ((r -= I_A) < I_A) { q.W = P.w_sgu_out; q.WT = P3_FUSED ? (bf16*)(ws + WS_WA) + 512 : (bf16*)(ws + WS_WS); q.ks = nullptr; q.K = SW; q.N = D; q.pitch = P3_FUSED ? 1024 : 0; }
    else if ((r -= I_A) < I_M) { q.W = P.w_mix_out; q.WT = (bf16*)(ws + WS_WM); q.ks = nullptr; q.K = D; q.N = D; }
    else if (!MOE_I8 && (r -= I_M) < NE * I_GU) { const int e = r / I_GU; r -= e * I_GU; q.W = P.w_gu + (size_t)e * D * 2 * DE; q.WT = (bf16*)(ws + WS_WGU) + (size_t)e * D * 2 * DE; q.ks = P.ffn_g; q.K = D; q.N = 2 * DE; }
    else { r -= MOE_I8 ? I_M : NE * I_GU; const int e = r / I_D; r -= e * I_D; q.W = P.w_down + (size_t)e * DE * D; q.WT = MOE_F8 ? (bf16*)(ws + WS_WD + (size_t)e * DE * D) : (bf16*)(ws + WS_WD) + (size_t)e * DE * D; q.ks = nullptr; q.K = DE; q.N = D; q.f8 = MOE_F8; }
    const int nblk = q.nblk ? q.nblk : q.N / 32; q.k0 = 64 * (r / nblk); q.n0 = 32 * (r % nblk); return q;
}
__device__ __forceinline__ void p0_load(const P0Item& q, int lane, f32x4 (&buf)[8]) {
    const float* src = q.W + (size_t)(q.k0 + (lane >> 3)) * q.N + q.n0 + 4 * (lane & 7);
#pragma unroll
    for (int i = 0; i < 8; ++i) buf[i] = __builtin_nontemporal_load((const GAS f32x4*)(src + (size_t)(8 * i) * q.N));
}
__device__ __forceinline__ void p0_store(const P0Item& q, int lane, const f32x4 (&buf)[8], LAS float* scr) {
#pragma unroll
    for (int i = 0; i < 8; ++i) { const int kk = (lane >> 3) + 8 * i; const float sc = q.ks ? q.ks[q.k0 + kk] : 1.f; LAS float* d = scr + kk * 33 + 4 * (lane & 7);
        d[0] = buf[i][0] * sc; d[1] = buf[i][1] * sc; d[2] = buf[i][2] * sc; d[3] = buf[i][3] * sc; }
    LDS_WAIT(); asm volatile("" ::: "memory");
    const int c = lane & 7;
#pragma unroll
    for (int j = 0; j < 4; ++j) { const int n = (lane >> 3) + 8 * j; const LAS float* s = scr + (8 * c) * 33 + n;
        if (q.f8) { u32x2 o; unsigned w = 0u; w = __builtin_amdgcn_cvt_pk_fp8_f32(s[0 * 33] * 32.f, s[1 * 33] * 32.f, w, false); w = __builtin_amdgcn_cvt_pk_fp8_f32(s[2 * 33] * 32.f, s[3 * 33] * 32.f, w, true); o.x = w;
            w = 0u; w = __builtin_amdgcn_cvt_pk_fp8_f32(s[4 * 33] * 32.f, s[5 * 33] * 32.f, w, false); w = __builtin_amdgcn_cvt_pk_fp8_f32(s[6 * 33] * 32.f, s[7 * 33] * 32.f, w, true); o.y = w;
            *(GAS u32x2*)((unsigned char*)q.WT + (size_t)(q.n0 + n) * q.K + q.k0 + 8 * c) = o; }
        else { u32x4 o; o.x = cvt_pk_bf16(s[0 * 33], s[1 * 33]); o.y = cvt_pk_bf16(s[2 * 33], s[3 * 33]); o.z = cvt_pk_bf16(s[4 * 33], s[5 * 33]); o.w = cvt_pk_bf16(s[6 * 33], s[7 * 33]);
            *(GAS u32x4*)(q.WT + (size_t)(q.n0 + n) * (q.pitch ? q.pitch : q.K) + q.k0 + 8 * c) = o; } }
    LDS_WAIT(); asm volatile("" ::: "memory");
}
__device__ __forceinline__ void p0_gu_load(const Ptrs& P, int s, int t, f32x4 (&v)[16]) {
    const bool gu = s < NE * 64; const int e = s >> 6, n0 = (s & 63) * 32; const size_t ld = gu ? (size_t)2 * DE : (size_t)NIN;
    const float* src = (gu ? P.w_gu + (size_t)e * D * 2 * DE + n0 : P.w_in + 256 * IN_BF_TILES + 32 * (s - NE * 64)) + 4 * (t & 7) + (size_t)(4 * (t >> 3)) * ld;
#pragma unroll
    for (int i = 0; i < 4; ++i)
#pragma unroll
        for (int j = 0; j < 4; ++j) v[4 * i + j] = __builtin_nontemporal_load((const GAS f32x4*)(src + (size_t)(256 * i + j) * ld));
}
#define LDS_BARRIER() asm volatile("s_waitcnt lgkmcnt(0)\n\ts_barrier" ::: "memory")
__device__ __forceinline__ void p0_gu_process(Frame& F, const Ptrs& P, int s, f32x4 (&va)[16], const f32x4 (&gk)[4]) {
    unsigned char* ws = P.ws; LAS unsigned char* tile = F.lds; LAS unsigned* lmax = (LAS unsigned*)(F.lds + 40960);
    const int t = F.tid, n4 = 4 * (t & 7), kq = t >> 3; const bool gu = s < NE * 64;
    unsigned char* qdst = gu ? ws + WS_WGU + (size_t)(s * 32) * 1024 : ws + WS_WINQ + (size_t)((s - NE * 64) * 32) * 1024;
    float* sdst = gu ? (float*)(ws + WS_SB) + s * 32 : (float*)(ws + WS_SBIN) + (s - NE * 64) * 32;
    if (t < 32) lmax[t] = 0u;
    f32x4 m = (f32x4){0.f, 0.f, 0.f, 0.f};
#pragma unroll
    for (int i = 0; i < 4; ++i)
#pragma unroll
        for (int j = 0; j < 4; ++j) { va[4 * i + j] = va[4 * i + j] * (gu ? gk[i][j] : 1.f); m = __builtin_elementwise_max(m, __builtin_elementwise_abs(va[4 * i + j])); }
    LDS_BARRIER();
#pragma unroll
    for (int c = 0; c < 4; ++c) __hip_atomic_fetch_max(lmax + n4 + c, __float_as_uint(m[c]), __ATOMIC_RELAXED, __HIP_MEMORY_SCOPE_WORKGROUP);
    LDS_BARRIER();
    f32x4 inv;
#pragma unroll
    for (int c = 0; c < 4; ++c) inv[c] = 127.f / fmaxf(__uint_as_float(lmax[n4 + c]), 1e-30f);
#pragma unroll
    for (int i = 0; i < 4; ++i)
#pragma unroll
        for (int c = 0; c < 4; ++c) { unsigned w = 0u;
#pragma unroll
            for (int j = 0; j < 4; ++j) { const int q = (int)__builtin_rintf(va[4 * i + j][c] * inv[c]); w |= ((unsigned)q & 0xffu) << (8 * j); }
            *(LAS unsigned*)(tile + (n4 + c) * 1040 + 4 * kq + 256 * i) = w; }
    LDS_BARRIER();
#pragma unroll
    for (int j = 0; j < 4; ++j) { const int ch = t + 512 * j, n = ch >> 6, kc = ch & 63; const u32x4 w = *(const LAS u32x4*)(tile + n * 1040 + 16 * kc);
        *(GAS u32x4*)(qdst + (size_t)n * 1024 + 16 * kc) = w; }
    if (t < 32) sdst[t] = __uint_as_float(lmax[t]) * (1.f / 127.f);
    LDS_BARRIER();
}
__device__ __forceinline__ void p0_gu_strips(Frame& F, const Ptrs& P) {
    const int t = F.tid, kq = t >> 3; constexpr int NS = NE * 64 + (IN_I8 ? (NIN - 256 * IN_BF_TILES) / 32 : 0);
    if (F.vcu >= NS) return;
    f32x4 va[16], vb[16]; p0_gu_load(P, F.vcu, t, va);
    f32x4 gk[4];
#pragma unroll
    for (int i = 0; i < 4; ++i) gk[i] = *(const f32x4*)(P.ffn_g + 4 * kq + 256 * i);
    for (int s0 = F.vcu;;) {
        const int s1 = s0 + F.G; const bool has1 = s1 < NS;
        p0_gu_load(P, has1 ? s1 : NS - 1, t, vb);
        p0_gu_process(F, P, s0, va, gk);
        if (!has1) break;
        s0 = s1 + F.G; const bool has0 = s0 < NS;
        p0_gu_load(P, has0 ? s0 : NS - 1, t, va);
        p0_gu_process(F, P, s1, vb, gk);
        if (!has0) break;
    }
}
#define SUBSTAMP(i) do { if (PROBE_K >= 0 && blockIdx.x == 0 && F.tid == 0) { ((LAS unsigned long long*)(F.lds + LX_MISC))[i] = __builtin_amdgcn_s_memrealtime(); } } while (0)
__device__ __forceinline__ void p0_prologue(Frame& F, const Ptrs& P) {
    unsigned char* ws = P.ws;
    const bool strips_first = (F.vcu & 1) == 0;
#if MOE_I8
    if (strips_first) p0_gu_strips(F, P);
#endif
    SUBSTAMP(10);
    LAS float* scr = (LAS float*)(F.lds + F.wave * 16384);
    const int gw = F.vcu * NWAVES + F.wave, NGW = F.G * NWAVES;
    constexpr int I_IN = (D / 64) * ((IN_I8 ? 256 * IN_BF_TILES : NIN) / 32), I_A = (AW / 64) * (D / 32), I_M = (D / 64) * (D / 32), I_GU = (D / 64) * (2 * DE / 32), I_D = (DE / 64) * (D / 32);
    constexpr int NITEMS = I_IN + 2 * I_A + I_M + (MOE_I8 ? 0 : NE * I_GU) + NE * I_D;
    if (gw < NITEMS) {
        P0Item cur = p0_decode(P, gw), nxt = cur; f32x4 bufA[8], bufB[8]; p0_load(cur, F.lane, bufA);
        for (int it = gw;;) {
            int nit = it + NGW; bool has = nit < NITEMS;
            nxt = p0_decode(P, has ? nit : NITEMS - 1); p0_load(nxt, F.lane, bufB);
            p0_store(cur, F.lane, bufA, scr);
            if (!has) break;
            it = nit + NGW; has = it < NITEMS;
            cur = p0_decode(P, has ? it : NITEMS - 1); p0_load(cur, F.lane, bufA);
            p0_store(nxt, F.lane, bufB, scr);
            if (!has) break;
        }
    }
    SUBSTAMP(11);
    for (int i = (F.vcu * NWAVES + F.wave) * 64 + F.lane; i < 8 * 128 * 128 / 2; i += NGW * 64) { const int e0 = 2 * i, t = (e0 >> 7) & 127, s0 = e0 & 127; const f32x2 wv = *(const f32x2*)(P.w_sp + e0);
        ((unsigned*)(ws + WS_WSP))[i] = cvt_pk_bf16(s0 <= t ? wv.x : 0.f, s0 + 1 <= t ? wv.y : 0.f); }
    for (int i = (F.vcu * NWAVES + F.wave) * 64 + F.lane; i < NE * D; i += NGW * 64) { const int e = i / D, k = i % D; const float v = P.w_router[(size_t)k * NE + e] * P.ffn_g[k];
        const unsigned h = f2bf(v); ((bf16*)(ws + WS_WR))[i] = (bf16)h; ((bf16*)(ws + WS_WR))[NE * D + i] = (bf16)f2bf(v - bf2f(h)); }
    f32x4 gg[4];
#pragma unroll
    for (int j = 0; j < 4; ++j) gg[j] = ((const f32x4*)P.mix_g)[F.lane + 64 * j];
    for (int row = gw; row < T; row += 2 * NGW) {
        const int row2 = row + NGW; const bool two = row2 < T;
        const GAS f32x4* xr = (const GAS f32x4*)(P.x + (size_t)row * D) + F.lane; const GAS f32x4* xr2 = (const GAS f32x4*)(P.x + (size_t)(two ? row2 : row) * D) + F.lane;
        f32x4 v[4], u[4]; float s = 0.f, s2 = 0.f;
#pragma unroll
        for (int j = 0; j < 4; ++j) { v[j] = __builtin_nontemporal_load(xr + 64 * j); u[j] = __builtin_nontemporal_load(xr2 + 64 * j); }
#pragma unroll
        for (int j = 0; j < 4; ++j) { s += (v[j].x * v[j].x + v[j].y * v[j].y) + (v[j].z * v[j].z + v[j].w * v[j].w); s2 += (u[j].x * u[j].x + u[j].y * u[j].y) + (u[j].z * u[j].z + u[j].w * u[j].w); }
        const float rstd = 1.f / sqrtf(wave_sum(s) * (1.f / D) + EPS), rstd2 = 1.f / sqrtf(wave_sum(s2) * (1.f / D) + EPS);
#pragma unroll
        for (int j = 0; j < 4; ++j) { v[j] = v[j] * rstd * gg[j]; u[j] = u[j] * rstd2 * gg[j]; }
#pragma unroll
        for (int j = 0; j < 4; ++j) { u32x2 o; o.x = cvt_pk_bf16(v[j].x, v[j].y); o.y = cvt_pk_bf16(v[j].z, v[j].w);
            *((GAS u32x2*)(ws + WS_XN + (size_t)row * D * 2) + F.lane + 64 * j) = o; }
        if (two) {
#pragma unroll
            for (int j = 0; j < 4; ++j) { u32x2 o; o.x = cvt_pk_bf16(u[j].x, u[j].y); o.y = cvt_pk_bf16(u[j].z, u[j].w);
                *((GAS u32x2*)(ws + WS_XN + (size_t)row2 * D * 2) + F.lane + 64 * j) = o; } }
#if IN_I8
        { float a1 = 0.f, a2 = 0.f;
#pragma unroll
          for (int j = 0; j < 4; ++j) { const f32x4 av = __builtin_elementwise_abs(v[j]), au = __builtin_elementwise_abs(u[j]); a1 = fmaxf(a1, fmaxf(fmaxf(av.x, av.y), fmaxf(av.z, av.w))); a2 = fmaxf(a2, fmaxf(fmaxf(au.x, au.y), fmaxf(au.z, au.w))); }
          a1 = fmaxf(wave_max(a1), 1e-30f); a2 = fmaxf(wave_max(a2), 1e-30f); const float q1 = 127.f / a1, q2 = 127.f / a2;
#pragma unroll
          for (int j = 0; j < 4; ++j) { const unsigned w = ((unsigned)(int)__builtin_rintf(v[j].x * q1) & 0xffu) | (((unsigned)(int)__builtin_rintf(v[j].y * q1) & 0xffu) << 8) | (((unsigned)(int)__builtin_rintf(v[j].z * q1) & 0xffu) << 16) | ((unsigned)(int)__builtin_rintf(v[j].w * q1) << 24);
              *((GAS unsigned*)(ws + WS_XNQ + (size_t)row * D) + F.lane + 64 * j) = w; }
          if (F.lane == 0) ((float*)(ws + WS_SXN))[row] = a1 * (1.f / 127.f);
          if (two) {
#pragma unroll
              for (int j = 0; j < 4; ++j) { const unsigned w = ((unsigned)(int)__builtin_rintf(u[j].x * q2) & 0xffu) | (((unsigned)(int)__builtin_rintf(u[j].y * q2) & 0xffu) << 8) | (((unsigned)(int)__builtin_rintf(u[j].z * q2) & 0xffu) << 16) | ((unsigned)(int)__builtin_rintf(u[j].w * q2) << 24);
                  *((GAS unsigned*)(ws + WS_XNQ + (size_t)row2 * D) + F.lane + 64 * j) = w; }
              if (F.lane == 0) ((float*)(ws + WS_SXN))[row2] = a2 * (1.f / 127.f); } }
#endif
    }
#if MOE_I8
    if (!strips_first) { __syncthreads(); p0_gu_strips(F, P); }
#endif
}
__device__ __forceinline__ void moe_tables(Frame& F, const unsigned* ctl) {
    LAS int* tbase = (LAS int*)(F.lds + LX_TBASE); LAS int* tile_e = (LAS int*)(F.lds + LX_TILEE);
    if (F.tid < 64) { const int c = F.tid < NE ? (int)ctl[CW_CNT + 64 * F.tid] : 0; const int n = (c + 255) >> 8; int incl = n;
#pragma unroll
        for (int o = 1; o < 64; o <<= 1) { const int t = __shfl_up(incl, o); if (F.lane >= o) incl += t; }
        if (F.tid <= NE) tbase[F.tid] = incl - n;
    }
    __syncthreads();
    for (int mt = F.tid; mt < NROWS_PAD / 256; mt += NWAVES * 64) { int e = 0;
        for (int i = 0; i < NE; ++i) if (mt >= tbase[i + 1]) e = i + 1;
        tile_e[mt] = e < NE ? e : NE - 1; }
    __syncthreads();
}


__device__ __forceinline__ void p5_router(Frame& F, const Ptrs& P) {
    unsigned char* ws = P.ws; unsigned* ctl = (unsigned*)(ws + WS_CTL);
    LAS float* red = (LAS float*)F.lds;
    LAS unsigned* lcnt = (LAS unsigned*)(F.lds + 40960);
    LAS f32x2* rowinfo = (LAS f32x2*)(F.lds + 41472);
    LAS unsigned* lbase = lcnt + 32;
    const int w = F.wave, lane = F.lane, gI = w & 1, kq = w >> 1, r32 = lane & 31, hi = lane >> 5;
    const bf16* WR = (const bf16*)(ws + WS_WR);
    for (int grp = blockIdx.x; grp < T / 64; grp += F.G) {
        if (F.tid < 64) lcnt[F.tid] = 0u;
        const int tok = grp * 64 + gI * 32 + r32;
        const float* xr = (const float*)(ws + WS_H1) + (size_t)tok * D + kq * 256 + 8 * hi;
        const bf16* xb = (const bf16*)(ws + WS_H1B) + (size_t)tok * D + kq * 256 + 8 * hi; (void)xb; (void)xr;
        const bf16* whi = WR + (size_t)r32 * D + kq * 256 + 8 * hi; const bf16* wlo = whi + NE * D;
        f32x16 c = {}; float ss = 0.f; f32x4 am = (f32x4){0.f, 0.f, 0.f, 0.f};
#if H1_BF16
        u32x4 xall[16];
#pragma unroll
        for (int s = 0; s < 16; ++s) xall[s] = *(const u32x4*)(xb + 16 * s);
#endif
#pragma unroll
        for (int s = 0; s < 16; ++s) {
#if H1_BF16
            const u32x4 xraw = xall[s];
            const f32x4 x0 = (f32x4){bf2f(xraw[0] & 0xffffu), bf2f(xraw[0] >> 16), bf2f(xraw[1] & 0xffffu), bf2f(xraw[1] >> 16)}, x1 = (f32x4){bf2f(xraw[2] & 0xffffu), bf2f(xraw[2] >> 16), bf2f(xraw[3] & 0xffffu), bf2f(xraw[3] >> 16)};
#else
            const f32x4 x0 = *(const f32x4*)(xr + 16 * s), x1 = *(const f32x4*)(xr + 16 * s + 4);
#endif
            am = __builtin_elementwise_max(am, __builtin_elementwise_max(__builtin_elementwise_abs(x0), __builtin_elementwise_abs(x1)));
            ss += (x0[0] * x0[0] + x0[1] * x0[1]) + (x0[2] * x0[2] + x0[3] * x0[3]) + (x1[0] * x1[0] + x1[1] * x1[1]) + (x1[2] * x1[2] + x1[3] * x1[3]);
            u32x4 hw, lw;
            { const unsigned h = cvt_pk_bf16(x0[0], x0[1]); hw[0] = h; lw[0] = cvt_pk_bf16(x0[0] - __uint_as_float(h << 16), x0[1] - __uint_as_float(h & 0xffff0000u)); }
            { const unsigned h = cvt_pk_bf16(x0[2], x0[3]); hw[1] = h; lw[1] = cvt_pk_bf16(x0[2] - __uint_as_float(h << 16), x0[3] - __uint_as_float(h & 0xffff0000u)); }
            { const unsigned h = cvt_pk_bf16(x1[0], x1[1]); hw[2] = h; lw[2] = cvt_pk_bf16(x1[0] - __uint_as_float(h << 16), x1[1] - __uint_as_float(h & 0xffff0000u)); }
            { const unsigned h = cvt_pk_bf16(x1[2], x1[3]); hw[3] = h; lw[3] = cvt_pk_bf16(x1[2] - __uint_as_float(h << 16), x1[3] - __uint_as_float(h & 0xffff0000u)); }
            const bf16x8 xh = __builtin_bit_cast(bf16x8, hw), xl = __builtin_bit_cast(bf16x8, lw);
            const bf16x8 ah = *(const bf16x8*)(whi + 16 * s), al = *(const bf16x8*)(wlo + 16 * s);
            c = __builtin_amdgcn_mfma_f32_32x32x16_bf16(ah, xh, c, 0, 0, 0);
            if (!H1_BF16) c = __builtin_amdgcn_mfma_f32_32x32x16_bf16(ah, xl, c, 0, 0, 0);
            c = __builtin_amdgcn_mfma_f32_32x32x16_bf16(al, xh, c, 0, 0, 0);
        }
#pragma unroll
        for (int r = 0; r < 16; ++r) red[(w * 18 + r) * 64 + lane] = c[r];
        red[(w * 18 + 16) * 64 + lane] = ss; red[(w * 18 + 17) * 64 + lane] = fmaxf(fmaxf(am[0], am[1]), fmaxf(am[2], am[3]));
        __syncthreads();
        int idx[4]; unsigned lpos[4]; float pw[4]; float rstd = 0.f;
        if (kq == 0) {
            float lg[16], pl[16]; float ssum = 0.f, amax = 0.f;
#pragma unroll
            for (int r = 0; r < 16; ++r) lg[r] = 0.f;
#pragma unroll
            for (int q = 0; q < 4; ++q) {
#pragma unroll
                for (int r = 0; r < 16; ++r) lg[r] += red[((w + 2 * q) * 18 + r) * 64 + lane];
                ssum += red[((w + 2 * q) * 18 + 16) * 64 + lane]; amax = fmaxf(amax, red[((w + 2 * q) * 18 + 17) * 64 + lane]); }
            ssum += __shfl_xor(ssum, 32); amax = fmaxf(fmaxf(amax, __shfl_xor(amax, 32)), 1e-30f);
            rstd = 1.f / sqrtf(ssum * (1.f / D) + EPS);
            if (hi == 0) rowinfo[gI * 32 + r32] = (f32x2){127.f / amax, MOE_I8 ? rstd * amax * (1.f / 127.f) : rstd};
#pragma unroll
            for (int r = 0; r < 16; ++r) { lg[r] = lg[r] * rstd + P.b_router[(r & 3) + 8 * (r >> 2) + 4 * hi]; pl[r] = __shfl_xor(lg[r], 32); }
            float v[32];
#pragma unroll
            for (int e = 0; e < 32; ++e) { const int half = (e >> 2) & 1, r = (e & 3) + 4 * (e >> 3); v[e] = (half == hi) ? lg[r] : pl[r]; }
            float val[4];
#pragma unroll
            for (int k = 0; k < 4; ++k) { int best = 0; float bv = -INFINITY;
#pragma unroll
                for (int e = 0; e < 32; ++e) if (v[e] > bv) { bv = v[e]; best = e; }
#pragma unroll
                for (int e = 0; e < 32; ++e) if (e == best) v[e] = -INFINITY;
                idx[k] = best; val[k] = bv; }
            float den = 0.f;
#pragma unroll
            for (int k = 0; k < 4; ++k) { pw[k] = __expf(val[k] - val[0]); den += pw[k]; }
            const float rden = 1.f / den;
#pragma unroll
            for (int k = 0; k < 4; ++k) { pw[k] *= rden; lpos[k] = 0u; if (hi == 0) lpos[k] = atomicAdd((unsigned*)&lcnt[idx[k]], 1u); }
        }
        __syncthreads();
        if (F.tid < NE) ((unsigned*)(ws + WS_HIST))[grp * NE + F.tid] = lcnt[F.tid];
        if (kq == 0 && hi == 0) {
            unsigned* slot = (unsigned*)(ws + WS_TOKSLOT); float* tw = (float*)(ws + WS_TOKW);
#pragma unroll
            for (int k = 0; k < 4; ++k) { slot[tok * 4 + k] = (unsigned)idx[k] | (lpos[k] << 8); tw[tok * 4 + k] = pw[k]; }
            ((float*)(ws + WS_RSTD2))[tok] = MOE_I8 ? rowinfo[gI * 32 + r32].y : rstd;
        }
#if MOE_I8
        { const float qs = rowinfo[gI * 32 + r32].x; unsigned char* qrow = ws + WS_H1Q + (size_t)tok * D + kq * 256 + 8 * hi; LAS unsigned char* qst = F.lds + 49152 + w * (32 * 272);
#if H1_BF16
          u32x4 xall[16];
#pragma unroll
          for (int s = 0; s < 16; ++s) xall[s] = *(const u32x4*)(xb + 16 * s);
#endif
#pragma unroll
          for (int s = 0; s < 16; ++s) {
#if H1_BF16
              const u32x4 xraw = xall[s];
              const f32x4 x0 = (f32x4){bf2f(xraw[0] & 0xffffu), bf2f(xraw[0] >> 16), bf2f(xraw[1] & 0xffffu), bf2f(xraw[1] >> 16)}, x1 = (f32x4){bf2f(xraw[2] & 0xffffu), bf2f(xraw[2] >> 16), bf2f(xraw[3] & 0xffffu), bf2f(xraw[3] >> 16)};
#else
              const f32x4 x0 = *(const f32x4*)(xr + 16 * s), x1 = *(const f32x4*)(xr + 16 * s + 4);
#endif
              u32x2 w;
              w.x = ((unsigned)(int)__builtin_rintf(x0[0] * qs) & 0xffu) | (((unsigned)(int)__builtin_rintf(x0[1] * qs) & 0xffu) << 8) | (((unsigned)(int)__builtin_rintf(x0[2] * qs) & 0xffu) << 16) | ((unsigned)(int)__builtin_rintf(x0[3] * qs) << 24);
              w.y = ((unsigned)(int)__builtin_rintf(x1[0] * qs) & 0xffu) | (((unsigned)(int)__builtin_rintf(x1[1] * qs) & 0xffu) << 8) | (((unsigned)(int)__builtin_rintf(x1[2] * qs) & 0xffu) << 16) | ((unsigned)(int)__builtin_rintf(x1[3] * qs) << 24);
              *(LAS u32x2*)(qst + r32 * 272 + 16 * s + 8 * hi) = w; (void)qrow; }
          asm volatile("s_waitcnt lgkmcnt(0)" ::: "memory");
#pragma unroll
          for (int j = 0; j < 8; ++j) { const int idx = lane + 64 * j, tk = idx >> 4, ch = idx & 15; const u32x4 v = *(const LAS u32x4*)(qst + tk * 272 + 16 * ch);
              *(u32x4*)(ws + WS_H1Q + (size_t)(grp * 64 + gI * 32 + tk) * D + kq * 256 + 16 * ch) = v; } }
#endif
        __syncthreads();
    }
}
__device__ __forceinline__ void p5b_lists(Frame& F, const Ptrs& P) {
    unsigned char* ws = P.ws; unsigned* ctl = (unsigned*)(ws + WS_CTL); const unsigned* hist = (const unsigned*)(ws + WS_HIST);
    LAS unsigned* part = (LAS unsigned*)F.lds;
    LAS unsigned* lbase = part + 512;
    for (int grp = blockIdx.x; grp < T / 64; grp += F.G) {
        { const int e = F.tid & 31, pt = F.tid >> 5; unsigned s = 0u;
#pragma unroll
          for (int i = 0; i < 16; ++i) { const int g2 = pt * 16 + i; const unsigned v = hist[g2 * NE + e]; s += (g2 < grp) ? v : 0u; }
          part[pt * 32 + e] = s; }
        __syncthreads();
        if (F.tid < NE) { unsigned s = 0u;
#pragma unroll
            for (int i = 0; i < 16; ++i) s += part[i * 32 + F.tid];
            lbase[F.tid] = s;
            if (grp == T / 64 - 1) ctl[CW_CNT + 64 * F.tid] = s + hist[grp * NE + F.tid]; }
        __syncthreads();
        if (F.tid < 256) { const int tok = grp * 64 + (F.tid >> 2); unsigned* slot = (unsigned*)(ws + WS_TOKSLOT) + tok * 4 + (F.tid & 3);
            const unsigned sv = *slot; const unsigned e = sv & 0xffu, pos = lbase[e] + (sv >> 8);
            *slot = e | (pos << 8); ((int*)(ws + WS_LIST))[(size_t)e * T + pos] = tok; ((float*)(ws + WS_RLIST))[(size_t)e * T + pos] = ((const float*)(ws + WS_RSTD2))[tok]; }
        __syncthreads();
    }
}
__device__ __forceinline__ void p8_combine(Frame& F, const Ptrs& P) {
    unsigned char* ws = P.ws; const LAS int* tbase = (const LAS int*)(F.lds + LX_TBASE);
    const int gw = F.vcu * NWAVES + F.wave, NGW = F.G * NWAVES, lane = F.lane;
    const bf16* Y = (const bf16*)(ws + WS_Y); const unsigned* slot = (const unsigned*)(ws + WS_TOKSLOT); const float* tw = (const float*)(ws + WS_TOKW);
    f32x4 gg[4];
#pragma unroll
    for (int j = 0; j < 2; ++j) { gg[2 * j] = *(const f32x4*)(P.fin_g + 8 * lane + 512 * j); gg[2 * j + 1] = *(const f32x4*)(P.fin_g + 8 * lane + 512 * j + 4); }
    for (int tok = gw; tok < T; tok += NGW) {
        const float* hr = (const float*)(ws + WS_H1) + (size_t)tok * D + 8 * lane; f32x4 v[4];
#pragma unroll
#if H1_BF16
        for (int j = 0; j < 2; ++j) { const u32x4 hb = *(const u32x4*)((const bf16*)(ws + WS_H1B) + (size_t)tok * D + 8 * lane + 512 * j);
            v[2 * j] = (f32x4){bf2f(hb[0] & 0xffffu), bf2f(hb[0] >> 16), bf2f(hb[1] & 0xffffu), bf2f(hb[1] >> 16)}; v[2 * j + 1] = (f32x4){bf2f(hb[2] & 0xffffu), bf2f(hb[2] >> 16), bf2f(hb[3] & 0xffffu), bf2f(hb[3] >> 16)}; }
        (void)hr;
#else
        for (int j = 0; j < 2; ++j) { v[2 * j] = *(const f32x4*)(hr + 512 * j); v[2 * j + 1] = *(const f32x4*)(hr + 512 * j + 4); }
#endif
        const u32x4 sl = *(const u32x4*)(slot + tok * 4); const f32x4 wv = *(const f32x4*)(tw + tok * 4);
#if Y_F8
        u32x2 y8[4][2];
#pragma unroll
        for (int k = 0; k < 4; ++k) { const int e = sl[k] & 0xff, pos = sl[k] >> 8; const unsigned char* yr = (const unsigned char*)Y + (size_t)(tbase[e] * 256 + pos) * D + 8 * lane; y8[k][0] = *(const u32x2*)yr; y8[k][1] = *(const u32x2*)(yr + 512); }
#pragma unroll
        for (int k = 0; k < 4; ++k)
#pragma unroll
            for (int j = 0; j < 2; ++j) { const u32x2 q = y8[k][j]; const float wk = wv[k];
                const f32x2 a = __builtin_amdgcn_cvt_pk_f32_fp8(q.x, false), b = __builtin_amdgcn_cvt_pk_f32_fp8(q.x, true), c = __builtin_amdgcn_cvt_pk_f32_fp8(q.y, false), d = __builtin_amdgcn_cvt_pk_f32_fp8(q.y, true);
                v[2 * j][0] += wk * a[0]; v[2 * j][1] += wk * a[1]; v[2 * j][2] += wk * b[0]; v[2 * j][3] += wk * b[1];
                v[2 * j + 1][0] += wk * c[0]; v[2 * j + 1][1] += wk * c[1]; v[2 * j + 1][2] += wk * d[0]; v[2 * j + 1][3] += wk * d[1]; }
#endif
        u32x4 y[4][2];
#pragma unroll
        for (int k = 0; k < 4; ++k) { if (Y_F8) break; const int e = sl[k] & 0xff, pos = sl[k] >> 8; const bf16* yr = Y + (size_t)(tbase[e] * 256 + pos) * D + 8 * lane; y[k][0] = *(const u32x4*)yr; y[k][1] = *(const u32x4*)(yr + 512); }
#pragma unroll
        for (int k = 0; k < 4; ++k)
#pragma unroll
            for (int j = 0; j < 2; ++j) { if (Y_F8) break; const u32x4 q = y[k][j]; const float wk = wv[k];
                v[2 * j][0] += wk * bf2f(q.x & 0xffffu); v[2 * j][1] += wk * bf2f(q.x >> 16); v[2 * j][2] += wk * bf2f(q.y & 0xffffu); v[2 * j][3] += wk * bf2f(q.y >> 16);
                v[2 * j + 1][0] += wk * bf2f(q.z & 0xffffu); v[2 * j + 1][1] += wk * bf2f(q.z >> 16); v[2 * j + 1][2] += wk * bf2f(q.w & 0xffffu); v[2 * j + 1][3] += wk * bf2f(q.w >> 16); }
        float s = 0.f;
#pragma unroll
        for (int j = 0; j < 4; ++j) s += (v[j][0] * v[j][0] + v[j][1] * v[j][1]) + (v[j][2] * v[j][2] + v[j][3] * v[j][3]);
        const float rstd = 1.f / sqrtf(wave_sum(s) * (1.f / D) + EPS);
        float* orow = P.out + (size_t)tok * D + 8 * lane;
#pragma unroll
        for (int j = 0; j < 2; ++j) { *(f32x4*)(orow + 512 * j) = v[2 * j] * rstd * gg[2 * j]; *(f32x4*)(orow + 512 * j + 4) = v[2 * j + 1] * rstd * gg[2 * j + 1]; }
    }
}

constexpr int SGU_PITCH = 136;
__device__ __forceinline__ void sgu_unit(Frame& F, const Ptrs& P, int hu) {
    unsigned char* ws = P.ws; const int b = hu >> 6, c = (hu >> 1) & 31, gh = hu & 1, tok0 = b * SEQ + c * 128;
    const bf16* VV = (const bf16*)(ws + WS_VV); const bf16* U = (const bf16*)(ws + WS_U); bf16* SG = (bf16*)(ws + WS_SG);
    LAS bf16* vnT = (LAS bf16*)F.lds;
    int tid = F.tid; asm volatile("" : "+v"(tid));
    const int w = __builtin_amdgcn_readfirstlane(tid >> 6), lane = tid & 63;
    const int gl = w >> 1, th = w & 1, g = 4 * gh + gl, r32 = lane & 31, hi = lane >> 5;
    u32x4 rs[16], ru[8];
#pragma unroll
    for (int i = 0; i < 16; ++i) rs[i] = *((const u32x4*)(VV + (size_t)(tok0 + 16 * w + i) * SW) + lane);
#pragma unroll
    for (int j = 0; j < 8; ++j) { const int idx = lane + 64 * j; ru[j] = *(const u32x4*)(U + (size_t)(tok0 + 64 * th + (idx >> 3)) * SW + g * 64 + 8 * (idx & 7)); }
    const int chunk = lane & 31; const bool mine = (lane >> 5) == gh;
    const f32x4 g0 = *(const f32x4*)(P.ln_g + 8 * lane), g1 = *(const f32x4*)(P.ln_g + 8 * lane + 4), b0 = *(const f32x4*)(P.ln_b + 8 * lane), b1 = *(const f32x4*)(P.ln_b + 8 * lane + 4);
#pragma unroll
    for (int i = 0; i < 16; ++i) { float v[8]; float s1 = 0.f, s2 = 0.f;
#pragma unroll
        for (int e = 0; e < 4; ++e) { v[2 * e] = bf2f(rs[i][e] & 0xffffu); v[2 * e + 1] = bf2f(rs[i][e] >> 16); s1 += v[2 * e] + v[2 * e + 1]; s2 += v[2 * e] * v[2 * e] + v[2 * e + 1] * v[2 * e + 1]; }
#pragma unroll
        for (int o = 1; o < 64; o <<= 1) { s1 += __shfl_xor(s1, o); s2 += __shfl_xor(s2, o); }
        const float mu = s1 * (1.f / SW), rstd = 1.f / sqrtf(fmaxf(s2 * (1.f / SW) - mu * mu, 0.f) + EPS);
        if (mine) { const int sp = (16 * w + i) ^ ((chunk & 15) << 3);
#pragma unroll
            for (int e = 0; e < 8; ++e) { const float gg = e < 4 ? g0[e] : g1[e - 4], bb = e < 4 ? b0[e] : b1[e - 4]; vnT[(8 * chunk + e) * SGU_PITCH + sp] = (bf16)f2bf((v[e] - mu) * rstd * gg + bb); } } }
    const bf16* Wg = (const bf16*)(ws + WS_WSP) + (size_t)g * 128 * 128;
    const int nst = 4 * th + 4;
    bf16x8 wf[2][8];
#pragma unroll
    for (int tt = 0; tt < 2; ++tt)
#pragma unroll
        for (int ks = 0; ks < 8; ++ks) { const int t = 64 * th + 32 * tt + r32, s0 = 16 * ks + 8 * hi; wf[tt][ks] = *(const bf16x8*)(Wg + (size_t)t * 128 + s0); }
    const float bias0 = P.b_sp[g * 128 + 64 * th + r32], bias1 = P.b_sp[g * 128 + 64 * th + 32 + r32];
    LDS_BARRIER();
    f32x16 acc[2][2];
#pragma unroll
    for (int dt = 0; dt < 2; ++dt)
#pragma unroll
        for (int tt = 0; tt < 2; ++tt) acc[dt][tt] = f32x16{};
#pragma unroll
    for (int ks = 0; ks < 8; ++ks) { if (ks < nst) {
        const int s0 = 16 * ks + 8 * hi; bf16x8 af[2];
#pragma unroll
        for (int dt = 0; dt < 2; ++dt) { const int cc = 64 * gl + 32 * dt + r32; af[dt] = *(const LAS bf16x8*)(vnT + cc * SGU_PITCH + (s0 ^ (((cc >> 3) & 15) << 3))); }
#pragma unroll
        for (int tt = 0; tt < 2; ++tt) {
#pragma unroll
            for (int dt = 0; dt < 2; ++dt) acc[dt][tt] = __builtin_amdgcn_mfma_f32_32x32x16_bf16(af[dt], wf[tt][ks], acc[dt][tt], 0, 0, 0); } } }
    LDS_BARRIER();
    LAS bf16* ost = (LAS bf16*)(F.lds + w * (64 * 72 * 2));
#pragma unroll
    for (int tt = 0; tt < 2; ++tt) { const float bias = tt ? bias1 : bias0;
#pragma unroll
        for (int dt = 0; dt < 2; ++dt)
#pragma unroll
            for (int q = 0; q < 4; ++q) { u32x2 ov; ov.x = cvt_pk_bf16(acc[dt][tt][4 * q] + bias, acc[dt][tt][4 * q + 1] + bias); ov.y = cvt_pk_bf16(acc[dt][tt][4 * q + 2] + bias, acc[dt][tt][4 * q + 3] + bias);
                *(LAS u32x2*)(ost + (32 * tt + r32) * 72 + 32 * dt + 8 * q + 4 * hi) = ov; } }
    asm volatile("s_waitcnt lgkmcnt(0)" ::: "memory");
#pragma unroll
    for (int j = 0; j < 8; ++j) { const int idx = lane + 64 * j, row = idx >> 3, ch = idx & 7; const u32x4 m = *(const LAS u32x4*)(ost + row * 72 + 8 * ch); const u32x4 uu = ru[j]; u32x4 o;
#pragma unroll
        for (int e = 0; e < 4; ++e) o[e] = cvt_pk_bf16(bf2f(uu[e] & 0xffffu) * bf2f(m[e] & 0xffffu), bf2f(uu[e] >> 16) * bf2f(m[e] >> 16));
        const size_t tok = (size_t)(tok0 + 64 * th + row); const int cch = g * 64 + 8 * ch;
        *(u32x4*)(P3_FUSED ? (bf16*)(ws + WS_O) + tok * 1024 + 512 + cch : SG + tok * SW + cch) = o; }
    LDS_BARRIER();
}
__device__ __forceinline__ void p2_mixer(Frame& F, const Ptrs& P, char* lds_generic, int nrep) {
    unsigned char* ws = P.ws;
    const attn_body::bf16* Q = (const attn_body::bf16*)(ws + WS_Q); const attn_body::bf16* K = (const attn_body::bf16*)(ws + WS_K); const attn_body::bf16* V = (const attn_body::bf16*)(ws + WS_V);
    const float* KM = (const float*)(ws + WS_CTL) + CW_KM; attn_body::bf16* O = (attn_body::bf16*)(ws + WS_O);
    SUBSTAMP(14);
    for (int p = F.vcu; p < NBATCH * NH * 8; p += F.G) { const int bh = p >> 3, s = p & 7;
        for (int r = 0; r < 2 * nrep; ++r)
            attn_body::attn_unit<8>(bh / NH, bh % NH, (r & 1) ? 15 - s : s, Q, K, V, KM, O, lds_generic); }
    SUBSTAMP(12);
    for (int hu = F.vcu; hu < NBATCH * 32 * 2; hu += F.G) for (int r = 0; r < SGU_REP; ++r) sgu_unit(F, P, hu);
    SUBSTAMP(13);
}

struct Args { Ptrs P; int ph_lo, ph_hi, li, pad; };
__global__ void __launch_bounds__(NWAVES * 64, 2) fwd(Args args) {
    extern __shared__ __attribute__((aligned(16))) unsigned char lds_raw[];
    Frame F; F.lds = (LAS unsigned char*)lds_raw; F.tid = threadIdx.x; F.lane = F.tid & 63; F.wave = __builtin_amdgcn_readfirstlane(F.tid >> 6);
    F.G = gridDim.x; { const int bx = blockIdx.x; F.vcu = (F.G % 8 == 0) ? (bx % 8) * (F.G / 8) + bx / 8 : bx; }
    const Ptrs& P = args.P; unsigned char* ws = P.ws; unsigned* ctl = (unsigned*)(ws + WS_CTL);
    if (F.tid < 4) ((LAS unsigned*)(F.lds + LX_BAR))[F.tid] = 0u;
    __syncthreads();
    XcdBarrier bar = xcd_barrier_post(ctl + CW_BAR + args.li * XCD_BAR_WORDS, (volatile LAS unsigned*)(F.lds + LX_BAR));
    const int lo = args.ph_lo, hi = args.ph_hi;
#define IN(k) (lo <= (k) && (k) < hi)
#define STAMP(i) do { if (PROBE_K >= 0 && blockIdx.x == 0 && F.tid == 0) { ((LAS unsigned long long*)(F.lds + LX_MISC))[i] = __builtin_amdgcn_s_memrealtime(); } } while (0)
#ifndef REP_PHASE
#define REP_PHASE -1
#endif
#define REPS(k) (((k) == REP_PHASE) ? 2 : 1)
#define SEAM(k) do { if (IN(k) && IN((k) + 1)) { STAMP(20 + (k)); xcd_barrier(bar); } } while (0)

    STAMP(0);
    if (IN(0)) _Pragma("unroll") for (int rep_ = 0; rep_ < REPS(0); ++rep_) { p0_prologue(F, P); if (rep_ + 1 < REPS(0)) xcd_barrier(bar); else SEAM(0); }
    STAMP(1);
    if (IN(1)) _Pragma("unroll") for (int rep_ = 0; rep_ < REPS(1); ++rep_) {
        DenseSched S{(const char*)(ws + WS_XN), (const char*)(ws + WS_WIN), D, D, T / 256, IN_I8 ? IN_BF_TILES : NIN / 256, F.G, (int)blockIdx.x, WGM_IN};
        EpiIn E{ws, (float*)(ws + WS_CTL) + CW_KM};
        pg8::gemm_phase<EpiIn, DenseSched, true>(F.lds, D, D, S, E);
#if IN_I8
        BalSched S2{(const char*)(ws + WS_XNQ), (const char*)(ws + WS_WINQ), D / 2, D / 2, T / 256, NIN / 256 - IN_BF_TILES, F.G, (int)blockIdx.x, (T / 256) * IN_BF_TILES};
        EpiInQ E2{ws, (const float*)(ws + WS_SXN), (const float*)(ws + WS_SBIN), (float*)(ws + WS_CTL) + CW_KM, F.lds};
        pg8::gemm_phase<EpiInQ, BalSched, true>(F.lds, D / 2, D / 2, S2, E2);
#endif
        if (rep_ + 1 < REPS(1)) xcd_barrier(bar); else SEAM(1);
    }
    STAMP(2);
    if (IN(2)) _Pragma("unroll") for (int rep_ = 0; rep_ < REPS(2); ++rep_) { p2_mixer(F, P, (char*)lds_raw, args.pad); if (rep_ + 1 < REPS(2)) xcd_barrier(bar); else SEAM(2); }
    STAMP(3);
    if (IN(3)) _Pragma("unroll") for (int rep_ = 0; rep_ < REPS(3); ++rep_) {
#if P3_FUSED
        DenseSched S{(const char*)(ws + WS_O), (const char*)(ws + WS_WA), D, D, T / 256, D / 256, F.G, (int)blockIdx.x, WGM_MID};
        EpiMergeF E{ws};
        pg8::gemm_phase<EpiMergeF, DenseSched, true>(F.lds, D, D, S, E);
#else
        MergeSched S{(const char*)(ws + WS_O), (const char*)(ws + WS_WA), F.G, (int)blockIdx.x};
        EpiMerge E{ws};
        pg8::gemm_phase<EpiMerge, MergeSched, true>(F.lds, AW, AW, S, E);
#endif
        if (rep_ + 1 < REPS(3)) xcd_barrier(bar); else SEAM(3);
    }
    STAMP(4);
    if (IN(4)) _Pragma("unroll") for (int rep_ = 0; rep_ < REPS(4); ++rep_) {
        DenseSched S{(const char*)(ws + WS_MG), (const char*)(ws + WS_WM), D, D, T / 256, D / 256, F.G, (int)blockIdx.x, WGM_MID};
        EpiH1 E{P.x, (float*)(ws + WS_H1), (bf16*)(ws + WS_H1B)};
        pg8::gemm_phase<EpiH1, DenseSched, true>(F.lds, D, D, S, E);
        if (rep_ + 1 < REPS(4)) xcd_barrier(bar); else SEAM(4);
    }
    STAMP(5);
    if (IN(5)) { p5_router(F, P); xcd_barrier(bar); p5b_lists(F, P); SEAM(5); }
    STAMP(6);
    if (IN(6)) _Pragma("unroll") for (int rep_ = 0; rep_ < REPS(6); ++rep_) {
        moe_tables(F, ctl);
#if MOE_I8
        MoeSched<true> S{(const char*)(ws + WS_H1Q), (const char*)(ws + WS_WGU), (const int*)(ws + WS_LIST), (const LAS int*)(F.lds + LX_TBASE), (const LAS int*)(F.lds + LX_TILEE), ctl, 8, F.G, (int)blockIdx.x, D / 2};
        EpiGuQ E{(const float*)(ws + WS_RLIST), (const float*)(ws + WS_SB), P.b_gu, (bf16*)(ws + WS_HID), F.lds};
        pg8::gemm_phase<EpiGuQ, MoeSched<true>, true>(F.lds, D / 2, D / 2, S, E);
#else
        MoeSched<true> S{(const char*)(ws + WS_H1B), (const char*)(ws + WS_WGU), (const int*)(ws + WS_LIST), (const LAS int*)(F.lds + LX_TBASE), (const LAS int*)(F.lds + LX_TILEE), ctl, 8, F.G, (int)blockIdx.x, D};
        EpiGu E{(const float*)(ws + WS_RLIST), P.b_gu, (bf16*)(ws + WS_HID)};
        pg8::gemm_phase<EpiGu, MoeSched<true>, true>(F.lds, D, D, S, E);
#endif
        if (rep_ + 1 < REPS(6)) xcd_barrier(bar); else SEAM(6);
    }
    STAMP(7);
    if (IN(7)) _Pragma("unroll") for (int rep_ = 0; rep_ < REPS(7); ++rep_) {
        moe_tables(F, ctl);
        MoeSched<false> S{(const char*)(ws + WS_HID), (const char*)(ws + WS_WD), nullptr, (const LAS int*)(F.lds + LX_TBASE), (const LAS int*)(F.lds + LX_TILEE), ctl, 4, F.G, (int)blockIdx.x, MOE_F8 ? DE / 2 : DE};
        EpiDown E{P.b_down, (bf16*)(ws + WS_Y), F.lds};
        pg8::gemm_phase<EpiDown, MoeSched<false>, true>(F.lds, MOE_F8 ? DE / 2 : DE, MOE_F8 ? DE / 2 : DE, S, E);
        if (rep_ + 1 < REPS(7)) xcd_barrier(bar); else SEAM(7);
    }
    STAMP(8);
    if (IN(8)) _Pragma("unroll") for (int rep_ = 0; rep_ < REPS(8); ++rep_) { moe_tables(F, ctl); p8_combine(F, P); if (rep_ + 1 < REPS(8)) xcd_barrier(bar); }
    STAMP(9);
    if (PROBE_K >= 0 && blockIdx.x == 0 && F.tid == 0) { const LAS unsigned long long* ts = (const LAS unsigned long long*)(F.lds + LX_MISC); const unsigned long long d = (PROBE_K == 9) ? ts[9] - ts[0] : (PROBE_K == 40) ? (ts[1] - ts[20]) + (ts[2] - ts[21]) + (ts[3] - ts[22]) + (ts[4] - ts[23]) + (ts[5] - ts[24]) + (ts[6] - ts[25]) + (ts[7] - ts[26]) + (ts[8] - ts[27]) : (PROBE_K == 24) ? ts[12] - ts[14] : (PROBE_K == 23) ? ts[13] - ts[12] : (PROBE_K == 20) ? ts[10] - ts[0] : (PROBE_K == 21) ? ts[11] - ts[10] : (PROBE_K == 22) ? ts[1] - ts[11] : ts[(PROBE_K + 1) % 10] - ts[PROBE_K % 10], t0 = __builtin_amdgcn_s_memrealtime();
        while (__builtin_amdgcn_s_memrealtime() - t0 < d) __builtin_amdgcn_s_sleep(8); }
#undef IN
#undef SEAM
}

#ifndef ATTN_REP
#define ATTN_REP 1
#endif
#ifndef REDO_MASK
#define REDO_MASK 0x000
#endif
#ifndef OPT_MASK
#define OPT_MASK 0x1FF
#endif
static void naive_phase(int k, const Ptrs& P, hipStream_t stream) {
    unsigned char* ws = P.ws;
    switch (k) {
    case 0:
        n_cvtT<<<dim3(NIN / 32, D / 32, 1), 256, 0, stream>>>(P.w_in, (bf16*)(ws + WS_WIN), D, NIN, nullptr);
        n_cvtT<<<dim3(D / 32, AW / 32, 1), 256, 0, stream>>>(P.w_attn_out, (bf16*)(ws + WS_WA), AW, D, nullptr);
        n_cvtT<<<dim3(D / 32, SW / 32, 1), 256, 0, stream>>>(P.w_sgu_out, (bf16*)(ws + WS_WS), SW, D, nullptr);
        n_cvtT<<<dim3(D / 32, D / 32, 1), 256, 0, stream>>>(P.w_mix_out, (bf16*)(ws + WS_WM), D, D, nullptr);
        n_cvtT<<<dim3(2 * DE / 32, D / 32, NE), 256, 0, stream>>>(P.w_gu, (bf16*)(ws + WS_WGU), D, 2 * DE, P.ffn_g);
        n_cvtT<<<dim3(D / 32, DE / 32, NE), 256, 0, stream>>>(P.w_down, (bf16*)(ws + WS_WD), DE, D, nullptr);
        n_cvt_router<<<NE * D / 256, 256, 0, stream>>>(P.w_router, P.ffn_g, (bf16*)(ws + WS_WR), (bf16*)(ws + WS_WR) + NE * D);
        n_rmsnorm<<<T / 4, 256, 0, stream>>>(P.x, P.mix_g, (bf16*)(ws + WS_XN));
        break;
    case 1:
        n_gemm<EPI_IN><<<dim3(NIN / 128, T / 128), 256, 0, stream>>>((const bf16*)(ws + WS_XN), D, (const bf16*)(ws + WS_WIN), D, D, P);
        n_kmean<<<NBATCH * NBLK * AW / 256, 256, 0, stream>>>((const bf16*)(ws + WS_K), (float*)(ws + WS_CTL) + CW_KM);
        break;
    case 2:
        n_attn<<<T * NH / 4, 256, 0, stream>>>((const bf16*)(ws + WS_Q), (const bf16*)(ws + WS_K), (const bf16*)(ws + WS_V), (const float*)(ws + WS_CTL) + CW_KM, (bf16*)(ws + WS_O));
        n_sgu_stats<<<T / 4, 256, 0, stream>>>((const bf16*)(ws + WS_VV), (float*)(ws + WS_STATS));
        n_sgu<<<T * SW / 256, 256, 0, stream>>>((const bf16*)(ws + WS_U), (const bf16*)(ws + WS_VV), (const float*)(ws + WS_STATS), P, (bf16*)(ws + WS_SG));
        break;
    case 3:
        n_gemm<EPI_MG1><<<dim3(D / 128, T / 128), 256, 0, stream>>>((const bf16*)(ws + WS_O), AW, (const bf16*)(ws + WS_WA), AW, AW, P);
        n_gemm<EPI_MG2><<<dim3(D / 128, T / 128), 256, 0, stream>>>((const bf16*)(ws + WS_SG), SW, (const bf16*)(ws + WS_WS), SW, SW, P);
        break;
    case 4: n_gemm<EPI_H1><<<dim3(D / 128, T / 128), 256, 0, stream>>>((const bf16*)(ws + WS_MG), D, (const bf16*)(ws + WS_WM), D, D, P); break;
    case 5: n_router<<<T / 4, 256, 0, stream>>>(P); break;
    case 6: n_moe_gu<<<dim3(DE / 128, NROWS_PAD / 128), 256, 0, stream>>>(P); break;
    case 7: n_moe_down<<<dim3(D / 128, NROWS_PAD / 128), 256, 0, stream>>>(P); break;
    default: n_combine<<<T / 4, 256, 0, stream>>>(P); break;
    }
}
extern "C" void kernel_launch(void* const* d_in, const int* in_sizes, int n_in, void* d_out, int out_size, void* d_ws, size_t ws_size, hipStream_t stream) {
    static int grid = 0;
    if (grid == 0) {
        if (n_in != 18 || in_sizes[0] != T * D || out_size != T * D || ws_size < WS_END) { fprintf(stderr, "kernel_launch: unexpected shapes (n_in %d, in0 %d, out %d, ws %zu)\n", n_in, n_in > 0 ? in_sizes[0] : -1, out_size, ws_size); grid = -1; return; }
        int dev = 0, cus = 0, per_cu = 0;
        if (hipGetDevice(&dev) != hipSuccess || hipDeviceGetAttribute(&cus, hipDeviceAttributeMultiprocessorCount, dev) != hipSuccess) { grid = -1; return; }
        if (hipFuncSetAttribute((const void*)fwd, hipFuncAttributeMaxDynamicSharedMemorySize, LDS_BYTES) != hipSuccess) { fprintf(stderr, "kernel_launch: hipFuncSetAttribute failed\n"); grid = -1; return; }
        if (hipOccupancyMaxActiveBlocksPerMultiprocessor(&per_cu, (const void*)fwd, NWAVES * 64, LDS_BYTES) != hipSuccess || per_cu < 1) fprintf(stderr, "kernel_launch: occupancy query says %d\n", per_cu);
        (void)hipGetLastError();
        grid = cus;
    }
    if (grid < 0) return;
    Ptrs P{};
    const float** pf = (const float**)&P;
    for (int i = 0; i < 18; ++i) pf[i] = (const float*)d_in[i];
    P.out = (float*)d_out; P.ws = (unsigned char*)d_ws;
    (void)hipMemsetAsync((unsigned char*)d_ws + WS_CTL, 0, CTL_ZERO_BYTES, stream);
    int li = 0;
    for (int k = 0; k < 9;) {
        if (!((OPT_MASK >> k) & 1)) { naive_phase(k, P, stream); ++k; continue; }
        int hi = k; while (hi < 9 && ((OPT_MASK >> hi) & 1)) ++hi;
        Args a{}; a.P = P; a.ph_lo = k; a.ph_hi = hi; a.li = li++; a.pad = ATTN_REP;
        hipLaunchKernelGGL(fwd, dim3(grid), dim3(NWAVES * 64), LDS_BYTES, stream, a);
        for (int q = k; q < hi; ++q) if ((REDO_MASK >> q) & 1) naive_phase(q, P, stream);
        k = hi;
    }
}
```

```cpp
#include <hip/hip_runtime.h>
#include <hip/hip_bf16.h>
#include <cstdio>
#include <cstdint>
#ifndef SGU_REP
#define SGU_REP 1
#ifndef EPI_PROBE
#define EPI_PROBE 0
#endif
#define EPI_PREF 1
#endif
#ifndef Y_F8
#define Y_F8 1
#endif
#ifndef GATE_U8
#define GATE_U8 1
#endif
#ifndef H1_BF16
#define H1_BF16 1
#endif
#ifndef WGM_IN
#define WGM_IN 2
#endif
#ifndef WGM_MID
#define WGM_MID 2
#endif
#ifndef WGM_GU
#define WGM_GU 2
#endif
#ifndef WGM_DN
#define WGM_DN 2
#endif
#ifndef P3_FUSED
#define P3_FUSED 1
#endif
#ifndef IN_I8
#define IN_I8 1
#endif
#define IN_BF_TILES 2
#ifndef MOE_F8
#define MOE_F8 1
#endif
#ifndef MOE_I8
#define MOE_I8 1
#endif
#ifndef PROBE_K
#define PROBE_K -1
#endif

typedef unsigned short bf16;
typedef short bf16x8 __attribute__((ext_vector_type(8)));
typedef float f32x4 __attribute__((ext_vector_type(4)));
typedef unsigned u32x4 __attribute__((ext_vector_type(4)));
typedef unsigned u32x2 __attribute__((ext_vector_type(2)));
typedef int i32x4 __attribute__((ext_vector_type(4)));
typedef int i32x8 __attribute__((ext_vector_type(8)));
typedef int i32x8a __attribute__((ext_vector_type(8), aligned(16)));

constexpr int T = 16384, D = 1024, SEQ = 4096, NBATCH = 4, NH = 8, HD = 64, AW = 512, SW = 512, NIN = 4608;
constexpr int NE = 32, TOPK = 4, DE = 1024, MB = 256  , NBLK = SEQ / MB  ;
constexpr int NROWS_PAD = 73728;
constexpr float EPS = 1e-5f;
constexpr float C2 = 0.125f * 1.4426950408889634f;
constexpr float LOG2E = 1.4426950408889634f;

constexpr size_t MiB = 1u << 20;
constexpr size_t WS_CTL = 0, CTL_ZERO_BYTES = 1 * MiB;
constexpr size_t WS_WIN = 2 * MiB, WS_WA = 12 * MiB, WS_WS = 13 * MiB, WS_WM = 14 * MiB, WS_WR = 16 * MiB;
constexpr size_t WS_WGU = 32 * MiB, WS_WD = 160 * MiB, WS_XN = 224 * MiB;
constexpr size_t WS_Q = 256 * MiB, WS_K = 272 * MiB, WS_V = 288 * MiB, WS_U = 304 * MiB, WS_VV = 320 * MiB, WS_O = 336 * MiB, WS_SG = 352 * MiB;
constexpr size_t WS_GA = 368 * MiB, WS_GS = 400 * MiB, WS_MG = 432 * MiB, WS_H1 = 464 * MiB, WS_H1B = 528 * MiB;
constexpr size_t WS_LIST = 560 * MiB, WS_TOKSLOT = 562 * MiB, WS_TOKW = 563 * MiB, WS_RSTD2 = 564 * MiB, WS_STATS = 565 * MiB, WS_RLIST = 566 * MiB, WS_HIST = 568 * MiB;
constexpr size_t WS_HID = 576 * MiB, WS_Y = 720 * MiB, WS_H1Q = 864 * MiB  , WS_SB = 569 * MiB  ,
    WS_SBIN = WS_SB + 256 * 1024  , WS_SXN = WS_SB + 320 * 1024  , WS_WSP = WS_SB + 384 * 1024  , WS_XNQ = 880 * MiB  , WS_WINQ = 896 * MiB  , WS_END = 900 * MiB;
constexpr int CW_TMO = 0, CW_CODE = 1, CW_BAR = 4096  , CW_CNT = 32768  , CW_KM = 65536  ;

struct Ptrs {
    const float *x, *mix_g, *w_in, *w_attn_out, *ln_g, *ln_b, *w_sp, *b_sp, *w_sgu_out, *w_mix_out, *ffn_g, *w_router, *b_router, *w_gu, *b_gu, *w_down, *b_down, *fin_g;
    float* out; unsigned char* ws;
};

__device__ __forceinline__ unsigned f2bf(float f) { unsigned u = __builtin_bit_cast(unsigned, f); return (u + 0x7fffu + ((u >> 16) & 1u)) >> 16; }
__device__ __forceinline__ float bf2f(unsigned h) { return __builtin_bit_cast(float, (h & 0xffffu) << 16); }
__device__ __forceinline__ float wave_sum(float v) {
#pragma unroll
    for (int o = 1; o < 64; o <<= 1) v += __shfl_xor(v, o);
    return v;
}
__device__ __forceinline__ float wave_max(float v) {
#pragma unroll
    for (int o = 1; o < 64; o <<= 1) v = fmaxf(v, __shfl_xor(v, o));
    return v;
}
__device__ __forceinline__ float gelu_erf(float v) { return 0.5f * v * (1.f + erff(v * 0.70710678118654752f)); }
__device__ __forceinline__ float sigmoidf(float v) { return 1.f / (1.f + __expf(-v)); }
__device__ __forceinline__ float swiglu(float g, float u) {
    g = fminf(g, 7.f); u = fminf(fmaxf(u, -7.f), 7.f);
    return g * (1.f / (1.f + __expf(-1.702f * g))) * (u + 1.f);
}

__global__ __launch_bounds__(256) void n_cvtT(const float* W, bf16* WT, int K, int N, const float* kscale) {
    __shared__ float t[32][33];
    const size_t boff = (size_t)blockIdx.z * K * N; W += boff; WT += boff;
    const int k0 = blockIdx.y * 32, n0 = blockIdx.x * 32, tx = threadIdx.x & 31, ty = threadIdx.x >> 5;
    for (int i = ty; i < 32; i += 8) t[i][tx] = W[(size_t)(k0 + i) * N + n0 + tx] * (kscale ? kscale[k0 + i] : 1.f);
    __syncthreads();
    for (int i = ty; i < 32; i += 8) WT[(size_t)(n0 + i) * K + k0 + tx] = (bf16)f2bf(t[tx][i]);
}
__global__ void n_cvt_router(const float* w, const float* g, bf16* hi, bf16* lo) {
    const int i = blockIdx.x * blockDim.x + threadIdx.x; if (i >= NE * D) return;
    const int e = i / D, k = i % D; const float v = w[(size_t)k * NE + e] * g[k];
    const unsigned h = f2bf(v); hi[i] = (bf16)h; lo[i] = (bf16)f2bf(v - bf2f(h));
}
__global__ __launch_bounds__(256) void n_rmsnorm(const float* x, const float* g, bf16* xn) {
    const int row = blockIdx.x * 4 + (threadIdx.x >> 6), lane = threadIdx.x & 63;
    const f32x4* xr = (const f32x4*)(x + (size_t)row * D) + lane; f32x4 v[4]; float s = 0.f;
#pragma unroll
    for (int j = 0; j < 4; ++j) { v[j] = xr[64 * j]; s += v[j].x * v[j].x + v[j].y * v[j].y + v[j].z * v[j].z + v[j].w * v[j].w; }
    const float rstd = 1.f / sqrtf(wave_sum(s) * (1.f / D) + EPS);
#pragma unroll
    for (int j = 0; j < 4; ++j) { const f32x4 gg = ((const f32x4*)g)[lane + 64 * j];
        u32x2 o; o.x = f2bf(v[j].x * rstd * gg.x) | (f2bf(v[j].y * rstd * gg.y) << 16); o.y = f2bf(v[j].z * rstd * gg.z) | (f2bf(v[j].w * rstd * gg.w) << 16);
        *((u32x2*)(xn + (size_t)row * D) + lane + 64 * j) = o; }
}

__device__ __forceinline__ void wave_gemm64(const bf16* a0, const bf16* a1, const bf16* a2, const bf16* a3, const bf16* b0, const bf16* b1, const bf16* b2, const bf16* b3, int K, f32x4 (&acc)[4][4]) {
    for (int k = 0; k < K; k += 32) {
        bf16x8 a[4], b[4];
        a[0] = *(const bf16x8*)(a0 + k); a[1] = *(const bf16x8*)(a1 + k); a[2] = *(const bf16x8*)(a2 + k); a[3] = *(const bf16x8*)(a3 + k);
        b[0] = *(const bf16x8*)(b0 + k); b[1] = *(const bf16x8*)(b1 + k); b[2] = *(const bf16x8*)(b2 + k); b[3] = *(const bf16x8*)(b3 + k);
#pragma unroll
        for (int mi = 0; mi < 4; ++mi)
#pragma unroll
            for (int ni = 0; ni < 4; ++ni) acc[mi][ni] = __builtin_amdgcn_mfma_f32_16x16x32_bf16(a[mi], b[ni], acc[mi][ni], 0, 0, 0);
    }
}
#define ZERO_ACC(acc) _Pragma("unroll") for (int _a = 0; _a < 4; ++_a) _Pragma("unroll") for (int _b = 0; _b < 4; ++_b) acc[_a][_b] = (f32x4){0.f, 0.f, 0.f, 0.f}

enum { EPI_IN = 0, EPI_MG1 = 1, EPI_MG2 = 2, EPI_H1 = 3 };
template <int MODE>
__global__ __launch_bounds__(256) void n_gemm(const bf16* A, int lda, const bf16* Bt, int ldb, int K, Ptrs P) {
    const int lane = threadIdx.x & 63, w = threadIdx.x >> 6, wy = w >> 1, wx = w & 1;
    const int row0 = blockIdx.y * 128 + wy * 64, col0 = blockIdx.x * 128 + wx * 64;
    const int lr = lane & 15, lq = lane >> 4;
    const bf16* ap = A + (size_t)(row0 + lr) * lda + 8 * lq; const bf16* bp = Bt + (size_t)(col0 + lr) * ldb + 8 * lq;
    f32x4 acc[4][4]; ZERO_ACC(acc);
    wave_gemm64(ap, ap + 16 * (size_t)lda, ap + 32 * (size_t)lda, ap + 48 * (size_t)lda, bp, bp + 16 * (size_t)ldb, bp + 32 * (size_t)ldb, bp + 48 * (size_t)ldb, K, acc);
    unsigned char* ws = P.ws;
#pragma unroll
    for (int mi = 0; mi < 4; ++mi)
#pragma unroll
        for (int ni = 0; ni < 4; ++ni)
#pragma unroll
            for (int j = 0; j < 4; ++j) {
                const int row = row0 + 16 * mi + lq * 4 + j, col = col0 + 16 * ni + lr; const float v = acc[mi][ni][j];
                if (MODE == EPI_IN) {
                    if (col < 512) ((bf16*)(ws + WS_Q))[(size_t)row * 512 + col] = (bf16)f2bf(v * C2);
                    else if (col < 1024) ((bf16*)(ws + WS_K))[(size_t)row * 512 + col - 512] = (bf16)f2bf(v);
                    else if (col < 1536) ((bf16*)(ws + WS_V))[(size_t)row * 512 + col - 1024] = (bf16)f2bf(v);
                    else if (col < 2048) ((bf16*)(ws + WS_U))[(size_t)row * 512 + col - 1536] = (bf16)f2bf(gelu_erf(v));
                    else if (col < 2560) ((bf16*)(ws + WS_VV))[(size_t)row * 512 + col - 2048] = (bf16)f2bf(gelu_erf(v));
                    else if (col < 3584) ((bf16*)(ws + WS_GA))[(size_t)row * 1024 + col - 2560] = (bf16)f2bf(sigmoidf(v));
                    else ((bf16*)(ws + WS_GS))[(size_t)row * 1024 + col - 3584] = (bf16)f2bf(sigmoidf(v));
                } else if (MODE == EPI_MG1) {
                    const size_t o = (size_t)row * 1024 + col; ((bf16*)(ws + WS_MG))[o] = (bf16)f2bf(v * bf2f(((const bf16*)(ws + WS_GA))[o]));
                } else if (MODE == EPI_MG2) {
                    const size_t o = (size_t)row * 1024 + col; bf16* mg = (bf16*)(ws + WS_MG); mg[o] = (bf16)f2bf(bf2f(mg[o]) + v * bf2f(((const bf16*)(ws + WS_GS))[o]));
                } else {
                    const size_t o = (size_t)row * 1024 + col; const float h = P.x[o] + v; ((float*)(ws + WS_H1))[o] = h; ((bf16*)(ws + WS_H1B))[o] = (bf16)f2bf(h);
                }
            }
}
__global__ void n_kmean(const bf16* Kb, float* KM) {
    const int i = blockIdx.x * blockDim.x + threadIdx.x; if (i >= NBATCH * NBLK * AW) return;
    const int c = i % AW, bb = i / AW; float s = 0.f;
    for (int r = 0; r < MB; ++r) s += bf2f(Kb[(size_t)(bb * MB + r) * AW + c]);
    KM[i] = s * (1.f / MB);
}
__global__ __launch_bounds__(256) void n_attn(const bf16* Q, const bf16* Kb, const bf16* Vb, const float* KM, bf16* O) {
    __shared__ float qs[4][64];
    const int lane = threadIdx.x & 63, w = threadIdx.x >> 6, gw = blockIdx.x * 4 + w, tok = gw >> 3, h = gw & 7;
    const int b = tok / SEQ, t = tok % SEQ, blk = t / MB;
    const float qd = bf2f(Q[(size_t)tok * AW + h * HD + lane]);
    qs[w][lane] = qd; __syncthreads();
    float g[16];
#pragma unroll
    for (int j = 0; j < 16; ++j) { float p = (j < blk) ? qd * KM[(size_t)(b * NBLK + j) * AW + h * HD + lane] : 0.f; p = wave_sum(p); g[j] = (j < blk) ? p : -INFINITY; }
    int sel[4];
#pragma unroll
    for (int s = 0; s < 3; ++s) { int best = -1; float bv = -INFINITY;
#pragma unroll
        for (int j = 0; j < 16; ++j) if (g[j] > bv) { bv = g[j]; best = j; }
#pragma unroll
        for (int j = 0; j < 16; ++j) if (j == best) g[j] = -INFINITY;
        sel[s] = best; }
    sel[3] = blk;
    const float slope2 = exp2f(-(float)(h + 1)) * LOG2E;
    float sc[16];
#pragma unroll
    for (int s = 0; s < 4; ++s) {
        const int kb = sel[s];
#pragma unroll
        for (int c = 0; c < 4; ++c) {
            float v = -INFINITY;
            if (kb >= 0) { const int key = kb * MB + c * 64 + lane;
                if (key <= t) { const bf16* kr = Kb + (size_t)(b * SEQ + key) * AW + h * HD; float a = 0.f;
                    for (int d8 = 0; d8 < 8; ++d8) { const u32x4 kk = *(const u32x4*)(kr + d8 * 8);
#pragma unroll
                        for (int e = 0; e < 4; ++e) { a += qs[w][d8 * 8 + 2 * e] * bf2f(kk[e] & 0xffffu) + qs[w][d8 * 8 + 2 * e + 1] * bf2f(kk[e] >> 16); } }
                    v = a + slope2 * (float)(key - t); } }
            sc[s * 4 + c] = v; }
    }
    float m = sc[0];
#pragma unroll
    for (int i = 1; i < 16; ++i) m = fmaxf(m, sc[i]);
    m = wave_max(m); float l = 0.f;
#pragma unroll
    for (int i = 0; i < 16; ++i) { sc[i] = (sc[i] == -INFINITY) ? 0.f : exp2f(sc[i] - m); l += sc[i]; }
    l = wave_sum(l); float o = 0.f;
#pragma unroll
    for (int s = 0; s < 4; ++s) { const int kb = sel[s]; if (kb < 0) continue;
#pragma unroll
        for (int c = 0; c < 4; ++c) { const int key0 = kb * MB + c * 64; if (key0 > t) continue;
            const bf16* vr = Vb + (size_t)(b * SEQ + key0) * AW + h * HD + lane;
            for (int kl = 0; kl < 64; ++kl) { const float p = __shfl(sc[s * 4 + c], kl); o += p * bf2f(vr[(size_t)kl * AW]); } } }
    O[(size_t)tok * AW + h * HD + lane] = (bf16)f2bf(o / l);
}
__global__ __launch_bounds__(256) void n_sgu_stats(const bf16* VV, float* stats) {
    const int row = blockIdx.x * 4 + (threadIdx.x >> 6), lane = threadIdx.x & 63;
    const u32x4 r = *((const u32x4*)(VV + (size_t)row * SW) + lane); float v[8];
#pragma unroll
    for (int e = 0; e < 4; ++e) { v[2 * e] = bf2f(r[e] & 0xffffu); v[2 * e + 1] = bf2f(r[e] >> 16); }
    float s = 0.f;
#pragma unroll
    for (int e = 0; e < 8; ++e) s += v[e];
    const float mu = wave_sum(s) * (1.f / SW); float q = 0.f;
#pragma unroll
    for (int e = 0; e < 8; ++e) q += (v[e] - mu) * (v[e] - mu);
    const float rstd = 1.f / sqrtf(wave_sum(q) * (1.f / SW) + EPS);
    if (lane == 0) { stats[2 * row] = mu; stats[2 * row + 1] = rstd; }
}
__global__ __launch_bounds__(256) void n_sgu(const bf16* U, const bf16* VV, const float* stats, Ptrs P, bf16* SG) {
    const int i = blockIdx.x * 256 + threadIdx.x, tok = i / SW, c = i % SW, g = c / 64, tl = tok % 128, s0 = tok - tl;
    const float lg = P.ln_g[c], lb = P.ln_b[c]; const float* wr = P.w_sp + ((size_t)g * 128 + tl) * 128; float a = 0.f;
    for (int s = 0; s <= tl; ++s) { const float vn = (bf2f(VV[(size_t)(s0 + s) * SW + c]) - stats[2 * (s0 + s)]) * stats[2 * (s0 + s) + 1] * lg + lb; a += wr[s] * vn; }
    SG[i] = (bf16)f2bf(bf2f(U[i]) * (a + P.b_sp[g * 128 + tl]));
}
__global__ __launch_bounds__(256) void n_router(Ptrs P) {
    unsigned char* ws = P.ws; const int tok = blockIdx.x * 4 + (threadIdx.x >> 6), lane = threadIdx.x & 63;
    const f32x4* hr = (const f32x4*)((const float*)(ws + WS_H1) + (size_t)tok * D) + lane; f32x4 v[4]; float s = 0.f;
#pragma unroll
    for (int j = 0; j < 4; ++j) { v[j] = hr[64 * j]; s += v[j].x * v[j].x + v[j].y * v[j].y + v[j].z * v[j].z + v[j].w * v[j].w; }
    const float rstd = 1.f / sqrtf(wave_sum(s) * (1.f / D) + EPS);
#pragma unroll
    for (int j = 0; j < 4; ++j) { const f32x4 gg = ((const f32x4*)P.ffn_g)[lane + 64 * j]; v[j] = v[j] * gg; }
    float lg[32];
#pragma unroll
    for (int e = 0; e < 32; ++e) { float a = 0.f;
#pragma unroll
        for (int j = 0; j < 4; ++j) { const float* wr = P.w_router + (size_t)(4 * lane + 256 * j) * NE + e; a += v[j].x * wr[0] + v[j].y * wr[NE] + v[j].z * wr[2 * NE] + v[j].w * wr[3 * NE]; }
        lg[e] = wave_sum(a) * rstd + P.b_router[e]; }
    int idx[4]; float val[4];
#pragma unroll
    for (int k = 0; k < 4; ++k) { int best = 0; float bv = -INFINITY;
#pragma unroll
        for (int e = 0; e < 32; ++e) if (lg[e] > bv) { bv = lg[e]; best = e; }
#pragma unroll
        for (int e = 0; e < 32; ++e) if (e == best) lg[e] = -INFINITY;
        idx[k] = best; val[k] = bv; }
    float den = 0.f, pw[4];
#pragma unroll
    for (int k = 0; k < 4; ++k) { pw[k] = __expf(val[k] - val[0]); den += pw[k]; }
    if (lane == 0) {
        unsigned* ctl = (unsigned*)(ws + WS_CTL); int* list = (int*)(ws + WS_LIST); unsigned* slot = (unsigned*)(ws + WS_TOKSLOT); float* tw = (float*)(ws + WS_TOKW);
#pragma unroll
        for (int k = 0; k < 4; ++k) { const unsigned pos = atomicAdd(ctl + CW_CNT + 64 * idx[k], 1u); list[(size_t)idx[k] * T + pos] = tok;
            slot[tok * 4 + k] = (unsigned)idx[k] | (pos << 8); tw[tok * 4 + k] = pw[k] / den; }
        ((float*)(ws + WS_RSTD2))[tok] = rstd;
        for (int k = 0; k < 4; ++k) { const unsigned s2 = slot[tok * 4 + k]; ((float*)(ws + WS_RLIST))[(size_t)(s2 & 0xff) * T + (s2 >> 8)] = rstd; }
    }
}
__device__ __forceinline__ bool tile_lookup(const unsigned* ctl, int mt, int& e, int& lt, int& cnt) {
    int base = 0;
    for (int i = 0; i < NE; ++i) { const int c = (int)ctl[CW_CNT + 64 * i], nt = (c + 255) >> 8; if (mt < base + nt) { e = i; lt = mt - base; cnt = c; return true; } base += nt; }
    return false;
}
__device__ __forceinline__ int expert_rowbase(const unsigned* ctl, int e) { int base = 0; for (int i = 0; i < e; ++i) base += ((int)ctl[CW_CNT + 64 * i] + 255) >> 8; return base * 256; }
__global__ __launch_bounds__(256) void n_moe_gu(Ptrs P) {
    unsigned char* ws = P.ws; const unsigned* ctl = (const unsigned*)(ws + WS_CTL);
    const int lane = threadIdx.x & 63, w = threadIdx.x >> 6, wy = w >> 1, wx = w & 1, lr = lane & 15, lq = lane >> 4;
    const int mt = blockIdx.y >> 1; int e, lt, cnt; if (!tile_lookup(ctl, mt, e, lt, cnt)) return;
    const int* list = (const int*)(ws + WS_LIST) + (size_t)e * T; const bf16* A = (const bf16*)(ws + WS_H1B); const bf16* Bt = (const bf16*)(ws + WS_WGU) + (size_t)e * 2048 * D;
    const int prow0 = lt * 256 + (blockIdx.y & 1) * 128 + wy * 64;
    const int j0 = blockIdx.x * 128 + wx * 64;
    const bf16* ap[4];
#pragma unroll
    for (int i = 0; i < 4; ++i) { const int pos = prow0 + 16 * i + lr; const int tok = list[pos < cnt ? pos : lt * 256]; ap[i] = A + (size_t)tok * D + 8 * lq; }
    const bf16* bg = Bt + (size_t)(2 * (j0 + lr)) * D + 8 * lq; const bf16* bu = bg + D;
    f32x4 accg[4][4], accu[4][4]; ZERO_ACC(accg); ZERO_ACC(accu);
    wave_gemm64(ap[0], ap[1], ap[2], ap[3], bg, bg + 32 * (size_t)D, bg + 64 * (size_t)D, bg + 96 * (size_t)D, D, accg);
    wave_gemm64(ap[0], ap[1], ap[2], ap[3], bu, bu + 32 * (size_t)D, bu + 64 * (size_t)D, bu + 96 * (size_t)D, D, accu);
    const float* rs = (const float*)(ws + WS_RSTD2); const float* bgu = P.b_gu + (size_t)e * 2048; bf16* HID = (bf16*)(ws + WS_HID);
#pragma unroll
    for (int mi = 0; mi < 4; ++mi)
#pragma unroll
        for (int j = 0; j < 4; ++j) { const int pos = prow0 + 16 * mi + lq * 4 + j; const int tok = list[pos < cnt ? pos : lt * 256]; const float r = rs[tok];
            const size_t orow = (size_t)mt * 256 + (blockIdx.y & 1) * 128 + wy * 64 + 16 * mi + lq * 4 + j;
#pragma unroll
            for (int ni = 0; ni < 4; ++ni) { const int jc = j0 + 16 * ni + lr; HID[orow * DE + jc] = (bf16)f2bf(swiglu(accg[mi][ni][j] * r + bgu[2 * jc], accu[mi][ni][j] * r + bgu[2 * jc + 1])); } }
}
__global__ __launch_bounds__(256) void n_moe_down(Ptrs P) {
    unsigned char* ws = P.ws; const unsigned* ctl = (const unsigned*)(ws + WS_CTL);
    const int lane = threadIdx.x & 63, w = threadIdx.x >> 6, wy = w >> 1, wx = w & 1, lr = lane & 15, lq = lane >> 4;
    const int mt = blockIdx.y >> 1; int e, lt, cnt; if (!tile_lookup(ctl, mt, e, lt, cnt)) return;
    const int row0 = blockIdx.y * 128 + wy * 64, col0 = blockIdx.x * 128 + wx * 64;
    const bf16* ap = (const bf16*)(ws + WS_HID) + (size_t)(row0 + lr) * DE + 8 * lq; const bf16* bp = (const bf16*)(ws + WS_WD) + ((size_t)e * D + col0 + lr) * DE + 8 * lq;
    f32x4 acc[4][4]; ZERO_ACC(acc);
    wave_gemm64(ap, ap + 16 * (size_t)DE, ap + 32 * (size_t)DE, ap + 48 * (size_t)DE, bp, bp + 16 * (size_t)DE, bp + 32 * (size_t)DE, bp + 48 * (size_t)DE, DE, acc);
    bf16* Y = (bf16*)(ws + WS_Y); const float* bd = P.b_down + (size_t)e * D;
#pragma unroll
    for (int mi = 0; mi < 4; ++mi)
#pragma unroll
        for (int ni = 0; ni < 4; ++ni)
#pragma unroll
            for (int j = 0; j < 4; ++j) { const int row = row0 + 16 * mi + lq * 4 + j, col = col0 + 16 * ni + lr; Y[(size_t)row * D + col] = (bf16)f2bf(acc[mi][ni][j] + bd[col]); }
}
__global__ __launch_bounds__(256) void n_combine(Ptrs P) {
    unsigned char* ws = P.ws; const unsigned* ctl = (const unsigned*)(ws + WS_CTL);
    const int tok = blockIdx.x * 4 + (threadIdx.x >> 6), lane = threadIdx.x & 63;
    const f32x4* hr = (const f32x4*)((const float*)(ws + WS_H1) + (size_t)tok * D) + lane; f32x4 v[4];
#pragma unroll
    for (int j = 0; j < 4; ++j) v[j] = hr[64 * j];
    const unsigned* slot = (const unsigned*)(ws + WS_TOKSLOT) + tok * 4; const float* tw = (const float*)(ws + WS_TOKW) + tok * 4; const bf16* Y = (const bf16*)(ws + WS_Y);
    for (int k = 0; k < 4; ++k) { const unsigned s = slot[k]; const int e = s & 0xff, pos = s >> 8; const float wgt = tw[k];
        const bf16* yr = Y + (size_t)(expert_rowbase(ctl, e) + pos) * D;
#pragma unroll
        for (int j = 0; j < 4; ++j) { const u32x2 y = *((const u32x2*)yr + lane + 64 * j);
            v[j].x += wgt * bf2f(y.x & 0xffffu); v[j].y += wgt * bf2f(y.x >> 16); v[j].z += wgt * bf2f(y.y & 0xffffu); v[j].w += wgt * bf2f(y.y >> 16); } }
    float s = 0.f;
#pragma unroll
    for (int j = 0; j < 4; ++j) s += v[j].x * v[j].x + v[j].y * v[j].y + v[j].z * v[j].z + v[j].w * v[j].w;
    const float rstd = 1.f / sqrtf(wave_sum(s) * (1.f / D) + EPS);
#pragma unroll
    for (int j = 0; j < 4; ++j) { const f32x4 gg = ((const f32x4*)P.fin_g)[lane + 64 * j]; *((f32x4*)(P.out + (size_t)tok * D) + lane + 64 * j) = v[j] * rstd * gg; }
}

#define GAS __attribute__((address_space(1)))
#define LAS __attribute__((address_space(3)))
typedef float f32x2 __attribute__((ext_vector_type(2)));
typedef float f32x16 __attribute__((ext_vector_type(16)));
constexpr int NWAVES = 8;
constexpr int RING_BYTES = 131072;
constexpr int LX_BAR = RING_BYTES, LX_TBASE = RING_BYTES + 64, LX_TILEE = RING_BYTES + 256, LX_ROWBASE = RING_BYTES + 2048, LX_MISC = RING_BYTES + 4096;
constexpr int LDS_BYTES = 147456;
constexpr int LX_EPI = RING_BYTES + 8192;

typedef __bf16 bf16x2_t __attribute__((ext_vector_type(2)));
__device__ __forceinline__ unsigned cvt_pk_bf16(float lo, float hi) { const f32x2 v = {lo, hi}; const bf16x2_t b = __builtin_convertvector(v, bf16x2_t); return __builtin_bit_cast(unsigned, b); }
__device__ __forceinline__ f32x2 gelu_pk(f32x2 v) {
    const f32x2 av = __builtin_elementwise_abs(v), d = av * 0.2316418882f + 1.0f;
    f32x2 t; t.x = __builtin_amdgcn_rcpf(d.x); t.y = __builtin_amdgcn_rcpf(d.y);
    f32x2 q = t * 0.5307027145f + (-0.7265760135f); q = q * t + 0.7107068705f; q = q * t + (-0.142248368f); q = q * t + 0.127414796f; q = q * t;
    const f32x2 s = (v * v) * (-0.72134752044f);
    f32x2 e; e.x = __builtin_amdgcn_exp2f(s.x); e.y = __builtin_amdgcn_exp2f(s.y);
    const f32x2 m = v * (q * e), r = v - m;
    f32x2 o; o.x = v.x < 0.f ? m.x : r.x; o.y = v.y < 0.f ? m.y : r.y; return o;
}
__device__ __forceinline__ float fast_sigmoid(float v) { return __builtin_amdgcn_rcpf(1.f + __builtin_amdgcn_exp2f(-LOG2E * v)); }
__device__ __forceinline__ float fast_swiglu(float g, float u) {
    g = fminf(g, 7.f); u = fminf(fmaxf(u, -7.f), 7.f);
    return g * __builtin_amdgcn_rcpf(1.f + __builtin_amdgcn_exp2f(-1.702f * LOG2E * g)) * (u + 1.f);
}

__device__ __forceinline__ float folded_swiglu(float t, float w) {
    constexpr float CC = -1.702f * LOG2E;
    t = __builtin_fmaxf(t, 7.f * CC); w = __builtin_amdgcn_fmed3f(w, 8.f / CC, -6.f / CC);
    return t * __builtin_amdgcn_rcpf(1.f + __builtin_amdgcn_exp2f(t)) * w;
}

#define XB_TMO      128
#define XB_XCNT(j)  (256  + 64 * (j))
#define XB_XSUB(j)  (1280 + 64 * (j))
#define XB_XGEN(j)  (2304 + 64 * (j))
#define XB_TOP      3328
#define XB_TOPGEN   3392
#define XCD_BAR_WORDS 3456
#define XB_SPIN_CAP (1u << 18)
__device__ __forceinline__ unsigned xb_ld(unsigned* p)              { return __hip_atomic_load(p, __ATOMIC_RELAXED, __HIP_MEMORY_SCOPE_AGENT); }
__device__ __forceinline__ unsigned xb_add(unsigned* p, unsigned v) { return __hip_atomic_fetch_add(p, v, __ATOMIC_RELAXED, __HIP_MEMORY_SCOPE_AGENT); }
__device__ __forceinline__ unsigned xb_xcc_id() { return (unsigned)__builtin_amdgcn_s_getreg((3 << 11) | 20) & 0xFu; }
#define XB_SPIN(cond, bar) do { unsigned _sp = 0; while (cond) { __builtin_amdgcn_s_sleep(1); \
    if ((++_sp & 255u) == 0u) { if (xb_ld(&(bar)[XB_TMO])) break; if (_sp > XB_SPIN_CAP) { atomicAdd(&(bar)[XB_TMO], 1u); break; } } } } while (0)
struct XcdBarrier { unsigned* bar; unsigned x; volatile LAS unsigned* st; };
__device__ __forceinline__ XcdBarrier xcd_barrier_post(unsigned* bar, volatile LAS unsigned* st) {
    XcdBarrier b; b.bar = bar; b.x = xb_xcc_id(); b.st = st;
    if (threadIdx.x == 0) (void)xb_add(&bar[XB_XCNT(b.x)], 1u);
    return b;
}
__device__ __forceinline__ void xcd_barrier_complete(unsigned* bar, unsigned x, unsigned& nloc, unsigned& nx) {
    const unsigned G = gridDim.x * gridDim.y * gridDim.z;
    unsigned sum, cnt, mine, sp = 0u;
    for (;;) {
        sum = 0u; cnt = 0u; mine = 0u;
#pragma unroll
        for (unsigned j = 0; j < 16; ++j) { const unsigned c = xb_ld(&bar[XB_XCNT(j)]); sum += c; cnt += (c > 0u) ? 1u : 0u; mine = (j == x) ? c : mine; }
        if (sum == G) break;
        __builtin_amdgcn_s_sleep(1);
        if ((++sp & 255u) == 0u) { if (xb_ld(&bar[XB_TMO])) break; if (sp > XB_SPIN_CAP) { atomicAdd(&bar[XB_TMO], 1u); break; } }
    }
    nloc = mine > 0u ? mine : 1u; nx = cnt > 0u ? cnt : 1u;
}
__device__ __forceinline__ void xcd_barrier(const XcdBarrier& b) {
    asm volatile("s_waitcnt vmcnt(0)" ::: "memory");
    __syncthreads();
    if (threadIdx.x == 0) {
        unsigned* bar = b.bar;
        __builtin_amdgcn_s_waitcnt(0);
        unsigned nloc = b.st[0], nx = b.st[1];
        if (nloc == 0u) { xcd_barrier_complete(bar, b.x, nloc, nx); b.st[0] = nloc; b.st[1] = nx; }
        const unsigned old = xb_add(&bar[XB_XSUB(b.x)], 1u);
        const unsigned gen = old / nloc;
        if (old + 1u == (gen + 1u) * nloc) {
            __builtin_amdgcn_fence(__ATOMIC_RELEASE, "agent");
            asm volatile("s_waitcnt vmcnt(0)" ::: "memory");
            const unsigned og = xb_add(&bar[XB_TOP], 1u);
            const unsigned tg = og / nx;
            if (og + 1u == (tg + 1u) * nx) xb_add(&bar[XB_TOPGEN], 1u);
            else XB_SPIN(xb_ld(&bar[XB_TOPGEN]) == tg, bar);
            __builtin_amdgcn_fence(__ATOMIC_ACQUIRE, "agent");
            xb_add(&bar[XB_XGEN(b.x)], 1u);
            asm volatile("s_waitcnt vmcnt(0)" ::: "memory");
        } else {
            XB_SPIN(xb_ld(&bar[XB_XGEN(b.x)]) == gen, bar);
            __builtin_amdgcn_fence(__ATOMIC_ACQUIRE, "agent");
            asm volatile("s_waitcnt vmcnt(0)" ::: "memory");
        }
    }
    __syncthreads();
}

namespace pg8 {
constexpr int BM = 256, BK = 64, HALF = 128, HTB = HALF * BK * 2, STAGE_BYTES = 8 * HTB, NXCD = 8;
__host__ __device__ __forceinline__ int lds_byte(int r, int c) { const int st = (r >> 4) * 2 + (c >> 5), rr = r & 15, cc = c & 31, ob = rr * 64 + cc * 2; return st * 1024 + (ob ^ (((ob >> 9) & 1) << 5)); }
__host__ __device__ __forceinline__ void stage_rc(int b, int& R, int& C) { const int st = b / 1024, sb = b % 1024, swz = sb ^ (((sb >> 9) & 1) << 5); R = (st >> 1) * 16 + swz / 64; C = (st & 1) * 32 + (swz % 64) / 2; }
__host__ __device__ __forceinline__ int perm32(int rho) { const int n = rho >> 4, i = rho & 15; return 8 * (i >> 2) + 4 * n + (i & 3); }

struct Unit { int pm, pn, e, lt, cnt, par; };

__device__ __forceinline__ void order_map(int L, int nM, int nN, int& pm, int& pn, int WGM) {
    const int nwg = nM * nN; int wgid = L; { const int q = nwg / NXCD, r = nwg % NXCD, xcd = wgid % NXCD, off = wgid / NXCD; wgid = (xcd < r ? xcd * (q + 1) : r * (q + 1) + (xcd - r) * q) + off; }
    const int nig = WGM * nN, gid = wgid / nig, fm = gid * WGM, gsz = (nM - fm) < WGM ? (nM - fm) : WGM;
    pm = fm + ((wgid % nig) % gsz); pn = (wgid % nig) / gsz;
}

template <class Epi, class Sched, bool ALIGN_EPI>
__device__ __forceinline__ void gemm_phase(LAS unsigned char* lds, const int K, const unsigned ldb, const Sched& S, const Epi& E) {
    const int tid = threadIdx.x, wid = __builtin_amdgcn_readfirstlane(tid >> 6), lane = tid & 63, wr = wid >> 2, wc = wid & 3, fr = lane & 15, fq = lane >> 4;
    const int nt = K / BK;
    int R[2], C[2]; unsigned voffB[2];
#pragma unroll
    for (int i = 0; i < 2; ++i) { stage_rc(tid * 16 + i * 8192, R[i], C[i]); const int Rb = (R[i] & ~31) + perm32(R[i] & 31); voffB[i] = (unsigned)(Rb * (int)ldb + C[i]) * 2u; }
    const unsigned kstep = (unsigned)(BK * 2);
    const size_t hstepB = (size_t)HALF * ldb * 2;
    const unsigned ldsw = (unsigned)wid * 1024u;
    constexpr int MODE = Epi::MODE; constexpr int KST = 1024;
    const int c8 = fq * 8;
    const int aoff = lds_byte(wr * 64 + fr, c8), boff = lds_byte(wc * 32 + fr, c8);
#define PG8_SA(b, h) (((b) * 2 + (h)) * HTB)
#define PG8_SB(b, h) ((4 + (b) * 2 + (h)) * HTB)
#define PG8_STAGE(bufoff, gbase, voff) do { _Pragma("unroll") for (int _i = 0; _i < 2; ++_i) \
        __builtin_amdgcn_global_load_lds((const unsigned*)((const char*)(gbase) + (voff)[_i]), (LAS unsigned*)(lds + (bufoff) + ldsw + _i * 8192), 16, 0, 0); } while (0)
#define PG8_LD32(p) __builtin_shufflevector(*(const LAS i32x4*)(p), *(const LAS i32x4*)((p) + KST), 0, 1, 2, 3, 4, 5, 6, 7)
#define PG8_LDA(dst, b, h) do { if constexpr (MODE == 2) { _Pragma("unroll") for (int m = 0; m < 4; ++m) dst##8[m] = PG8_LD32(lds + PG8_SA(b, h) + aoff + m * 2048); } \
        else { _Pragma("unroll") for (int m = 0; m < 4; ++m) _Pragma("unroll") for (int k = 0; k < 2; ++k) dst[m][k] = *(const LAS bf16x8*)(lds + PG8_SA(b, h) + aoff + m * 2048 + k * KST); } } while (0)
#define PG8_LDB(dst, b, h) do { if constexpr (MODE == 2) { _Pragma("unroll") for (int n = 0; n < 2; ++n) dst##8[n] = PG8_LD32(lds + PG8_SB(b, h) + boff + n * 2048); } \
        else { _Pragma("unroll") for (int n = 0; n < 2; ++n) _Pragma("unroll") for (int k = 0; k < 2; ++k) dst[n][k] = *(const LAS bf16x8*)(lds + PG8_SB(b, h) + boff + n * 2048 + k * KST); } } while (0)
#define PG8_CAT(x) __builtin_shufflevector(__builtin_bit_cast(i32x4, x[0]), __builtin_bit_cast(i32x4, x[1]), 0, 1, 2, 3, 4, 5, 6, 7)
#define PG8_MMA(ai, bj, At, Bt) do { __builtin_amdgcn_s_setprio(1); _Pragma("unroll") for (int m = 0; m < 4; ++m) _Pragma("unroll") for (int n = 0; n < 2; ++n) { \
        if constexpr (MODE == 2) asm volatile("v_mfma_scale_f32_16x16x128_f8f6f4 %0, %1, %2, %0, %3, %3 op_sel_hi:[0,0,0]" : "+v"(acc[ai][bj][m][n]) : "v"(Bt##8[n]), "v"(At##8[m]), "v"(one_scale)); \
        else { _Pragma("unroll") for (int k = 0; k < 2; ++k) { if constexpr (MODE == 1) acc[ai][bj][m][n] = __builtin_amdgcn_mfma_i32_16x16x64_i8(__builtin_bit_cast(i32x4, Bt[n][k]), __builtin_bit_cast(i32x4, At[m][k]), acc[ai][bj][m][n], 0, 0, 0); \
          else acc[ai][bj][m][n] = __builtin_amdgcn_mfma_f32_16x16x32_bf16(Bt[n][k], At[m][k], acc[ai][bj][m][n], 0, 0, 0); } } } __builtin_amdgcn_s_setprio(0); } while (0)
#define PG8_WAIT_V(n) asm volatile("s_waitcnt vmcnt(" #n ")" ::: "memory")
#define PG8_WAIT_L(n) asm volatile("s_waitcnt lgkmcnt(" #n ")" ::: "memory")
#define PG8_BAR __builtin_amdgcn_s_barrier()
#define PG8_SCHED __builtin_amdgcn_sched_barrier(0)
#define PG8_PIN4(v) asm volatile("" : "+v"(v[0][0]), "+v"(v[0][1]), "+v"(v[1][0]), "+v"(v[1][1]))
    Unit cur, nxt; int ui = 0;
    if (!S.next(0, cur)) return;
    typedef typename Epi::acc_t acc_t;
    acc_t acc[2][2][4][2];
#pragma unroll
    for (int a = 0; a < 2; ++a)
#pragma unroll
        for (int b = 0; b < 2; ++b)
#pragma unroll
            for (int m = 0; m < 4; ++m)
#pragma unroll
                for (int n = 0; n < 2; ++n) acc[a][b][m][n] = acc_t{};
    bf16x8 At[4][2], B0[2][2], B1[2][2]; i32x8 At8[4], B08[2], B18[2];
    unsigned one_scale = 0x7f7f7f7fu; if constexpr (MODE == 2) asm volatile("" : "+v"(one_scale));
    unsigned cvo[2][2], nvo[2][2];
    const char* const Ab = S.a_base();
    const char* cA = Ab;
    if constexpr (Sched::GATHER) { S.a_off(cur, R, C, cvo); PG8_PIN4(cvo); } else { S.lane_off(R, C, cvo); cA = Ab + S.a_ubase(cur); }
    const char* cB = S.b_ptr(cur);
    cur.par = 0;
    if constexpr (Epi::PREF) { if (wid == 0) E.pref(lds + LX_EPI, cur, lane); }
    PG8_STAGE(PG8_SB(0, 0), cB, voffB); PG8_STAGE(PG8_SB(0, 1), cB + hstepB, voffB); PG8_STAGE(PG8_SA(0, 0), cA, cvo[0]); PG8_STAGE(PG8_SA(0, 1), cA, cvo[1]);
    if (wr == 1) PG8_BAR;
    PG8_WAIT_V(2); PG8_BAR;
    PG8_STAGE(PG8_SB(1, 0), cB + kstep, voffB); PG8_STAGE(PG8_SA(1, 0), cA + kstep, cvo[0]); PG8_STAGE(PG8_SB(1, 1), cB + hstepB + kstep, voffB);
    PG8_WAIT_V(6); PG8_BAR;
    for (;;) {
        const bool has_next = S.next(ui + 1, nxt);
        const char* nA = cA;
        if constexpr (Sched::GATHER) {
            if (has_next) { S.a_off(nxt, R, C, nvo); } else { nvo[0][0] = cvo[0][0]; nvo[0][1] = cvo[0][1]; nvo[1][0] = cvo[1][0]; nvo[1][1] = cvo[1][1]; }
            PG8_PIN4(nvo);
        } else { if (has_next) nA = Ab + S.a_ubase(nxt); }
        const char* nB = has_next ? S.b_ptr(nxt) : cB;
        if constexpr (Epi::PREF) { if (ui > 0 && wid == 0) E.pref(lds + LX_EPI + cur.par * 3072, cur, lane); }
#pragma nounroll
        for (int t = 0; t < nt; t += 2) {
            const bool last = (t == nt - 2);
            if constexpr (Epi::MIDK) { if (t == nt / 2) E.mid(acc, cur, wr, wc, fr, fq); }
            const char* a1 = cA + (size_t)(t + 1) * kstep;
            const char* a2 = last ? nA : cA + (size_t)(t + 2) * kstep; const char* b2 = last ? nB : cB + (size_t)(t + 2) * kstep;
            const char* a3 = a2 + kstep; const char* b3 = b2 + kstep;
            unsigned v2[2][2];
#pragma unroll
            for (int h = 0; h < 2; ++h)
#pragma unroll
                for (int i = 0; i < 2; ++i) v2[h][i] = (Sched::GATHER && last) ? nvo[h][i] : cvo[h][i];
            PG8_LDB(B0, 0, 0); PG8_LDB(B1, 0, 1); PG8_SCHED; PG8_LDA(At, 0, 0); PG8_STAGE(PG8_SA(1, 1), a1, cvo[1]);
            PG8_WAIT_V(8); PG8_WAIT_L(0); PG8_BAR; PG8_MMA(0, 0, At, B0); PG8_MMA(0, 1, At, B1); PG8_BAR; PG8_SCHED;
            PG8_LDA(At, 0, 1); PG8_STAGE(PG8_SB(0, 0), b2, voffB); PG8_STAGE(PG8_SB(0, 1), b2 + hstepB, voffB); PG8_STAGE(PG8_SA(0, 0), a2, v2[0]);
            PG8_WAIT_V(8); PG8_WAIT_L(0); PG8_BAR; PG8_MMA(1, 0, At, B0); PG8_MMA(1, 1, At, B1); PG8_BAR; PG8_SCHED;
            PG8_LDB(B0, 1, 0); PG8_LDB(B1, 1, 1); PG8_SCHED; PG8_LDA(At, 1, 0); PG8_STAGE(PG8_SA(0, 1), a2, v2[1]);
            PG8_WAIT_V(8); PG8_WAIT_L(0); PG8_BAR; PG8_MMA(0, 0, At, B0); PG8_MMA(0, 1, At, B1); PG8_BAR; PG8_SCHED;
            PG8_LDA(At, 1, 1); PG8_STAGE(PG8_SB(1, 0), b3, voffB); PG8_STAGE(PG8_SB(1, 1), b3 + hstepB, voffB); PG8_STAGE(PG8_SA(1, 0), a3, v2[0]);
            PG8_WAIT_V(8); PG8_WAIT_L(0); PG8_BAR; PG8_MMA(1, 0, At, B0); PG8_MMA(1, 1, At, B1); PG8_BAR; PG8_SCHED;
        }
        if constexpr (ALIGN_EPI) { if (wr == 0) PG8_BAR; }
        if constexpr (MODE == 2) asm volatile("s_nop 15\n\ts_nop 15" ::: "memory");
        E(acc, cur, wr, wc, fr, fq);
        if constexpr (EPI_PROBE == 6 && Epi::MODE == 1 && Sched::GATHER) { asm volatile("" ::: "memory"); E(acc, cur, wr, wc, fr, fq); }
        if constexpr (EPI_PROBE == 7 && Epi::MODE == 2) { asm volatile("" ::: "memory"); E(acc, cur, wr, wc, fr, fq); }
        if (!has_next) break;
#pragma unroll
        for (int a = 0; a < 2; ++a)
#pragma unroll
            for (int b = 0; b < 2; ++b)
#pragma unroll
                for (int m = 0; m < 4; ++m)
#pragma unroll
                    for (int n = 0; n < 2; ++n) acc[a][b][m][n] = acc_t{};
        cur = nxt; cB = nB; cA = nA; ++ui; cur.par = ui & 1;
        if constexpr (Sched::GATHER) {
#pragma unroll
        for (int h = 0; h < 2; ++h)
#pragma unroll
            for (int i = 0; i < 2; ++i) cvo[h][i] = nvo[h][i]; }
        if constexpr (ALIGN_EPI) { if (wr == 1) PG8_BAR; }
    }
    PG8_WAIT_V(0);
    if constexpr (!ALIGN_EPI) { if (wr == 0) PG8_BAR; }
    PG8_BAR;
#undef PG8_SA
#undef PG8_SB
#undef PG8_STAGE
#undef PG8_LDA
#undef PG8_LD32
#undef PG8_LDB
#undef PG8_MMA
#undef PG8_CAT
#undef PG8_WAIT_V
#undef PG8_WAIT_L
#undef PG8_BAR
#undef PG8_SCHED
#undef PG8_PIN4
}
}

struct DenseSched {
    static constexpr bool GATHER = false;
    const char* A; const char* Bt; int lda, ldb, nM, nN, G, c, wgm;
    __device__ __forceinline__ bool next(int i, pg8::Unit& u) const { const int L = i * G + c; if (L >= nM * nN) return false; pg8::order_map(L, nM, nN, u.pm, u.pn, wgm); u.e = 0; u.lt = 0; u.cnt = 0; return true; }
    __device__ __forceinline__ void a_off(const pg8::Unit& u, const int (&R)[2], const int (&C)[2], unsigned (&vo)[2][2]) const {
#pragma unroll
        for (int h = 0; h < 2; ++h)
#pragma unroll
            for (int i = 0; i < 2; ++i) vo[h][i] = (unsigned)((u.pm * 256 + 128 * h + R[i]) * lda + C[i]) * 2u; }
    __device__ __forceinline__ void lane_off(const int (&R)[2], const int (&C)[2], unsigned (&vo)[2][2]) const {
#pragma unroll
        for (int h = 0; h < 2; ++h)
#pragma unroll
            for (int i = 0; i < 2; ++i) vo[h][i] = (unsigned)((128 * h + R[i]) * lda + C[i]) * 2u; }
    __device__ __forceinline__ size_t a_ubase(const pg8::Unit& u) const { return (size_t)u.pm * 256 * lda * 2; }
    __device__ __forceinline__ const char* a_base() const { return A; }
    __device__ __forceinline__ const char* b_ptr(const pg8::Unit& u) const { return Bt + (size_t)u.pn * 256 * ldb * 2; }
};
struct BalSched {
    static constexpr bool GATHER = false;
    const char* A; const char* Bt; int lda, ldb, nM, nN, G, c, nbf;
    __device__ __forceinline__ bool next(int i, pg8::Unit& u) const {
        int L;
        if (G == 256 && nbf == 128 && nM * nN == 1024) { if (c < 128) { if (i >= 3) return false; L = 128 * i + c; } else { if (i >= 5) return false; L = 384 + 128 * i + (c - 128); } }
        else { L = i * G + c; if (L >= nM * nN) return false; }
        pg8::order_map(L, nM, nN, u.pm, u.pn, WGM_IN); u.e = 0; u.lt = 0; u.cnt = 0; return true; }
    __device__ __forceinline__ void a_off(const pg8::Unit&, const int (&)[2], const int (&)[2], unsigned (&)[2][2]) const {}
    __device__ __forceinline__ void lane_off(const int (&R)[2], const int (&C)[2], unsigned (&vo)[2][2]) const {
#pragma unroll
        for (int h = 0; h < 2; ++h)
#pragma unroll
            for (int i = 0; i < 2; ++i) vo[h][i] = (unsigned)((128 * h + R[i]) * lda + C[i]) * 2u; }
    __device__ __forceinline__ size_t a_ubase(const pg8::Unit& u) const { return (size_t)u.pm * 256 * lda * 2; }
    __device__ __forceinline__ const char* a_base() const { return A; }
    __device__ __forceinline__ const char* b_ptr(const pg8::Unit& u) const { return Bt + (size_t)u.pn * 256 * ldb * 2; }
};
struct MergeSched {
    static constexpr bool GATHER = false;
    const char* A; const char* Bt; int G, c;
    __device__ __forceinline__ bool next(int i, pg8::Unit& u) const { const int v = i & 1, L = (i >> 1) * G + c; if (L >= 256 || i >= 2 * ((256 + G - 1) / G)) return false; pg8::order_map(L, 64, 4, u.pm, u.pn, WGM_MID); u.e = v; u.lt = 0; u.cnt = 0; return true; }
    __device__ __forceinline__ void a_off(const pg8::Unit& u, const int (&R)[2], const int (&C)[2], unsigned (&vo)[2][2]) const {
#pragma unroll
        for (int h = 0; h < 2; ++h)
#pragma unroll
            for (int i = 0; i < 2; ++i) vo[h][i] = (unsigned)u.e * (unsigned)(WS_SG - WS_O) + (unsigned)((u.pm * 256 + 128 * h + R[i]) * 512 + C[i]) * 2u; }
    __device__ __forceinline__ void lane_off(const int (&R)[2], const int (&C)[2], unsigned (&vo)[2][2]) const {
#pragma unroll
        for (int h = 0; h < 2; ++h)
#pragma unroll
            for (int i = 0; i < 2; ++i) vo[h][i] = (unsigned)((128 * h + R[i]) * 512 + C[i]) * 2u; }
    __device__ __forceinline__ size_t a_ubase(const pg8::Unit& u) const { return (size_t)u.e * (WS_SG - WS_O) + (size_t)u.pm * 256 * 512 * 2; }
    __device__ __forceinline__ const char* a_base() const { return A; }
    __device__ __forceinline__ const char* b_ptr(const pg8::Unit& u) const { return Bt + (size_t)u.e * (WS_WS - WS_WA) + (size_t)u.pn * 256 * 512 * 2; }
};
template <bool GU>
struct MoeSched {
    static constexpr bool GATHER = GU;
    const char* A; const char* Bt; const int* list; const LAS int* tbase; const LAS int* tile_e; const unsigned* cnt; int nN, G, c, ldk;
    __device__ __forceinline__ bool next(int i, pg8::Unit& u) const {
        const int nM = tbase[NE]; const int L = i * G + c; if (L >= nM * nN) return false;
        pg8::order_map(L, nM, nN, u.pm, u.pn, GU ? WGM_GU : WGM_DN); u.e = tile_e[u.pm]; u.lt = u.pm - tbase[u.e]; u.cnt = (int)cnt[CW_CNT + 64 * u.e]; return true; }
    __device__ __forceinline__ void a_off(const pg8::Unit& u, const int (&R)[2], const int (&C)[2], unsigned (&vo)[2][2]) const {
#pragma unroll
        for (int h = 0; h < 2; ++h)
#pragma unroll
            for (int i = 0; i < 2; ++i) {
                if (GU) { const int pos = u.lt * 256 + 128 * h + R[i]; const int tok = list[(size_t)u.e * T + (pos < u.cnt ? pos : u.lt * 256)]; vo[h][i] = (unsigned)(tok * ldk + C[i]) * 2u; }
                else vo[h][i] = (unsigned)((u.pm * 256 + 128 * h + R[i]) * ldk + C[i]) * 2u; } }
    __device__ __forceinline__ void lane_off(const int (&R)[2], const int (&C)[2], unsigned (&vo)[2][2]) const {
#pragma unroll
        for (int h = 0; h < 2; ++h)
#pragma unroll
            for (int i = 0; i < 2; ++i) vo[h][i] = (unsigned)((128 * h + R[i]) * ldk + C[i]) * 2u; }
    __device__ __forceinline__ size_t a_ubase(const pg8::Unit& u) const { return (size_t)u.pm * 256 * ldk * 2; }
    __device__ __forceinline__ const char* a_base() const { return A; }
    __device__ __forceinline__ const char* b_ptr(const pg8::Unit& u) const { return Bt + ((size_t)u.e * nN + u.pn) * 256 * ldk * 2; }
};

#ifndef KM_ATOMICS
#define KM_ATOMICS 1
#endif
struct EpiIn {
    typedef f32x4 acc_t; static constexpr int MODE = 0;
    static constexpr bool MIDK = false; static constexpr bool PREF = false;
    unsigned char* ws; float* km;
    template <int ACT>
    __device__ __forceinline__ void store(const f32x4 (&acc)[2][2][4][2], bf16* base, int ldc, int row0, int col0, float sc) const {
#pragma unroll
        for (int ai = 0; ai < 2; ++ai)
#pragma unroll
            for (int m = 0; m < 4; ++m) { bf16* rowp = base + (size_t)(row0 + ai * 128 + m * 16) * ldc + col0;
#pragma unroll
                for (int bj = 0; bj < 2; ++bj) { f32x4 v0 = acc[ai][bj][m][0], v1 = acc[ai][bj][m][1];
                    if (ACT == 0) { v0 = v0 * sc; v1 = v1 * sc; }
                    if (ACT == 1) { const f32x2 a = gelu_pk((f32x2){v0[0], v0[1]}), b = gelu_pk((f32x2){v0[2], v0[3]}), c = gelu_pk((f32x2){v1[0], v1[1]}), d = gelu_pk((f32x2){v1[2], v1[3]});
                        v0 = (f32x4){a.x, a.y, b.x, b.y}; v1 = (f32x4){c.x, c.y, d.x, d.y}; }
                    if (ACT == 2) {
#pragma unroll
                        for (int j = 0; j < 4; ++j) { v0[j] = fast_sigmoid(v0[j]); v1[j] = fast_sigmoid(v1[j]); } }
                    u32x4 w; w.x = cvt_pk_bf16(v0[0], v0[1]); w.y = cvt_pk_bf16(v0[2], v0[3]); w.z = cvt_pk_bf16(v1[0], v1[1]); w.w = cvt_pk_bf16(v1[2], v1[3]);
                    *(u32x4*)(rowp + bj * 128) = w; } }
    }
    __device__ __forceinline__ void operator()(const f32x4 (&acc)[2][2][4][2], const pg8::Unit& u, int wr, int wc, int fr, int fq) const {
        const int pn = u.pn, row0 = u.pm * 256 + wr * 64 + fr;
        if (pn < 10) {
            const int kind = pn >> 1, col0 = (pn & 1) * 256 + wc * 32 + 8 * fq; bf16* base = (bf16*)(ws + WS_Q + (size_t)kind * 16 * MiB);
            if (kind == 0) store<0>(acc, base, 512, row0, col0, C2);
            else if (kind < 3) store<0>(acc, base, 512, row0, col0, 1.f);
            else store<1>(acc, base, 512, row0, col0, 1.f);
            if (KM_ATOMICS && kind == 1) {
#pragma unroll
                for (int bj = 0; bj < 2; ++bj)
#pragma unroll
                    for (int n = 0; n < 2; ++n) { f32x4 s = (f32x4){0.f, 0.f, 0.f, 0.f};
#pragma unroll
                        for (int ai = 0; ai < 2; ++ai)
#pragma unroll
                            for (int m = 0; m < 4; ++m) s = s + acc[ai][bj][m][n];
#pragma unroll
                        for (int j = 0; j < 4; ++j) { float t = s[j]; t += __shfl_xor(t, 1); t += __shfl_xor(t, 2); t += __shfl_xor(t, 4); t += __shfl_xor(t, 8); s[j] = t; }
                        if (fr == 0) { float* dst = km + (size_t)u.pm * 512 + col0 + bj * 128 + 4 * n;
#pragma unroll
                            for (int j = 0; j < 4; ++j) unsafeAtomicAdd(dst + j, s[j] * (1.f / 256.f)); } }
            }
        } else {
            const int gsel = (pn - 10) >> 2, col0 = ((pn - 10) & 3) * 256 + wc * 32 + 8 * fq; bf16* base = (bf16*)(ws + (gsel ? WS_GS : WS_GA));
            store<2>(acc, base, 1024, row0, col0, 1.f);
        }
    }
};
struct EpiInQ {
    typedef i32x4 acc_t; static constexpr int MODE = 1;
    static constexpr bool MIDK = false; static constexpr bool PREF = EPI_PREF != 0;
    unsigned char* ws; const float* sxn; const float* sbin; float* km; LAS unsigned char* lds;
    __device__ __forceinline__ void pref(LAS unsigned char* buf, const pg8::Unit& u, int lane) const {
        __builtin_amdgcn_global_load_lds((const unsigned*)(sbin + u.pn * 256 + 4 * lane), (LAS unsigned*)buf, 16, 0, 0);
        __builtin_amdgcn_global_load_lds((const unsigned*)(sxn + u.pm * 256 + 4 * lane), (LAS unsigned*)(buf + 1024), 16, 0, 0);
    }
    __device__ __forceinline__ f32x4 ldsc(const float* sbp, const LAS float* esb, int off) const { if constexpr (PREF) return *(const LAS f32x4*)(esb + off); else return *(const f32x4*)(sbp + off); }
    __device__ __forceinline__ float ldsr(int row, const LAS float* esr, int off) const { if constexpr (PREF) return esr[off]; else return sxn[row]; }
    template <int ACT>
    __device__ __forceinline__ void store(const i32x4 (&acc)[2][2][4][2], bf16* base, int ldc, int row0, int col0, const float* sbp, const LAS float* esb, const LAS float* esr) const {
        f32x4 s0[2], s1[2];
#pragma unroll
        for (int bj = 0; bj < 2; ++bj) { s0[bj] = ldsc(sbp, esb, bj * 128); s1[bj] = ldsc(sbp, esb, bj * 128 + 4); }
#pragma unroll
        for (int ai = 0; ai < 2; ++ai)
#pragma unroll
            for (int m = 0; m < 4; ++m) { const int row = row0 + ai * 128 + m * 16; const float sa = ldsr(row, esr, ai * 128 + m * 16); bf16* rowp = base + (size_t)row * ldc + col0;
#pragma unroll
                for (int bj = 0; bj < 2; ++bj) { f32x4 v0 = __builtin_convertvector(acc[ai][bj][m][0], f32x4) * (s0[bj] * sa), v1 = __builtin_convertvector(acc[ai][bj][m][1], f32x4) * (s1[bj] * sa);
                    if (ACT == 1) { const f32x2 a = gelu_pk((f32x2){v0[0], v0[1]}), b = gelu_pk((f32x2){v0[2], v0[3]}), c = gelu_pk((f32x2){v1[0], v1[1]}), d = gelu_pk((f32x2){v1[2], v1[3]});
                        v0 = (f32x4){a.x, a.y, b.x, b.y}; v1 = (f32x4){c.x, c.y, d.x, d.y}; }
                    if (ACT == 2) {
#pragma unroll
                        for (int j = 0; j < 4; ++j) { v0[j] = fast_sigmoid(v0[j]); v1[j] = fast_sigmoid(v1[j]); } }
                    u32x4 w; w.x = cvt_pk_bf16(v0[0], v0[1]); w.y = cvt_pk_bf16(v0[2], v0[3]); w.z = cvt_pk_bf16(v1[0], v1[1]); w.w = cvt_pk_bf16(v1[2], v1[3]);
                    *(u32x4*)(rowp + bj * 128) = w; } }
    }
    __device__ __forceinline__ void operator()(const i32x4 (&acc)[2][2][4][2], const pg8::Unit& u, int wr, int wc, int fr, int fq) const {
        const int pn = u.pn + IN_BF_TILES, row0 = u.pm * 256 + wr * 64 + fr; const float* sbp = sbin + u.pn * 256 + wc * 32 + 8 * fq;
        const LAS float* esb = (const LAS float*)(lds + LX_EPI + u.par * 3072) + wc * 32 + 8 * fq; const LAS float* esr = (const LAS float*)(lds + LX_EPI + u.par * 3072) + 256 + wr * 64 + fr;
        if (pn < 10) { const int kind = pn >> 1, col0 = (pn & 1) * 256 + wc * 32 + 8 * fq; bf16* base = (bf16*)(ws + WS_Q + (size_t)kind * 16 * MiB);
            if (kind <= 2) store<0>(acc, base, 512, row0, col0, sbp, esb, esr); else store<1>(acc, base, 512, row0, col0, sbp, esb, esr);
            if (KM_ATOMICS && kind == 1) {
                float sa[2][4];
#pragma unroll
                for (int ai = 0; ai < 2; ++ai)
#pragma unroll
                    for (int m = 0; m < 4; ++m) sa[ai][m] = ldsr(row0 + ai * 128 + m * 16, esr, ai * 128 + m * 16);
#pragma unroll
                for (int bj = 0; bj < 2; ++bj)
#pragma unroll
                    for (int n = 0; n < 2; ++n) { f32x4 s = (f32x4){0.f, 0.f, 0.f, 0.f};
#pragma unroll
                        for (int ai = 0; ai < 2; ++ai)
#pragma unroll
                            for (int m = 0; m < 4; ++m) s = s + __builtin_convertvector(acc[ai][bj][m][n], f32x4) * sa[ai][m];
                        s = s * ldsc(sbp, esb, bj * 128 + 4 * n);
#pragma unroll
                        for (int j = 0; j < 4; ++j) { float t = s[j]; t += __shfl_xor(t, 1); t += __shfl_xor(t, 2); t += __shfl_xor(t, 4); t += __shfl_xor(t, 8); s[j] = t; }
                        if (fr == 0) { float* dst = km + (size_t)u.pm * 512 + col0 + bj * 128 + 4 * n;
#pragma unroll
                            for (int j = 0; j < 4; ++j) unsafeAtomicAdd(dst + j, s[j] * (1.f / 256.f)); } }
            }
        } else { const int gsel = (pn - 10) >> 2, col0 = ((pn - 10) & 3) * 256 + wc * 32 + 8 * fq; bf16* base = (bf16*)(ws + (gsel ? WS_GS : WS_GA));
#if GATE_U8
            { f32x4 s0[2], s1[2];
#pragma unroll
              for (int bj = 0; bj < 2; ++bj) { s0[bj] = ldsc(sbp, esb, bj * 128); s1[bj] = ldsc(sbp, esb, bj * 128 + 4); }
#pragma unroll
              for (int ai = 0; ai < 2; ++ai)
#pragma unroll
                for (int m = 0; m < 4; ++m) { const int row = row0 + ai * 128 + m * 16; const float sa = ldsr(row, esr, ai * 128 + m * 16); unsigned char* rowp = (unsigned char*)base + (size_t)row * 1024 + col0;
#pragma unroll
                    for (int bj = 0; bj < 2; ++bj) { const f32x4 v0 = __builtin_convertvector(acc[ai][bj][m][0], f32x4) * (s0[bj] * sa), v1 = __builtin_convertvector(acc[ai][bj][m][1], f32x4) * (s1[bj] * sa); unsigned q[8];
#pragma unroll
                        for (int j = 0; j < 4; ++j) { q[j] = (unsigned)(int)fmaxf(__builtin_rintf(fast_sigmoid(v0[j]) * 255.f), 1.f); q[4 + j] = (unsigned)(int)fmaxf(__builtin_rintf(fast_sigmoid(v1[j]) * 255.f), 1.f); }
                        u32x2 w; w.x = q[0] | (q[1] << 8) | (q[2] << 16) | (q[3] << 24); w.y = q[4] | (q[5] << 8) | (q[6] << 16) | (q[7] << 24);
                        *(u32x2*)(rowp + bj * 128) = w; } } }
#else
            store<2>(acc, base, 1024, row0, col0, sbp, esb, esr);
#endif
        }
    }
};
struct EpiMerge {
    typedef f32x4 acc_t; static constexpr int MODE = 0;
    static constexpr bool MIDK = false; static constexpr bool PREF = false;
    unsigned char* ws;
    __device__ __forceinline__ void operator()(const f32x4 (&acc)[2][2][4][2], const pg8::Unit& u, int wr, int wc, int fr, int fq) const {
        const int row0 = u.pm * 256 + wr * 64 + fr, col0 = u.pn * 256 + wc * 32 + 8 * fq;
        const bf16* gate = (const bf16*)(ws + (u.e ? WS_GS : WS_GA)); bf16* mg = (bf16*)(ws + WS_MG);
#pragma unroll
        for (int ai = 0; ai < 2; ++ai)
#pragma unroll
            for (int m = 0; m < 4; ++m) { const size_t ro = (size_t)(row0 + ai * 128 + m * 16) * 1024 + col0;
#pragma unroll
                for (int bj = 0; bj < 2; ++bj) { const u32x4 g = *(const u32x4*)(gate + ro + bj * 128); f32x4 v0 = acc[ai][bj][m][0], v1 = acc[ai][bj][m][1];
                    v0[0] *= bf2f(g.x & 0xffffu); v0[1] *= bf2f(g.x >> 16); v0[2] *= bf2f(g.y & 0xffffu); v0[3] *= bf2f(g.y >> 16);
                    v1[0] *= bf2f(g.z & 0xffffu); v1[1] *= bf2f(g.z >> 16); v1[2] *= bf2f(g.w & 0xffffu); v1[3] *= bf2f(g.w >> 16);
                    if (u.e) { const u32x4 p = *(const u32x4*)(mg + ro + bj * 128);
                        v0[0] += bf2f(p.x & 0xffffu); v0[1] += bf2f(p.x >> 16); v0[2] += bf2f(p.y & 0xffffu); v0[3] += bf2f(p.y >> 16);
                        v1[0] += bf2f(p.z & 0xffffu); v1[1] += bf2f(p.z >> 16); v1[2] += bf2f(p.w & 0xffffu); v1[3] += bf2f(p.w >> 16); }
                    u32x4 w; w.x = cvt_pk_bf16(v0[0], v0[1]); w.y = cvt_pk_bf16(v0[2], v0[3]); w.z = cvt_pk_bf16(v1[0], v1[1]); w.w = cvt_pk_bf16(v1[2], v1[3]);
                    *(u32x4*)(mg + ro + bj * 128) = w; } }
    }
};
struct EpiMergeF {
    typedef f32x4 acc_t; static constexpr int MODE = 0; static constexpr bool MIDK = true; static constexpr bool PREF = false;
    unsigned char* ws;
    __device__ __forceinline__ void mid(f32x4 (&acc)[2][2][4][2], const pg8::Unit& u, int wr, int wc, int fr, int fq) const {
        asm volatile("" : "+v"(fr), "+v"(fq));
        const int row0 = u.pm * 256 + wr * 64 + fr, col0 = u.pn * 256 + wc * 32 + 8 * fq; const bf16* ga = (const bf16*)(ws + WS_GA); const bf16* gs = (const bf16*)(ws + WS_GS);
#pragma unroll
        for (int ai = 0; ai < 2; ++ai)
#pragma unroll
            for (int m = 0; m < 4; ++m) { const size_t ro = (size_t)(row0 + ai * 128 + m * 16) * 1024 + col0;
#pragma unroll
                for (int bj = 0; bj < 2; ++bj) {
#if GATE_U8
                    const u32x2 a = *(const u32x2*)((const unsigned char*)ga + ro + bj * 128), b = *(const u32x2*)((const unsigned char*)gs + ro + bj * 128);
#pragma unroll
                    for (int j = 0; j < 8; ++j) { const float r = (float)((a[j >> 2] >> (8 * (j & 3))) & 0xffu) * __builtin_amdgcn_rcpf((float)((b[j >> 2] >> (8 * (j & 3))) & 0xffu)); acc[ai][bj][m][j >> 2][j & 3] *= r; }
#else
                    const u32x4 a = *(const u32x4*)(ga + ro + bj * 128), b = *(const u32x4*)(gs + ro + bj * 128);
#pragma unroll
                    for (int j = 0; j < 4; ++j) { const float rl = bf2f(a[j] & 0xffffu) * __builtin_amdgcn_rcpf(bf2f(b[j] & 0xffffu)), rh = bf2f(a[j] >> 16) * __builtin_amdgcn_rcpf(bf2f(b[j] >> 16));
                        acc[ai][bj][m][j >> 1][2 * (j & 1)] *= rl; acc[ai][bj][m][j >> 1][2 * (j & 1) + 1] *= rh; }
#endif
                }
                if (m == 3) asm volatile("" ::: "memory"); }
    }
    __device__ __forceinline__ void operator()(const f32x4 (&acc)[2][2][4][2], const pg8::Unit& u, int wr, int wc, int fr, int fq) const {
        const int row0 = u.pm * 256 + wr * 64 + fr, col0 = u.pn * 256 + wc * 32 + 8 * fq; const bf16* gs = (const bf16*)(ws + WS_GS); bf16* mg = (bf16*)(ws + WS_MG);
#if GATE_U8
        u32x2 gq[2][4][2];
#pragma unroll
        for (int ai = 0; ai < 2; ++ai)
#pragma unroll
            for (int m = 0; m < 4; ++m)
#pragma unroll
                for (int bj = 0; bj < 2; ++bj) gq[ai][m][bj] = *(const u32x2*)((const unsigned char*)gs + (size_t)(row0 + ai * 128 + m * 16) * 1024 + col0 + bj * 128);
#endif
#pragma unroll
        for (int ai = 0; ai < 2; ++ai)
#pragma unroll
            for (int m = 0; m < 4; ++m) { const size_t ro = (size_t)(row0 + ai * 128 + m * 16) * 1024 + col0;
#pragma unroll
                for (int bj = 0; bj < 2; ++bj) { f32x4 v0 = acc[ai][bj][m][0], v1 = acc[ai][bj][m][1];
#if GATE_U8
                    const u32x2 g = gq[ai][m][bj];
#pragma unroll
                    for (int j = 0; j < 4; ++j) { v0[j] *= (float)((g.x >> (8 * j)) & 0xffu) * (1.f / 255.f); v1[j] *= (float)((g.y >> (8 * j)) & 0xffu) * (1.f / 255.f); }
#else
                    const u32x4 g = *(const u32x4*)(gs + ro + bj * 128);
                    v0[0] *= bf2f(g.x & 0xffffu); v0[1] *= bf2f(g.x >> 16); v0[2] *= bf2f(g.y & 0xffffu); v0[3] *= bf2f(g.y >> 16);
                    v1[0] *= bf2f(g.z & 0xffffu); v1[1] *= bf2f(g.z >> 16); v1[2] *= bf2f(g.w & 0xffffu); v1[3] *= bf2f(g.w >> 16);
#endif
                    u32x4 w; w.x = cvt_pk_bf16(v0[0], v0[1]); w.y = cvt_pk_bf16(v0[2], v0[3]); w.z = cvt_pk_bf16(v1[0], v1[1]); w.w = cvt_pk_bf16(v1[2], v1[3]);
                    *(u32x4*)(mg + ro + bj * 128) = w; } }
    }
};
struct EpiH1 {
    typedef f32x4 acc_t; static constexpr int MODE = 0;
    static constexpr bool MIDK = false; static constexpr bool PREF = false;
    const float* x; float* h1; bf16* h1b;
    __device__ __forceinline__ void operator()(const f32x4 (&acc)[2][2][4][2], const pg8::Unit& u, int wr, int wc, int fr, int fq) const {
        const int row0 = u.pm * 256 + wr * 64 + fr, col0 = u.pn * 256 + wc * 32 + 8 * fq;
        f32x4 xq[4][2][2];
#pragma unroll
        for (int g = 0; g < 4; ++g)
#pragma unroll
            for (int bj = 0; bj < 2; ++bj) { const size_t ro = (size_t)(row0 + (g >> 2) * 128 + (g & 3) * 16) * 1024 + col0;
                xq[g][bj][0] = __builtin_nontemporal_load((const f32x4*)(x + ro + bj * 128)); xq[g][bj][1] = __builtin_nontemporal_load((const f32x4*)(x + ro + bj * 128 + 4)); }
#pragma unroll
        for (int ai = 0; ai < 2; ++ai)
#pragma unroll
            for (int m = 0; m < 4; ++m) { const size_t ro = (size_t)(row0 + ai * 128 + m * 16) * 1024 + col0; const int g = ai * 4 + m;
                f32x4 xc[2][2];
#pragma unroll
                for (int bj = 0; bj < 2; ++bj) { xc[bj][0] = xq[g & 3][bj][0]; xc[bj][1] = xq[g & 3][bj][1]; }
                if (g + 4 < 8) {
#pragma unroll
                    for (int bj = 0; bj < 2; ++bj) { const size_t rn = (size_t)(row0 + ((g + 4) >> 2) * 128 + ((g + 4) & 3) * 16) * 1024 + col0;
                        xq[g & 3][bj][0] = __builtin_nontemporal_load((const f32x4*)(x + rn + bj * 128)); xq[g & 3][bj][1] = __builtin_nontemporal_load((const f32x4*)(x + rn + bj * 128 + 4)); } }
#pragma unroll
                for (int bj = 0; bj < 2; ++bj) { const f32x4 x0 = xc[bj][0], x1 = xc[bj][1];
                    const f32x4 v0 = acc[ai][bj][m][0] + x0, v1 = acc[ai][bj][m][1] + x1;
                    if (!H1_BF16) { *(f32x4*)(h1 + ro + bj * 128) = v0; *(f32x4*)(h1 + ro + bj * 128 + 4) = v1; }
                    if (!MOE_I8 || H1_BF16) { u32x4 w; w.x = cvt_pk_bf16(v0[0], v0[1]); w.y = cvt_pk_bf16(v0[2], v0[3]); w.z = cvt_pk_bf16(v1[0], v1[1]); w.w = cvt_pk_bf16(v1[2], v1[3]);
                        *(u32x4*)(h1b + ro + bj * 128) = w; } } }
    }
};
struct EpiGu {
    typedef f32x4 acc_t; static constexpr int MODE = 0;
    static constexpr bool MIDK = false; static constexpr bool PREF = false;
    const float* rlist; const float* bgu; bf16* hid;
    __device__ __forceinline__ void operator()(const f32x4 (&acc)[2][2][4][2], const pg8::Unit& u, int wr, int wc, int fr, int fq) const {
        const int lrow0 = wr * 64 + fr, col0 = u.pn * 256 + wc * 32 + 8 * fq; const float* bb = bgu + (size_t)u.e * 2048 + col0;
        f32x4 b0[2], b1[2];
#pragma unroll
        for (int bj = 0; bj < 2; ++bj) { b0[bj] = *(const f32x4*)(bb + bj * 128); b1[bj] = *(const f32x4*)(bb + bj * 128 + 4); }
#pragma unroll
        for (int ai = 0; ai < 2; ++ai)
#pragma unroll
            for (int m = 0; m < 4; ++m) { const int lr = lrow0 + ai * 128 + m * 16, pos = u.lt * 256 + lr; const float r = pos < u.cnt ? rlist[(size_t)u.e * T + pos] : 0.f;
                bf16* rowp = hid + (size_t)(u.pm * 256 + lr) * DE + (col0 >> 1);
#pragma unroll
                for (int bj = 0; bj < 2; ++bj) { const f32x4 v0 = acc[ai][bj][m][0] * r + b0[bj], v1 = acc[ai][bj][m][1] * r + b1[bj];
                    u32x2 w; w.x = cvt_pk_bf16(fast_swiglu(v0[0], v0[1]), fast_swiglu(v0[2], v0[3])); w.y = cvt_pk_bf16(fast_swiglu(v1[0], v1[1]), fast_swiglu(v1[2], v1[3]));
                    *(u32x2*)(rowp + bj * 64) = w; } }
    }
};
struct EpiGuQ {
    typedef i32x4 acc_t; static constexpr int MODE = 1;
    static constexpr bool MIDK = false; static constexpr bool PREF = EPI_PREF != 0;
    const float* rlist; const float* sb; const float* bgu; bf16* hid; LAS unsigned char* lds;
    __device__ __forceinline__ void pref(LAS unsigned char* buf, const pg8::Unit& u, int lane) const {
        __builtin_amdgcn_global_load_lds((const unsigned*)(bgu + (size_t)u.e * 2048 + u.pn * 256 + 4 * lane), (LAS unsigned*)buf, 16, 0, 0);
        __builtin_amdgcn_global_load_lds((const unsigned*)(sb + (size_t)u.e * 2048 + u.pn * 256 + 4 * lane), (LAS unsigned*)(buf + 1024), 16, 0, 0);
        __builtin_amdgcn_global_load_lds((const unsigned*)(rlist + (size_t)u.e * T + u.lt * 256 + 4 * lane), (LAS unsigned*)(buf + 2048), 16, 0, 0);
    }
    __device__ __forceinline__ void operator()(const i32x4 (&acc)[2][2][4][2], const pg8::Unit& u, int wr, int wc, int fr, int fq) const {
        const int lrow0 = wr * 64 + fr, col0 = u.pn * 256 + wc * 32 + 8 * fq; const float* bb = bgu + (size_t)u.e * 2048 + col0; const float* ss = sb + (size_t)u.e * 2048 + col0;
        const LAS float* eb = (const LAS float*)(lds + LX_EPI + u.par * 3072) + wc * 32 + 8 * fq; (void)eb;
        f32x4 b0[2], b1[2], s0[2], s1[2];
#pragma unroll
        for (int bj = 0; bj < 2; ++bj) {
            if constexpr (PREF) { b0[bj] = *(const LAS f32x4*)(eb + bj * 128); b1[bj] = *(const LAS f32x4*)(eb + bj * 128 + 4); s0[bj] = *(const LAS f32x4*)(eb + 256 + bj * 128); s1[bj] = *(const LAS f32x4*)(eb + 256 + bj * 128 + 4); }
            else { b0[bj] = *(const f32x4*)(bb + bj * 128); b1[bj] = *(const f32x4*)(bb + bj * 128 + 4); s0[bj] = *(const f32x4*)(ss + bj * 128); s1[bj] = *(const f32x4*)(ss + bj * 128 + 4); } }
        const LAS float* er = (const LAS float*)(lds + LX_EPI + u.par * 3072) + 512; (void)er;
#if MOE_F8
        { constexpr float CC = -1.702f * LOG2E, IC = 1.f / CC; const f32x4 cm = (f32x4){CC, IC, CC, IC}, ca = (f32x4){0.f, IC, 0.f, IC};
#pragma unroll
          for (int bj = 0; bj < 2; ++bj) { s0[bj] = s0[bj] * cm; s1[bj] = s1[bj] * cm; b0[bj] = b0[bj] * cm + ca; b1[bj] = b1[bj] * cm + ca; } }
#endif
#pragma unroll
        for (int ai = 0; ai < 2; ++ai)
#pragma unroll
            for (int m = 0; m < 4; ++m) { const int lr = lrow0 + ai * 128 + m * 16, pos = u.lt * 256 + lr; float r;
                if constexpr (PREF) { const float rv = er[lr]; r = pos < u.cnt ? rv : 0.f; } else r = pos < u.cnt ? rlist[(size_t)u.e * T + pos] : 0.f;
                bf16* rowp = hid + (size_t)(u.pm * 256 + lr) * DE + (col0 >> 1);
#pragma unroll
                for (int bj = 0; bj < 2; ++bj) { const f32x4 v0 = __builtin_convertvector(acc[ai][bj][m][0], f32x4) * (s0[bj] * r) + b0[bj], v1 = __builtin_convertvector(acc[ai][bj][m][1], f32x4) * (s1[bj] * r) + b1[bj];
#if MOE_F8
                    unsigned w = 0u; w = __builtin_amdgcn_cvt_pk_fp8_f32(folded_swiglu(v0[0], v0[1]), folded_swiglu(v0[2], v0[3]), w, false); w = __builtin_amdgcn_cvt_pk_fp8_f32(folded_swiglu(v1[0], v1[1]), folded_swiglu(v1[2], v1[3]), w, true);
                    *(unsigned*)((unsigned char*)hid + (size_t)(u.pm * 256 + lr) * DE + (col0 >> 1) + bj * 64) = w; (void)rowp;
#else
                    u32x2 w; w.x = cvt_pk_bf16(fast_swiglu(v0[0], v0[1]), fast_swiglu(v0[2], v0[3])); w.y = cvt_pk_bf16(fast_swiglu(v1[0], v1[1]), fast_swiglu(v1[2], v1[3]));
                    *(u32x2*)(rowp + bj * 64) = w;
#endif
                } }
    }
};
struct EpiDown {
    typedef f32x4 acc_t; static constexpr int MODE = MOE_F8 ? 2 : 0;
    static constexpr bool MIDK = false; static constexpr bool PREF = EPI_PREF != 0;
    const float* bd; bf16* y; LAS unsigned char* lds;
    __device__ __forceinline__ void pref(LAS unsigned char* buf, const pg8::Unit& u, int lane) const {
        __builtin_amdgcn_global_load_lds((const unsigned*)(bd + (size_t)u.e * D + u.pn * 256 + 4 * lane), (LAS unsigned*)buf, 16, 0, 0);
    }
    __device__ __forceinline__ void operator()(const f32x4 (&acc)[2][2][4][2], const pg8::Unit& u, int wr, int wc, int fr, int fq) const {
        const int lrow0 = wr * 64 + fr, col0 = u.pn * 256 + wc * 32 + 8 * fq; const float* bb = bd + (size_t)u.e * D + col0;
        const LAS float* eb = (const LAS float*)(lds + LX_EPI + u.par * 3072) + wc * 32 + 8 * fq; (void)eb;
        f32x4 b0[2], b1[2];
#pragma unroll
        for (int bj = 0; bj < 2; ++bj) {
            if constexpr (PREF) { b0[bj] = *(const LAS f32x4*)(eb + bj * 128); b1[bj] = *(const LAS f32x4*)(eb + bj * 128 + 4); }
            else { b0[bj] = *(const f32x4*)(bb + bj * 128); b1[bj] = *(const f32x4*)(bb + bj * 128 + 4); } }
#pragma unroll
        for (int ai = 0; ai < 2; ++ai)
#pragma unroll
            for (int m = 0; m < 4; ++m) { bf16* rowp = y + (size_t)(u.pm * 256 + lrow0 + ai * 128 + m * 16) * D + col0;
#pragma unroll
                for (int bj = 0; bj < 2; ++bj) { constexpr float ws_ = MOE_F8 ? (1.f / 32.f) : 1.f; const f32x4 v0 = acc[ai][bj][m][0] * ws_ + b0[bj], v1 = acc[ai][bj][m][1] * ws_ + b1[bj];
#if Y_F8
                    u32x2 w; unsigned t = 0u; t = __builtin_amdgcn_cvt_pk_fp8_f32(v0[0], v0[1], t, false); t = __builtin_amdgcn_cvt_pk_fp8_f32(v0[2], v0[3], t, true); w.x = t;
                    t = 0u; t = __builtin_amdgcn_cvt_pk_fp8_f32(v1[0], v1[1], t, false); t = __builtin_amdgcn_cvt_pk_fp8_f32(v1[2], v1[3], t, true); w.y = t;
                    *(u32x2*)((unsigned char*)y + (size_t)(u.pm * 256 + lrow0 + ai * 128 + m * 16) * D + col0 + bj * 128) = w; (void)rowp;
#else
                    u32x4 w; w.x = cvt_pk_bf16(v0[0], v0[1]); w.y = cvt_pk_bf16(v0[2], v0[3]); w.z = cvt_pk_bf16(v1[0], v1[1]); w.w = cvt_pk_bf16(v1[2], v1[3]);
                    *(u32x4*)(rowp + bj * 128) = w;
#endif
                } }
    }
};

namespace attn_body {
using bf16=__hip_bfloat16;
using bf16x8=__attribute__((ext_vector_type(8)))short;
using s16x4=__attribute__((ext_vector_type(4)))short;
using f32x16=__attribute__((ext_vector_type(16)))float;
using u32x4=__attribute__((ext_vector_type(4)))unsigned;
constexpr int BATCH=4,NHEAD=8,SEQ=4096,D=64,DM=NHEAD*D;
constexpr int NW=8,QBLK=32,QB=QBLK*NW,KVBLK=64,NQB=SEQ/QB;
__device__ __forceinline__ int crow(int r,int hi){return (r&3)+8*(r>>2)+4*hi;}
#define SBAR() __builtin_amdgcn_sched_barrier(0)
__device__ __forceinline__ void cmask(f32x16&p0,f32x16&p1,int jb,int qrel,int hi){
  const float NEG=-INFINITY; int kb=64*jb+4*hi;
  #pragma unroll
  for(int r=0;r<16;++r){int kv=kb+(r&3)+8*(r>>2); if(kv>qrel)p0[r]=NEG; if(kv+32>qrel)p1[r]=NEG;}
}
constexpr int NSLOT=3, SLOTB=8192;
constexpr int LDS_K=0, LDS_V=NSLOT*SLOTB, LDS_WS=2*NSLOT*SLOTB, LDS_OST=LDS_WS+NW*64*4, LDS_BYTES=LDS_OST+NW*4096;
constexpr int LDS_GATE=LDS_OST;
__device__ __forceinline__ void glds16(const void*gsrc,unsigned lds_dst){unsigned keep;
  asm volatile("s_mov_b32 %0, m0\n\ts_mov_b32 m0, %2\n\ts_nop 0\n\tglobal_load_lds_dwordx4 %1, off\n\ts_mov_b32 m0, %0":"=&s"(keep):"v"(gsrc),"s"(lds_dst):"memory");}
typedef float f32x2_t __attribute__((ext_vector_type(2))); typedef __bf16 bf16x2_t __attribute__((ext_vector_type(2)));
__device__ __forceinline__ unsigned cvtpk_s(float lo,float hi){f32x2_t v={lo,hi};bf16x2_t b=__builtin_convertvector(v,bf16x2_t);return __builtin_bit_cast(unsigned,b);}
#define WAIT_BAR(N) asm volatile("s_waitcnt vmcnt(" #N ") lgkmcnt(0)\n\ts_barrier":::"memory")
__device__ __forceinline__ float max3f(float a,float b,float c){return __builtin_fmaxf(__builtin_fmaxf(a,b),c);}
typedef __attribute__((address_space(3))) const char* lds_cptr;
typedef short v4i16_t __attribute__((ext_vector_type(4)));
__device__ __forceinline__ void kload8(bf16x8*kf,lds_cptr kp){
  kf[0]=*(const __attribute__((address_space(3))) bf16x8*)(kp);      kf[1]=*(const __attribute__((address_space(3))) bf16x8*)(kp+512);
  kf[2]=*(const __attribute__((address_space(3))) bf16x8*)(kp+2048); kf[3]=*(const __attribute__((address_space(3))) bf16x8*)(kp+2560);
  kf[4]=*(const __attribute__((address_space(3))) bf16x8*)(kp+4096); kf[5]=*(const __attribute__((address_space(3))) bf16x8*)(kp+4608);
  kf[6]=*(const __attribute__((address_space(3))) bf16x8*)(kp+6144); kf[7]=*(const __attribute__((address_space(3))) bf16x8*)(kp+6656);
}
__device__ __forceinline__ void kload2(bf16x8*kf,lds_cptr kp,int j){ kf[2*j]=*(const __attribute__((address_space(3))) bf16x8*)(kp+j*2048); kf[2*j+1]=*(const __attribute__((address_space(3))) bf16x8*)(kp+j*2048+512); }
__device__ __forceinline__ s16x4 vtr(lds_cptr p){ return __builtin_bit_cast(s16x4,__builtin_amdgcn_ds_read_tr16_b64_v4i16((__attribute__((address_space(3))) v4i16_t*)p)); }
__device__ __forceinline__ float rowmax(const f32x16&p0,const f32x16&p1){
  float a=max3f(p0[0],p0[1],p1[0]),b=max3f(p0[2],p0[3],p1[1]);a=max3f(a,p1[2],p1[3]);
  #pragma unroll
  for(int r=4;r<16;r+=4){a=max3f(a,p0[r],p0[r+1]);b=max3f(b,p0[r+2],p0[r+3]);a=max3f(a,p1[r],p1[r+1]);b=max3f(b,p1[r+2],p1[r+3]);}
  const float m=__builtin_fmaxf(a,b);
  auto rr=__builtin_amdgcn_permlane32_swap(__float_as_uint(m),__float_as_uint(m),false,false);
  return __builtin_fmaxf(__uint_as_float(rr[0]),__uint_as_float(rr[1]));
}
__device__ __forceinline__ void pv(f32x16*o,int vb,bf16x8 pa0,bf16x8 pa1,bf16x8 pa2,bf16x8 pa3){
  #pragma unroll
  for(int d0=0;d0<2;++d0){s16x4 lo[4],hi[4];
    #pragma unroll
    for(int ks=0;ks<4;++ks){
      asm volatile("ds_read_b64_tr_b16 %0,%1 offset:%c2":"=&v"(lo[ks]):"v"(vb),"i"(d0*4096+ks*1024):"memory");
      asm volatile("ds_read_b64_tr_b16 %0,%1 offset:%c2":"=&v"(hi[ks]):"v"(vb),"i"(d0*4096+ks*1024+512):"memory");}
    asm volatile("s_waitcnt lgkmcnt(0)":::"memory");SBAR();
    #define PK(k) (bf16x8){lo[k][0],lo[k][1],lo[k][2],lo[k][3],hi[k][0],hi[k][1],hi[k][2],hi[k][3]}
    o[d0]=__builtin_amdgcn_mfma_f32_32x32x16_bf16(pa0,PK(0),o[d0],0,0,0);
    o[d0]=__builtin_amdgcn_mfma_f32_32x32x16_bf16(pa1,PK(1),o[d0],0,0,0);
    o[d0]=__builtin_amdgcn_mfma_f32_32x32x16_bf16(pa2,PK(2),o[d0],0,0,0);
    o[d0]=__builtin_amdgcn_mfma_f32_32x32x16_bf16(pa3,PK(3),o[d0],0,0,0);
    #undef PK
  }
}
constexpr float MASKED=-1.0e30f, LOWREF=-1000.f;
template<int THRL> __device__ __forceinline__ void attn_unit(int b,int h,int qb,const bf16*Q,const bf16*__restrict__ K,const bf16*__restrict__ V,const float*__restrict__ KM,bf16*O,char*shm){
  int tid=threadIdx.x; asm volatile("":"+v"(tid));
  const int lane=tid&63,r32=lane&31,hi=lane>>5; const int wid=__builtin_amdgcn_readfirstlane(tid>>6);
  const long rowbase=(long)b*SEQ; const int q0=qb*QB;
  const bf16*Qw=Q+(rowbase+q0+wid*QBLK)*DM+h*D;
  const bf16*Kh=K+rowbase*DM+h*D,*Vh=V+rowbase*DM+h*D;
  const unsigned lds0=(unsigned)(uintptr_t)shm;
  __attribute__((address_space(3))) float*wsf=(__attribute__((address_space(3))) float*)((__attribute__((address_space(3))) char*)shm+LDS_WS)+wid*64;
  const bf16*ksrc=Kh+(long)lane*DM+wid*8;
  const bf16*vsrc=Vh+(long)(16*(wid&3)+(lane>>2))*DM+(wid>>2)*32+(lane&3)*8;
  const unsigned kdst=lds0+LDS_K+wid*1024, vdst=lds0+LDS_V+wid*1024;
  #define DMA_K(t,slot) glds16(ksrc+(long)(t)*KVBLK*DM,(unsigned)__builtin_amdgcn_readfirstlane(kdst+(slot)))
  #define DMA_V(t,slot) glds16(vsrc+(long)(t)*KVBLK*DM,(unsigned)__builtin_amdgcn_readfirstlane(vdst+(slot)))
  const int vb0=(int)(lds0+LDS_V)+((lane>>4)&1)*32+(lane&3)*8+(4*hi+((lane&15)>>2))*64;
  bf16x8 kf[8];
  const lds_cptr shm3=(lds_cptr)shm; const lds_cptr kp0=shm3+LDS_K+hi*1024+r32*16; const lds_cptr vp0=shm3+LDS_V+((lane>>4)&1)*32+(lane&3)*8+(4*hi+((lane&15)>>2))*64;
  const int NT=(q0+QB)/KVBLK;
  DMA_K(0,0);DMA_V(0,0);DMA_K(1,SLOTB);
  bf16x8 qr[4];
  #pragma unroll
  for(int d0=0;d0<4;++d0)qr[d0]=*reinterpret_cast<const bf16x8*>(&Qw[(long)r32*DM+d0*16+hi*8]);
  { const int row=tid>>4, dg=tid&15, j=row&15; f32x4 m4=(f32x4){0.f,0.f,0.f,0.f};
    if(j<qb) m4=*(const f32x4*)(KM+((long)(b*NQB+j))*DM+h*D+4*dg);
    unsigned w0,w1; { const unsigned h0=cvtpk_s(m4[0],m4[1]),h1=cvtpk_s(m4[2],m4[3]);
      if(row<16){w0=h0;w1=h1;} else { w0=cvtpk_s(m4[0]-__uint_as_float(h0<<16),m4[1]-__uint_as_float(h0&0xffff0000u)); w1=cvtpk_s(m4[2]-__uint_as_float(h1<<16),m4[3]-__uint_as_float(h1&0xffff0000u)); } }
    typedef unsigned u32x2_t __attribute__((ext_vector_type(2)));
    *(__attribute__((address_space(3))) u32x2_t*)(shm3+LDS_GATE+(dg>>1)*512+row*16+(dg&1)*8)=(u32x2_t){w0,w1}; }
  float mhat=0.f,l_reg=0.f;
  const int qrel=wid*QBLK+r32;
  const float sl2=exp2f(-(float)(h+1))*1.4426950408889634f;
  const float cb0=sl2*(float)(4*hi-(q0+qrel));
  #define CMASK(P0,P1,t) do{int jb_=(t)-(NT-4); if(jb_>=0)cmask(P0,P1,jb_,qrel,hi);}while(0)
  #define CINIT(C0,C1,t) do{ const bool s_=((selmask>>((t)>>2))&1u)!=0u; const float bt_=s_?(cb0+sl2*(float)(64*(t))-mhat):MASKED; \
      _Pragma("unroll") for(int r=0;r<16;++r){ const float kc_=(float)((r&3)+8*(r>>2)); C0[r]=__builtin_fmaf(sl2,kc_,bt_); C1[r]=__builtin_fmaf(sl2,kc_+32.f,bt_);} }while(0)
  bool resc=false;
  #define START(P0,P1) do{ const float rm=rowmax(P0,P1); resc=false; \
    { const float dl=__builtin_fmaxf(rm,LOWREF); mhat+=dl; \
      _Pragma("unroll") for(int r=0;r<16;++r){P0[r]-=dl;P1[r]-=dl;} } \
    _Pragma("unroll") for(int r=0;r<16;++r)P0[r]=__builtin_amdgcn_exp2f(P0[r]); }while(0)
  #define RESC() do{ if(resc){ asm volatile("s_waitcnt lgkmcnt(0)":::"memory"); \
      _Pragma("unroll") for(int d_=0;d_<2;++d_) _Pragma("unroll") for(int r=0;r<16;++r)o[d_][r]*=wsf[crow(r,hi)]; } }while(0)
  f32x16 pA0,pA1,pB0,pB1;
  int sl_prev=0,sl_cur=0,sl_next=SLOTB;
  #define ROT() do{sl_prev=sl_cur;sl_cur=sl_next;sl_next=(sl_next==(NSLOT-1)*SLOTB)?0:sl_next+SLOTB;}while(0)
  DMA_K(2,2*SLOTB);
  WAIT_BAR(3);
  unsigned selmask=1u<<qb;
  if(qb>0){
    f32x16 g=f32x16{};
    #pragma unroll
    for(int d0=0;d0<4;++d0){ const bf16x8 a=*(const __attribute__((address_space(3))) bf16x8*)(shm3+LDS_GATE+(2*d0+hi)*512+r32*16); g=__builtin_amdgcn_mfma_f32_32x32x16_bf16(a,qr[d0],g,0,0,0); }
    float gl[8],gp[8];
    #pragma unroll
    for(int i=0;i<4;++i){ gl[i]=g[i]+g[8+i]; gl[4+i]=g[4+i]+g[12+i]; }
    #pragma unroll
    for(int i=0;i<8;++i) gp[i]=__shfl_xor(gl[i],32);
    float gv[16];
    #pragma unroll
    for(int j=0;j<16;++j){ const int half=(j>>2)&1, i=(j&3)+4*(j>>3); const float v=(half==hi)?gl[i]:gp[i]; gv[j]=(j<qb)?v:-INFINITY; }
    #pragma unroll
    for(int s=0;s<3;++s){ int best=-1; float bv=-INFINITY;
      #pragma unroll
      for(int j=0;j<16;++j) if(gv[j]>bv){bv=gv[j];best=j;}
      #pragma unroll
      for(int j=0;j<16;++j) if(j==best) gv[j]=-INFINITY;
      if(best>=0) selmask|=1u<<best; }
  }
  f32x16 o[2];o[0]=f32x16{};o[1]=f32x16{}; asm volatile("":"+v"(o[0]),"+v"(o[1]));
  { const lds_cptr kp=kp0; kload8(kf,kp); }
  CINIT(pA0,pA1,0);
  #pragma unroll
  for(int d0=0;d0<4;++d0){ pA0=__builtin_amdgcn_mfma_f32_32x32x16_bf16(kf[2*d0],qr[d0],pA0,0,0,0); pA1=__builtin_amdgcn_mfma_f32_32x32x16_bf16(kf[2*d0+1],qr[d0],pA1,0,0,0); }
  CMASK(pA0,pA1,0);
  START(pA0,pA1);
  _Pragma("unroll") for(int r=0;r<16;++r)pA1[r]=__builtin_amdgcn_exp2f(pA1[r]);
  WAIT_BAR(0);
  DMA_K(3,0);DMA_V(1,SLOTB);
  ROT();
  kload8(kf,kp0+sl_cur);
  WAIT_BAR(2);
  s16x4 vlo[8],vhi[8]; u32x4 pw0,pw1,pw2,pw3;
  #define PKW(P,B) cvtpk_s(P[B],P[B+1])
  #define PAF(k) __builtin_bit_cast(bf16x8,pw##k)
  #define VFR(i) (bf16x8){vlo[i][0],vlo[i][1],vlo[i][2],vlo[i][3],vhi[i][0],vhi[i][1],vhi[i][2],vhi[i][3]}
  #define PIN(x) asm volatile("":"+v"(x))
  #define MX3(a,b,c) __builtin_fmaxf(__builtin_fmaxf((a),(b)),(c))
  #define GAPA(MF,A0,A1,A2,A3,W0,W1,PW) do{ MF; sacc+=A0; sacc+=A1; sacc+=A2; sacc+=A3; PIN(sacc); W0; W1; PIN(PW); SBAR(); }while(0)
  #define EX(v) __builtin_amdgcn_exp2f(v)
  #define KCF(r) ((float)(((r)&3)+8*((r)>>2)))
  #define GAPB(MF,X,B,N0,N1,R) do{ MF; X[B]=EX(X[B]); X[B+1]=EX(X[B+1]); X[B+2]=EX(X[B+2]); X[B+3]=EX(X[B+3]); PIN(X); \
    N0[R]=__builtin_fmaf(sl2,KCF(R),btn_); N0[R+1]=__builtin_fmaf(sl2,KCF(R+1),btn_); N1[R]=__builtin_fmaf(sl2,KCF(R)+32.f,btn_); N1[R+1]=__builtin_fmaf(sl2,KCF(R+1)+32.f,btn_); SBAR(); }while(0)
  #define VRD(i) do{ vlo[i]=vtr(vp_+(((i)>>2)*4096+((i)&3)*1024)); vhi[i]=vtr(vp_+(((i)>>2)*4096+((i)&3)*1024+512)); }while(0)
  #define KRD(G,j) do{ if(G){ kload2(kf,kp0+sl_next,j); SBAR(); } }while(0)
  #define STEP(C0,C1,P0,P1,t,GK,GV,GL) do{ SBAR(); \
    const lds_cptr vp_=vp0+sl_prev; \
    VRD(0); SBAR(); float sacc=(P0[0]+P0[1]); \
    GAPA(C0=__builtin_amdgcn_mfma_f32_32x32x16_bf16(kf[0],qr[0],C0,0,0,0), P0[2],P0[3],P0[4],P0[5],     pw0[0]=PKW(P0,0), pw0[1]=PKW(P0,2), pw0); \
    VRD(4); SBAR(); GAPA(C1=__builtin_amdgcn_mfma_f32_32x32x16_bf16(kf[1],qr[0],C1,0,0,0), P0[6],P0[7],P0[8],P0[9],     pw0[2]=PKW(P0,4), pw0[3]=PKW(P0,6), pw0); \
    VRD(1); SBAR(); GAPA(C0=__builtin_amdgcn_mfma_f32_32x32x16_bf16(kf[2],qr[1],C0,0,0,0),   P0[10],P0[11],P0[12],P0[13], pw1[0]=PKW(P0,8), pw1[1]=PKW(P0,10), pw1); \
    VRD(5); SBAR(); GAPA(C1=__builtin_amdgcn_mfma_f32_32x32x16_bf16(kf[3],qr[1],C1,0,0,0),   P0[14],P0[15],P1[0],P1[1],   pw1[2]=PKW(P0,12),pw1[3]=PKW(P0,14), pw1); \
    VRD(2); SBAR(); GAPA(C0=__builtin_amdgcn_mfma_f32_32x32x16_bf16(kf[4],qr[2],C0,0,0,0),   P1[2],P1[3],P1[4],P1[5],     pw2[0]=PKW(P1,0), pw2[1]=PKW(P1,2), pw2); \
    VRD(6); SBAR(); GAPA(C1=__builtin_amdgcn_mfma_f32_32x32x16_bf16(kf[5],qr[2],C1,0,0,0),   P1[6],P1[7],P1[8],P1[9],     pw2[2]=PKW(P1,4), pw2[3]=PKW(P1,6), pw2); \
    VRD(3); SBAR(); GAPA(C0=__builtin_amdgcn_mfma_f32_32x32x16_bf16(kf[6],qr[3],C0,0,0,0),   P1[10],P1[11],P1[12],P1[13], pw3[0]=PKW(P1,8), pw3[1]=PKW(P1,10), pw3); \
    VRD(7); SBAR(); GAPA(C1=__builtin_amdgcn_mfma_f32_32x32x16_bf16(kf[7],qr[3],C1,0,0,0),   P1[14],P1[15],0.f,0.f,       pw3[2]=PKW(P1,12),pw3[3]=PKW(P1,14), pw3); \
    l_reg+=sacc; \
    if(GK){DMA_K((t)+3,sl_cur);} if(GV){DMA_V((t)+1,sl_next);} \
    CMASK(C0,C1,t); \
    { float a=MX3(C0[0],C0[1],C1[0]),b=MX3(C0[2],C0[3],C1[1]); a=MX3(a,C1[2],C1[3]); \
      _Pragma("unroll") for(int r=4;r<16;r+=4){a=MX3(a,C0[r],C0[r+1]);b=MX3(b,C0[r+2],C0[r+3]);a=MX3(a,C1[r],C1[r+1]);b=MX3(b,C1[r+2],C1[r+3]);} \
      float rm=__builtin_fmaxf(a,b); { auto rr=__builtin_amdgcn_permlane32_swap(__float_as_uint(rm),__float_as_uint(rm),false,false); rm=__builtin_fmaxf(__uint_as_float(rr[0]),__uint_as_float(rr[1])); } \
      resc=false; \
      if(__builtin_expect(__any(rm>(float)THRL),0)){ const float dl=__builtin_fmaxf(rm,0.f); mhat+=dl; \
        _Pragma("unroll") for(int r=0;r<16;++r){C0[r]-=dl;C1[r]-=dl;} \
        const float f=__builtin_amdgcn_exp2f(-dl); l_reg*=f; if(hi==0)wsf[r32]=f; resc=true; } } \
    const float btn_=(((selmask>>(((t)+1)>>2))&1u)!=0u)?(cb0+sl2*(float)(64*((t)+1))-mhat):MASKED; \
    SBAR(); \
    GAPB(o[0]=__builtin_amdgcn_mfma_f32_32x32x16_bf16(PAF(0),VFR(0),o[0],0,0,0), C0,0, P0,P1,0); \
    GAPB(o[1]=__builtin_amdgcn_mfma_f32_32x32x16_bf16(PAF(0),VFR(4),o[1],0,0,0), C0,4, P0,P1,2); \
    KRD(GL,0); GAPB(o[0]=__builtin_amdgcn_mfma_f32_32x32x16_bf16(PAF(1),VFR(1),o[0],0,0,0), C0,8, P0,P1,4); \
    KRD(GL,1); GAPB(o[1]=__builtin_amdgcn_mfma_f32_32x32x16_bf16(PAF(1),VFR(5),o[1],0,0,0), C0,12, P0,P1,6); \
    KRD(GL,2); GAPB(o[0]=__builtin_amdgcn_mfma_f32_32x32x16_bf16(PAF(2),VFR(2),o[0],0,0,0), C1,0, P0,P1,8); \
    KRD(GL,3); GAPB(o[1]=__builtin_amdgcn_mfma_f32_32x32x16_bf16(PAF(2),VFR(6),o[1],0,0,0), C1,4, P0,P1,10); \
    GAPB(o[0]=__builtin_amdgcn_mfma_f32_32x32x16_bf16(PAF(3),VFR(3),o[0],0,0,0), C1,8, P0,P1,12); \
    GAPB(o[1]=__builtin_amdgcn_mfma_f32_32x32x16_bf16(PAF(3),VFR(7),o[1],0,0,0), C1,12, P0,P1,14); \
    }while(0)
  CINIT(pB0,pB1,1);
  int t=1;
  #undef CMASK
  #define CMASK(P0,P1,t) do{}while(0)
  for(;t+5<NT;t+=2){
    STEP(pB0,pB1,pA0,pA1,t,true,true,true);     WAIT_BAR(2); RESC(); ROT();
    STEP(pA0,pA1,pB0,pB1,t+1,true,true,true);   WAIT_BAR(2); RESC(); ROT();
  }
  #undef CMASK
  #define CMASK(P0,P1,t) do{int jb_=(t)-(NT-4); if(jb_>=0)cmask(P0,P1,jb_,qrel,hi);}while(0)
  #define ENDW(tt) do{ if((tt)+3<NT){WAIT_BAR(2);} else if((tt)+2<NT){WAIT_BAR(1);} else {WAIT_BAR(0);} }while(0)
  for(;t+1<NT;t+=2){
    STEP(pB0,pB1,pA0,pA1,t,(t+3<NT),(t+1<NT),(t+1<NT));       ENDW(t);   RESC(); ROT();
    STEP(pA0,pA1,pB0,pB1,t+1,(t+4<NT),(t+2<NT),(t+2<NT));     ENDW(t+1); RESC(); ROT();
  }
  STEP(pB0,pB1,pA0,pA1,NT-1,false,false,false); RESC();
  { float sacc=pB0[0]+pB0[1]; _Pragma("unroll") for(int r=2;r<16;++r)sacc+=pB0[r]; _Pragma("unroll") for(int r=0;r<16;++r)sacc+=pB1[r]; l_reg+=sacc;
    pw0=(u32x4){PKW(pB0,0),PKW(pB0,2),PKW(pB0,4),PKW(pB0,6)};pw1=(u32x4){PKW(pB0,8),PKW(pB0,10),PKW(pB0,12),PKW(pB0,14)};pw2=(u32x4){PKW(pB1,0),PKW(pB1,2),PKW(pB1,4),PKW(pB1,6)};pw3=(u32x4){PKW(pB1,8),PKW(pB1,10),PKW(pB1,12),PKW(pB1,14)};
    SBAR(); pv(o,vb0+sl_cur,PAF(0),PAF(1),PAF(2),PAF(3)); }
  #undef PKW
  #undef PAF
  #undef VFR
  #undef PIN
  #undef MX3
  #undef GAPA
  #undef GAPB
  #undef KCF
  #undef EX
  #undef VRD
  #undef KRD
  #undef STEP
  #undef ENDW
  {auto rr=__builtin_amdgcn_permlane32_swap(__float_as_uint(l_reg),__float_as_uint(l_reg),false,false);l_reg=__uint_as_float(rr[0])+__uint_as_float(rr[1]);}
  if(hi==0)wsf[32+r32]=l_reg;asm volatile("s_waitcnt lgkmcnt(0)":::"memory");
  float rli[16];
  #pragma unroll
  for(int r=0;r<16;++r)rli[r]=__builtin_amdgcn_rcpf(wsf[32+crow(r,hi)]);
  int lane2=lane; asm volatile("":"+v"(lane2));
  constexpr int OP=P3_FUSED?2*DM:DM;
  bf16*Ow=O+(rowbase+q0+wid*QBLK)*OP+h*D;
  { __attribute__((address_space(3))) unsigned short*stg=(__attribute__((address_space(3))) unsigned short*)((__attribute__((address_space(3))) char*)shm+LDS_OST)+wid*2048;
    #pragma unroll
    for(int r=0;r<16;++r){const int orow=crow(r,hi);
      #pragma unroll
      for(int d0=0;d0<2;++d0)stg[orow*64+d0*32+r32]=(unsigned short)(cvtpk_s(o[d0][r]*rli[r],0.f)&0xffffu);}
    asm volatile("s_waitcnt lgkmcnt(0)":::"memory");
    #pragma unroll
    for(int i=0;i<4;++i){const int row=i*8+(lane2>>3),ch=lane2&7; const u32x4 v=*(const __attribute__((address_space(3))) u32x4*)(stg+row*64+ch*8); *(u32x4*)(Ow+(long)row*OP+ch*8)=v;} }
  asm volatile("s_waitcnt lgkmcnt(0)\n\ts_barrier":::"memory");
  #undef DMA_K
  #undef DMA_V
  #undef CMASK
  #undef CINIT
  #undef START
  #undef RESC
  #undef ROT
}
constexpr int ATTN_LDS_BYTES=LDS_BYTES;
#undef SBAR
#undef WAIT_BAR
}

struct Frame { LAS unsigned char* lds; int tid, lane, wave, vcu, G; };
#define LDS_WAIT() asm volatile("s_waitcnt lgkmcnt(0)" ::: "memory")

struct P0Item { const float* W; bf16* WT; const float* ks; int K, N, k0, n0, f8, nblk, pitch; };
__device__ __forceinline__ P0Item p0_decode(const Ptrs& P, int it) {
    constexpr int I_IN = (D / 64) * ((IN_I8 ? 256 * IN_BF_TILES : NIN) / 32), I_A = (AW / 64) * (D / 32), I_M = (D / 64) * (D / 32), I_GU = (D / 64) * (2 * DE / 32), I_D = (DE / 64) * (D / 32);
    unsigned char* ws = P.ws; P0Item q; int r = it; q.f8 = 0; q.nblk = 0; q.pitch = 0;
    if (r < I_IN) { q.W = P.w_in; q.WT = (bf16*)(ws + WS_WIN); q.ks = nullptr; q.K = D; q.N = NIN; q.nblk = (IN_I8 ? 256 * IN_BF_TILES : NIN) / 32; }
    else if ((r -= I_IN) < I_A) { q.W = P.w_attn_out; q.WT = (bf16*)(ws + WS_WA); q.ks = nullptr; q.K = AW; q.N = D; q.pitch = P3_FUSED ? 1024 : 0; }
    else if ((r -= I_A) < I_A) { q.W = P.w_sgu_out; q.WT = P3_FUSED ? (bf16*)(ws + WS_WA) + 512 : (bf16*)(ws + WS_WS); q.ks = nullptr; q.K = SW; q.N = D; q.pitch = P3_FUSED ? 1024 : 0; }
    else if ((r -= I_A) < I_M) { q.W = P.w_mix_out; q.WT = (bf16*)(ws + WS_WM); q.ks = nullptr; q.K = D; q.N = D; }
    else if (!MOE_I8 && (r -= I_M) < NE * I_GU) { const int e = r / I_GU; r -= e * I_GU; q.W = P.w_gu + (size_t)e * D * 2 * DE; q.WT = (bf16*)(ws + WS_WGU) + (size_t)e * D * 2 * DE; q.ks = P.ffn_g; q.K = D; q.N = 2 * DE; }
    else { r -= MOE_I8 ? I_M : NE * I_GU; const int e = r / I_D; r -= e * I_D; q.W = P.w_down + (size_t)e * DE * D; q.WT = MOE_F8 ? (bf16*)(ws + WS_WD + (size_t)e * DE * D) : (bf16*)(ws + WS_WD) + (size_t)e * DE * D; q.ks = nullptr; q.K = DE; q.N = D; q.f8 = MOE_F8; }
    const int nblk = q.nblk ? q.nblk : q.N / 32; q.k0 = 64 * (r / nblk); q.n0 = 32 * (r % nblk); return q;
}
__device__ __forceinline__ void p0_load(const P0Item& q, int lane, f32x4 (&buf)[8]) {
    const float* src = q.W + (size_t)(q.k0 + (lane >> 3)) * q.N + q.n0 + 4 * (lane & 7);
#pragma unroll
    for (int i = 0; i < 8; ++i) buf[i] = __builtin_nontemporal_load((const GAS f32x4*)(src + (size_t)(8 * i) * q.N));
}
__device__ __forceinline__ void p0_store(const P0Item& q, int lane, const f32x4 (&buf)[8], LAS float* scr) {
#pragma unroll
    for (int i = 0; i < 8; ++i) { const int kk = (lane >> 3) + 8 * i; const float sc = q.ks ? q.ks[q.k0 + kk] : 1.f; LAS float* d = scr + kk * 33 + 4 * (lane & 7);
        d[0] = buf[i][0] * sc; d[1] = buf[i][1] * sc; d[2] = buf[i][2] * sc; d[3] = buf[i][3] * sc; }
    LDS_WAIT(); asm volatile("" ::: "memory");
    const int c = lane & 7;
#pragma unroll
    for (int j = 0; j < 4; ++j) { const int n = (lane >> 3) + 8 * j; const LAS float* s = scr + (8 * c) * 33 + n;
        if (q.f8) { u32x2 o; unsigned w = 0u; w = __builtin_amdgcn_cvt_pk_fp8_f32(s[0 * 33] * 32.f, s[1 * 33] * 32.f, w, false); w = __builtin_amdgcn_cvt_pk_fp8_f32(s[2 * 33] * 32.f, s[3 * 33] * 32.f, w, true); o.x = w;
            w = 0u; w = __builtin_amdgcn_cvt_pk_fp8_f32(s[4 * 33] * 32.f, s[5 * 33] * 32.f, w, false); w = __builtin_amdgcn_cvt_pk_fp8_f32(s[6 * 33] * 32.f, s[7 * 33] * 32.f, w, true); o.y = w;
            *(GAS u32x2*)((unsigned char*)q.WT + (size_t)(q.n0 + n) * q.K + q.k0 + 8 * c) = o; }
        else { u32x4 o; o.x = cvt_pk_bf16(s[0 * 33], s[1 * 33]); o.y = cvt_pk_bf16(s[2 * 33], s[3 * 33]); o.z = cvt_pk_bf16(s[4 * 33], s[5 * 33]); o.w = cvt_pk_bf16(s[6 * 33], s[7 * 33]);
            *(GAS u32x4*)(q.WT + (size_t)(q.n0 + n) * (q.pitch ? q.pitch : q.K) + q.k0 + 8 * c) = o; } }
    LDS_WAIT(); asm volatile("" ::: "memory");
}
__device__ __forceinline__ void p0_gu_load(const Ptrs& P, int s, int t, f32x4 (&v)[16]) {
    const bool gu = s < NE * 64; const int e = s >> 6, n0 = (s & 63) * 32; const size_t ld = gu ? (size_t)2 * DE : (size_t)NIN;
    const float* src = (gu ? P.w_gu + (size_t)e * D * 2 * DE + n0 : P.w_in + 256 * IN_BF_TILES + 32 * (s - NE * 64)) + 4 * (t & 7) + (size_t)(4 * (t >> 3)) * ld;
#pragma unroll
    for (int i = 0; i < 4; ++i)
#pragma unroll
        for (int j = 0; j < 4; ++j) v[4 * i + j] = __builtin_nontemporal_load((const GAS f32x4*)(src + (size_t)(256 * i + j) * ld));
}
#define LDS_BARRIER() asm volatile("s_waitcnt lgkmcnt(0)\n\ts_barrier" ::: "memory")
__device__ __forceinline__ void p0_gu_process(Frame& F, const Ptrs& P, int s, f32x4 (&va)[16], const f32x4 (&gk)[4]) {
    unsigned char* ws = P.ws; LAS unsigned char* tile = F.lds; LAS unsigned* lmax = (LAS unsigned*)(F.lds + 40960);
    const int t = F.tid, n4 = 4 * (t & 7), kq = t >> 3; const bool gu = s < NE * 64;
    unsigned char* qdst = gu ? ws + WS_WGU + (size_t)(s * 32) * 1024 : ws + WS_WINQ + (size_t)((s - NE * 64) * 32) * 1024;
    float* sdst = gu ? (float*)(ws + WS_SB) + s * 32 : (float*)(ws + WS_SBIN) + (s - NE * 64) * 32;
    if (t < 32) lmax[t] = 0u;
    f32x4 m = (f32x4){0.f, 0.f, 0.f, 0.f};
#pragma unroll
    for (int i = 0; i < 4; ++i)
#pragma unroll
        for (int j = 0; j < 4; ++j) { va[4 * i + j] = va[4 * i + j] * (gu ? gk[i][j] : 1.f); m = __builtin_elementwise_max(m, __builtin_elementwise_abs(va[4 * i + j])); }
    LDS_BARRIER();
#pragma unroll
    for (int c = 0; c < 4; ++c) __hip_atomic_fetch_max(lmax + n4 + c, __float_as_uint(m[c]), __ATOMIC_RELAXED, __HIP_MEMORY_SCOPE_WORKGROUP);
    LDS_BARRIER();
    f32x4 inv;
#pragma unroll
    for (int c = 0; c < 4; ++c) inv[c] = 127.f / fmaxf(__uint_as_float(lmax[n4 + c]), 1e-30f);
#pragma unroll
    for (int i = 0; i < 4; ++i)
#pragma unroll
        for (int c = 0; c < 4; ++c) { unsigned w = 0u;
#pragma unroll
            for (int j = 0; j < 4; ++j) { const int q = (int)__builtin_rintf(va[4 * i + j][c] * inv[c]); w |= ((unsigned)q & 0xffu) << (8 * j); }
            *(LAS unsigned*)(tile + (n4 + c) * 1040 + 4 * kq + 256 * i) = w; }
    LDS_BARRIER();
#pragma unroll
    for (int j = 0; j < 4; ++j) { const int ch = t + 512 * j, n = ch >> 6, kc = ch & 63; const u32x4 w = *(const LAS u32x4*)(tile + n * 1040 + 16 * kc);
        *(GAS u32x4*)(qdst + (size_t)n * 1024 + 16 * kc) = w; }
    if (t < 32) sdst[t] = __uint_as_float(lmax[t]) * (1.f / 127.f);
    LDS_BARRIER();
}
__device__ __forceinline__ void p0_gu_strips(Frame& F, const Ptrs& P) {
    const int t = F.tid, kq = t >> 3; constexpr int NS = NE * 64 + (IN_I8 ? (NIN - 256 * IN_BF_TILES) / 32 : 0);
    if (F.vcu >= NS) return;
    f32x4 va[16], vb[16]; p0_gu_load(P, F.vcu, t, va);
    f32x4 gk[4];
#pragma unroll
    for (int i = 0; i < 4; ++i) gk[i] = *(const f32x4*)(P.ffn_g + 4 * kq + 256 * i);
    for (int s0 = F.vcu;;) {
        const int s1 = s0 + F.G; const bool has1 = s1 < NS;
        p0_gu_load(P, has1 ? s1 : NS - 1, t, vb);
        p0_gu_process(F, P, s0, va, gk);
        if (!has1) break;
        s0 = s1 + F.G; const bool has0 = s0 < NS;
        p0_gu_load(P, has0 ? s0 : NS - 1, t, va);
        p0_gu_process(F, P, s1, vb, gk);
        if (!has0) break;
    }
}
#define SUBSTAMP(i) do { if (PROBE_K >= 0 && blockIdx.x == 0 && F.tid == 0) { ((LAS unsigned long long*)(F.lds + LX_MISC))[i] = __builtin_amdgcn_s_memrealtime(); } } while (0)
__device__ __forceinline__ void p0_prologue(Frame& F, const Ptrs& P) {
    unsigned char* ws = P.ws;
    const bool strips_first = (F.vcu & 1) == 0;
#if MOE_I8
    if (strips_first) p0_gu_strips(F, P);
#endif
    SUBSTAMP(10);
    LAS float* scr = (LAS float*)(F.lds + F.wave * 16384);
    const int gw = F.vcu * NWAVES + F.wave, NGW = F.G * NWAVES;
    constexpr int I_IN = (D / 64) * ((IN_I8 ? 256 * IN_BF_TILES : NIN) / 32), I_A = (AW / 64) * (D / 32), I_M = (D / 64) * (D / 32), I_GU = (D / 64) * (2 * DE / 32), I_D = (DE / 64) * (D / 32);
    constexpr int NITEMS = I_IN + 2 * I_A + I_M + (MOE_I8 ? 0 : NE * I_GU) + NE * I_D;
    if (gw < NITEMS) {
        P0Item cur = p0_decode(P, gw), nxt = cur; f32x4 bufA[8], bufB[8]; p0_load(cur, F.lane, bufA);
        for (int it = gw;;) {
            int nit = it + NGW; bool has = nit < NITEMS;
            nxt = p0_decode(P, has ? nit : NITEMS - 1); p0_load(nxt, F.lane, bufB);
            p0_store(cur, F.lane, bufA, scr);
            if (!has) break;
            it = nit + NGW; has = it < NITEMS;
            cur = p0_decode(P, has ? it : NITEMS - 1); p0_load(cur, F.lane, bufA);
            p0_store(nxt, F.lane, bufB, scr);
            if (!has) break;
        }
    }
    SUBSTAMP(11);
    for (int i = (F.vcu * NWAVES + F.wave) * 64 + F.lane; i < 8 * 128 * 128 / 2; i += NGW * 64) { const int e0 = 2 * i, t = (e0 >> 7) & 127, s0 = e0 & 127; const f32x2 wv = *(const f32x2*)(P.w_sp + e0);
        ((unsigned*)(ws + WS_WSP))[i] = cvt_pk_bf16(s0 <= t ? wv.x : 0.f, s0 + 1 <= t ? wv.y : 0.f); }
    for (int i = (F.vcu * NWAVES + F.wave) * 64 + F.lane; i < NE * D; i += NGW * 64) { const int e = i / D, k = i % D; const float v = P.w_router[(size_t)k * NE + e] * P.ffn_g[k];
        const unsigned h = f2bf(v); ((bf16*)(ws + WS_WR))[i] = (bf16)h; ((bf16*)(ws + WS_WR))[NE * D + i] = (bf16)f2bf(v - bf2f(h)); }
    f32x4 gg[4];
#pragma unroll
    for (int j = 0; j < 4; ++j) gg[j] = ((const f32x4*)P.mix_g)[F.lane + 64 * j];
    for (int row = gw; row < T; row += 2 * NGW) {
        const int row2 = row + NGW; const bool two = row2 < T;
        const GAS f32x4* xr = (const GAS f32x4*)(P.x + (size_t)row * D) + F.lane; const GAS f32x4* xr2 = (const GAS f32x4*)(P.x + (size_t)(two ? row2 : row) * D) + F.lane;
        f32x4 v[4], u[4]; float s = 0.f, s2 = 0.f;
#pragma unroll
        for (int j = 0; j < 4; ++j) { v[j] = __builtin_nontemporal_load(xr + 64 * j); u[j] = __builtin_nontemporal_load(xr2 + 64 * j); }
#pragma unroll
        for (int j = 0; j < 4; ++j) { s += (v[j].x * v[j].x + v[j].y * v[j].y) + (v[j].z * v[j].z + v[j].w * v[j].w); s2 += (u[j].x * u[j].x + u[j].y * u[j].y) + (u[j].z * u[j].z + u[j].w * u[j].w); }
        const float rstd = 1.f / sqrtf(wave_sum(s) * (1.f / D) + EPS), rstd2 = 1.f / sqrtf(wave_sum(s2) * (1.f / D) + EPS);
#pragma unroll
        for (int j = 0; j < 4; ++j) { v[j] = v[j] * rstd * gg[j]; u[j] = u[j] * rstd2 * gg[j]; }
#pragma unroll
        for (int j = 0; j < 4; ++j) { u32x2 o; o.x = cvt_pk_bf16(v[j].x, v[j].y); o.y = cvt_pk_bf16(v[j].z, v[j].w);
            *((GAS u32x2*)(ws + WS_XN + (size_t)row * D * 2) + F.lane + 64 * j) = o; }
        if (two) {
#pragma unroll
            for (int j = 0; j < 4; ++j) { u32x2 o; o.x = cvt_pk_bf16(u[j].x, u[j].y); o.y = cvt_pk_bf16(u[j].z, u[j].w);
                *((GAS u32x2*)(ws + WS_XN + (size_t)row2 * D * 2) + F.lane + 64 * j) = o; } }
#if IN_I8
        { float a1 = 0.f, a2 = 0.f;
#pragma unroll
          for (int j = 0; j < 4; ++j) { const f32x4 av = __builtin_elementwise_abs(v[j]), au = __builtin_elementwise_abs(u[j]); a1 = fmaxf(a1, fmaxf(fmaxf(av.x, av.y), fmaxf(av.z, av.w))); a2 = fmaxf(a2, fmaxf(fmaxf(au.x, au.y), fmaxf(au.z, au.w))); }
          a1 = fmaxf(wave_max(a1), 1e-30f); a2 = fmaxf(wave_max(a2), 1e-30f); const float q1 = 127.f / a1, q2 = 127.f / a2;
#pragma unroll
          for (int j = 0; j < 4; ++j) { const unsigned w = ((unsigned)(int)__builtin_rintf(v[j].x * q1) & 0xffu) | (((unsigned)(int)__builtin_rintf(v[j].y * q1) & 0xffu) << 8) | (((unsigned)(int)__builtin_rintf(v[j].z * q1) & 0xffu) << 16) | ((unsigned)(int)__builtin_rintf(v[j].w * q1) << 24);
              *((GAS unsigned*)(ws + WS_XNQ + (size_t)row * D) + F.lane + 64 * j) = w; }
          if (F.lane == 0) ((float*)(ws + WS_SXN))[row] = a1 * (1.f / 127.f);
          if (two) {
#pragma unroll
              for (int j = 0; j < 4; ++j) { const unsigned w = ((unsigned)(int)__builtin_rintf(u[j].x * q2) & 0xffu) | (((unsigned)(int)__builtin_rintf(u[j].y * q2) & 0xffu) << 8) | (((unsigned)(int)__builtin_rintf(u[j].z * q2) & 0xffu) << 16) | ((unsigned)(int)__builtin_rintf(u[j].w * q2) << 24);
                  *((GAS unsigned*)(ws + WS_XNQ + (size_t)row2 * D) + F.lane + 64 * j) = w; }
              if (F.lane == 0) ((float*)(ws + WS_SXN))[row2] = a2 * (1.f / 127.f); } }
#endif
    }
#if MOE_I8
    if (!strips_first) { __syncthreads(); p0_gu_strips(F, P); }
#endif
}
__device__ __forceinline__ void moe_tables(Frame& F, const unsigned* ctl) {
    LAS int* tbase = (LAS int*)(F.lds + LX_TBASE); LAS int* tile_e = (LAS int*)(F.lds + LX_TILEE);
    if (F.tid < 64) { const int c = F.tid < NE ? (int)ctl[CW_CNT + 64 * F.tid] : 0; const int n = (c + 255) >> 8; int incl = n;
#pragma unroll
        for (int o = 1; o < 64; o <<= 1) { const int t = __shfl_up(incl, o); if (F.lane >= o) incl += t; }
        if (F.tid <= NE) tbase[F.tid] = incl - n;
    }
    __syncthreads();
    for (int mt = F.tid; mt < NROWS_PAD / 256; mt += NWAVES * 64) { int e = 0;
        for (int i = 0; i < NE; ++i) if (mt >= tbase[i + 1]) e = i + 1;
        tile_e[mt] = e < NE ? e : NE - 1; }
    __syncthreads();
}


__device__ __forceinline__ void p5_router(Frame& F, const Ptrs& P) {
    unsigned char* ws = P.ws; unsigned* ctl = (unsigned*)(ws + WS_CTL);
    LAS float* red = (LAS float*)F.lds;
    LAS unsigned* lcnt = (LAS unsigned*)(F.lds + 40960);
    LAS f32x2* rowinfo = (LAS f32x2*)(F.lds + 41472);
    LAS unsigned* lbase = lcnt + 32;
    const int w = F.wave, lane = F.lane, gI = w & 1, kq = w >> 1, r32 = lane & 31, hi = lane >> 5;
    const bf16* WR = (const bf16*)(ws + WS_WR);
    for (int grp = blockIdx.x; grp < T / 64; grp += F.G) {
        if (F.tid < 64) lcnt[F.tid] = 0u;
        const int tok = grp * 64 + gI * 32 + r32;
        const float* xr = (const float*)(ws + WS_H1) + (size_t)tok * D + kq * 256 + 8 * hi;
        const bf16* xb = (const bf16*)(ws + WS_H1B) + (size_t)tok * D + kq * 256 + 8 * hi; (void)xb; (void)xr;
        const bf16* whi = WR + (size_t)r32 * D + kq * 256 + 8 * hi; const bf16* wlo = whi + NE * D;
        f32x16 c = {}; float ss = 0.f; f32x4 am = (f32x4){0.f, 0.f, 0.f, 0.f};
#pragma unroll 4
        for (int s = 0; s < 16; ++s) {
#if H1_BF16
            const u32x4 xraw = *(const u32x4*)(xb + 16 * s);
            const f32x4 x0 = (f32x4){bf2f(xraw[0] & 0xffffu), bf2f(xraw[0] >> 16), bf2f(xraw[1] & 0xffffu), bf2f(xraw[1] >> 16)}, x1 = (f32x4){bf2f(xraw[2] & 0xffffu), bf2f(xraw[2] >> 16), bf2f(xraw[3] & 0xffffu), bf2f(xraw[3] >> 16)};
#else
            const f32x4 x0 = *(const f32x4*)(xr + 16 * s), x1 = *(const f32x4*)(xr + 16 * s + 4);
#endif
            am = __builtin_elementwise_max(am, __builtin_elementwise_max(__builtin_elementwise_abs(x0), __builtin_elementwise_abs(x1)));
            ss += (x0[0] * x0[0] + x0[1] * x0[1]) + (x0[2] * x0[2] + x0[3] * x0[3]) + (x1[0] * x1[0] + x1[1] * x1[1]) + (x1[2] * x1[2] + x1[3] * x1[3]);
            u32x4 hw, lw;
            { const unsigned h = cvt_pk_bf16(x0[0], x0[1]); hw[0] = h; lw[0] = cvt_pk_bf16(x0[0] - __uint_as_float(h << 16), x0[1] - __uint_as_float(h & 0xffff0000u)); }
            { const unsigned h = cvt_pk_bf16(x0[2], x0[3]); hw[1] = h; lw[1] = cvt_pk_bf16(x0[2] - __uint_as_float(h << 16), x0[3] - __uint_as_float(h & 0xffff0000u)); }
            { const unsigned h = cvt_pk_bf16(x1[0], x1[1]); hw[2] = h; lw[2] = cvt_pk_bf16(x1[0] - __uint_as_float(h << 16), x1[1] - __uint_as_float(h & 0xffff0000u)); }
            { const unsigned h = cvt_pk_bf16(x1[2], x1[3]); hw[3] = h; lw[3] = cvt_pk_bf16(x1[2] - __uint_as_float(h << 16), x1[3] - __uint_as_float(h & 0xffff0000u)); }
            const bf16x8 xh = __builtin_bit_cast(bf16x8, hw), xl = __builtin_bit_cast(bf16x8, lw);
            const bf16x8 ah = *(const bf16x8*)(whi + 16 * s), al = *(const bf16x8*)(wlo + 16 * s);
            c = __builtin_amdgcn_mfma_f32_32x32x16_bf16(ah, xh, c, 0, 0, 0);
            if (!H1_BF16) c = __builtin_amdgcn_mfma_f32_32x32x16_bf16(ah, xl, c, 0, 0, 0);
            c = __builtin_amdgcn_mfma_f32_32x32x16_bf16(al, xh, c, 0, 0, 0);
        }
#pragma unroll
        for (int r = 0; r < 16; ++r) red[(w * 18 + r) * 64 + lane] = c[r];
        red[(w * 18 + 16) * 64 + lane] = ss; red[(w * 18 + 17) * 64 + lane] = fmaxf(fmaxf(am[0], am[1]), fmaxf(am[2], am[3]));
        __syncthreads();
        int idx[4]; unsigned lpos[4]; float pw[4]; float rstd = 0.f;
        if (kq == 0) {
            float lg[16], pl[16]; float ssum = 0.f, amax = 0.f;
#pragma unroll
            for (int r = 0; r < 16; ++r) lg[r] = 0.f;
#pragma unroll
            for (int q = 0; q < 4; ++q) {
#pragma unroll
                for (int r = 0; r < 16; ++r) lg[r] += red[((w + 2 * q) * 18 + r) * 64 + lane];
                ssum += red[((w + 2 * q) * 18 + 16) * 64 + lane]; amax = fmaxf(amax, red[((w + 2 * q) * 18 + 17) * 64 + lane]); }
            ssum += __shfl_xor(ssum, 32); amax = fmaxf(fmaxf(amax, __shfl_xor(amax, 32)), 1e-30f);
            rstd = 1.f / sqrtf(ssum * (1.f / D) + EPS);
            if (hi == 0) rowinfo[gI * 32 + r32] = (f32x2){127.f / amax, MOE_I8 ? rstd * amax * (1.f / 127.f) : rstd};
#pragma unroll
            for (int r = 0; r < 16; ++r) { lg[r] = lg[r] * rstd + P.b_router[(r & 3) + 8 * (r >> 2) + 4 * hi]; pl[r] = __shfl_xor(lg[r], 32); }
            float v[32];
#pragma unroll
            for (int e = 0; e < 32; ++e) { const int half = (e >> 2) & 1, r = (e & 3) + 4 * (e >> 3); v[e] = (half == hi) ? lg[r] : pl[r]; }
            float val[4];
#pragma unroll
            for (int k = 0; k < 4; ++k) { int best = 0; float bv = -INFINITY;
#pragma unroll
                for (int e = 0; e < 32; ++e) if (v[e] > bv) { bv = v[e]; best = e; }
#pragma unroll
                for (int e = 0; e < 32; ++e) if (e == best) v[e] = -INFINITY;
                idx[k] = best; val[k] = bv; }
            float den = 0.f;
#pragma unroll
            for (int k = 0; k < 4; ++k) { pw[k] = __expf(val[k] - val[0]); den += pw[k]; }
            const float rden = 1.f / den;
#pragma unroll
            for (int k = 0; k < 4; ++k) { pw[k] *= rden; lpos[k] = 0u; if (hi == 0) lpos[k] = atomicAdd((unsigned*)&lcnt[idx[k]], 1u); }
        }
        __syncthreads();
        if (F.tid < NE) ((unsigned*)(ws + WS_HIST))[grp * NE + F.tid] = lcnt[F.tid];
        if (kq == 0 && hi == 0) {
            unsigned* slot = (unsigned*)(ws + WS_TOKSLOT); float* tw = (float*)(ws + WS_TOKW);
#pragma unroll
            for (int k = 0; k < 4; ++k) { slot[tok * 4 + k] = (unsigned)idx[k] | (lpos[k] << 8); tw[tok * 4 + k] = pw[k]; }
            ((float*)(ws + WS_RSTD2))[tok] = MOE_I8 ? rowinfo[gI * 32 + r32].y : rstd;
        }
#if MOE_I8
        { const float qs = rowinfo[gI * 32 + r32].x; unsigned char* qrow = ws + WS_H1Q + (size_t)tok * D + kq * 256 + 8 * hi; LAS unsigned char* qst = F.lds + 49152 + w * (32 * 272);
#pragma unroll 4
          for (int s = 0; s < 16; ++s) {
#if H1_BF16
              const u32x4 xraw = *(const u32x4*)(xb + 16 * s);
              const f32x4 x0 = (f32x4){bf2f(xraw[0] & 0xffffu), bf2f(xraw[0] >> 16), bf2f(xraw[1] & 0xffffu), bf2f(xraw[1] >> 16)}, x1 = (f32x4){bf2f(xraw[2] & 0xffffu), bf2f(xraw[2] >> 16), bf2f(xraw[3] & 0xffffu), bf2f(xraw[3] >> 16)};
#else
              const f32x4 x0 = *(const f32x4*)(xr + 16 * s), x1 = *(const f32x4*)(xr + 16 * s + 4);
#endif
              u32x2 w;
              w.x = ((unsigned)(int)__builtin_rintf(x0[0] * qs) & 0xffu) | (((unsigned)(int)__builtin_rintf(x0[1] * qs) & 0xffu) << 8) | (((unsigned)(int)__builtin_rintf(x0[2] * qs) & 0xffu) << 16) | ((unsigned)(int)__builtin_rintf(x0[3] * qs) << 24);
              w.y = ((unsigned)(int)__builtin_rintf(x1[0] * qs) & 0xffu) | (((unsigned)(int)__builtin_rintf(x1[1] * qs) & 0xffu) << 8) | (((unsigned)(int)__builtin_rintf(x1[2] * qs) & 0xffu) << 16) | ((unsigned)(int)__builtin_rintf(x1[3] * qs) << 24);
              *(LAS u32x2*)(qst + r32 * 272 + 16 * s + 8 * hi) = w; (void)qrow; }
          asm volatile("s_waitcnt lgkmcnt(0)" ::: "memory");
#pragma unroll
          for (int j = 0; j < 8; ++j) { const int idx = lane + 64 * j, tk = idx >> 4, ch = idx & 15; const u32x4 v = *(const LAS u32x4*)(qst + tk * 272 + 16 * ch);
              *(u32x4*)(ws + WS_H1Q + (size_t)(grp * 64 + gI * 32 + tk) * D + kq * 256 + 16 * ch) = v; } }
#endif
        __syncthreads();
    }
}
__device__ __forceinline__ void p5b_lists(Frame& F, const Ptrs& P) {
    unsigned char* ws = P.ws; unsigned* ctl = (unsigned*)(ws + WS_CTL); const unsigned* hist = (const unsigned*)(ws + WS_HIST);
    LAS unsigned* part = (LAS unsigned*)F.lds;
    LAS unsigned* lbase = part + 512;
    for (int grp = blockIdx.x; grp < T / 64; grp += F.G) {
        { const int e = F.tid & 31, pt = F.tid >> 5; unsigned s = 0u;
#pragma unroll
          for (int i = 0; i < 16; ++i) { const int g2 = pt * 16 + i; const unsigned v = hist[g2 * NE + e]; s += (g2 < grp) ? v : 0u; }
          part[pt * 32 + e] = s; }
        __syncthreads();
        if (F.tid < NE) { unsigned s = 0u;
#pragma unroll
            for (int i = 0; i < 16; ++i) s += part[i * 32 + F.tid];
            lbase[F.tid] = s;
            if (grp == T / 64 - 1) ctl[CW_CNT + 64 * F.tid] = s + hist[grp * NE + F.tid]; }
        __syncthreads();
        if (F.tid < 256) { const int tok = grp * 64 + (F.tid >> 2); unsigned* slot = (unsigned*)(ws + WS_TOKSLOT) + tok * 4 + (F.tid & 3);
            const unsigned sv = *slot; const unsigned e = sv & 0xffu, pos = lbase[e] + (sv >> 8);
            *slot = e | (pos << 8); ((int*)(ws + WS_LIST))[(size_t)e * T + pos] = tok; ((float*)(ws + WS_RLIST))[(size_t)e * T + pos] = ((const float*)(ws + WS_RSTD2))[tok]; }
        __syncthreads();
    }
}
__device__ __forceinline__ void p8_combine(Frame& F, const Ptrs& P) {
    unsigned char* ws = P.ws; const LAS int* tbase = (const LAS int*)(F.lds + LX_TBASE);
    const int gw = F.vcu * NWAVES + F.wave, NGW = F.G * NWAVES, lane = F.lane;
    const bf16* Y = (const bf16*)(ws + WS_Y); const unsigned* slot = (const unsigned*)(ws + WS_TOKSLOT); const float* tw = (const float*)(ws + WS_TOKW);
    f32x4 gg[4];
#pragma unroll
    for (int j = 0; j < 2; ++j) { gg[2 * j] = *(const f32x4*)(P.fin_g + 8 * lane + 512 * j); gg[2 * j + 1] = *(const f32x4*)(P.fin_g + 8 * lane + 512 * j + 4); }
    for (int tok = gw; tok < T; tok += NGW) {
        const float* hr = (const float*)(ws + WS_H1) + (size_t)tok * D + 8 * lane; f32x4 v[4];
#pragma unroll
#if H1_BF16
        for (int j = 0; j < 2; ++j) { const u32x4 hb = *(const u32x4*)((const bf16*)(ws + WS_H1B) + (size_t)tok * D + 8 * lane + 512 * j);
            v[2 * j] = (f32x4){bf2f(hb[0] & 0xffffu), bf2f(hb[0] >> 16), bf2f(hb[1] & 0xffffu), bf2f(hb[1] >> 16)}; v[2 * j + 1] = (f32x4){bf2f(hb[2] & 0xffffu), bf2f(hb[2] >> 16), bf2f(hb[3] & 0xffffu), bf2f(hb[3] >> 16)}; }
        (void)hr;
#else
        for (int j = 0; j < 2; ++j) { v[2 * j] = *(const f32x4*)(hr + 512 * j); v[2 * j + 1] = *(const f32x4*)(hr + 512 * j + 4); }
#endif
        const u32x4 sl = *(const u32x4*)(slot + tok * 4); const f32x4 wv = *(const f32x4*)(tw + tok * 4);
#if Y_F8
        u32x2 y8[4][2];
#pragma unroll
        for (int k = 0; k < 4; ++k) { const int e = sl[k] & 0xff, pos = sl[k] >> 8; const unsigned char* yr = (const unsigned char*)Y + (size_t)(tbase[e] * 256 + pos) * D + 8 * lane; y8[k][0] = *(const u32x2*)yr; y8[k][1] = *(const u32x2*)(yr + 512); }
#pragma unroll
        for (int k = 0; k < 4; ++k)
#pragma unroll
            for (int j = 0; j < 2; ++j) { const u32x2 q = y8[k][j]; const float wk = wv[k];
                const f32x2 a = __builtin_amdgcn_cvt_pk_f32_fp8(q.x, false), b = __builtin_amdgcn_cvt_pk_f32_fp8(q.x, true), c = __builtin_amdgcn_cvt_pk_f32_fp8(q.y, false), d = __builtin_amdgcn_cvt_pk_f32_fp8(q.y, true);
                v[2 * j][0] += wk * a[0]; v[2 * j][1] += wk * a[1]; v[2 * j][2] += wk * b[0]; v[2 * j][3] += wk * b[1];
                v[2 * j + 1][0] += wk * c[0]; v[2 * j + 1][1] += wk * c[1]; v[2 * j + 1][2] += wk * d[0]; v[2 * j + 1][3] += wk * d[1]; }
#endif
        u32x4 y[4][2];
#pragma unroll
        for (int k = 0; k < 4; ++k) { if (Y_F8) break; const int e = sl[k] & 0xff, pos = sl[k] >> 8; const bf16* yr = Y + (size_t)(tbase[e] * 256 + pos) * D + 8 * lane; y[k][0] = *(const u32x4*)yr; y[k][1] = *(const u32x4*)(yr + 512); }
#pragma unroll
        for (int k = 0; k < 4; ++k)
#pragma unroll
            for (int j = 0; j < 2; ++j) { if (Y_F8) break; const u32x4 q = y[k][j]; const float wk = wv[k];
                v[2 * j][0] += wk * bf2f(q.x & 0xffffu); v[2 * j][1] += wk * bf2f(q.x >> 16); v[2 * j][2] += wk * bf2f(q.y & 0xffffu); v[2 * j][3] += wk * bf2f(q.y >> 16);
                v[2 * j + 1][0] += wk * bf2f(q.z & 0xffffu); v[2 * j + 1][1] += wk * bf2f(q.z >> 16); v[2 * j + 1][2] += wk * bf2f(q.w & 0xffffu); v[2 * j + 1][3] += wk * bf2f(q.w >> 16); }
        float s = 0.f;
#pragma unroll
        for (int j = 0; j < 4; ++j) s += (v[j][0] * v[j][0] + v[j][1] * v[j][1]) + (v[j][2] * v[j][2] + v[j][3] * v[j][3]);
        const float rstd = 1.f / sqrtf(wave_sum(s) * (1.f / D) + EPS);
        float* orow = P.out + (size_t)tok * D + 8 * lane;
#pragma unroll
        for (int j = 0; j < 2; ++j) { *(f32x4*)(orow + 512 * j) = v[2 * j] * rstd * gg[2 * j]; *(f32x4*)(orow + 512 * j + 4) = v[2 * j + 1] * rstd * gg[2 * j + 1]; }
    }
}

constexpr int SGU_PITCH = 136;
__device__ __forceinline__ void sgu_unit(Frame& F, const Ptrs& P, int hu) {
    unsigned char* ws = P.ws; const int b = hu >> 6, c = (hu >> 1) & 31, gh = hu & 1, tok0 = b * SEQ + c * 128;
    const bf16* VV = (const bf16*)(ws + WS_VV); const bf16* U = (const bf16*)(ws + WS_U); bf16* SG = (bf16*)(ws + WS_SG);
    LAS bf16* vnT = (LAS bf16*)F.lds;
    int tid = F.tid; asm volatile("" : "+v"(tid));
    const int w = __builtin_amdgcn_readfirstlane(tid >> 6), lane = tid & 63;
    const int gl = w >> 1, th = w & 1, g = 4 * gh + gl, r32 = lane & 31, hi = lane >> 5;
    u32x4 rs[16], ru[8];
#pragma unroll
    for (int i = 0; i < 16; ++i) rs[i] = *((const u32x4*)(VV + (size_t)(tok0 + 16 * w + i) * SW) + lane);
#pragma unroll
    for (int j = 0; j < 8; ++j) { const int idx = lane + 64 * j; ru[j] = *(const u32x4*)(U + (size_t)(tok0 + 64 * th + (idx >> 3)) * SW + g * 64 + 8 * (idx & 7)); }
    const int chunk = lane & 31; const bool mine = (lane >> 5) == gh;
    const f32x4 g0 = *(const f32x4*)(P.ln_g + 8 * lane), g1 = *(const f32x4*)(P.ln_g + 8 * lane + 4), b0 = *(const f32x4*)(P.ln_b + 8 * lane), b1 = *(const f32x4*)(P.ln_b + 8 * lane + 4);
#pragma unroll
    for (int i = 0; i < 16; ++i) { float v[8]; float s1 = 0.f, s2 = 0.f;
#pragma unroll
        for (int e = 0; e < 4; ++e) { v[2 * e] = bf2f(rs[i][e] & 0xffffu); v[2 * e + 1] = bf2f(rs[i][e] >> 16); s1 += v[2 * e] + v[2 * e + 1]; s2 += v[2 * e] * v[2 * e] + v[2 * e + 1] * v[2 * e + 1]; }
#pragma unroll
        for (int o = 1; o < 64; o <<= 1) { s1 += __shfl_xor(s1, o); s2 += __shfl_xor(s2, o); }
        const float mu = s1 * (1.f / SW), rstd = 1.f / sqrtf(fmaxf(s2 * (1.f / SW) - mu * mu, 0.f) + EPS);
        if (mine) { const int sp = (16 * w + i) ^ ((chunk & 15) << 3);
#pragma unroll
            for (int e = 0; e < 8; ++e) { const float gg = e < 4 ? g0[e] : g1[e - 4], bb = e < 4 ? b0[e] : b1[e - 4]; vnT[(8 * chunk + e) * SGU_PITCH + sp] = (bf16)f2bf((v[e] - mu) * rstd * gg + bb); } } }
    const bf16* Wg = (const bf16*)(ws + WS_WSP) + (size_t)g * 128 * 128;
    const int nst = 4 * th + 4;
    bf16x8 wf[2][8];
#pragma unroll
    for (int tt = 0; tt < 2; ++tt)
#pragma unroll
        for (int ks = 0; ks < 8; ++ks) { const int t = 64 * th + 32 * tt + r32, s0 = 16 * ks + 8 * hi; wf[tt][ks] = *(const bf16x8*)(Wg + (size_t)t * 128 + s0); }
    const float bias0 = P.b_sp[g * 128 + 64 * th + r32], bias1 = P.b_sp[g * 128 + 64 * th + 32 + r32];
    LDS_BARRIER();
    f32x16 acc[2][2];
#pragma unroll
    for (int dt = 0; dt < 2; ++dt)
#pragma unroll
        for (int tt = 0; tt < 2; ++tt) acc[dt][tt] = f32x16{};
#pragma unroll
    for (int ks = 0; ks < 8; ++ks) { if (ks < nst) {
        const int s0 = 16 * ks + 8 * hi; bf16x8 af[2];
#pragma unroll
        for (int dt = 0; dt < 2; ++dt) { const int cc = 64 * gl + 32 * dt + r32; af[dt] = *(const LAS bf16x8*)(vnT + cc * SGU_PITCH + (s0 ^ (((cc >> 3) & 15) << 3))); }
#pragma unroll
        for (int tt = 0; tt < 2; ++tt) {
#pragma unroll
            for (int dt = 0; dt < 2; ++dt) acc[dt][tt] = __builtin_amdgcn_mfma_f32_32x32x16_bf16(af[dt], wf[tt][ks], acc[dt][tt], 0, 0, 0); } } }
    LDS_BARRIER();
    LAS bf16* ost = (LAS bf16*)(F.lds + w * (64 * 72 * 2));
#pragma unroll
    for (int tt = 0; tt < 2; ++tt) { const float bias = tt ? bias1 : bias0;
#pragma unroll
        for (int dt = 0; dt < 2; ++dt)
#pragma unroll
            for (int q = 0; q < 4; ++q) { u32x2 ov; ov.x = cvt_pk_bf16(acc[dt][tt][4 * q] + bias, acc[dt][tt][4 * q + 1] + bias); ov.y = cvt_pk_bf16(acc[dt][tt][4 * q + 2] + bias, acc[dt][tt][4 * q + 3] + bias);
                *(LAS u32x2*)(ost + (32 * tt + r32) * 72 + 32 * dt + 8 * q + 4 * hi) = ov; } }
    asm volatile("s_waitcnt lgkmcnt(0)" ::: "memory");
#pragma unroll
    for (int j = 0; j < 8; ++j) { const int idx = lane + 64 * j, row = idx >> 3, ch = idx & 7; const u32x4 m = *(const LAS u32x4*)(ost + row * 72 + 8 * ch); const u32x4 uu = ru[j]; u32x4 o;
#pragma unroll
        for (int e = 0; e < 4; ++e) o[e] = cvt_pk_bf16(bf2f(uu[e] & 0xffffu) * bf2f(m[e] & 0xffffu), bf2f(uu[e] >> 16) * bf2f(m[e] >> 16));
        const size_t tok = (size_t)(tok0 + 64 * th + row); const int cch = g * 64 + 8 * ch;
        *(u32x4*)(P3_FUSED ? (bf16*)(ws + WS_O) + tok * 1024 + 512 + cch : SG + tok * SW + cch) = o; }
    LDS_BARRIER();
}
__device__ __forceinline__ void p2_mixer(Frame& F, const Ptrs& P, char* lds_generic, int nrep) {
    unsigned char* ws = P.ws;
    const attn_body::bf16* Q = (const attn_body::bf16*)(ws + WS_Q); const attn_body::bf16* K = (const attn_body::bf16*)(ws + WS_K); const attn_body::bf16* V = (const attn_body::bf16*)(ws + WS_V);
    const float* KM = (const float*)(ws + WS_CTL) + CW_KM; attn_body::bf16* O = (attn_body::bf16*)(ws + WS_O);
    SUBSTAMP(14);
    for (int p = F.vcu; p < NBATCH * NH * 8; p += F.G) { const int bh = p >> 3, s = p & 7;
        for (int r = 0; r < 2 * nrep; ++r)
            attn_body::attn_unit<8>(bh / NH, bh % NH, (r & 1) ? 15 - s : s, Q, K, V, KM, O, lds_generic); }
    SUBSTAMP(12);
    for (int hu = F.vcu; hu < NBATCH * 32 * 2; hu += F.G) for (int r = 0; r < SGU_REP; ++r) sgu_unit(F, P, hu);
    SUBSTAMP(13);
}

struct Args { Ptrs P; int ph_lo, ph_hi, li, pad; };
__global__ void __launch_bounds__(NWAVES * 64, 2) fwd(Args args) {
    extern __shared__ __attribute__((aligned(16))) unsigned char lds_raw[];
    Frame F; F.lds = (LAS unsigned char*)lds_raw; F.tid = threadIdx.x; F.lane = F.tid & 63; F.wave = __builtin_amdgcn_readfirstlane(F.tid >> 6);
    F.G = gridDim.x; { const int bx = blockIdx.x; F.vcu = (F.G % 8 == 0) ? (bx % 8) * (F.G / 8) + bx / 8 : bx; }
    const Ptrs& P = args.P; unsigned char* ws = P.ws; unsigned* ctl = (unsigned*)(ws + WS_CTL);
    if (F.tid < 4) ((LAS unsigned*)(F.lds + LX_BAR))[F.tid] = 0u;
    __syncthreads();
    XcdBarrier bar = xcd_barrier_post(ctl + CW_BAR + args.li * XCD_BAR_WORDS, (volatile LAS unsigned*)(F.lds + LX_BAR));
    const int lo = args.ph_lo, hi = args.ph_hi;
#define IN(k) (lo <= (k) && (k) < hi)
#define STAMP(i) do { if (PROBE_K >= 0 && blockIdx.x == 0 && F.tid == 0) { ((LAS unsigned long long*)(F.lds + LX_MISC))[i] = __builtin_amdgcn_s_memrealtime(); } } while (0)
#ifndef REP_PHASE
#define REP_PHASE -1
#endif
#define REPS(k) (((k) == REP_PHASE) ? 2 : 1)
#define SEAM(k) do { if (IN(k) && IN((k) + 1)) { STAMP(20 + (k)); xcd_barrier(bar); } } while (0)

    STAMP(0);
    if (IN(0)) _Pragma("unroll") for (int rep_ = 0; rep_ < REPS(0); ++rep_) { p0_prologue(F, P); if (rep_ + 1 < REPS(0)) xcd_barrier(bar); else SEAM(0); }
    STAMP(1);
    if (IN(1)) _Pragma("unroll") for (int rep_ = 0; rep_ < REPS(1); ++rep_) {
        DenseSched S{(const char*)(ws + WS_XN), (const char*)(ws + WS_WIN), D, D, T / 256, IN_I8 ? IN_BF_TILES : NIN / 256, F.G, (int)blockIdx.x, WGM_IN};
        EpiIn E{ws, (float*)(ws + WS_CTL) + CW_KM};
        pg8::gemm_phase<EpiIn, DenseSched, true>(F.lds, D, D, S, E);
#if IN_I8
        BalSched S2{(const char*)(ws + WS_XNQ), (const char*)(ws + WS_WINQ), D / 2, D / 2, T / 256, NIN / 256 - IN_BF_TILES, F.G, (int)blockIdx.x, (T / 256) * IN_BF_TILES};
        EpiInQ E2{ws, (const float*)(ws + WS_SXN), (const float*)(ws + WS_SBIN), (float*)(ws + WS_CTL) + CW_KM, F.lds};
        pg8::gemm_phase<EpiInQ, BalSched, true>(F.lds, D / 2, D / 2, S2, E2);
#endif
        if (rep_ + 1 < REPS(1)) xcd_barrier(bar); else SEAM(1);
    }
    STAMP(2);
    if (IN(2)) _Pragma("unroll") for (int rep_ = 0; rep_ < REPS(2); ++rep_) { p2_mixer(F, P, (char*)lds_raw, args.pad); if (rep_ + 1 < REPS(2)) xcd_barrier(bar); else SEAM(2); }
    STAMP(3);
    if (IN(3)) _Pragma("unroll") for (int rep_ = 0; rep_ < REPS(3); ++rep_) {
#if P3_FUSED
        DenseSched S{(const char*)(ws + WS_O), (const char*)(ws + WS_WA), D, D, T / 256, D / 256, F.G, (int)blockIdx.x, WGM_MID};
        EpiMergeF E{ws};
        pg8::gemm_phase<EpiMergeF, DenseSched, true>(F.lds, D, D, S, E);
#else
        MergeSched S{(const char*)(ws + WS_O), (const char*)(ws + WS_WA), F.G, (int)blockIdx.x};
        EpiMerge E{ws};
        pg8::gemm_phase<EpiMerge, MergeSched, true>(F.lds, AW, AW, S, E);
#endif
        if (rep_ + 1 < REPS(3)) xcd_barrier(bar); else SEAM(3);
    }
    STAMP(4);
    if (IN(4)) _Pragma("unroll") for (int rep_ = 0; rep_ < REPS(4); ++rep_) {
        DenseSched S{(const char*)(ws + WS_MG), (const char*)(ws + WS_WM), D, D, T / 256, D / 256, F.G, (int)blockIdx.x, WGM_MID};
        EpiH1 E{P.x, (float*)(ws + WS_H1), (bf16*)(ws + WS_H1B)};
        pg8::gemm_phase<EpiH1, DenseSched, true>(F.lds, D, D, S, E);
        if (rep_ + 1 < REPS(4)) xcd_barrier(bar); else SEAM(4);
    }
    STAMP(5);
    if (IN(5)) { p5_router(F, P); xcd_barrier(bar); p5b_lists(F, P); SEAM(5); }
    STAMP(6);
    if (IN(6)) _Pragma("unroll") for (int rep_ = 0; rep_ < REPS(6); ++rep_) {
        moe_tables(F, ctl);
#if MOE_I8
        MoeSched<true> S{(const char*)(ws + WS_H1Q), (const char*)(ws + WS_WGU), (const int*)(ws + WS_LIST), (const LAS int*)(F.lds + LX_TBASE), (const LAS int*)(F.lds + LX_TILEE), ctl, 8, F.G, (int)blockIdx.x, D / 2};
        EpiGuQ E{(const float*)(ws + WS_RLIST), (const float*)(ws + WS_SB), P.b_gu, (bf16*)(ws + WS_HID), F.lds};
        pg8::gemm_phase<EpiGuQ, MoeSched<true>, true>(F.lds, D / 2, D / 2, S, E);
#else
        MoeSched<true> S{(const char*)(ws + WS_H1B), (const char*)(ws + WS_WGU), (const int*)(ws + WS_LIST), (const LAS int*)(F.lds + LX_TBASE), (const LAS int*)(F.lds + LX_TILEE), ctl, 8, F.G, (int)blockIdx.x, D};
        EpiGu E{(const float*)(ws + WS_RLIST), P.b_gu, (bf16*)(ws + WS_HID)};
        pg8::gemm_phase<EpiGu, MoeSched<true>, true>(F.lds, D, D, S, E);
#endif
        if (rep_ + 1 < REPS(6)) xcd_barrier(bar); else SEAM(6);
    }
    STAMP(7);
    if (IN(7)) _Pragma("unroll") for (int rep_ = 0; rep_ < REPS(7); ++rep_) {
        if (!IN(6)) moe_tables(F, ctl);
        MoeSched<false> S{(const char*)(ws + WS_HID), (const char*)(ws + WS_WD), nullptr, (const LAS int*)(F.lds + LX_TBASE), (const LAS int*)(F.lds + LX_TILEE), ctl, 4, F.G, (int)blockIdx.x, MOE_F8 ? DE / 2 : DE};
        EpiDown E{P.b_down, (bf16*)(ws + WS_Y), F.lds};
        pg8::gemm_phase<EpiDown, MoeSched<false>, true>(F.lds, MOE_F8 ? DE / 2 : DE, MOE_F8 ? DE / 2 : DE, S, E);
        if (rep_ + 1 < REPS(7)) xcd_barrier(bar); else SEAM(7);
    }
    STAMP(8);
    if (IN(8)) _Pragma("unroll") for (int rep_ = 0; rep_ < REPS(8); ++rep_) { if (!IN(6)) moe_tables(F, ctl); p8_combine(F, P); if (rep_ + 1 < REPS(8)) xcd_barrier(bar); }
    STAMP(9);
    if (PROBE_K >= 0 && blockIdx.x == 0 && F.tid == 0) { const LAS unsigned long long* ts = (const LAS unsigned long long*)(F.lds + LX_MISC); const unsigned long long d = (PROBE_K == 9) ? ts[9] - ts[0] : (PROBE_K == 40) ? (ts[1] - ts[20]) + (ts[2] - ts[21]) + (ts[3] - ts[22]) + (ts[4] - ts[23]) + (ts[5] - ts[24]) + (ts[6] - ts[25]) + (ts[7] - ts[26]) + (ts[8] - ts[27]) : (PROBE_K == 24) ? ts[12] - ts[14] : (PROBE_K == 23) ? ts[13] - ts[12] : (PROBE_K == 20) ? ts[10] - ts[0] : (PROBE_K == 21) ? ts[11] - ts[10] : (PROBE_K == 22) ? ts[1] - ts[11] : ts[(PROBE_K + 1) % 10] - ts[PROBE_K % 10], t0 = __builtin_amdgcn_s_memrealtime();
        while (__builtin_amdgcn_s_memrealtime() - t0 < d) __builtin_amdgcn_s_sleep(8); }
#undef IN
#undef SEAM
}

#ifndef ATTN_REP
#define ATTN_REP 1
#endif
#ifndef REDO_MASK
#define REDO_MASK 0x000
#endif
#ifndef OPT_MASK
#define OPT_MASK 0x1FF
#endif
static void naive_phase(int k, const Ptrs& P, hipStream_t stream) {
    unsigned char* ws = P.ws;
    switch (k) {
    case 0:
        n_cvtT<<<dim3(NIN / 32, D / 32, 1), 256, 0, stream>>>(P.w_in, (bf16*)(ws + WS_WIN), D, NIN, nullptr);
        n_cvtT<<<dim3(D / 32, AW / 32, 1), 256, 0, stream>>>(P.w_attn_out, (bf16*)(ws + WS_WA), AW, D, nullptr);
        n_cvtT<<<dim3(D / 32, SW / 32, 1), 256, 0, stream>>>(P.w_sgu_out, (bf16*)(ws + WS_WS), SW, D, nullptr);
        n_cvtT<<<dim3(D / 32, D / 32, 1), 256, 0, stream>>>(P.w_mix_out, (bf16*)(ws + WS_WM), D, D, nullptr);
        n_cvtT<<<dim3(2 * DE / 32, D / 32, NE), 256, 0, stream>>>(P.w_gu, (bf16*)(ws + WS_WGU), D, 2 * DE, P.ffn_g);
        n_cvtT<<<dim3(D / 32, DE / 32, NE), 256, 0, stream>>>(P.w_down, (bf16*)(ws + WS_WD), DE, D, nullptr);
        n_cvt_router<<<NE * D / 256, 256, 0, stream>>>(P.w_router, P.ffn_g, (bf16*)(ws + WS_WR), (bf16*)(ws + WS_WR) + NE * D);
        n_rmsnorm<<<T / 4, 256, 0, stream>>>(P.x, P.mix_g, (bf16*)(ws + WS_XN));
        break;
    case 1:
        n_gemm<EPI_IN><<<dim3(NIN / 128, T / 128), 256, 0, stream>>>((const bf16*)(ws + WS_XN), D, (const bf16*)(ws + WS_WIN), D, D, P);
        n_kmean<<<NBATCH * NBLK * AW / 256, 256, 0, stream>>>((const bf16*)(ws + WS_K), (float*)(ws + WS_CTL) + CW_KM);
        break;
    case 2:
        n_attn<<<T * NH / 4, 256, 0, stream>>>((const bf16*)(ws + WS_Q), (const bf16*)(ws + WS_K), (const bf16*)(ws + WS_V), (const float*)(ws + WS_CTL) + CW_KM, (bf16*)(ws + WS_O));
        n_sgu_stats<<<T / 4, 256, 0, stream>>>((const bf16*)(ws + WS_VV), (float*)(ws + WS_STATS));
        n_sgu<<<T * SW / 256, 256, 0, stream>>>((const bf16*)(ws + WS_U), (const bf16*)(ws + WS_VV), (const float*)(ws + WS_STATS), P, (bf16*)(ws + WS_SG));
        break;
    case 3:
        n_gemm<EPI_MG1><<<dim3(D / 128, T / 128), 256, 0, stream>>>((const bf16*)(ws + WS_O), AW, (const bf16*)(ws + WS_WA), AW, AW, P);
        n_gemm<EPI_MG2><<<dim3(D / 128, T / 128), 256, 0, stream>>>((const bf16*)(ws + WS_SG), SW, (const bf16*)(ws + WS_WS), SW, SW, P);
        break;
    case 4: n_gemm<EPI_H1><<<dim3(D / 128, T / 128), 256, 0, stream>>>((const bf16*)(ws + WS_MG), D, (const bf16*)(ws + WS_WM), D, D, P); break;
    case 5: n_router<<<T / 4, 256, 0, stream>>>(P); break;
    case 6: n_moe_gu<<<dim3(DE / 128, NROWS_PAD / 128), 256, 0, stream>>>(P); break;
    case 7: n_moe_down<<<dim3(D / 128, NROWS_PAD / 128), 256, 0, stream>>>(P); break;
    default: n_combine<<<T / 4, 256, 0, stream>>>(P); break;
    }
}
extern "C" void kernel_launch(void* const* d_in, const int* in_sizes, int n_in, void* d_out, int out_size, void* d_ws, size_t ws_size, hipStream_t stream) {
    static int grid = 0;
    if (grid == 0) {
        if (n_in != 18 || in_sizes[0] != T * D || out_size != T * D || ws_size < WS_END) { fprintf(stderr, "kernel_launch: unexpected shapes (n_in %d, in0 %d, out %d, ws %zu)\n", n_in, n_in > 0 ? in_sizes[0] : -1, out_size, ws_size); grid = -1; return; }
        int dev = 0, cus = 0, per_cu = 0;
        if (hipGetDevice(&dev) != hipSuccess || hipDeviceGetAttribute(&cus, hipDeviceAttributeMultiprocessorCount, dev) != hipSuccess) { grid = -1; return; }
        if (hipFuncSetAttribute((const void*)fwd, hipFuncAttributeMaxDynamicSharedMemorySize, LDS_BYTES) != hipSuccess) { fprintf(stderr, "kernel_launch: hipFuncSetAttribute failed\n"); grid = -1; return; }
        if (hipOccupancyMaxActiveBlocksPerMultiprocessor(&per_cu, (const void*)fwd, NWAVES * 64, LDS_BYTES) != hipSuccess || per_cu < 1) fprintf(stderr, "kernel_launch: occupancy query says %d\n", per_cu);
        (void)hipGetLastError();
        grid = cus;
    }
    if (grid < 0) return;
    Ptrs P{};
    const float** pf = (const float**)&P;
    for (int i = 0; i < 18; ++i) pf[i] = (const float*)d_in[i];
    P.out = (float*)d_out; P.ws = (unsigned char*)d_ws;
    (void)hipMemsetAsync((unsigned char*)d_ws + WS_CTL, 0, CTL_ZERO_BYTES, stream);
    int li = 0;
    for (int k = 0; k < 9;) {
        if (!((OPT_MASK >> k) & 1)) { naive_phase(k, P, stream); ++k; continue; }
        int hi = k; while (hi < 9 && ((OPT_MASK >> hi) & 1)) ++hi;
        Args a{}; a.P = P; a.ph_lo = k; a.ph_hi = hi; a.li = li++; a.pad = ATTN_REP;
        hipLaunchKernelGGL(fwd, dim3(grid), dim3(NWAVES * 64), LDS_BYTES, stream, a);
        for (int q = k; q < hi; ++q) if ((REDO_MASK >> q) & 1) naive_phase(q, P, stream);
        k = hi;
    }
}
```

```cpp
#include <hip/hip_runtime.h>
#include <hip/hip_bf16.h>
#include <cstdio>
#include <cstdint>
#ifndef SGU_REP
#define SGU_REP 1
#ifndef EPI_PROBE
#define EPI_PROBE 0
#endif
#define EPI_PREF 1
#endif
#ifndef Y_F8
#define Y_F8 1
#endif
#ifndef GATE_U8
#define GATE_U8 1
#endif
#ifndef H1_BF16
#define H1_BF16 1
#endif
#ifndef WGM_IN
#define WGM_IN 2
#endif
#ifndef WGM_MID
#define WGM_MID 2
#endif
#ifndef WGM_GU
#define WGM_GU 2
#endif
#ifndef WGM_DN
#define WGM_DN 2
#endif
#ifndef P3_FUSED
#define P3_FUSED 1
#endif
#ifndef IN_I8
#define IN_I8 1
#endif
#define IN_BF_TILES 2
#ifndef MOE_F8
#define MOE_F8 1
#endif
#ifndef MOE_I8
#define MOE_I8 1
#endif
#ifndef PROBE_K
#define PROBE_K -1
#endif

typedef unsigned short bf16;
typedef short bf16x8 __attribute__((ext_vector_type(8)));
typedef float f32x4 __attribute__((ext_vector_type(4)));
typedef unsigned u32x4 __attribute__((ext_vector_type(4)));
typedef unsigned u32x2 __attribute__((ext_vector_type(2)));
typedef int i32x4 __attribute__((ext_vector_type(4)));
typedef int i32x8 __attribute__((ext_vector_type(8)));
typedef int i32x8a __attribute__((ext_vector_type(8), aligned(16)));

constexpr int T = 16384, D = 1024, SEQ = 4096, NBATCH = 4, NH = 8, HD = 64, AW = 512, SW = 512, NIN = 4608;
constexpr int NE = 32, TOPK = 4, DE = 1024, MB = 256  , NBLK = SEQ / MB  ;
constexpr int NROWS_PAD = 73728;
constexpr float EPS = 1e-5f;
constexpr float C2 = 0.125f * 1.4426950408889634f;
constexpr float LOG2E = 1.4426950408889634f;

constexpr size_t MiB = 1u << 20;
constexpr size_t WS_CTL = 0, CTL_ZERO_BYTES = 1 * MiB;
constexpr size_t WS_WIN = 2 * MiB, WS_WA = 12 * MiB, WS_WS = 13 * MiB, WS_WM = 14 * MiB, WS_WR = 16 * MiB;
constexpr size_t WS_WGU = 32 * MiB, WS_WD = 160 * MiB, WS_XN = 224 * MiB;
constexpr size_t WS_Q = 256 * MiB, WS_K = 272 * MiB, WS_V = 288 * MiB, WS_U = 304 * MiB, WS_VV = 320 * MiB, WS_O = 336 * MiB, WS_SG = 352 * MiB;
constexpr size_t WS_GA = 368 * MiB, WS_GS = 400 * MiB, WS_MG = 432 * MiB, WS_H1 = 464 * MiB, WS_H1B = 528 * MiB;
constexpr size_t WS_LIST = 560 * MiB, WS_TOKSLOT = 562 * MiB, WS_TOKW = 563 * MiB, WS_RSTD2 = 564 * MiB, WS_STATS = 565 * MiB, WS_RLIST = 566 * MiB, WS_HIST = 568 * MiB;
constexpr size_t WS_HID = 576 * MiB, WS_Y = 720 * MiB, WS_H1Q = 864 * MiB  , WS_SB = 569 * MiB  ,
    WS_SBIN = WS_SB + 256 * 1024  , WS_SXN = WS_SB + 320 * 1024  , WS_WSP = WS_SB + 384 * 1024  , WS_XNQ = 880 * MiB  , WS_WINQ = 896 * MiB  , WS_END = 900 * MiB;
constexpr int CW_TMO = 0, CW_CODE = 1, CW_BAR = 4096  , CW_CNT = 32768  , CW_KM = 65536  ;

struct Ptrs {
    const float *x, *mix_g, *w_in, *w_attn_out, *ln_g, *ln_b, *w_sp, *b_sp, *w_sgu_out, *w_mix_out, *ffn_g, *w_router, *b_router, *w_gu, *b_gu, *w_down, *b_down, *fin_g;
    float* out; unsigned char* ws;
};

__device__ __forceinline__ unsigned f2bf(float f) { unsigned u = __builtin_bit_cast(unsigned, f); return (u + 0x7fffu + ((u >> 16) & 1u)) >> 16; }
__device__ __forceinline__ float bf2f(unsigned h) { return __builtin_bit_cast(float, (h & 0xffffu) << 16); }
__device__ __forceinline__ float wave_sum(float v) {
#pragma unroll
    for (int o = 1; o < 64; o <<= 1) v += __shfl_xor(v, o);
    return v;
}
__device__ __forceinline__ float wave_max(float v) {
#pragma unroll
    for (int o = 1; o < 64; o <<= 1) v = fmaxf(v, __shfl_xor(v, o));
    return v;
}
__device__ __forceinline__ float gelu_erf(float v) { return 0.5f * v * (1.f + erff(v * 0.70710678118654752f)); }
__device__ __forceinline__ float sigmoidf(float v) { return 1.f / (1.f + __expf(-v)); }
__device__ __forceinline__ float swiglu(float g, float u) {
    g = fminf(g, 7.f); u = fminf(fmaxf(u, -7.f), 7.f);
    return g * (1.f / (1.f + __expf(-1.702f * g))) * (u + 1.f);
}

__global__ __launch_bounds__(256) void n_cvtT(const float* W, bf16* WT, int K, int N, const float* kscale) {
    __shared__ float t[32][33];
    const size_t boff = (size_t)blockIdx.z * K * N; W += boff; WT += boff;
    const int k0 = blockIdx.y * 32, n0 = blockIdx.x * 32, tx = threadIdx.x & 31, ty = threadIdx.x >> 5;
    for (int i = ty; i < 32; i += 8) t[i][tx] = W[(size_t)(k0 + i) * N + n0 + tx] * (kscale ? kscale[k0 + i] : 1.f);
    __syncthreads();
    for (int i = ty; i < 32; i += 8) WT[(size_t)(n0 + i) * K + k0 + tx] = (bf16)f2bf(t[tx][i]);
}
__global__ void n_cvt_router(const float* w, const float* g, bf16* hi, bf16* lo) {
    const int i = blockIdx.x * blockDim.x + threadIdx.x; if (i >= NE * D) return;
    const int e = i / D, k = i % D; const float v = w[(size_t)k * NE + e] * g[k];
    const unsigned h = f2bf(v); hi[i] = (bf16)h; lo[i] = (bf16)f2bf(v - bf2f(h));
}
__global__ __launch_bounds__(256) void n_rmsnorm(const float* x, const float* g, bf16* xn) {
    const int row = blockIdx.x * 4 + (threadIdx.x >> 6), lane = threadIdx.x & 63;
    const f32x4* xr = (const f32x4*)(x + (size_t)row * D) + lane; f32x4 v[4]; float s = 0.f;
#pragma unroll
    for (int j = 0; j < 4; ++j) { v[j] = xr[64 * j]; s += v[j].x * v[j].x + v[j].y * v[j].y + v[j].z * v[j].z + v[j].w * v[j].w; }
    const float rstd = 1.f / sqrtf(wave_sum(s) * (1.f / D) + EPS);
#pragma unroll
    for (int j = 0; j < 4; ++j) { const f32x4 gg = ((const f32x4*)g)[lane + 64 * j];
        u32x2 o; o.x = f2bf(v[j].x * rstd * gg.x) | (f2bf(v[j].y * rstd * gg.y) << 16); o.y = f2bf(v[j].z * rstd * gg.z) | (f2bf(v[j].w * rstd * gg.w) << 16);
        *((u32x2*)(xn + (size_t)row * D) + lane + 64 * j) = o; }
}

__device__ __forceinline__ void wave_gemm64(const bf16* a0, const bf16* a1, const bf16* a2, const bf16* a3, const bf16* b0, const bf16* b1, const bf16* b2, const bf16* b3, int K, f32x4 (&acc)[4][4]) {
    for (int k = 0; k < K; k += 32) {
        bf16x8 a[4], b[4];
        a[0] = *(const bf16x8*)(a0 + k); a[1] = *(const bf16x8*)(a1 + k); a[2] = *(const bf16x8*)(a2 + k); a[3] = *(const bf16x8*)(a3 + k);
        b[0] = *(const bf16x8*)(b0 + k); b[1] = *(const bf16x8*)(b1 + k); b[2] = *(const bf16x8*)(b2 + k); b[3] = *(const bf16x8*)(b3 + k);
#pragma unroll
        for (int mi = 0; mi < 4; ++mi)
#pragma unroll
            for (int ni = 0; ni < 4; ++ni) acc[mi][ni] = __builtin_amdgcn_mfma_f32_16x16x32_bf16(a[mi], b[ni], acc[mi][ni], 0, 0, 0);
    }
}
#define ZERO_ACC(acc) _Pragma("unroll") for (int _a = 0; _a < 4; ++_a) _Pragma("unroll") for (int _b = 0; _b < 4; ++_b) acc[_a][_b] = (f32x4){0.f, 0.f, 0.f, 0.f}

enum { EPI_IN = 0, EPI_MG1 = 1, EPI_MG2 = 2, EPI_H1 = 3 };
template <int MODE>
__global__ __launch_bounds__(256) void n_gemm(const bf16* A, int lda, const bf16* Bt, int ldb, int K, Ptrs P) {
    const int lane = threadIdx.x & 63, w = threadIdx.x >> 6, wy = w >> 1, wx = w & 1;
    const int row0 = blockIdx.y * 128 + wy * 64, col0 = blockIdx.x * 128 + wx * 64;
    const int lr = lane & 15, lq = lane >> 4;
    const bf16* ap = A + (size_t)(row0 + lr) * lda + 8 * lq; const bf16* bp = Bt + (size_t)(col0 + lr) * ldb + 8 * lq;
    f32x4 acc[4][4]; ZERO_ACC(acc);
    wave_gemm64(ap, ap + 16 * (size_t)lda, ap + 32 * (size_t)lda, ap + 48 * (size_t)lda, bp, bp + 16 * (size_t)ldb, bp + 32 * (size_t)ldb, bp + 48 * (size_t)ldb, K, acc);
    unsigned char* ws = P.ws;
#pragma unroll
    for (int mi = 0; mi < 4; ++mi)
#pragma unroll
        for (int ni = 0; ni < 4; ++ni)
#pragma unroll
            for (int j = 0; j < 4; ++j) {
                const int row = row0 + 16 * mi + lq * 4 + j, col = col0 + 16 * ni + lr; const float v = acc[mi][ni][j];
                if (MODE == EPI_IN) {
                    if (col < 512) ((bf16*)(ws + WS_Q))[(size_t)row * 512 + col] = (bf16)f2bf(v * C2);
                    else if (col < 1024) ((bf16*)(ws + WS_K))[(size_t)row * 512 + col - 512] = (bf16)f2bf(v);
                    else if (col < 1536) ((bf16*)(ws + WS_V))[(size_t)row * 512 + col - 1024] = (bf16)f2bf(v);
                    else if (col < 2048) ((bf16*)(ws + WS_U))[(size_t)row * 512 + col - 1536] = (bf16)f2bf(gelu_erf(v));
                    else if (col < 2560) ((bf16*)(ws + WS_VV))[(size_t)row * 512 + col - 2048] = (bf16)f2bf(gelu_erf(v));
                    else if (col < 3584) ((bf16*)(ws + WS_GA))[(size_t)row * 1024 + col - 2560] = (bf16)f2bf(sigmoidf(v));
                    else ((bf16*)(ws + WS_GS))[(size_t)row * 1024 + col - 3584] = (bf16)f2bf(sigmoidf(v));
                } else if (MODE == EPI_MG1) {
                    const size_t o = (size_t)row * 1024 + col; ((bf16*)(ws + WS_MG))[o] = (bf16)f2bf(v * bf2f(((const bf16*)(ws + WS_GA))[o]));
                } else if (MODE == EPI_MG2) {
                    const size_t o = (size_t)row * 1024 + col; bf16* mg = (bf16*)(ws + WS_MG); mg[o] = (bf16)f2bf(bf2f(mg[o]) + v * bf2f(((const bf16*)(ws + WS_GS))[o]));
                } else {
                    const size_t o = (size_t)row * 1024 + col; const float h = P.x[o] + v; ((float*)(ws + WS_H1))[o] = h; ((bf16*)(ws + WS_H1B))[o] = (bf16)f2bf(h);
                }
            }
}
__global__ void n_kmean(const bf16* Kb, float* KM) {
    const int i = blockIdx.x * blockDim.x + threadIdx.x; if (i >= NBATCH * NBLK * AW) return;
    const int c = i % AW, bb = i / AW; float s = 0.f;
    for (int r = 0; r < MB; ++r) s += bf2f(Kb[(size_t)(bb * MB + r) * AW + c]);
    KM[i] = s * (1.f / MB);
}
__global__ __launch_bounds__(256) void n_attn(const bf16* Q, const bf16* Kb, const bf16* Vb, const float* KM, bf16* O) {
    __shared__ float qs[4][64];
    const int lane = threadIdx.x & 63, w = threadIdx.x >> 6, gw = blockIdx.x * 4 + w, tok = gw >> 3, h = gw & 7;
    const int b = tok / SEQ, t = tok % SEQ, blk = t / MB;
    const float qd = bf2f(Q[(size_t)tok * AW + h * HD + lane]);
    qs[w][lane] = qd; __syncthreads();
    float g[16];
#pragma unroll
    for (int j = 0; j < 16; ++j) { float p = (j < blk) ? qd * KM[(size_t)(b * NBLK + j) * AW + h * HD + lane] : 0.f; p = wave_sum(p); g[j] = (j < blk) ? p : -INFINITY; }
    int sel[4];
#pragma unroll
    for (int s = 0; s < 3; ++s) { int best = -1; float bv = -INFINITY;
#pragma unroll
        for (int j = 0; j < 16; ++j) if (g[j] > bv) { bv = g[j]; best = j; }
#pragma unroll
        for (int j = 0; j < 16; ++j) if (j == best) g[j] = -INFINITY;
        sel[s] = best; }
    sel[3] = blk;
    const float slope2 = exp2f(-(float)(h + 1)) * LOG2E;
    float sc[16];
#pragma unroll
    for (int s = 0; s < 4; ++s) {
        const int kb = sel[s];
#pragma unroll
        for (int c = 0; c < 4; ++c) {
            float v = -INFINITY;
            if (kb >= 0) { const int key = kb * MB + c * 64 + lane;
                if (key <= t) { const bf16* kr = Kb + (size_t)(b * SEQ + key) * AW + h * HD; float a = 0.f;
                    for (int d8 = 0; d8 < 8; ++d8) { const u32x4 kk = *(const u32x4*)(kr + d8 * 8);
#pragma unroll
                        for (int e = 0; e < 4; ++e) { a += qs[w][d8 * 8 + 2 * e] * bf2f(kk[e] & 0xffffu) + qs[w][d8 * 8 + 2 * e + 1] * bf2f(kk[e] >> 16); } }
                    v = a + slope2 * (float)(key - t); } }
            sc[s * 4 + c] = v; }
    }
    float m = sc[0];
#pragma unroll
    for (int i = 1; i < 16; ++i) m = fmaxf(m, sc[i]);
    m = wave_max(m); float l = 0.f;
#pragma unroll
    for (int i = 0; i < 16; ++i) { sc[i] = (sc[i] == -INFINITY) ? 0.f : exp2f(sc[i] - m); l += sc[i]; }
    l = wave_sum(l); float o = 0.f;
#pragma unroll
    for (int s = 0; s < 4; ++s) { const int kb = sel[s]; if (kb < 0) continue;
#pragma unroll
        for (int c = 0; c < 4; ++c) { const int key0 = kb * MB + c * 64; if (key0 > t) continue;
            const bf16* vr = Vb + (size_t)(b * SEQ + key0) * AW + h * HD + lane;
            for (int kl = 0; kl < 64; ++kl) { const float p = __shfl(sc[s * 4 + c], kl); o += p * bf2f(vr[(size_t)kl * AW]); } } }
    O[(size_t)tok * AW + h * HD + lane] = (bf16)f2bf(o / l);
}
__global__ __launch_bounds__(256) void n_sgu_stats(const bf16* VV, float* stats) {
    const int row = blockIdx.x * 4 + (threadIdx.x >> 6), lane = threadIdx.x & 63;
    const u32x4 r = *((const u32x4*)(VV + (size_t)row * SW) + lane); float v[8];
#pragma unroll
    for (int e = 0; e < 4; ++e) { v[2 * e] = bf2f(r[e] & 0xffffu); v[2 * e + 1] = bf2f(r[e] >> 16); }
    float s = 0.f;
#pragma unroll
    for (int e = 0; e < 8; ++e) s += v[e];
    const float mu = wave_sum(s) * (1.f / SW); float q = 0.f;
#pragma unroll
    for (int e = 0; e < 8; ++e) q += (v[e] - mu) * (v[e] - mu);
    const float rstd = 1.f / sqrtf(wave_sum(q) * (1.f / SW) + EPS);
    if (lane == 0) { stats[2 * row] = mu; stats[2 * row + 1] = rstd; }
}
__global__ __launch_bounds__(256) void n_sgu(const bf16* U, const bf16* VV, const float* stats, Ptrs P, bf16* SG) {
    const int i = blockIdx.x * 256 + threadIdx.x, tok = i / SW, c = i % SW, g = c / 64, tl = tok % 128, s0 = tok - tl;
    const float lg = P.ln_g[c], lb = P.ln_b[c]; const float* wr = P.w_sp + ((size_t)g * 128 + tl) * 128; float a = 0.f;
    for (int s = 0; s <= tl; ++s) { const float vn = (bf2f(VV[(size_t)(s0 + s) * SW + c]) - stats[2 * (s0 + s)]) * stats[2 * (s0 + s) + 1] * lg + lb; a += wr[s] * vn; }
    SG[i] = (bf16)f2bf(bf2f(U[i]) * (a + P.b_sp[g * 128 + tl]));
}
__global__ __launch_bounds__(256) void n_router(Ptrs P) {
    unsigned char* ws = P.ws; const int tok = blockIdx.x * 4 + (threadIdx.x >> 6), lane = threadIdx.x & 63;
    const f32x4* hr = (const f32x4*)((const float*)(ws + WS_H1) + (size_t)tok * D) + lane; f32x4 v[4]; float s = 0.f;
#pragma unroll
    for (int j = 0; j < 4; ++j) { v[j] = hr[64 * j]; s += v[j].x * v[j].x + v[j].y * v[j].y + v[j].z * v[j].z + v[j].w * v[j].w; }
    const float rstd = 1.f / sqrtf(wave_sum(s) * (1.f / D) + EPS);
#pragma unroll
    for (int j = 0; j < 4; ++j) { const f32x4 gg = ((const f32x4*)P.ffn_g)[lane + 64 * j]; v[j] = v[j] * gg; }
    float lg[32];
#pragma unroll
    for (int e = 0; e < 32; ++e) { float a = 0.f;
#pragma unroll
        for (int j = 0; j < 4; ++j) { const float* wr = P.w_router + (size_t)(4 * lane + 256 * j) * NE + e; a += v[j].x * wr[0] + v[j].y * wr[NE] + v[j].z * wr[2 * NE] + v[j].w * wr[3 * NE]; }
        lg[e] = wave_sum(a) * rstd + P.b_router[e]; }
    int idx[4]; float val[4];
#pragma unroll
    for (int k = 0; k < 4; ++k) { int best = 0; float bv = -INFINITY;
#pragma unroll
        for (int e = 0; e < 32; ++e) if (lg[e] > bv) { bv = lg[e]; best = e; }
#pragma unroll
        for (int e = 0; e < 32; ++e) if (e == best) lg[e] = -INFINITY;
        idx[k] = best; val[k] = bv; }
    float den = 0.f, pw[4];
#pragma unroll
    for (int k = 0; k < 4; ++k) { pw[k] = __expf(val[k] - val[0]); den += pw[k]; }
    if (lane == 0) {
        unsigned* ctl = (unsigned*)(ws + WS_CTL); int* list = (int*)(ws + WS_LIST); unsigned* slot = (unsigned*)(ws + WS_TOKSLOT); float* tw = (float*)(ws + WS_TOKW);
#pragma unroll
        for (int k = 0; k < 4; ++k) { const unsigned pos = atomicAdd(ctl + CW_CNT + 64 * idx[k], 1u); list[(size_t)idx[k] * T + pos] = tok;
            slot[tok * 4 + k] = (unsigned)idx[k] | (pos << 8); tw[tok * 4 + k] = pw[k] / den; }
        ((float*)(ws + WS_RSTD2))[tok] = rstd;
        for (int k = 0; k < 4; ++k) { const unsigned s2 = slot[tok * 4 + k]; ((float*)(ws + WS_RLIST))[(size_t)(s2 & 0xff) * T + (s2 >> 8)] = rstd; }
    }
}
__device__ __forceinline__ bool tile_lookup(const unsigned* ctl, int mt, int& e, int& lt, int& cnt) {
    int base = 0;
    for (int i = 0; i < NE; ++i) { const int c = (int)ctl[CW_CNT + 64 * i], nt = (c + 255) >> 8; if (mt < base + nt) { e = i; lt = mt - base; cnt = c; return true; } base += nt; }
    return false;
}
__device__ __forceinline__ int expert_rowbase(const unsigned* ctl, int e) { int base = 0; for (int i = 0; i < e; ++i) base += ((int)ctl[CW_CNT + 64 * i] + 255) >> 8; return base * 256; }
__global__ __launch_bounds__(256) void n_moe_gu(Ptrs P) {
    unsigned char* ws = P.ws; const unsigned* ctl = (const unsigned*)(ws + WS_CTL);
    const int lane = threadIdx.x & 63, w = threadIdx.x >> 6, wy = w >> 1, wx = w & 1, lr = lane & 15, lq = lane >> 4;
    const int mt = blockIdx.y >> 1; int e, lt, cnt; if (!tile_lookup(ctl, mt, e, lt, cnt)) return;
    const int* list = (const int*)(ws + WS_LIST) + (size_t)e * T; const bf16* A = (const bf16*)(ws + WS_H1B); const bf16* Bt = (const bf16*)(ws + WS_WGU) + (size_t)e * 2048 * D;
    const int prow0 = lt * 256 + (blockIdx.y & 1) * 128 + wy * 64;
    const int j0 = blockIdx.x * 128 + wx * 64;
    const bf16* ap[4];
#pragma unroll
    for (int i = 0; i < 4; ++i) { const int pos = prow0 + 16 * i + lr; const int tok = list[pos < cnt ? pos : lt * 256]; ap[i] = A + (size_t)tok * D + 8 * lq; }
    const bf16* bg = Bt + (size_t)(2 * (j0 + lr)) * D + 8 * lq; const bf16* bu = bg + D;
    f32x4 accg[4][4], accu[4][4]; ZERO_ACC(accg); ZERO_ACC(accu);
    wave_gemm64(ap[0], ap[1], ap[2], ap[3], bg, bg + 32 * (size_t)D, bg + 64 * (size_t)D, bg + 96 * (size_t)D, D, accg);
    wave_gemm64(ap[0], ap[1], ap[2], ap[3], bu, bu + 32 * (size_t)D, bu + 64 * (size_t)D, bu + 96 * (size_t)D, D, accu);
    const float* rs = (const float*)(ws + WS_RSTD2); const float* bgu = P.b_gu + (size_t)e * 2048; bf16* HID = (bf16*)(ws + WS_HID);
#pragma unroll
    for (int mi = 0; mi < 4; ++mi)
#pragma unroll
        for (int j = 0; j < 4; ++j) { const int pos = prow0 + 16 * mi + lq * 4 + j; const int tok = list[pos < cnt ? pos : lt * 256]; const float r = rs[tok];
            const size_t orow = (size_t)mt * 256 + (blockIdx.y & 1) * 128 + wy * 64 + 16 * mi + lq * 4 + j;
#pragma unroll
            for (int ni = 0; ni < 4; ++ni) { const int jc = j0 + 16 * ni + lr; HID[orow * DE + jc] = (bf16)f2bf(swiglu(accg[mi][ni][j] * r + bgu[2 * jc], accu[mi][ni][j] * r + bgu[2 * jc + 1])); } }
}
__global__ __launch_bounds__(256) void n_moe_down(Ptrs P) {
    unsigned char* ws = P.ws; const unsigned* ctl = (const unsigned*)(ws + WS_CTL);
    const int lane = threadIdx.x & 63, w = threadIdx.x >> 6, wy = w >> 1, wx = w & 1, lr = lane & 15, lq = lane >> 4;
    const int mt = blockIdx.y >> 1; int e, lt, cnt; if (!tile_lookup(ctl, mt, e, lt, cnt)) return;
    const int row0 = blockIdx.y * 128 + wy * 64, col0 = blockIdx.x * 128 + wx * 64;
    const bf16* ap = (const bf16*)(ws + WS_HID) + (size_t)(row0 + lr) * DE + 8 * lq; const bf16* bp = (const bf16*)(ws + WS_WD) + ((size_t)e * D + col0 + lr) * DE + 8 * lq;
    f32x4 acc[4][4]; ZERO_ACC(acc);
    wave_gemm64(ap, ap + 16 * (size_t)DE, ap + 32 * (size_t)DE, ap + 48 * (size_t)DE, bp, bp + 16 * (size_t)DE, bp + 32 * (size_t)DE, bp + 48 * (size_t)DE, DE, acc);
    bf16* Y = (bf16*)(ws + WS_Y); const float* bd = P.b_down + (size_t)e * D;
#pragma unroll
    for (int mi = 0; mi < 4; ++mi)
#pragma unroll
        for (int ni = 0; ni < 4; ++ni)
#pragma unroll
            for (int j = 0; j < 4; ++j) { const int row = row0 + 16 * mi + lq * 4 + j, col = col0 + 16 * ni + lr; Y[(size_t)row * D + col] = (bf16)f2bf(acc[mi][ni][j] + bd[col]); }
}
__global__ __launch_bounds__(256) void n_combine(Ptrs P) {
    unsigned char* ws = P.ws; const unsigned* ctl = (const unsigned*)(ws + WS_CTL);
    const int tok = blockIdx.x * 4 + (threadIdx.x >> 6), lane = threadIdx.x & 63;
    const f32x4* hr = (const f32x4*)((const float*)(ws + WS_H1) + (size_t)tok * D) + lane; f32x4 v[4];
#pragma unroll
    for (int j = 0; j < 4; ++j) v[j] = hr[64 * j];
    const unsigned* slot = (const unsigned*)(ws + WS_TOKSLOT) + tok * 4; const float* tw = (const float*)(ws + WS_TOKW) + tok * 4; const bf16* Y = (const bf16*)(ws + WS_Y);
    for (int k = 0; k < 4; ++k) { const unsigned s = slot[k]; const int e = s & 0xff, pos = s >> 8; const float wgt = tw[k];
        const bf16* yr = Y + (size_t)(expert_rowbase(ctl, e) + pos) * D;
#pragma unroll
        for (int j = 0; j < 4; ++j) { const u32x2 y = *((const u32x2*)yr + lane + 64 * j);
            v[j].x += wgt * bf2f(y.x & 0xffffu); v[j].y += wgt * bf2f(y.x >> 16); v[j].z += wgt * bf2f(y.y & 0xffffu); v[j].w += wgt * bf2f(y.y >> 16); } }
    float s = 0.f;
#pragma unroll
    for (int j = 0; j < 4; ++j) s += v[j].x * v[j].x + v[j].y * v[j].y + v[j].z * v[j].z + v[j].w * v[j].w;
    const float rstd = 1.f / sqrtf(wave_sum(s) * (1.f / D) + EPS);
#pragma unroll
    for (int j = 0; j < 4; ++j) { const f32x4 gg = ((const f32x4*)P.fin_g)[lane + 64 * j]; *((f32x4*)(P.out + (size_t)tok * D) + lane + 64 * j) = v[j] * rstd * gg; }
}

#define GAS __attribute__((address_space(1)))
#define LAS __attribute__((address_space(3)))
typedef float f32x2 __attribute__((ext_vector_type(2)));
typedef float f32x16 __attribute__((ext_vector_type(16)));
constexpr int NWAVES = 8;
constexpr int RING_BYTES = 131072;
constexpr int LX_BAR = RING_BYTES, LX_TBASE = RING_BYTES + 64, LX_TILEE = RING_BYTES + 256, LX_ROWBASE = RING_BYTES + 2048, LX_MISC = RING_BYTES + 4096;
constexpr int LDS_BYTES = 147456;
constexpr int LX_EPI = RING_BYTES + 8192;

typedef __bf16 bf16x2_t __attribute__((ext_vector_type(2)));
__device__ __forceinline__ unsigned cvt_pk_bf16(float lo, float hi) { const f32x2 v = {lo, hi}; const bf16x2_t b = __builtin_convertvector(v, bf16x2_t); return __builtin_bit_cast(unsigned, b); }
__device__ __forceinline__ f32x2 gelu_pk(f32x2 v) {
    const f32x2 av = __builtin_elementwise_abs(v), d = av * 0.2316418882f + 1.0f;
    f32x2 t; t.x = __builtin_amdgcn_rcpf(d.x); t.y = __builtin_amdgcn_rcpf(d.y);
    f32x2 q = t * 0.5307027145f + (-0.7265760135f); q = q * t + 0.7107068705f; q = q * t + (-0.142248368f); q = q * t + 0.127414796f; q = q * t;
    const f32x2 s = (v * v) * (-0.72134752044f);
    f32x2 e; e.x = __builtin_amdgcn_exp2f(s.x); e.y = __builtin_amdgcn_exp2f(s.y);
    const f32x2 m = v * (q * e), r = v - m;
    f32x2 o; o.x = v.x < 0.f ? m.x : r.x; o.y = v.y < 0.f ? m.y : r.y; return o;
}
__device__ __forceinline__ float fast_sigmoid(float v) { return __builtin_amdgcn_rcpf(1.f + __builtin_amdgcn_exp2f(-LOG2E * v)); }
__device__ __forceinline__ float fast_swiglu(float g, float u) {
    g = fminf(g, 7.f); u = fminf(fmaxf(u, -7.f), 7.f);
    return g * __builtin_amdgcn_rcpf(1.f + __builtin_amdgcn_exp2f(-1.702f * LOG2E * g)) * (u + 1.f);
}

__device__ __forceinline__ float folded_swiglu(float t, float w) {
    constexpr float CC = -1.702f * LOG2E;
    t = __builtin_fmaxf(t, 7.f * CC); w = __builtin_amdgcn_fmed3f(w, 8.f / CC, -6.f / CC);
    return t * __builtin_amdgcn_rcpf(1.f + __builtin_amdgcn_exp2f(t)) * w;
}

#define XB_TMO      128
#define XB_XCNT(j)  (256  + 64 * (j))
#define XB_XSUB(j)  (1280 + 64 * (j))
#define XB_XGEN(j)  (2304 + 64 * (j))
#define XB_TOP      3328
#define XB_TOPGEN   3392
#define XCD_BAR_WORDS 3456
#define XB_SPIN_CAP (1u << 18)
__device__ __forceinline__ unsigned xb_ld(unsigned* p)              { return __hip_atomic_load(p, __ATOMIC_RELAXED, __HIP_MEMORY_SCOPE_AGENT); }
__device__ __forceinline__ unsigned xb_add(unsigned* p, unsigned v) { return __hip_atomic_fetch_add(p, v, __ATOMIC_RELAXED, __HIP_MEMORY_SCOPE_AGENT); }
__device__ __forceinline__ unsigned xb_xcc_id() { return (unsigned)__builtin_amdgcn_s_getreg((3 << 11) | 20) & 0xFu; }
#define XB_SPIN(cond, bar) do { unsigned _sp = 0; while (cond) { __builtin_amdgcn_s_sleep(1); \
    if ((++_sp & 255u) == 0u) { if (xb_ld(&(bar)[XB_TMO])) break; if (_sp > XB_SPIN_CAP) { atomicAdd(&(bar)[XB_TMO], 1u); break; } } } } while (0)
struct XcdBarrier { unsigned* bar; unsigned x; volatile LAS unsigned* st; };
__device__ __forceinline__ XcdBarrier xcd_barrier_post(unsigned* bar, volatile LAS unsigned* st) {
    XcdBarrier b; b.bar = bar; b.x = xb_xcc_id(); b.st = st;
    if (threadIdx.x == 0) (void)xb_add(&bar[XB_XCNT(b.x)], 1u);
    return b;
}
__device__ __forceinline__ void xcd_barrier_complete(unsigned* bar, unsigned x, unsigned& nloc, unsigned& nx) {
    const unsigned G = gridDim.x * gridDim.y * gridDim.z;
    unsigned sum, cnt, mine, sp = 0u;
    for (;;) {
        sum = 0u; cnt = 0u; mine = 0u;
#pragma unroll
        for (unsigned j = 0; j < 16; ++j) { const unsigned c = xb_ld(&bar[XB_XCNT(j)]); sum += c; cnt += (c > 0u) ? 1u : 0u; mine = (j == x) ? c : mine; }
        if (sum == G) break;
        __builtin_amdgcn_s_sleep(1);
        if ((++sp & 255u) == 0u) { if (xb_ld(&bar[XB_TMO])) break; if (sp > XB_SPIN_CAP) { atomicAdd(&bar[XB_TMO], 1u); break; } }
    }
    nloc = mine > 0u ? mine : 1u; nx = cnt > 0u ? cnt : 1u;
}
__device__ __forceinline__ void xcd_barrier(const XcdBarrier& b) {
    asm volatile("s_waitcnt vmcnt(0)" ::: "memory");
    __syncthreads();
    if (threadIdx.x == 0) {
        unsigned* bar = b.bar;
        __builtin_amdgcn_s_waitcnt(0);
        unsigned nloc = b.st[0], nx = b.st[1];
        if (nloc == 0u) { xcd_barrier_complete(bar, b.x, nloc, nx); b.st[0] = nloc; b.st[1] = nx; }
        const unsigned old = xb_add(&bar[XB_XSUB(b.x)], 1u);
        const unsigned gen = old / nloc;
        if (old + 1u == (gen + 1u) * nloc) {
            __builtin_amdgcn_fence(__ATOMIC_RELEASE, "agent");
            asm volatile("s_waitcnt vmcnt(0)" ::: "memory");
            const unsigned og = xb_add(&bar[XB_TOP], 1u);
            const unsigned tg = og / nx;
            if (og + 1u == (tg + 1u) * nx) xb_add(&bar[XB_TOPGEN], 1u);
            else XB_SPIN(xb_ld(&bar[XB_TOPGEN]) == tg, bar);
            __builtin_amdgcn_fence(__ATOMIC_ACQUIRE, "agent");
            xb_add(&bar[XB_XGEN(b.x)], 1u);
            asm volatile("s_waitcnt vmcnt(0)" ::: "memory");
        } else {
            XB_SPIN(xb_ld(&bar[XB_XGEN(b.x)]) == gen, bar);
            __builtin_amdgcn_fence(__ATOMIC_ACQUIRE, "agent");
            asm volatile("s_waitcnt vmcnt(0)" ::: "memory");
        }
    }
    __syncthreads();
}

namespace pg8 {
constexpr int BM = 256, BK = 64, HALF = 128, HTB = HALF * BK * 2, STAGE_BYTES = 8 * HTB, NXCD = 8;
__host__ __device__ __forceinline__ int lds_byte(int r, int c) { const int st = (r >> 4) * 2 + (c >> 5), rr = r & 15, cc = c & 31, ob = rr * 64 + cc * 2; return st * 1024 + (ob ^ (((ob >> 9) & 1) << 5)); }
__host__ __device__ __forceinline__ void stage_rc(int b, int& R, int& C) { const int st = b / 1024, sb = b % 1024, swz = sb ^ (((sb >> 9) & 1) << 5); R = (st >> 1) * 16 + swz / 64; C = (st & 1) * 32 + (swz % 64) / 2; }
__host__ __device__ __forceinline__ int perm32(int rho) { const int n = rho >> 4, i = rho & 15; return 8 * (i >> 2) + 4 * n + (i & 3); }

struct Unit { int pm, pn, e, lt, cnt, par; };

__device__ __forceinline__ void order_map(int L, int nM, int nN, int& pm, int& pn, int WGM) {
    const int nwg = nM * nN; int wgid = L; { const int q = nwg / NXCD, r = nwg % NXCD, xcd = wgid % NXCD, off = wgid / NXCD; wgid = (xcd < r ? xcd * (q + 1) : r * (q + 1) + (xcd - r) * q) + off; }
    const int nig = WGM * nN, gid = wgid / nig, fm = gid * WGM, gsz = (nM - fm) < WGM ? (nM - fm) : WGM;
    pm = fm + ((wgid % nig) % gsz); pn = (wgid % nig) / gsz;
}

template <class Epi, class Sched, bool ALIGN_EPI>
__device__ __forceinline__ void gemm_phase(LAS unsigned char* lds, const int K, const unsigned ldb, const Sched& S, const Epi& E) {
    const int tid = threadIdx.x, wid = __builtin_amdgcn_readfirstlane(tid >> 6), lane = tid & 63, wr = wid >> 2, wc = wid & 3, fr = lane & 15, fq = lane >> 4;
    const int nt = K / BK;
    int R[2], C[2]; unsigned voffB[2];
#pragma unroll
    for (int i = 0; i < 2; ++i) { stage_rc(tid * 16 + i * 8192, R[i], C[i]); const int Rb = (R[i] & ~31) + perm32(R[i] & 31); voffB[i] = (unsigned)(Rb * (int)ldb + C[i]) * 2u; }
    const unsigned kstep = (unsigned)(BK * 2);
    const size_t hstepB = (size_t)HALF * ldb * 2;
    const unsigned ldsw = (unsigned)wid * 1024u;
    constexpr int MODE = Epi::MODE; constexpr int KST = 1024;
    const int c8 = fq * 8;
    const int aoff = lds_byte(wr * 64 + fr, c8), boff = lds_byte(wc * 32 + fr, c8);
#define PG8_SA(b, h) (((b) * 2 + (h)) * HTB)
#define PG8_SB(b, h) ((4 + (b) * 2 + (h)) * HTB)
#define PG8_STAGE(bufoff, gbase, voff) do { _Pragma("unroll") for (int _i = 0; _i < 2; ++_i) \
        __builtin_amdgcn_global_load_lds((const unsigned*)((const char*)(gbase) + (voff)[_i]), (LAS unsigned*)(lds + (bufoff) + ldsw + _i * 8192), 16, 0, 0); } while (0)
#define PG8_LD32(p) __builtin_shufflevector(*(const LAS i32x4*)(p), *(const LAS i32x4*)((p) + KST), 0, 1, 2, 3, 4, 5, 6, 7)
#define PG8_LDA(dst, b, h) do { if constexpr (MODE == 2) { _Pragma("unroll") for (int m = 0; m < 4; ++m) dst##8[m] = PG8_LD32(lds + PG8_SA(b, h) + aoff + m * 2048); } \
        else { _Pragma("unroll") for (int m = 0; m < 4; ++m) _Pragma("unroll") for (int k = 0; k < 2; ++k) dst[m][k] = *(const LAS bf16x8*)(lds + PG8_SA(b, h) + aoff + m * 2048 + k * KST); } } while (0)
#define PG8_LDB(dst, b, h) do { if constexpr (MODE == 2) { _Pragma("unroll") for (int n = 0; n < 2; ++n) dst##8[n] = PG8_LD32(lds + PG8_SB(b, h) + boff + n * 2048); } \
        else { _Pragma("unroll") for (int n = 0; n < 2; ++n) _Pragma("unroll") for (int k = 0; k < 2; ++k) dst[n][k] = *(const LAS bf16x8*)(lds + PG8_SB(b, h) + boff + n * 2048 + k * KST); } } while (0)
#define PG8_CAT(x) __builtin_shufflevector(__builtin_bit_cast(i32x4, x[0]), __builtin_bit_cast(i32x4, x[1]), 0, 1, 2, 3, 4, 5, 6, 7)
#define PG8_MMA(ai, bj, At, Bt) do { __builtin_amdgcn_s_setprio(1); _Pragma("unroll") for (int m = 0; m < 4; ++m) _Pragma("unroll") for (int n = 0; n < 2; ++n) { \
        if constexpr (MODE == 2) asm volatile("v_mfma_scale_f32_16x16x128_f8f6f4 %0, %1, %2, %0, %3, %3 op_sel_hi:[0,0,0]" : "+v"(acc[ai][bj][m][n]) : "v"(Bt##8[n]), "v"(At##8[m]), "v"(one_scale)); \
        else { _Pragma("unroll") for (int k = 0; k < 2; ++k) { if constexpr (MODE == 1) acc[ai][bj][m][n] = __builtin_amdgcn_mfma_i32_16x16x64_i8(__builtin_bit_cast(i32x4, Bt[n][k]), __builtin_bit_cast(i32x4, At[m][k]), acc[ai][bj][m][n], 0, 0, 0); \
          else acc[ai][bj][m][n] = __builtin_amdgcn_mfma_f32_16x16x32_bf16(Bt[n][k], At[m][k], acc[ai][bj][m][n], 0, 0, 0); } } } __builtin_amdgcn_s_setprio(0); } while (0)
#define PG8_WAIT_V(n) asm volatile("s_waitcnt vmcnt(" #n ")" ::: "memory")
#define PG8_WAIT_L(n) asm volatile("s_waitcnt lgkmcnt(" #n ")" ::: "memory")
#define PG8_BAR __builtin_amdgcn_s_barrier()
#define PG8_SCHED __builtin_amdgcn_sched_barrier(0)
#define PG8_PIN4(v) asm volatile("" : "+v"(v[0][0]), "+v"(v[0][1]), "+v"(v[1][0]), "+v"(v[1][1]))
    Unit cur, nxt; int ui = 0;
    if (!S.next(0, cur)) return;
    typedef typename Epi::acc_t acc_t;
    acc_t acc[2][2][4][2];
#pragma unroll
    for (int a = 0; a < 2; ++a)
#pragma unroll
        for (int b = 0; b < 2; ++b)
#pragma unroll
            for (int m = 0; m < 4; ++m)
#pragma unroll
                for (int n = 0; n < 2; ++n) acc[a][b][m][n] = acc_t{};
    bf16x8 At[4][2], B0[2][2], B1[2][2]; i32x8 At8[4], B08[2], B18[2];
    unsigned one_scale = 0x7f7f7f7fu; if constexpr (MODE == 2) asm volatile("" : "+v"(one_scale));
    unsigned cvo[2][2], nvo[2][2];
    const char* const Ab = S.a_base();
    const char* cA = Ab;
    if constexpr (Sched::GATHER) { S.a_off(cur, R, C, cvo); PG8_PIN4(cvo); } else { S.lane_off(R, C, cvo); cA = Ab + S.a_ubase(cur); }
    const char* cB = S.b_ptr(cur);
    cur.par = 0;
    if constexpr (Epi::PREF) { if (wid == 0) E.pref(lds + LX_EPI, cur, lane); }
    PG8_STAGE(PG8_SB(0, 0), cB, voffB); PG8_STAGE(PG8_SB(0, 1), cB + hstepB, voffB); PG8_STAGE(PG8_SA(0, 0), cA, cvo[0]); PG8_STAGE(PG8_SA(0, 1), cA, cvo[1]);
    if (wr == 1) PG8_BAR;
    PG8_WAIT_V(2); PG8_BAR;
    PG8_STAGE(PG8_SB(1, 0), cB + kstep, voffB); PG8_STAGE(PG8_SA(1, 0), cA + kstep, cvo[0]); PG8_STAGE(PG8_SB(1, 1), cB + hstepB + kstep, voffB);
    PG8_WAIT_V(6); PG8_BAR;
    for (;;) {
        const bool has_next = S.next(ui + 1, nxt);
        const char* nA = cA;
        if constexpr (Sched::GATHER) {
            if (has_next) { S.a_off(nxt, R, C, nvo); } else { nvo[0][0] = cvo[0][0]; nvo[0][1] = cvo[0][1]; nvo[1][0] = cvo[1][0]; nvo[1][1] = cvo[1][1]; }
            PG8_PIN4(nvo);
        } else { if (has_next) nA = Ab + S.a_ubase(nxt); }
        const char* nB = has_next ? S.b_ptr(nxt) : cB;
        if constexpr (Epi::PREF) { if (ui > 0 && wid == 0) E.pref(lds + LX_EPI + cur.par * 3072, cur, lane); }
#pragma nounroll
        for (int t = 0; t < nt; t += 2) {
            const bool last = (t == nt - 2);
            if constexpr (Epi::MIDK) { if (t == nt / 2) E.mid(acc, cur, wr, wc, fr, fq); }
            const char* a1 = cA + (size_t)(t + 1) * kstep;
            const char* a2 = last ? nA : cA + (size_t)(t + 2) * kstep; const char* b2 = last ? nB : cB + (size_t)(t + 2) * kstep;
            const char* a3 = a2 + kstep; const char* b3 = b2 + kstep;
            unsigned v2[2][2];
#pragma unroll
            for (int h = 0; h < 2; ++h)
#pragma unroll
                for (int i = 0; i < 2; ++i) v2[h][i] = (Sched::GATHER && last) ? nvo[h][i] : cvo[h][i];
            PG8_LDB(B0, 0, 0); PG8_LDB(B1, 0, 1); PG8_SCHED; PG8_LDA(At, 0, 0); PG8_STAGE(PG8_SA(1, 1), a1, cvo[1]);
            PG8_WAIT_V(8); PG8_WAIT_L(0); PG8_BAR; PG8_MMA(0, 0, At, B0); PG8_MMA(0, 1, At, B1); PG8_BAR; PG8_SCHED;
            PG8_LDA(At, 0, 1); PG8_STAGE(PG8_SB(0, 0), b2, voffB); PG8_STAGE(PG8_SB(0, 1), b2 + hstepB, voffB); PG8_STAGE(PG8_SA(0, 0), a2, v2[0]);
            PG8_WAIT_V(8); PG8_WAIT_L(0); PG8_BAR; PG8_MMA(1, 0, At, B0); PG8_MMA(1, 1, At, B1); PG8_BAR; PG8_SCHED;
            PG8_LDB(B0, 1, 0); PG8_LDB(B1, 1, 1); PG8_SCHED; PG8_LDA(At, 1, 0); PG8_STAGE(PG8_SA(0, 1), a2, v2[1]);
            PG8_WAIT_V(8); PG8_WAIT_L(0); PG8_BAR; PG8_MMA(0, 0, At, B0); PG8_MMA(0, 1, At, B1); PG8_BAR; PG8_SCHED;
            PG8_LDA(At, 1, 1); PG8_STAGE(PG8_SB(1, 0), b3, voffB); PG8_STAGE(PG8_SB(1, 1), b3 + hstepB, voffB); PG8_STAGE(PG8_SA(1, 0), a3, v2[0]);
            PG8_WAIT_V(8); PG8_WAIT_L(0); PG8_BAR; PG8_MMA(1, 0, At, B0); PG8_MMA(1, 1, At, B1); PG8_BAR; PG8_SCHED;
        }
        if constexpr (ALIGN_EPI) { if (wr == 0) PG8_BAR; }
        if constexpr (MODE == 2) asm volatile("s_nop 15\n\ts_nop 15" ::: "memory");
        E(acc, cur, wr, wc, fr, fq);
        if constexpr (EPI_PROBE == 6 && Epi::MODE == 1 && Sched::GATHER) { asm volatile("" ::: "memory"); E(acc, cur, wr, wc, fr, fq); }
        if constexpr (EPI_PROBE == 7 && Epi::MODE == 2) { asm volatile("" ::: "memory"); E(acc, cur, wr, wc, fr, fq); }
        if (!has_next) break;
#pragma unroll
        for (int a = 0; a < 2; ++a)
#pragma unroll
            for (int b = 0; b < 2; ++b)
#pragma unroll
                for (int m = 0; m < 4; ++m)
#pragma unroll
                    for (int n = 0; n < 2; ++n) acc[a][b][m][n] = acc_t{};
        cur = nxt; cB = nB; cA = nA; ++ui; cur.par = ui & 1;
        if constexpr (Sched::GATHER) {
#pragma unroll
        for (int h = 0; h < 2; ++h)
#pragma unroll
            for (int i = 0; i < 2; ++i) cvo[h][i] = nvo[h][i]; }
        if constexpr (ALIGN_EPI) { if (wr == 1) PG8_BAR; }
    }
    PG8_WAIT_V(0);
    if constexpr (!ALIGN_EPI) { if (wr == 0) PG8_BAR; }
    PG8_BAR;
#undef PG8_SA
#undef PG8_SB
#undef PG8_STAGE
#undef PG8_LDA
#undef PG8_LD32
#undef PG8_LDB
#undef PG8_MMA
#undef PG8_CAT
#undef PG8_WAIT_V
#undef PG8_WAIT_L
#undef PG8_BAR
#undef PG8_SCHED
#undef PG8_PIN4
}
}

struct DenseSched {
    static constexpr bool GATHER = false;
    const char* A; const char* Bt; int lda, ldb, nM, nN, G, c, wgm;
    __device__ __forceinline__ bool next(int i, pg8::Unit& u) const { const int L = i * G + c; if (L >= nM * nN) return false; pg8::order_map(L, nM, nN, u.pm, u.pn, wgm); u.e = 0; u.lt = 0; u.cnt = 0; return true; }
    __device__ __forceinline__ void a_off(const pg8::Unit& u, const int (&R)[2], const int (&C)[2], unsigned (&vo)[2][2]) const {
#pragma unroll
        for (int h = 0; h < 2; ++h)
#pragma unroll
            for (int i = 0; i < 2; ++i) vo[h][i] = (unsigned)((u.pm * 256 + 128 * h + R[i]) * lda + C[i]) * 2u; }
    __device__ __forceinline__ void lane_off(const int (&R)[2], const int (&C)[2], unsigned (&vo)[2][2]) const {
#pragma unroll
        for (int h = 0; h < 2; ++h)
#pragma unroll
            for (int i = 0; i < 2; ++i) vo[h][i] = (unsigned)((128 * h + R[i]) * lda + C[i]) * 2u; }
    __device__ __forceinline__ size_t a_ubase(const pg8::Unit& u) const { return (size_t)u.pm * 256 * lda * 2; }
    __device__ __forceinline__ const char* a_base() const { return A; }
    __device__ __forceinline__ const char* b_ptr(const pg8::Unit& u) const { return Bt + (size_t)u.pn * 256 * ldb * 2; }
};
struct BalSched {
    static constexpr bool GATHER = false;
    const char* A; const char* Bt; int lda, ldb, nM, nN, G, c, nbf;
    __device__ __forceinline__ bool next(int i, pg8::Unit& u) const {
        int L;
        if (G == 256 && nbf == 128 && nM * nN == 1024) { if (c < 128) { if (i >= 3) return false; L = 128 * i + c; } else { if (i >= 5) return false; L = 384 + 128 * i + (c - 128); } }
        else { L = i * G + c; if (L >= nM * nN) return false; }
        pg8::order_map(L, nM, nN, u.pm, u.pn, WGM_IN); u.e = 0; u.lt = 0; u.cnt = 0; return true; }
    __device__ __forceinline__ void a_off(const pg8::Unit&, const int (&)[2], const int (&)[2], unsigned (&)[2][2]) const {}
    __device__ __forceinline__ void lane_off(const int (&R)[2], const int (&C)[2], unsigned (&vo)[2][2]) const {
#pragma unroll
        for (int h = 0; h < 2; ++h)
#pragma unroll
            for (int i = 0; i < 2; ++i) vo[h][i] = (unsigned)((128 * h + R[i]) * lda + C[i]) * 2u; }
    __device__ __forceinline__ size_t a_ubase(const pg8::Unit& u) const { return (size_t)u.pm * 256 * lda * 2; }
    __device__ __forceinline__ const char* a_base() const { return A; }
    __device__ __forceinline__ const char* b_ptr(const pg8::Unit& u) const { return Bt + (size_t)u.pn * 256 * ldb * 2; }
};
struct MergeSched {
    static constexpr bool GATHER = false;
    const char* A; const char* Bt; int G, c;
    __device__ __forceinline__ bool next(int i, pg8::Unit& u) const { const int v = i & 1, L = (i >> 1) * G + c; if (L >= 256 || i >= 2 * ((256 + G - 1) / G)) return false; pg8::order_map(L, 64, 4, u.pm, u.pn, WGM_MID); u.e = v; u.lt = 0; u.cnt = 0; return true; }
    __device__ __forceinline__ void a_off(const pg8::Unit& u, const int (&R)[2], const int (&C)[2], unsigned (&vo)[2][2]) const {
#pragma unroll
        for (int h = 0; h < 2; ++h)
#pragma unroll
            for (int i = 0; i < 2; ++i) vo[h][i] = (unsigned)u.e * (unsigned)(WS_SG - WS_O) + (unsigned)((u.pm * 256 + 128 * h + R[i]) * 512 + C[i]) * 2u; }
    __device__ __forceinline__ void lane_off(const int (&R)[2], const int (&C)[2], unsigned (&vo)[2][2]) const {
#pragma unroll
        for (int h = 0; h < 2; ++h)
#pragma unroll
            for (int i = 0; i < 2; ++i) vo[h][i] = (unsigned)((128 * h + R[i]) * 512 + C[i]) * 2u; }
    __device__ __forceinline__ size_t a_ubase(const pg8::Unit& u) const { return (size_t)u.e * (WS_SG - WS_O) + (size_t)u.pm * 256 * 512 * 2; }
    __device__ __forceinline__ const char* a_base() const { return A; }
    __device__ __forceinline__ const char* b_ptr(const pg8::Unit& u) const { return Bt + (size_t)u.e * (WS_WS - WS_WA) + (size_t)u.pn * 256 * 512 * 2; }
};
template <bool GU>
struct MoeSched {
    static constexpr bool GATHER = GU;
    const char* A; const char* Bt; const int* list; const LAS int* tbase; const LAS int* tile_e; const unsigned* cnt; int nN, G, c, ldk;
    __device__ __forceinline__ bool next(int i, pg8::Unit& u) const {
        const int nM = tbase[NE]; const int L = i * G + c; if (L >= nM * nN) return false;
        pg8::order_map(L, nM, nN, u.pm, u.pn, GU ? WGM_GU : WGM_DN); u.e = tile_e[u.pm]; u.lt = u.pm - tbase[u.e]; u.cnt = (int)cnt[CW_CNT + 64 * u.e]; return true; }
    __device__ __forceinline__ void a_off(const pg8::Unit& u, const int (&R)[2], const int (&C)[2], unsigned (&vo)[2][2]) const {
#pragma unroll
        for (int h = 0; h < 2; ++h)
#pragma unroll
            for (int i = 0; i < 2; ++i) {
                if (GU) { const int pos = u.lt * 256 + 128 * h + R[i]; const int tok = list[(size_t)u.e * T + (pos < u.cnt ? pos : u.lt * 256)]; vo[h][i] = (unsigned)(tok * ldk + C[i]) * 2u; }
                else vo[h][i] = (unsigned)((u.pm * 256 + 128 * h + R[i]) * ldk + C[i]) * 2u; } }
    __device__ __forceinline__ void lane_off(const int (&R)[2], const int (&C)[2], unsigned (&vo)[2][2]) const {
#pragma unroll
        for (int h = 0; h < 2; ++h)
#pragma unroll
            for (int i = 0; i < 2; ++i) vo[h][i] = (unsigned)((128 * h + R[i]) * ldk + C[i]) * 2u; }
    __device__ __forceinline__ size_t a_ubase(const pg8::Unit& u) const { return (size_t)u.pm * 256 * ldk * 2; }
    __device__ __forceinline__ const char* a_base() const { return A; }
    __device__ __forceinline__ const char* b_ptr(const pg8::Unit& u) const { return Bt + ((size_t)u.e * nN + u.pn) * 256 * ldk * 2; }
};

#ifndef KM_ATOMICS
#define KM_ATOMICS 1
#endif
struct EpiIn {
    typedef f32x4 acc_t; static constexpr int MODE = 0;
    static constexpr bool MIDK = false; static constexpr bool PREF = false;
    unsigned char* ws; float* km;
    template <int ACT>
    __device__ __forceinline__ void store(const f32x4 (&acc)[2][2][4][2], bf16* base, int ldc, int row0, int col0, float sc) const {
#pragma unroll
        for (int ai = 0; ai < 2; ++ai)
#pragma unroll
            for (int m = 0; m < 4; ++m) { bf16* rowp = base + (size_t)(row0 + ai * 128 + m * 16) * ldc + col0;
#pragma unroll
                for (int bj = 0; bj < 2; ++bj) { f32x4 v0 = acc[ai][bj][m][0], v1 = acc[ai][bj][m][1];
                    if (ACT == 0) { v0 = v0 * sc; v1 = v1 * sc; }
                    if (ACT == 1) { const f32x2 a = gelu_pk((f32x2){v0[0], v0[1]}), b = gelu_pk((f32x2){v0[2], v0[3]}), c = gelu_pk((f32x2){v1[0], v1[1]}), d = gelu_pk((f32x2){v1[2], v1[3]});
                        v0 = (f32x4){a.x, a.y, b.x, b.y}; v1 = (f32x4){c.x, c.y, d.x, d.y}; }
                    if (ACT == 2) {
#pragma unroll
                        for (int j = 0; j < 4; ++j) { v0[j] = fast_sigmoid(v0[j]); v1[j] = fast_sigmoid(v1[j]); } }
                    u32x4 w; w.x = cvt_pk_bf16(v0[0], v0[1]); w.y = cvt_pk_bf16(v0[2], v0[3]); w.z = cvt_pk_bf16(v1[0], v1[1]); w.w = cvt_pk_bf16(v1[2], v1[3]);
                    *(u32x4*)(rowp + bj * 128) = w; } }
    }
    __device__ __forceinline__ void operator()(const f32x4 (&acc)[2][2][4][2], const pg8::Unit& u, int wr, int wc, int fr, int fq) const {
        const int pn = u.pn, row0 = u.pm * 256 + wr * 64 + fr;
        if (pn < 10) {
            const int kind = pn >> 1, col0 = (pn & 1) * 256 + wc * 32 + 8 * fq; bf16* base = (bf16*)(ws + WS_Q + (size_t)kind * 16 * MiB);
            if (kind == 0) store<0>(acc, base, 512, row0, col0, C2);
            else if (kind < 3) store<0>(acc, base, 512, row0, col0, 1.f);
            else store<1>(acc, base, 512, row0, col0, 1.f);
            if (KM_ATOMICS && kind == 1) {
#pragma unroll
                for (int bj = 0; bj < 2; ++bj)
#pragma unroll
                    for (int n = 0; n < 2; ++n) { f32x4 s = (f32x4){0.f, 0.f, 0.f, 0.f};
#pragma unroll
                        for (int ai = 0; ai < 2; ++ai)
#pragma unroll
                            for (int m = 0; m < 4; ++m) s = s + acc[ai][bj][m][n];
#pragma unroll
                        for (int j = 0; j < 4; ++j) { float t = s[j]; t += __shfl_xor(t, 1); t += __shfl_xor(t, 2); t += __shfl_xor(t, 4); t += __shfl_xor(t, 8); s[j] = t; }
                        if (fr == 0) { float* dst = km + (size_t)u.pm * 512 + col0 + bj * 128 + 4 * n;
#pragma unroll
                            for (int j = 0; j < 4; ++j) unsafeAtomicAdd(dst + j, s[j] * (1.f / 256.f)); } }
            }
        } else {
            const int gsel = (pn - 10) >> 2, col0 = ((pn - 10) & 3) * 256 + wc * 32 + 8 * fq; bf16* base = (bf16*)(ws + (gsel ? WS_GS : WS_GA));
            store<2>(acc, base, 1024, row0, col0, 1.f);
        }
    }
};
struct EpiInQ {
    typedef i32x4 acc_t; static constexpr int MODE = 1;
    static constexpr bool MIDK = false; static constexpr bool PREF = EPI_PREF != 0;
    unsigned char* ws; const float* sxn; const float* sbin; float* km; LAS unsigned char* lds;
    __device__ __forceinline__ void pref(LAS unsigned char* buf, const pg8::Unit& u, int lane) const {
        __builtin_amdgcn_global_load_lds((const unsigned*)(sbin + u.pn * 256 + 4 * lane), (LAS unsigned*)buf, 16, 0, 0);
        __builtin_amdgcn_global_load_lds((const unsigned*)(sxn + u.pm * 256 + 4 * lane), (LAS unsigned*)(buf + 1024), 16, 0, 0);
    }
    __device__ __forceinline__ f32x4 ldsc(const float* sbp, const LAS float* esb, int off) const { if constexpr (PREF) return *(const LAS f32x4*)(esb + off); else return *(const f32x4*)(sbp + off); }
    __device__ __forceinline__ float ldsr(int row, const LAS float* esr, int off) const { if constexpr (PREF) return esr[off]; else return sxn[row]; }
    template <int ACT>
    __device__ __forceinline__ void store(const i32x4 (&acc)[2][2][4][2], bf16* base, int ldc, int row0, int col0, const float* sbp, const LAS float* esb, const LAS float* esr) const {
        f32x4 s0[2], s1[2];
#pragma unroll
        for (int bj = 0; bj < 2; ++bj) { s0[bj] = ldsc(sbp, esb, bj * 128); s1[bj] = ldsc(sbp, esb, bj * 128 + 4); }
#pragma unroll
        for (int ai = 0; ai < 2; ++ai)
#pragma unroll
            for (int m = 0; m < 4; ++m) { const int row = row0 + ai * 128 + m * 16; const float sa = ldsr(row, esr, ai * 128 + m * 16); bf16* rowp = base + (size_t)row * ldc + col0;
#pragma unroll
                for (int bj = 0; bj < 2; ++bj) { f32x4 v0 = __builtin_convertvector(acc[ai][bj][m][0], f32x4) * (s0[bj] * sa), v1 = __builtin_convertvector(acc[ai][bj][m][1], f32x4) * (s1[bj] * sa);
                    if (ACT == 1) { const f32x2 a = gelu_pk((f32x2){v0[0], v0[1]}), b = gelu_pk((f32x2){v0[2], v0[3]}), c = gelu_pk((f32x2){v1[0], v1[1]}), d = gelu_pk((f32x2){v1[2], v1[3]});
                        v0 = (f32x4){a.x, a.y, b.x, b.y}; v1 = (f32x4){c.x, c.y, d.x, d.y}; }
                    if (ACT == 2) {
#pragma unroll
                        for (int j = 0; j < 4; ++j) { v0[j] = fast_sigmoid(v0[j]); v1[j] = fast_sigmoid(v1[j]); } }
                    u32x4 w; w.x = cvt_pk_bf16(v0[0], v0[1]); w.y = cvt_pk_bf16(v0[2], v0[3]); w.z = cvt_pk_bf16(v1[0], v1[1]); w.w = cvt_pk_bf16(v1[2], v1[3]);
                    *(u32x4*)(rowp + bj * 128) = w; } }
    }
    __device__ __forceinline__ void operator()(const i32x4 (&acc)[2][2][4][2], const pg8::Unit& u, int wr, int wc, int fr, int fq) const {
        const int pn = u.pn + IN_BF_TILES, row0 = u.pm * 256 + wr * 64 + fr; const float* sbp = sbin + u.pn * 256 + wc * 32 + 8 * fq;
        const LAS float* esb = (const LAS float*)(lds + LX_EPI + u.par * 3072) + wc * 32 + 8 * fq; const LAS float* esr = (const LAS float*)(lds + LX_EPI + u.par * 3072) + 256 + wr * 64 + fr;
        if (pn < 10) { const int kind = pn >> 1, col0 = (pn & 1) * 256 + wc * 32 + 8 * fq; bf16* base = (bf16*)(ws + WS_Q + (size_t)kind * 16 * MiB);
            if (kind <= 2) store<0>(acc, base, 512, row0, col0, sbp, esb, esr); else store<1>(acc, base, 512, row0, col0, sbp, esb, esr);
            if (KM_ATOMICS && kind == 1) {
                float sa[2][4];
#pragma unroll
                for (int ai = 0; ai < 2; ++ai)
#pragma unroll
                    for (int m = 0; m < 4; ++m) sa[ai][m] = ldsr(row0 + ai * 128 + m * 16, esr, ai * 128 + m * 16);
#pragma unroll
                for (int bj = 0; bj < 2; ++bj)
#pragma unroll
                    for (int n = 0; n < 2; ++n) { f32x4 s = (f32x4){0.f, 0.f, 0.f, 0.f};
#pragma unroll
                        for (int ai = 0; ai < 2; ++ai)
#pragma unroll
                            for (int m = 0; m < 4; ++m) s = s + __builtin_convertvector(acc[ai][bj][m][n], f32x4) * sa[ai][m];
                        s = s * ldsc(sbp, esb, bj * 128 + 4 * n);
#pragma unroll
                        for (int j = 0; j < 4; ++j) { float t = s[j]; t += __shfl_xor(t, 1); t += __shfl_xor(t, 2); t += __shfl_xor(t, 4); t += __shfl_xor(t, 8); s[j] = t; }
                        if (fr == 0) { float* dst = km + (size_t)u.pm * 512 + col0 + bj * 128 + 4 * n;
#pragma unroll
                            for (int j = 0; j < 4; ++j) unsafeAtomicAdd(dst + j, s[j] * (1.f / 256.f)); } }
            }
        } else { const int gsel = (pn - 10) >> 2, col0 = ((pn - 10) & 3) * 256 + wc * 32 + 8 * fq; bf16* base = (bf16*)(ws + (gsel ? WS_GS : WS_GA));
#if GATE_U8
            { f32x4 s0[2], s1[2];
#pragma unroll
              for (int bj = 0; bj < 2; ++bj) { s0[bj] = ldsc(sbp, esb, bj * 128) * -LOG2E; s1[bj] = ldsc(sbp, esb, bj * 128 + 4) * -LOG2E; }
#pragma unroll
              for (int ai = 0; ai < 2; ++ai)
#pragma unroll
                for (int m = 0; m < 4; ++m) { const int row = row0 + ai * 128 + m * 16; const float sa = ldsr(row, esr, ai * 128 + m * 16); unsigned char* rowp = (unsigned char*)base + (size_t)row * 1024 + col0;
#pragma unroll
                    for (int bj = 0; bj < 2; ++bj) { const f32x4 v0 = __builtin_convertvector(acc[ai][bj][m][0], f32x4) * (s0[bj] * sa), v1 = __builtin_convertvector(acc[ai][bj][m][1], f32x4) * (s1[bj] * sa); unsigned q[8];
#pragma unroll
                        for (int j = 0; j < 4; ++j) { q[j] = __float_as_uint(__builtin_fmaxf(__builtin_amdgcn_rcpf(__builtin_fmaf(__builtin_amdgcn_exp2f(v0[j]), 1.f / 255.f, 1.f / 255.f)), 1.f) + 8388608.f);
                            q[4 + j] = __float_as_uint(__builtin_fmaxf(__builtin_amdgcn_rcpf(__builtin_fmaf(__builtin_amdgcn_exp2f(v1[j]), 1.f / 255.f, 1.f / 255.f)), 1.f) + 8388608.f); }
                        u32x2 w;
                        w.x = __builtin_amdgcn_perm(q[1], q[0], 0x0c0c0400u) | __builtin_amdgcn_perm(q[3], q[2], 0x04000c0cu); w.y = __builtin_amdgcn_perm(q[5], q[4], 0x0c0c0400u) | __builtin_amdgcn_perm(q[7], q[6], 0x04000c0cu);
                        *(u32x2*)(rowp + bj * 128) = w; } } }
#else
            store<2>(acc, base, 1024, row0, col0, sbp, esb, esr);
#endif
        }
    }
};
struct EpiMerge {
    typedef f32x4 acc_t; static constexpr int MODE = 0;
    static constexpr bool MIDK = false; static constexpr bool PREF = false;
    unsigned char* ws;
    __device__ __forceinline__ void operator()(const f32x4 (&acc)[2][2][4][2], const pg8::Unit& u, int wr, int wc, int fr, int fq) const {
        const int row0 = u.pm * 256 + wr * 64 + fr, col0 = u.pn * 256 + wc * 32 + 8 * fq;
        const bf16* gate = (const bf16*)(ws + (u.e ? WS_GS : WS_GA)); bf16* mg = (bf16*)(ws + WS_MG);
#pragma unroll
        for (int ai = 0; ai < 2; ++ai)
#pragma unroll
            for (int m = 0; m < 4; ++m) { const size_t ro = (size_t)(row0 + ai * 128 + m * 16) * 1024 + col0;
#pragma unroll
                for (int bj = 0; bj < 2; ++bj) { const u32x4 g = *(const u32x4*)(gate + ro + bj * 128); f32x4 v0 = acc[ai][bj][m][0], v1 = acc[ai][bj][m][1];
                    v0[0] *= bf2f(g.x & 0xffffu); v0[1] *= bf2f(g.x >> 16); v0[2] *= bf2f(g.y & 0xffffu); v0[3] *= bf2f(g.y >> 16);
                    v1[0] *= bf2f(g.z & 0xffffu); v1[1] *= bf2f(g.z >> 16); v1[2] *= bf2f(g.w & 0xffffu); v1[3] *= bf2f(g.w >> 16);
                    if (u.e) { const u32x4 p = *(const u32x4*)(mg + ro + bj * 128);
                        v0[0] += bf2f(p.x & 0xffffu); v0[1] += bf2f(p.x >> 16); v0[2] += bf2f(p.y & 0xffffu); v0[3] += bf2f(p.y >> 16);
                        v1[0] += bf2f(p.z & 0xffffu); v1[1] += bf2f(p.z >> 16); v1[2] += bf2f(p.w & 0xffffu); v1[3] += bf2f(p.w >> 16); }
                    u32x4 w; w.x = cvt_pk_bf16(v0[0], v0[1]); w.y = cvt_pk_bf16(v0[2], v0[3]); w.z = cvt_pk_bf16(v1[0], v1[1]); w.w = cvt_pk_bf16(v1[2], v1[3]);
                    *(u32x4*)(mg + ro + bj * 128) = w; } }
    }
};
struct EpiMergeF {
    typedef f32x4 acc_t; static constexpr int MODE = 0; static constexpr bool MIDK = true; static constexpr bool PREF = false;
    unsigned char* ws;
    __device__ __forceinline__ void mid(f32x4 (&acc)[2][2][4][2], const pg8::Unit& u, int wr, int wc, int fr, int fq) const {
        asm volatile("" : "+v"(fr), "+v"(fq));
        const int row0 = u.pm * 256 + wr * 64 + fr, col0 = u.pn * 256 + wc * 32 + 8 * fq; const bf16* ga = (const bf16*)(ws + WS_GA); const bf16* gs = (const bf16*)(ws + WS_GS);
#pragma unroll
        for (int ai = 0; ai < 2; ++ai)
#pragma unroll
            for (int m = 0; m < 4; ++m) { const size_t ro = (size_t)(row0 + ai * 128 + m * 16) * 1024 + col0;
#pragma unroll
                for (int bj = 0; bj < 2; ++bj) {
#if GATE_U8
                    const u32x2 a = *(const u32x2*)((const unsigned char*)ga + ro + bj * 128), b = *(const u32x2*)((const unsigned char*)gs + ro + bj * 128);
#pragma unroll
                    for (int j = 0; j < 8; ++j) { const float r = (float)((a[j >> 2] >> (8 * (j & 3))) & 0xffu) * __builtin_amdgcn_rcpf((float)((b[j >> 2] >> (8 * (j & 3))) & 0xffu)); acc[ai][bj][m][j >> 2][j & 3] *= r; }
#else
                    const u32x4 a = *(const u32x4*)(ga + ro + bj * 128), b = *(const u32x4*)(gs + ro + bj * 128);
#pragma unroll
                    for (int j = 0; j < 4; ++j) { const float rl = bf2f(a[j] & 0xffffu) * __builtin_amdgcn_rcpf(bf2f(b[j] & 0xffffu)), rh = bf2f(a[j] >> 16) * __builtin_amdgcn_rcpf(bf2f(b[j] >> 16));
                        acc[ai][bj][m][j >> 1][2 * (j & 1)] *= rl; acc[ai][bj][m][j >> 1][2 * (j & 1) + 1] *= rh; }
#endif
                }
                if (m == 3) asm volatile("" ::: "memory"); }
    }
    __device__ __forceinline__ void operator()(const f32x4 (&acc)[2][2][4][2], const pg8::Unit& u, int wr, int wc, int fr, int fq) const {
        const int row0 = u.pm * 256 + wr * 64 + fr, col0 = u.pn * 256 + wc * 32 + 8 * fq; const bf16* gs = (const bf16*)(ws + WS_GS); bf16* mg = (bf16*)(ws + WS_MG);
#if GATE_U8
        u32x2 gq[2][4][2];
#pragma unroll
        for (int ai = 0; ai < 2; ++ai)
#pragma unroll
            for (int m = 0; m < 4; ++m)
#pragma unroll
                for (int bj = 0; bj < 2; ++bj) gq[ai][m][bj] = *(const u32x2*)((const unsigned char*)gs + (size_t)(row0 + ai * 128 + m * 16) * 1024 + col0 + bj * 128);
#endif
#pragma unroll
        for (int ai = 0; ai < 2; ++ai)
#pragma unroll
            for (int m = 0; m < 4; ++m) { const size_t ro = (size_t)(row0 + ai * 128 + m * 16) * 1024 + col0;
#pragma unroll
                for (int bj = 0; bj < 2; ++bj) { f32x4 v0 = acc[ai][bj][m][0], v1 = acc[ai][bj][m][1];
#if GATE_U8
                    const u32x2 g = gq[ai][m][bj];
#pragma unroll
                    for (int j = 0; j < 4; ++j) { v0[j] *= (float)((g.x >> (8 * j)) & 0xffu) * (1.f / 255.f); v1[j] *= (float)((g.y >> (8 * j)) & 0xffu) * (1.f / 255.f); }
#else
                    const u32x4 g = *(const u32x4*)(gs + ro + bj * 128);
                    v0[0] *= bf2f(g.x & 0xffffu); v0[1] *= bf2f(g.x >> 16); v0[2] *= bf2f(g.y & 0xffffu); v0[3] *= bf2f(g.y >> 16);
                    v1[0] *= bf2f(g.z & 0xffffu); v1[1] *= bf2f(g.z >> 16); v1[2] *= bf2f(g.w & 0xffffu); v1[3] *= bf2f(g.w >> 16);
#endif
                    u32x4 w; w.x = cvt_pk_bf16(v0[0], v0[1]); w.y = cvt_pk_bf16(v0[2], v0[3]); w.z = cvt_pk_bf16(v1[0], v1[1]); w.w = cvt_pk_bf16(v1[2], v1[3]);
                    *(u32x4*)(mg + ro + bj * 128) = w; } }
    }
};
struct EpiH1 {
    typedef f32x4 acc_t; static constexpr int MODE = 0;
    static constexpr bool MIDK = false; static constexpr bool PREF = false;
    const float* x; float* h1; bf16* h1b;
    __device__ __forceinline__ void operator()(const f32x4 (&acc)[2][2][4][2], const pg8::Unit& u, int wr, int wc, int fr, int fq) const {
        const int row0 = u.pm * 256 + wr * 64 + fr, col0 = u.pn * 256 + wc * 32 + 8 * fq;
        f32x4 xq[4][2][2];
#pragma unroll
        for (int g = 0; g < 4; ++g)
#pragma unroll
            for (int bj = 0; bj < 2; ++bj) { const size_t ro = (size_t)(row0 + (g >> 2) * 128 + (g & 3) * 16) * 1024 + col0;
                xq[g][bj][0] = __builtin_nontemporal_load((const f32x4*)(x + ro + bj * 128)); xq[g][bj][1] = __builtin_nontemporal_load((const f32x4*)(x + ro + bj * 128 + 4)); }
#pragma unroll
        for (int ai = 0; ai < 2; ++ai)
#pragma unroll
            for (int m = 0; m < 4; ++m) { const size_t ro = (size_t)(row0 + ai * 128 + m * 16) * 1024 + col0; const int g = ai * 4 + m;
                f32x4 xc[2][2];
#pragma unroll
                for (int bj = 0; bj < 2; ++bj) { xc[bj][0] = xq[g & 3][bj][0]; xc[bj][1] = xq[g & 3][bj][1]; }
                if (g + 4 < 8) {
#pragma unroll
                    for (int bj = 0; bj < 2; ++bj) { const size_t rn = (size_t)(row0 + ((g + 4) >> 2) * 128 + ((g + 4) & 3) * 16) * 1024 + col0;
                        xq[g & 3][bj][0] = __builtin_nontemporal_load((const f32x4*)(x + rn + bj * 128)); xq[g & 3][bj][1] = __builtin_nontemporal_load((const f32x4*)(x + rn + bj * 128 + 4)); } }
#pragma unroll
                for (int bj = 0; bj < 2; ++bj) { const f32x4 x0 = xc[bj][0], x1 = xc[bj][1];
                    const f32x4 v0 = acc[ai][bj][m][0] + x0, v1 = acc[ai][bj][m][1] + x1;
                    if (!H1_BF16) { *(f32x4*)(h1 + ro + bj * 128) = v0; *(f32x4*)(h1 + ro + bj * 128 + 4) = v1; }
                    if (!MOE_I8 || H1_BF16) { u32x4 w; w.x = cvt_pk_bf16(v0[0], v0[1]); w.y = cvt_pk_bf16(v0[2], v0[3]); w.z = cvt_pk_bf16(v1[0], v1[1]); w.w = cvt_pk_bf16(v1[2], v1[3]);
                        *(u32x4*)(h1b + ro + bj * 128) = w; } } }
    }
};
struct EpiGu {
    typedef f32x4 acc_t; static constexpr int MODE = 0;
    static constexpr bool MIDK = false; static constexpr bool PREF = false;
    const float* rlist; const float* bgu; bf16* hid;
    __device__ __forceinline__ void operator()(const f32x4 (&acc)[2][2][4][2], const pg8::Unit& u, int wr, int wc, int fr, int fq) const {
        const int lrow0 = wr * 64 + fr, col0 = u.pn * 256 + wc * 32 + 8 * fq; const float* bb = bgu + (size_t)u.e * 2048 + col0;
        f32x4 b0[2], b1[2];
#pragma unroll
        for (int bj = 0; bj < 2; ++bj) { b0[bj] = *(const f32x4*)(bb + bj * 128); b1[bj] = *(const f32x4*)(bb + bj * 128 + 4); }
#pragma unroll
        for (int ai = 0; ai < 2; ++ai)
#pragma unroll
            for (int m = 0; m < 4; ++m) { const int lr = lrow0 + ai * 128 + m * 16, pos = u.lt * 256 + lr; const float r = pos < u.cnt ? rlist[(size_t)u.e * T + pos] : 0.f;
                bf16* rowp = hid + (size_t)(u.pm * 256 + lr) * DE + (col0 >> 1);
#pragma unroll
                for (int bj = 0; bj < 2; ++bj) { const f32x4 v0 = acc[ai][bj][m][0] * r + b0[bj], v1 = acc[ai][bj][m][1] * r + b1[bj];
                    u32x2 w; w.x = cvt_pk_bf16(fast_swiglu(v0[0], v0[1]), fast_swiglu(v0[2], v0[3])); w.y = cvt_pk_bf16(fast_swiglu(v1[0], v1[1]), fast_swiglu(v1[2], v1[3]));
                    *(u32x2*)(rowp + bj * 64) = w; } }
    }
};
struct EpiGuQ {
    typedef i32x4 acc_t; static constexpr int MODE = 1;
    static constexpr bool MIDK = false; static constexpr bool PREF = EPI_PREF != 0;
    const float* rlist; const float* sb; const float* bgu; bf16* hid; LAS unsigned char* lds;
    __device__ __forceinline__ void pref(LAS unsigned char* buf, const pg8::Unit& u, int lane) const {
        __builtin_amdgcn_global_load_lds((const unsigned*)(bgu + (size_t)u.e * 2048 + u.pn * 256 + 4 * lane), (LAS unsigned*)buf, 16, 0, 0);
        __builtin_amdgcn_global_load_lds((const unsigned*)(sb + (size_t)u.e * 2048 + u.pn * 256 + 4 * lane), (LAS unsigned*)(buf + 1024), 16, 0, 0);
        __builtin_amdgcn_global_load_lds((const unsigned*)(rlist + (size_t)u.e * T + u.lt * 256 + 4 * lane), (LAS unsigned*)(buf + 2048), 16, 0, 0);
    }
    __device__ __forceinline__ void operator()(const i32x4 (&acc)[2][2][4][2], const pg8::Unit& u, int wr, int wc, int fr, int fq) const {
        const int lrow0 = wr * 64 + fr, col0 = u.pn * 256 + wc * 32 + 8 * fq; const float* bb = bgu + (size_t)u.e * 2048 + col0; const float* ss = sb + (size_t)u.e * 2048 + col0;
        const LAS float* eb = (const LAS float*)(lds + LX_EPI + u.par * 3072) + wc * 32 + 8 * fq; (void)eb;
        f32x4 b0[2], b1[2], s0[2], s1[2];
#pragma unroll
        for (int bj = 0; bj < 2; ++bj) {
            if constexpr (PREF) { b0[bj] = *(const LAS f32x4*)(eb + bj * 128); b1[bj] = *(const LAS f32x4*)(eb + bj * 128 + 4); s0[bj] = *(const LAS f32x4*)(eb + 256 + bj * 128); s1[bj] = *(const LAS f32x4*)(eb + 256 + bj * 128 + 4); }
            else { b0[bj] = *(const f32x4*)(bb + bj * 128); b1[bj] = *(const f32x4*)(bb + bj * 128 + 4); s0[bj] = *(const f32x4*)(ss + bj * 128); s1[bj] = *(const f32x4*)(ss + bj * 128 + 4); } }
        const LAS float* er = (const LAS float*)(lds + LX_EPI + u.par * 3072) + 512; (void)er;
#if MOE_F8
        { constexpr float CC = -1.702f * LOG2E, IC = 1.f / CC; const f32x4 cm = (f32x4){CC, IC, CC, IC}, ca = (f32x4){0.f, IC, 0.f, IC};
#pragma unroll
          for (int bj = 0; bj < 2; ++bj) { s0[bj] = s0[bj] * cm; s1[bj] = s1[bj] * cm; b0[bj] = b0[bj] * cm + ca; b1[bj] = b1[bj] * cm + ca; } }
#endif
#pragma unroll
        for (int ai = 0; ai < 2; ++ai)
#pragma unroll
            for (int m = 0; m < 4; ++m) { const int lr = lrow0 + ai * 128 + m * 16, pos = u.lt * 256 + lr; float r;
                if constexpr (PREF) { const float rv = er[lr]; r = pos < u.cnt ? rv : 0.f; } else r = pos < u.cnt ? rlist[(size_t)u.e * T + pos] : 0.f;
                bf16* rowp = hid + (size_t)(u.pm * 256 + lr) * DE + (col0 >> 1);
#pragma unroll
                for (int bj = 0; bj < 2; ++bj) { const f32x4 v0 = __builtin_convertvector(acc[ai][bj][m][0], f32x4) * (s0[bj] * r) + b0[bj], v1 = __builtin_convertvector(acc[ai][bj][m][1], f32x4) * (s1[bj] * r) + b1[bj];
#if MOE_F8
                    unsigned w = 0u; w = __builtin_amdgcn_cvt_pk_fp8_f32(folded_swiglu(v0[0], v0[1]), folded_swiglu(v0[2], v0[3]), w, false); w = __builtin_amdgcn_cvt_pk_fp8_f32(folded_swiglu(v1[0], v1[1]), folded_swiglu(v1[2], v1[3]), w, true);
                    *(unsigned*)((unsigned char*)hid + (size_t)(u.pm * 256 + lr) * DE + (col0 >> 1) + bj * 64) = w; (void)rowp;
#else
                    u32x2 w; w.x = cvt_pk_bf16(fast_swiglu(v0[0], v0[1]), fast_swiglu(v0[2], v0[3])); w.y = cvt_pk_bf16(fast_swiglu(v1[0], v1[1]), fast_swiglu(v1[2], v1[3]));
                    *(u32x2*)(rowp + bj * 64) = w;
#endif
                } }
    }
};
struct EpiDown {
    typedef f32x4 acc_t; static constexpr int MODE = MOE_F8 ? 2 : 0;
    static constexpr bool MIDK = false; static constexpr bool PREF = EPI_PREF != 0;
    const float* bd; bf16* y; LAS unsigned char* lds;
    __device__ __forceinline__ void pref(LAS unsigned char* buf, const pg8::Unit& u, int lane) const {
        __builtin_amdgcn_global_load_lds((const unsigned*)(bd + (size_t)u.e * D + u.pn * 256 + 4 * lane), (LAS unsigned*)buf, 16, 0, 0);
    }
    __device__ __forceinline__ void operator()(const f32x4 (&acc)[2][2][4][2], const pg8::Unit& u, int wr, int wc, int fr, int fq) const {
        const int lrow0 = wr * 64 + fr, col0 = u.pn * 256 + wc * 32 + 8 * fq; const float* bb = bd + (size_t)u.e * D + col0;
        const LAS float* eb = (const LAS float*)(lds + LX_EPI + u.par * 3072) + wc * 32 + 8 * fq; (void)eb;
        f32x4 b0[2], b1[2];
#pragma unroll
        for (int bj = 0; bj < 2; ++bj) {
            if constexpr (PREF) { b0[bj] = *(const LAS f32x4*)(eb + bj * 128); b1[bj] = *(const LAS f32x4*)(eb + bj * 128 + 4); }
            else { b0[bj] = *(const f32x4*)(bb + bj * 128); b1[bj] = *(const f32x4*)(bb + bj * 128 + 4); } }
#pragma unroll
        for (int ai = 0; ai < 2; ++ai)
#pragma unroll
            for (int m = 0; m < 4; ++m) { bf16* rowp = y + (size_t)(u.pm * 256 + lrow0 + ai * 128 + m * 16) * D + col0;
#pragma unroll
                for (int bj = 0; bj < 2; ++bj) { constexpr float ws_ = MOE_F8 ? (1.f / 32.f) : 1.f; const f32x4 v0 = acc[ai][bj][m][0] * ws_ + b0[bj], v1 = acc[ai][bj][m][1] * ws_ + b1[bj];
#if Y_F8
                    u32x2 w; unsigned t = 0u; t = __builtin_amdgcn_cvt_pk_fp8_f32(v0[0], v0[1], t, false); t = __builtin_amdgcn_cvt_pk_fp8_f32(v0[2], v0[3], t, true); w.x = t;
                    t = 0u; t = __builtin_amdgcn_cvt_pk_fp8_f32(v1[0], v1[1], t, false); t = __builtin_amdgcn_cvt_pk_fp8_f32(v1[2], v1[3], t, true); w.y = t;
                    *(u32x2*)((unsigned char*)y + (size_t)(u.pm * 256 + lrow0 + ai * 128 + m * 16) * D + col0 + bj * 128) = w; (void)rowp;
#else
                    u32x4 w; w.x = cvt_pk_bf16(v0[0], v0[1]); w.y = cvt_pk_bf16(v0[2], v0[3]); w.z = cvt_pk_bf16(v1[0], v1[1]); w.w = cvt_pk_bf16(v1[2], v1[3]);
                    *(u32x4*)(rowp + bj * 128) = w;
#endif
                } }
    }
};

namespace attn_body {
using bf16=__hip_bfloat16;
using bf16x8=__attribute__((ext_vector_type(8)))short;
using s16x4=__attribute__((ext_vector_type(4)))short;
using f32x16=__attribute__((ext_vector_type(16)))float;
using u32x4=__attribute__((ext_vector_type(4)))unsigned;
constexpr int BATCH=4,NHEAD=8,SEQ=4096,D=64,DM=NHEAD*D;
constexpr int NW=8,QBLK=32,QB=QBLK*NW,KVBLK=64,NQB=SEQ/QB;
__device__ __forceinline__ int crow(int r,int hi){return (r&3)+8*(r>>2)+4*hi;}
#define SBAR() __builtin_amdgcn_sched_barrier(0)
__device__ __forceinline__ void cmask(f32x16&p0,f32x16&p1,int jb,int qrel,int hi){
  const float NEG=-INFINITY; int kb=64*jb+4*hi;
  #pragma unroll
  for(int r=0;r<16;++r){int kv=kb+(r&3)+8*(r>>2); if(kv>qrel)p0[r]=NEG; if(kv+32>qrel)p1[r]=NEG;}
}
constexpr int NSLOT=3, SLOTB=8192;
constexpr int LDS_K=0, LDS_V=NSLOT*SLOTB, LDS_WS=2*NSLOT*SLOTB, LDS_OST=LDS_WS+NW*64*4, LDS_BYTES=LDS_OST+NW*4096;
constexpr int LDS_GATE=LDS_OST;
__device__ __forceinline__ void glds16(const void*gsrc,unsigned lds_dst){unsigned keep;
  asm volatile("s_mov_b32 %0, m0\n\ts_mov_b32 m0, %2\n\ts_nop 0\n\tglobal_load_lds_dwordx4 %1, off\n\ts_mov_b32 m0, %0":"=&s"(keep):"v"(gsrc),"s"(lds_dst):"memory");}
typedef float f32x2_t __attribute__((ext_vector_type(2))); typedef __bf16 bf16x2_t __attribute__((ext_vector_type(2)));
__device__ __forceinline__ unsigned cvtpk_s(float lo,float hi){f32x2_t v={lo,hi};bf16x2_t b=__builtin_convertvector(v,bf16x2_t);return __builtin_bit_cast(unsigned,b);}
#define WAIT_BAR(N) asm volatile("s_waitcnt vmcnt(" #N ") lgkmcnt(0)\n\ts_barrier":::"memory")
__device__ __forceinline__ float max3f(float a,float b,float c){return __builtin_fmaxf(__builtin_fmaxf(a,b),c);}
typedef __attribute__((address_space(3))) const char* lds_cptr;
typedef short v4i16_t __attribute__((ext_vector_type(4)));
__device__ __forceinline__ void kload8(bf16x8*kf,lds_cptr kp){
  kf[0]=*(const __attribute__((address_space(3))) bf16x8*)(kp);      kf[1]=*(const __attribute__((address_space(3))) bf16x8*)(kp+512);
  kf[2]=*(const __attribute__((address_space(3))) bf16x8*)(kp+2048); kf[3]=*(const __attribute__((address_space(3))) bf16x8*)(kp+2560);
  kf[4]=*(const __attribute__((address_space(3))) bf16x8*)(kp+4096); kf[5]=*(const __attribute__((address_space(3))) bf16x8*)(kp+4608);
  kf[6]=*(const __attribute__((address_space(3))) bf16x8*)(kp+6144); kf[7]=*(const __attribute__((address_space(3))) bf16x8*)(kp+6656);
}
__device__ __forceinline__ void kload2(bf16x8*kf,lds_cptr kp,int j){ kf[2*j]=*(const __attribute__((address_space(3))) bf16x8*)(kp+j*2048); kf[2*j+1]=*(const __attribute__((address_space(3))) bf16x8*)(kp+j*2048+512); }
__device__ __forceinline__ s16x4 vtr(lds_cptr p){ return __builtin_bit_cast(s16x4,__builtin_amdgcn_ds_read_tr16_b64_v4i16((__attribute__((address_space(3))) v4i16_t*)p)); }
__device__ __forceinline__ float rowmax(const f32x16&p0,const f32x16&p1){
  float a=max3f(p0[0],p0[1],p1[0]),b=max3f(p0[2],p0[3],p1[1]);a=max3f(a,p1[2],p1[3]);
  #pragma unroll
  for(int r=4;r<16;r+=4){a=max3f(a,p0[r],p0[r+1]);b=max3f(b,p0[r+2],p0[r+3]);a=max3f(a,p1[r],p1[r+1]);b=max3f(b,p1[r+2],p1[r+3]);}
  const float m=__builtin_fmaxf(a,b);
  auto rr=__builtin_amdgcn_permlane32_swap(__float_as_uint(m),__float_as_uint(m),false,false);
  return __builtin_fmaxf(__uint_as_float(rr[0]),__uint_as_float(rr[1]));
}
__device__ __forceinline__ void pv(f32x16*o,int vb,bf16x8 pa0,bf16x8 pa1,bf16x8 pa2,bf16x8 pa3){
  #pragma unroll
  for(int d0=0;d0<2;++d0){s16x4 lo[4],hi[4];
    #pragma unroll
    for(int ks=0;ks<4;++ks){
      asm volatile("ds_read_b64_tr_b16 %0,%1 offset:%c2":"=&v"(lo[ks]):"v"(vb),"i"(d0*4096+ks*1024):"memory");
      asm volatile("ds_read_b64_tr_b16 %0,%1 offset:%c2":"=&v"(hi[ks]):"v"(vb),"i"(d0*4096+ks*1024+512):"memory");}
    asm volatile("s_waitcnt lgkmcnt(0)":::"memory");SBAR();
    #define PK(k) (bf16x8){lo[k][0],lo[k][1],lo[k][2],lo[k][3],hi[k][0],hi[k][1],hi[k][2],hi[k][3]}
    o[d0]=__builtin_amdgcn_mfma_f32_32x32x16_bf16(pa0,PK(0),o[d0],0,0,0);
    o[d0]=__builtin_amdgcn_mfma_f32_32x32x16_bf16(pa1,PK(1),o[d0],0,0,0);
    o[d0]=__builtin_amdgcn_mfma_f32_32x32x16_bf16(pa2,PK(2),o[d0],0,0,0);
    o[d0]=__builtin_amdgcn_mfma_f32_32x32x16_bf16(pa3,PK(3),o[d0],0,0,0);
    #undef PK
  }
}
constexpr float MASKED=-1.0e30f, LOWREF=-1000.f;
template<int THRL> __device__ __forceinline__ void attn_unit(int b,int h,int qb,const bf16*Q,const bf16*__restrict__ K,const bf16*__restrict__ V,const float*__restrict__ KM,bf16*O,char*shm){
  int tid=threadIdx.x; asm volatile("":"+v"(tid));
  const int lane=tid&63,r32=lane&31,hi=lane>>5; const int wid=__builtin_amdgcn_readfirstlane(tid>>6);
  const long rowbase=(long)b*SEQ; const int q0=qb*QB;
  const bf16*Qw=Q+(rowbase+q0+wid*QBLK)*DM+h*D;
  const bf16*Kh=K+rowbase*DM+h*D,*Vh=V+rowbase*DM+h*D;
  const unsigned lds0=(unsigned)(uintptr_t)shm;
  __attribute__((address_space(3))) float*wsf=(__attribute__((address_space(3))) float*)((__attribute__((address_space(3))) char*)shm+LDS_WS)+wid*64;
  const bf16*ksrc=Kh+(long)lane*DM+wid*8;
  const bf16*vsrc=Vh+(long)(16*(wid&3)+(lane>>2))*DM+(wid>>2)*32+(lane&3)*8;
  const unsigned kdst=lds0+LDS_K+wid*1024, vdst=lds0+LDS_V+wid*1024;
  #define DMA_K(t,slot) glds16(ksrc+(long)(t)*KVBLK*DM,(unsigned)__builtin_amdgcn_readfirstlane(kdst+(slot)))
  #define DMA_V(t,slot) glds16(vsrc+(long)(t)*KVBLK*DM,(unsigned)__builtin_amdgcn_readfirstlane(vdst+(slot)))
  const int vb0=(int)(lds0+LDS_V)+((lane>>4)&1)*32+(lane&3)*8+(4*hi+((lane&15)>>2))*64;
  bf16x8 kf[8];
  const lds_cptr shm3=(lds_cptr)shm; const lds_cptr kp0=shm3+LDS_K+hi*1024+r32*16; const lds_cptr vp0=shm3+LDS_V+((lane>>4)&1)*32+(lane&3)*8+(4*hi+((lane&15)>>2))*64;
  const int NT=(q0+QB)/KVBLK;
  DMA_K(0,0);DMA_V(0,0);DMA_K(1,SLOTB);
  bf16x8 qr[4];
  #pragma unroll
  for(int d0=0;d0<4;++d0)qr[d0]=*reinterpret_cast<const bf16x8*>(&Qw[(long)r32*DM+d0*16+hi*8]);
  { const int row=tid>>4, dg=tid&15, j=row&15; f32x4 m4=(f32x4){0.f,0.f,0.f,0.f};
    if(j<qb) m4=*(const f32x4*)(KM+((long)(b*NQB+j))*DM+h*D+4*dg);
    unsigned w0,w1; { const unsigned h0=cvtpk_s(m4[0],m4[1]),h1=cvtpk_s(m4[2],m4[3]);
      if(row<16){w0=h0;w1=h1;} else { w0=cvtpk_s(m4[0]-__uint_as_float(h0<<16),m4[1]-__uint_as_float(h0&0xffff0000u)); w1=cvtpk_s(m4[2]-__uint_as_float(h1<<16),m4[3]-__uint_as_float(h1&0xffff0000u)); } }
    typedef unsigned u32x2_t __attribute__((ext_vector_type(2)));
    *(__attribute__((address_space(3))) u32x2_t*)(shm3+LDS_GATE+(dg>>1)*512+row*16+(dg&1)*8)=(u32x2_t){w0,w1}; }
  float mhat=0.f,l_reg=0.f;
  const int qrel=wid*QBLK+r32;
  const float sl2=exp2f(-(float)(h+1))*1.4426950408889634f;
  const float cb0=sl2*(float)(4*hi-(q0+qrel));
  #define CMASK(P0,P1,t) do{int jb_=(t)-(NT-4); if(jb_>=0)cmask(P0,P1,jb_,qrel,hi);}while(0)
  #define CINIT(C0,C1,t) do{ const bool s_=((selmask>>((t)>>2))&1u)!=0u; const float bt_=s_?(cb0+sl2*(float)(64*(t))-mhat):MASKED; \
      _Pragma("unroll") for(int r=0;r<16;++r){ const float kc_=(float)((r&3)+8*(r>>2)); C0[r]=__builtin_fmaf(sl2,kc_,bt_); C1[r]=__builtin_fmaf(sl2,kc_+32.f,bt_);} }while(0)
  bool resc=false;
  #define START(P0,P1) do{ const float rm=rowmax(P0,P1); resc=false; \
    { const float dl=__builtin_fmaxf(rm,LOWREF); mhat+=dl; \
      _Pragma("unroll") for(int r=0;r<16;++r){P0[r]-=dl;P1[r]-=dl;} } \
    _Pragma("unroll") for(int r=0;r<16;++r)P0[r]=__builtin_amdgcn_exp2f(P0[r]); }while(0)
  #define RESC() do{ if(resc){ asm volatile("s_waitcnt lgkmcnt(0)":::"memory"); \
      _Pragma("unroll") for(int d_=0;d_<2;++d_) _Pragma("unroll") for(int r=0;r<16;++r)o[d_][r]*=wsf[crow(r,hi)]; } }while(0)
  f32x16 pA0,pA1,pB0,pB1;
  int sl_prev=0,sl_cur=0,sl_next=SLOTB;
  #define ROT() do{sl_prev=sl_cur;sl_cur=sl_next;sl_next=(sl_next==(NSLOT-1)*SLOTB)?0:sl_next+SLOTB;}while(0)
  DMA_K(2,2*SLOTB);
  WAIT_BAR(3);
  unsigned selmask=1u<<qb;
  if(qb>0){
    f32x16 g=f32x16{};
    #pragma unroll
    for(int d0=0;d0<4;++d0){ const bf16x8 a=*(const __attribute__((address_space(3))) bf16x8*)(shm3+LDS_GATE+(2*d0+hi)*512+r32*16); g=__builtin_amdgcn_mfma_f32_32x32x16_bf16(a,qr[d0],g,0,0,0); }
    float gl[8],gp[8];
    #pragma unroll
    for(int i=0;i<4;++i){ gl[i]=g[i]+g[8+i]; gl[4+i]=g[4+i]+g[12+i]; }
    #pragma unroll
    for(int i=0;i<8;++i) gp[i]=__shfl_xor(gl[i],32);
    float gv[16];
    #pragma unroll
    for(int j=0;j<16;++j){ const int half=(j>>2)&1, i=(j&3)+4*(j>>3); const float v=(half==hi)?gl[i]:gp[i]; gv[j]=(j<qb)?v:-INFINITY; }
    #pragma unroll
    for(int s=0;s<3;++s){ int best=-1; float bv=-INFINITY;
      #pragma unroll
      for(int j=0;j<16;++j) if(gv[j]>bv){bv=gv[j];best=j;}
      #pragma unroll
      for(int j=0;j<16;++j) if(j==best) gv[j]=-INFINITY;
      if(best>=0) selmask|=1u<<best; }
  }
  f32x16 o[2];o[0]=f32x16{};o[1]=f32x16{}; asm volatile("":"+v"(o[0]),"+v"(o[1]));
  { const lds_cptr kp=kp0; kload8(kf,kp); }
  CINIT(pA0,pA1,0);
  #pragma unroll
  for(int d0=0;d0<4;++d0){ pA0=__builtin_amdgcn_mfma_f32_32x32x16_bf16(kf[2*d0],qr[d0],pA0,0,0,0); pA1=__builtin_amdgcn_mfma_f32_32x32x16_bf16(kf[2*d0+1],qr[d0],pA1,0,0,0); }
  CMASK(pA0,pA1,0);
  START(pA0,pA1);
  _Pragma("unroll") for(int r=0;r<16;++r)pA1[r]=__builtin_amdgcn_exp2f(pA1[r]);
  WAIT_BAR(0);
  DMA_K(3,0);DMA_V(1,SLOTB);
  ROT();
  kload8(kf,kp0+sl_cur);
  WAIT_BAR(2);
  s16x4 vlo[8],vhi[8]; u32x4 pw0,pw1,pw2,pw3;
  #define PKW(P,B) cvtpk_s(P[B],P[B+1])
  #define PAF(k) __builtin_bit_cast(bf16x8,pw##k)
  #define VFR(i) (bf16x8){vlo[i][0],vlo[i][1],vlo[i][2],vlo[i][3],vhi[i][0],vhi[i][1],vhi[i][2],vhi[i][3]}
  #define PIN(x) asm volatile("":"+v"(x))
  #define MX3(a,b,c) __builtin_fmaxf(__builtin_fmaxf((a),(b)),(c))
  #define GAPA(MF,A0,A1,A2,A3,W0,W1,PW) do{ MF; sacc+=A0; sacc+=A1; sacc+=A2; sacc+=A3; PIN(sacc); W0; W1; PIN(PW); SBAR(); }while(0)
  #define EX(v) __builtin_amdgcn_exp2f(v)
  #define KCF(r) ((float)(((r)&3)+8*((r)>>2)))
  #define GAPB(MF,X,B,N0,N1,R) do{ MF; X[B]=EX(X[B]); X[B+1]=EX(X[B+1]); X[B+2]=EX(X[B+2]); X[B+3]=EX(X[B+3]); PIN(X); \
    N0[R]=__builtin_fmaf(sl2,KCF(R),btn_); N0[R+1]=__builtin_fmaf(sl2,KCF(R+1),btn_); N1[R]=__builtin_fmaf(sl2,KCF(R)+32.f,btn_); N1[R+1]=__builtin_fmaf(sl2,KCF(R+1)+32.f,btn_); SBAR(); }while(0)
  #define VRD(i) do{ vlo[i]=vtr(vp_+(((i)>>2)*4096+((i)&3)*1024)); vhi[i]=vtr(vp_+(((i)>>2)*4096+((i)&3)*1024+512)); }while(0)
  #define KRD(G,j) do{ if(G){ kload2(kf,kp0+sl_next,j); SBAR(); } }while(0)
  #define STEP(C0,C1,P0,P1,t,GK,GV,GL) do{ SBAR(); \
    const lds_cptr vp_=vp0+sl_prev; \
    VRD(0); SBAR(); float sacc=(P0[0]+P0[1]); \
    GAPA(C0=__builtin_amdgcn_mfma_f32_32x32x16_bf16(kf[0],qr[0],C0,0,0,0), P0[2],P0[3],P0[4],P0[5],     pw0[0]=PKW(P0,0), pw0[1]=PKW(P0,2), pw0); \
    VRD(4); SBAR(); GAPA(C1=__builtin_amdgcn_mfma_f32_32x32x16_bf16(kf[1],qr[0],C1,0,0,0), P0[6],P0[7],P0[8],P0[9],     pw0[2]=PKW(P0,4), pw0[3]=PKW(P0,6), pw0); \
    VRD(1); SBAR(); GAPA(C0=__builtin_amdgcn_mfma_f32_32x32x16_bf16(kf[2],qr[1],C0,0,0,0),   P0[10],P0[11],P0[12],P0[13], pw1[0]=PKW(P0,8), pw1[1]=PKW(P0,10), pw1); \
    VRD(5); SBAR(); GAPA(C1=__builtin_amdgcn_mfma_f32_32x32x16_bf16(kf[3],qr[1],C1,0,0,0),   P0[14],P0[15],P1[0],P1[1],   pw1[2]=PKW(P0,12),pw1[3]=PKW(P0,14), pw1); \
    VRD(2); SBAR(); GAPA(C0=__builtin_amdgcn_mfma_f32_32x32x16_bf16(kf[4],qr[2],C0,0,0,0),   P1[2],P1[3],P1[4],P1[5],     pw2[0]=PKW(P1,0), pw2[1]=PKW(P1,2), pw2); \
    VRD(6); SBAR(); GAPA(C1=__builtin_amdgcn_mfma_f32_32x32x16_bf16(kf[5],qr[2],C1,0,0,0),   P1[6],P1[7],P1[8],P1[9],     pw2[2]=PKW(P1,4), pw2[3]=PKW(P1,6), pw2); \
    VRD(3); SBAR(); GAPA(C0=__builtin_amdgcn_mfma_f32_32x32x16_bf16(kf[6],qr[3],C0,0,0,0),   P1[10],P1[11],P1[12],P1[13], pw3[0]=PKW(P1,8), pw3[1]=PKW(P1,10), pw3); \
    VRD(7); SBAR(); GAPA(C1=__builtin_amdgcn_mfma_f32_32x32x16_bf16(kf[7],qr[3],C1,0,0,0),   P1[14],P1[15],0.f,0.f,       pw3[2]=PKW(P1,12),pw3[3]=PKW(P1,14), pw3); \
    l_reg+=sacc; \
    if(GK){DMA_K((t)+3,sl_cur);} if(GV){DMA_V((t)+1,sl_next);} \
    CMASK(C0,C1,t); \
    { float a=MX3(C0[0],C0[1],C1[0]),b=MX3(C0[2],C0[3],C1[1]); a=MX3(a,C1[2],C1[3]); \
      _Pragma("unroll") for(int r=4;r<16;r+=4){a=MX3(a,C0[r],C0[r+1]);b=MX3(b,C0[r+2],C0[r+3]);a=MX3(a,C1[r],C1[r+1]);b=MX3(b,C1[r+2],C1[r+3]);} \
      float rm=__builtin_fmaxf(a,b); { auto rr=__builtin_amdgcn_permlane32_swap(__float_as_uint(rm),__float_as_uint(rm),false,false); rm=__builtin_fmaxf(__uint_as_float(rr[0]),__uint_as_float(rr[1])); } \
      resc=false; \
      if(__builtin_expect(__any(rm>(float)THRL),0)){ const float dl=__builtin_fmaxf(rm,0.f); mhat+=dl; \
        _Pragma("unroll") for(int r=0;r<16;++r){C0[r]-=dl;C1[r]-=dl;} \
        const float f=__builtin_amdgcn_exp2f(-dl); l_reg*=f; if(hi==0)wsf[r32]=f; resc=true; } } \
    const float btn_=(((selmask>>(((t)+1)>>2))&1u)!=0u)?(cb0+sl2*(float)(64*((t)+1))-mhat):MASKED; \
    SBAR(); \
    GAPB(o[0]=__builtin_amdgcn_mfma_f32_32x32x16_bf16(PAF(0),VFR(0),o[0],0,0,0), C0,0, P0,P1,0); \
    GAPB(o[1]=__builtin_amdgcn_mfma_f32_32x32x16_bf16(PAF(0),VFR(4),o[1],0,0,0), C0,4, P0,P1,2); \
    KRD(GL,0); GAPB(o[0]=__builtin_amdgcn_mfma_f32_32x32x16_bf16(PAF(1),VFR(1),o[0],0,0,0), C0,8, P0,P1,4); \
    KRD(GL,1); GAPB(o[1]=__builtin_amdgcn_mfma_f32_32x32x16_bf16(PAF(1),VFR(5),o[1],0,0,0), C0,12, P0,P1,6); \
    KRD(GL,2); GAPB(o[0]=__builtin_amdgcn_mfma_f32_32x32x16_bf16(PAF(2),VFR(2),o[0],0,0,0), C1,0, P0,P1,8); \
    KRD(GL,3); GAPB(o[1]=__builtin_amdgcn_mfma_f32_32x32x16_bf16(PAF(2),VFR(6),o[1],0,0,0), C1,4, P0,P1,10); \
    GAPB(o[0]=__builtin_amdgcn_mfma_f32_32x32x16_bf16(PAF(3),VFR(3),o[0],0,0,0), C1,8, P0,P1,12); \
    GAPB(o[1]=__builtin_amdgcn_mfma_f32_32x32x16_bf16(PAF(3),VFR(7),o[1],0,0,0), C1,12, P0,P1,14); \
    }while(0)
  CINIT(pB0,pB1,1);
  int t=1;
  #undef CMASK
  #define CMASK(P0,P1,t) do{}while(0)
  for(;t+5<NT;t+=2){
    STEP(pB0,pB1,pA0,pA1,t,true,true,true);     WAIT_BAR(2); RESC(); ROT();
    STEP(pA0,pA1,pB0,pB1,t+1,true,true,true);   WAIT_BAR(2); RESC(); ROT();
  }
  #undef CMASK
  #define CMASK(P0,P1,t) do{int jb_=(t)-(NT-4); if(jb_>=0)cmask(P0,P1,jb_,qrel,hi);}while(0)
  #define ENDW(tt) do{ if((tt)+3<NT){WAIT_BAR(2);} else if((tt)+2<NT){WAIT_BAR(1);} else {WAIT_BAR(0);} }while(0)
  for(;t+1<NT;t+=2){
    STEP(pB0,pB1,pA0,pA1,t,(t+3<NT),(t+1<NT),(t+1<NT));       ENDW(t);   RESC(); ROT();
    STEP(pA0,pA1,pB0,pB1,t+1,(t+4<NT),(t+2<NT),(t+2<NT));     ENDW(t+1); RESC(); ROT();
  }
  STEP(pB0,pB1,pA0,pA1,NT-1,false,false,false); RESC();
  { float sacc=pB0[0]+pB0[1]; _Pragma("unroll") for(int r=2;r<16;++r)sacc+=pB0[r]; _Pragma("unroll") for(int r=0;r<16;++r)sacc+=pB1[r]; l_reg+=sacc;
    pw0=(u32x4){PKW(pB0,0),PKW(pB0,2),PKW(pB0,4),PKW(pB0,6)};pw1=(u32x4){PKW(pB0,8),PKW(pB0,10),PKW(pB0,12),PKW(pB0,14)};pw2=(u32x4){PKW(pB1,0),PKW(pB1,2),PKW(pB1,4),PKW(pB1,6)};pw3=(u32x4){PKW(pB1,8),PKW(pB1,10),PKW(pB1,12),PKW(pB1,14)};
    SBAR(); pv(o,vb0+sl_cur,PAF(0),PAF(1),PAF(2),PAF(3)); }
  #undef PKW
  #undef PAF
  #undef VFR
  #undef PIN
  #undef MX3
  #undef GAPA
  #undef GAPB
  #undef KCF
  #undef EX
  #undef VRD
  #undef KRD
  #undef STEP
  #undef ENDW
  {auto rr=__builtin_amdgcn_permlane32_swap(__float_as_uint(l_reg),__float_as_uint(l_reg),false,false);l_reg=__uint_as_float(rr[0])+__uint_as_float(rr[1]);}
  if(hi==0)wsf[32+r32]=l_reg;asm volatile("s_waitcnt lgkmcnt(0)":::"memory");
  float rli[16];
  #pragma unroll
  for(int r=0;r<16;++r)rli[r]=__builtin_amdgcn_rcpf(wsf[32+crow(r,hi)]);
  int lane2=lane; asm volatile("":"+v"(lane2));
  constexpr int OP=P3_FUSED?2*DM:DM;
  bf16*Ow=O+(rowbase+q0+wid*QBLK)*OP+h*D;
  { __attribute__((address_space(3))) unsigned short*stg=(__attribute__((address_space(3))) unsigned short*)((__attribute__((address_space(3))) char*)shm+LDS_OST)+wid*2048;
    #pragma unroll
    for(int r=0;r<16;++r){const int orow=crow(r,hi);
      #pragma unroll
      for(int d0=0;d0<2;++d0)stg[orow*64+d0*32+r32]=(unsigned short)(cvtpk_s(o[d0][r]*rli[r],0.f)&0xffffu);}
    asm volatile("s_waitcnt lgkmcnt(0)":::"memory");
    #pragma unroll
    for(int i=0;i<4;++i){const int row=i*8+(lane2>>3),ch=lane2&7; const u32x4 v=*(const __attribute__((address_space(3))) u32x4*)(stg+row*64+ch*8); *(u32x4*)(Ow+(long)row*OP+ch*8)=v;} }
  asm volatile("s_waitcnt lgkmcnt(0)\n\ts_barrier":::"memory");
  #undef DMA_K
  #undef DMA_V
  #undef CMASK
  #undef CINIT
  #undef START
  #undef RESC
  #undef ROT
}
constexpr int ATTN_LDS_BYTES=LDS_BYTES;
#undef SBAR
#undef WAIT_BAR
}

struct Frame { LAS unsigned char* lds; int tid, lane, wave, vcu, G; };
#define LDS_WAIT() asm volatile("s_waitcnt lgkmcnt(0)" ::: "memory")

struct P0Item { const float* W; bf16* WT; const float* ks; int K, N, k0, n0, f8, nblk, pitch; };
__device__ __forceinline__ P0Item p0_decode(const Ptrs& P, int it) {
    constexpr int I_IN = (D / 64) * ((IN_I8 ? 256 * IN_BF_TILES : NIN) / 32), I_A = (AW / 64) * (D / 32), I_M = (D / 64) * (D / 32), I_GU = (D / 64) * (2 * DE / 32), I_D = (DE / 64) * (D / 32);
    unsigned char* ws = P.ws; P0Item q; int r = it; q.f8 = 0; q.nblk = 0; q.pitch = 0;
    if (r < I_IN) { q.W = P.w_in; q.WT = (bf16*)(ws + WS_WIN); q.ks = nullptr; q.K = D; q.N = NIN; q.nblk = (IN_I8 ? 256 * IN_BF_TILES : NIN) / 32; }
    else if ((r -= I_IN) < I_A) { q.W = P.w_attn_out; q.WT = (bf16*)(ws + WS_WA); q.ks = nullptr; q.K = AW; q.N = D; q.pitch = P3_FUSED ? 1024 : 0; }
    else if ((r -= I_A) < I_A) { q.W = P.w_sgu_out; q.WT = P3_FUSED ? (bf16*)(ws + WS_WA) + 512 : (bf16*)(ws + WS_WS); q.ks = nullptr; q.K = SW; q.N = D; q.pitch = P3_FUSED ? 1024 : 0; }
    else if ((r -= I_A) < I_M) { q.W = P.w_mix_out; q.WT = (bf16*)(ws + WS_WM); q.ks = nullptr; q.K = D; q.N = D; }
    else if (!MOE_I8 && (r -= I_M) < NE * I_GU) { const int e = r / I_GU; r -= e * I_GU; q.W = P.w_gu + (size_t)e * D * 2 * DE; q.WT = (bf16*)(ws + WS_WGU) + (size_t)e * D * 2 * DE; q.ks = P.ffn_g; q.K = D; q.N = 2 * DE; }
    else { r -= MOE_I8 ? I_M : NE * I_GU; const int e = r / I_D; r -= e * I_D; q.W = P.w_down + (size_t)e * DE * D; q.WT = MOE_F8 ? (bf16*)(ws + WS_WD + (size_t)e * DE * D) : (bf16*)(ws + WS_WD) + (size_t)e * DE * D; q.ks = nullptr; q.K = DE; q.N = D; q.f8 = MOE_F8; }
    const int nblk = q.nblk ? q.nblk : q.N / 32; q.k0 = 64 * (r / nblk); q.n0 = 32 * (r % nblk); return q;
}
__device__ __forceinline__ void p0_load(const P0Item& q, int lane, f32x4 (&buf)[8]) {
    const float* src = q.W + (size_t)(q.k0 + (lane >> 3)) * q.N + q.n0 + 4 * (lane & 7);
#pragma unroll
    for (int i = 0; i < 8; ++i) buf[i] = __builtin_nontemporal_load((const GAS f32x4*)(src + (size_t)(8 * i) * q.N));
}
__device__ __forceinline__ void p0_store(const P0Item& q, int lane, const f32x4 (&buf)[8], LAS float* scr) {
#pragma unroll
    for (int i = 0; i < 8; ++i) { const int kk = (lane >> 3) + 8 * i; const float sc = q.ks ? q.ks[q.k0 + kk] : 1.f; LAS float* d = scr + kk * 33 + 4 * (lane & 7);
        d[0] = buf[i][0] * sc; d[1] = buf[i][1] * sc; d[2] = buf[i][2] * sc; d[3] = buf[i][3] * sc; }
    LDS_WAIT(); asm volatile("" ::: "memory");
    const int c = lane & 7;
#pragma unroll
    for (int j = 0; j < 4; ++j) { const int n = (lane >> 3) + 8 * j; const LAS float* s = scr + (8 * c) * 33 + n;
        if (q.f8) { u32x2 o; unsigned w = 0u; w = __builtin_amdgcn_cvt_pk_fp8_f32(s[0 * 33] * 32.f, s[1 * 33] * 32.f, w, false); w = __builtin_amdgcn_cvt_pk_fp8_f32(s[2 * 33] * 32.f, s[3 * 33] * 32.f, w, true); o.x = w;
            w = 0u; w = __builtin_amdgcn_cvt_pk_fp8_f32(s[4 * 33] * 32.f, s[5 * 33] * 32.f, w, false); w = __builtin_amdgcn_cvt_pk_fp8_f32(s[6 * 33] * 32.f, s[7 * 33] * 32.f, w, true); o.y = w;
            *(GAS u32x2*)((unsigned char*)q.WT + (size_t)(q.n0 + n) * q.K + q.k0 + 8 * c) = o; }
        else { u32x4 o; o.x = cvt_pk_bf16(s[0 * 33], s[1 * 33]); o.y = cvt_pk_bf16(s[2 * 33], s[3 * 33]); o.z = cvt_pk_bf16(s[4 * 33], s[5 * 33]); o.w = cvt_pk_bf16(s[6 * 33], s[7 * 33]);
            *(GAS u32x4*)(q.WT + (size_t)(q.n0 + n) * (q.pitch ? q.pitch : q.K) + q.k0 + 8 * c) = o; } }
    LDS_WAIT(); asm volatile("" ::: "memory");
}
__device__ __forceinline__ void p0_gu_load(const Ptrs& P, int s, int t, f32x4 (&v)[16]) {
    const bool gu = s < NE * 64; const int e = s >> 6, n0 = (s & 63) * 32; const size_t ld = gu ? (size_t)2 * DE : (size_t)NIN;
    const float* src = (gu ? P.w_gu + (size_t)e * D * 2 * DE + n0 : P.w_in + 256 * IN_BF_TILES + 32 * (s - NE * 64)) + 4 * (t & 7) + (size_t)(4 * (t >> 3)) * ld;
#pragma unroll
    for (int i = 0; i < 4; ++i)
#pragma unroll
        for (int j = 0; j < 4; ++j) v[4 * i + j] = __builtin_nontemporal_load((const GAS f32x4*)(src + (size_t)(256 * i + j) * ld));
}
#define LDS_BARRIER() asm volatile("s_waitcnt lgkmcnt(0)\n\ts_barrier" ::: "memory")
__device__ __forceinline__ void p0_gu_process(Frame& F, const Ptrs& P, int s, f32x4 (&va)[16], const f32x4 (&gk)[4]) {
    unsigned char* ws = P.ws; LAS unsigned char* tile = F.lds; LAS unsigned* lmax = (LAS unsigned*)(F.lds + 40960);
    const int t = F.tid, n4 = 4 * (t & 7), kq = t >> 3; const bool gu = s < NE * 64;
    unsigned char* qdst = gu ? ws + WS_WGU + (size_t)(s * 32) * 1024 : ws + WS_WINQ + (size_t)((s - NE * 64) * 32) * 1024;
    float* sdst = gu ? (float*)(ws + WS_SB) + s * 32 : (float*)(ws + WS_SBIN) + (s - NE * 64) * 32;
    if (t < 32) lmax[t] = 0u;
    f32x4 m = (f32x4){0.f, 0.f, 0.f, 0.f};
#pragma unroll
    for (int i = 0; i < 4; ++i)
#pragma unroll
        for (int j = 0; j < 4; ++j) { va[4 * i + j] = va[4 * i + j] * (gu ? gk[i][j] : 1.f); m = __builtin_elementwise_max(m, __builtin_elementwise_abs(va[4 * i + j])); }
    LDS_BARRIER();
#pragma unroll
    for (int c = 0; c < 4; ++c) __hip_atomic_fetch_max(lmax + n4 + c, __float_as_uint(m[c]), __ATOMIC_RELAXED, __HIP_MEMORY_SCOPE_WORKGROUP);
    LDS_BARRIER();
    f32x4 inv;
#pragma unroll
    for (int c = 0; c < 4; ++c) inv[c] = 127.f / fmaxf(__uint_as_float(lmax[n4 + c]), 1e-30f);
#pragma unroll
    for (int i = 0; i < 4; ++i)
#pragma unroll
        for (int c = 0; c < 4; ++c) { unsigned w = 0u;
#pragma unroll
            for (int j = 0; j < 4; ++j) { const int q = (int)__builtin_rintf(va[4 * i + j][c] * inv[c]); w |= ((unsigned)q & 0xffu) << (8 * j); }
            *(LAS unsigned*)(tile + (n4 + c) * 1040 + 4 * kq + 256 * i) = w; }
    LDS_BARRIER();
#pragma unroll
    for (int j = 0; j < 4; ++j) { const int ch = t + 512 * j, n = ch >> 6, kc = ch & 63; const u32x4 w = *(const LAS u32x4*)(tile + n * 1040 + 16 * kc);
        *(GAS u32x4*)(qdst + (size_t)n * 1024 + 16 * kc) = w; }
    if (t < 32) sdst[t] = __uint_as_float(lmax[t]) * (1.f / 127.f);
    LDS_BARRIER();
}
__device__ __forceinline__ void p0_gu_strips(Frame& F, const Ptrs& P) {
    const int t = F.tid, kq = t >> 3; constexpr int NS = NE * 64 + (IN_I8 ? (NIN - 256 * IN_BF_TILES) / 32 : 0);
    if (F.vcu >= NS) return;
    f32x4 va[16], vb[16]; p0_gu_load(P, F.vcu, t, va);
    f32x4 gk[4];
#pragma unroll
    for (int i = 0; i < 4; ++i) gk[i] = *(const f32x4*)(P.ffn_g + 4 * kq + 256 * i);
    for (int s0 = F.vcu;;) {
        const int s1 = s0 + F.G; const bool has1 = s1 < NS;
        p0_gu_load(P, has1 ? s1 : NS - 1, t, vb);
        p0_gu_process(F, P, s0, va, gk);
        if (!has1) break;
        s0 = s1 + F.G; const bool has0 = s0 < NS;
        p0_gu_load(P, has0 ? s0 : NS - 1, t, va);
        p0_gu_process(F, P, s1, vb, gk);
        if (!has0) break;
    }
}
#define SUBSTAMP(i) do { if (PROBE_K >= 0 && blockIdx.x == 0 && F.tid == 0) { ((LAS unsigned long long*)(F.lds + LX_MISC))[i] = __builtin_amdgcn_s_memrealtime(); } } while (0)
__device__ __forceinline__ void p0_prologue(Frame& F, const Ptrs& P) {
    unsigned char* ws = P.ws;
    const bool strips_first = (F.vcu & 1) == 0;
#if MOE_I8
    if (strips_first) p0_gu_strips(F, P);
#endif
    SUBSTAMP(10);
    LAS float* scr = (LAS float*)(F.lds + F.wave * 16384);
    const int gw = F.vcu * NWAVES + F.wave, NGW = F.G * NWAVES;
    constexpr int I_IN = (D / 64) * ((IN_I8 ? 256 * IN_BF_TILES : NIN) / 32), I_A = (AW / 64) * (D / 32), I_M = (D / 64) * (D / 32), I_GU = (D / 64) * (2 * DE / 32), I_D = (DE / 64) * (D / 32);
    constexpr int NITEMS = I_IN + 2 * I_A + I_M + (MOE_I8 ? 0 : NE * I_GU) + NE * I_D;
    if (gw < NITEMS) {
        P0Item cur = p0_decode(P, gw), nxt = cur; f32x4 bufA[8], bufB[8]; p0_load(cur, F.lane, bufA);
        for (int it = gw;;) {
            int nit = it + NGW; bool has = nit < NITEMS;
            nxt = p0_decode(P, has ? nit : NITEMS - 1); p0_load(nxt, F.lane, bufB);
            p0_store(cur, F.lane, bufA, scr);
            if (!has) break;
            it = nit + NGW; has = it < NITEMS;
            cur = p0_decode(P, has ? it : NITEMS - 1); p0_load(cur, F.lane, bufA);
            p0_store(nxt, F.lane, bufB, scr);
            if (!has) break;
        }
    }
    SUBSTAMP(11);
    for (int i = (F.vcu * NWAVES + F.wave) * 64 + F.lane; i < 8 * 128 * 128 / 2; i += NGW * 64) { const int e0 = 2 * i, t = (e0 >> 7) & 127, s0 = e0 & 127; const f32x2 wv = *(const f32x2*)(P.w_sp + e0);
        ((unsigned*)(ws + WS_WSP))[i] = cvt_pk_bf16(s0 <= t ? wv.x : 0.f, s0 + 1 <= t ? wv.y : 0.f); }
    for (int i = (F.vcu * NWAVES + F.wave) * 64 + F.lane; i < NE * D; i += NGW * 64) { const int e = i / D, k = i % D; const float v = P.w_router[(size_t)k * NE + e] * P.ffn_g[k];
        const unsigned h = f2bf(v); ((bf16*)(ws + WS_WR))[i] = (bf16)h; ((bf16*)(ws + WS_WR))[NE * D + i] = (bf16)f2bf(v - bf2f(h)); }
    f32x4 gg[4];
#pragma unroll
    for (int j = 0; j < 4; ++j) gg[j] = ((const f32x4*)P.mix_g)[F.lane + 64 * j];
    for (int row = gw; row < T; row += 2 * NGW) {
        const int row2 = row + NGW; const bool two = row2 < T;
        const GAS f32x4* xr = (const GAS f32x4*)(P.x + (size_t)row * D) + F.lane; const GAS f32x4* xr2 = (const GAS f32x4*)(P.x + (size_t)(two ? row2 : row) * D) + F.lane;
        f32x4 v[4], u[4]; float s = 0.f, s2 = 0.f;
#pragma unroll
        for (int j = 0; j < 4; ++j) { v[j] = __builtin_nontemporal_load(xr + 64 * j); u[j] = __builtin_nontemporal_load(xr2 + 64 * j); }
#pragma unroll
        for (int j = 0; j < 4; ++j) { s += (v[j].x * v[j].x + v[j].y * v[j].y) + (v[j].z * v[j].z + v[j].w * v[j].w); s2 += (u[j].x * u[j].x + u[j].y * u[j].y) + (u[j].z * u[j].z + u[j].w * u[j].w); }
        const float rstd = 1.f / sqrtf(wave_sum(s) * (1.f / D) + EPS), rstd2 = 1.f / sqrtf(wave_sum(s2) * (1.f / D) + EPS);
#pragma unroll
        for (int j = 0; j < 4; ++j) { v[j] = v[j] * rstd * gg[j]; u[j] = u[j] * rstd2 * gg[j]; }
#pragma unroll
        for (int j = 0; j < 4; ++j) { u32x2 o; o.x = cvt_pk_bf16(v[j].x, v[j].y); o.y = cvt_pk_bf16(v[j].z, v[j].w);
            *((GAS u32x2*)(ws + WS_XN + (size_t)row * D * 2) + F.lane + 64 * j) = o; }
        if (two) {
#pragma unroll
            for (int j = 0; j < 4; ++j) { u32x2 o; o.x = cvt_pk_bf16(u[j].x, u[j].y); o.y = cvt_pk_bf16(u[j].z, u[j].w);
                *((GAS u32x2*)(ws + WS_XN + (size_t)row2 * D * 2) + F.lane + 64 * j) = o; } }
#if IN_I8
        { float a1 = 0.f, a2 = 0.f;
#pragma unroll
          for (int j = 0; j < 4; ++j) { const f32x4 av = __builtin_elementwise_abs(v[j]), au = __builtin_elementwise_abs(u[j]); a1 = fmaxf(a1, fmaxf(fmaxf(av.x, av.y), fmaxf(av.z, av.w))); a2 = fmaxf(a2, fmaxf(fmaxf(au.x, au.y), fmaxf(au.z, au.w))); }
          a1 = fmaxf(wave_max(a1), 1e-30f); a2 = fmaxf(wave_max(a2), 1e-30f); const float q1 = 127.f / a1, q2 = 127.f / a2;
#pragma unroll
          for (int j = 0; j < 4; ++j) { const unsigned w = ((unsigned)(int)__builtin_rintf(v[j].x * q1) & 0xffu) | (((unsigned)(int)__builtin_rintf(v[j].y * q1) & 0xffu) << 8) | (((unsigned)(int)__builtin_rintf(v[j].z * q1) & 0xffu) << 16) | ((unsigned)(int)__builtin_rintf(v[j].w * q1) << 24);
              *((GAS unsigned*)(ws + WS_XNQ + (size_t)row * D) + F.lane + 64 * j) = w; }
          if (F.lane == 0) ((float*)(ws + WS_SXN))[row] = a1 * (1.f / 127.f);
          if (two) {
#pragma unroll
              for (int j = 0; j < 4; ++j) { const unsigned w = ((unsigned)(int)__builtin_rintf(u[j].x * q2) & 0xffu) | (((unsigned)(int)__builtin_rintf(u[j].y * q2) & 0xffu) << 8) | (((unsigned)(int)__builtin_rintf(u[j].z * q2) & 0xffu) << 16) | ((unsigned)(int)__builtin_rintf(u[j].w * q2) << 24);
                  *((GAS unsigned*)(ws + WS_XNQ + (size_t)row2 * D) + F.lane + 64 * j) = w; }
              if (F.lane == 0) ((float*)(ws + WS_SXN))[row2] = a2 * (1.f / 127.f); } }
#endif
    }
#if MOE_I8
    if (!strips_first) { __syncthreads(); p0_gu_strips(F, P); }
#endif
}
__device__ __forceinline__ void moe_tables(Frame& F, const unsigned* ctl) {
    LAS int* tbase = (LAS int*)(F.lds + LX_TBASE); LAS int* tile_e = (LAS int*)(F.lds + LX_TILEE);
    if (F.tid < 64) { const int c = F.tid < NE ? (int)ctl[CW_CNT + 64 * F.tid] : 0; const int n = (c + 255) >> 8; int incl = n;
#pragma unroll
        for (int o = 1; o < 64; o <<= 1) { const int t = __shfl_up(incl, o); if (F.lane >= o) incl += t; }
        if (F.tid <= NE) tbase[F.tid] = incl - n;
    }
    __syncthreads();
    for (int mt = F.tid; mt < NROWS_PAD / 256; mt += NWAVES * 64) { int e = 0;
        for (int i = 0; i < NE; ++i) if (mt >= tbase[i + 1]) e = i + 1;
        tile_e[mt] = e < NE ? e : NE - 1; }
    __syncthreads();
}


__device__ __forceinline__ void p5_router(Frame& F, const Ptrs& P) {
    unsigned char* ws = P.ws; unsigned* ctl = (unsigned*)(ws + WS_CTL);
    LAS float* red = (LAS float*)F.lds;
    LAS unsigned* lcnt = (LAS unsigned*)(F.lds + 40960);
    LAS f32x2* rowinfo = (LAS f32x2*)(F.lds + 41472);
    LAS unsigned* lbase = lcnt + 32;
    const int w = F.wave, lane = F.lane, gI = w & 1, kq = w >> 1, r32 = lane & 31, hi = lane >> 5;
    const bf16* WR = (const bf16*)(ws + WS_WR);
    for (int grp = blockIdx.x; grp < T / 64; grp += F.G) {
        if (F.tid < 64) lcnt[F.tid] = 0u;
        const int tok = grp * 64 + gI * 32 + r32;
        const float* xr = (const float*)(ws + WS_H1) + (size_t)tok * D + kq * 256 + 8 * hi;
        const bf16* xb = (const bf16*)(ws + WS_H1B) + (size_t)tok * D + kq * 256 + 8 * hi; (void)xb; (void)xr;
        const bf16* whi = WR + (size_t)r32 * D + kq * 256 + 8 * hi; const bf16* wlo = whi + NE * D;
        f32x16 c = {}; float ss = 0.f; f32x4 am = (f32x4){0.f, 0.f, 0.f, 0.f};
#pragma unroll 4
        for (int s = 0; s < 16; ++s) {
#if H1_BF16
            const u32x4 xraw = *(const u32x4*)(xb + 16 * s);
            const f32x4 x0 = (f32x4){bf2f(xraw[0] & 0xffffu), bf2f(xraw[0] >> 16), bf2f(xraw[1] & 0xffffu), bf2f(xraw[1] >> 16)}, x1 = (f32x4){bf2f(xraw[2] & 0xffffu), bf2f(xraw[2] >> 16), bf2f(xraw[3] & 0xffffu), bf2f(xraw[3] >> 16)};
#else
            const f32x4 x0 = *(const f32x4*)(xr + 16 * s), x1 = *(const f32x4*)(xr + 16 * s + 4);
#endif
            am = __builtin_elementwise_max(am, __builtin_elementwise_max(__builtin_elementwise_abs(x0), __builtin_elementwise_abs(x1)));
            ss += (x0[0] * x0[0] + x0[1] * x0[1]) + (x0[2] * x0[2] + x0[3] * x0[3]) + (x1[0] * x1[0] + x1[1] * x1[1]) + (x1[2] * x1[2] + x1[3] * x1[3]);
            u32x4 hw, lw;
            { const unsigned h = cvt_pk_bf16(x0[0], x0[1]); hw[0] = h; lw[0] = cvt_pk_bf16(x0[0] - __uint_as_float(h << 16), x0[1] - __uint_as_float(h & 0xffff0000u)); }
            { const unsigned h = cvt_pk_bf16(x0[2], x0[3]); hw[1] = h; lw[1] = cvt_pk_bf16(x0[2] - __uint_as_float(h << 16), x0[3] - __uint_as_float(h & 0xffff0000u)); }
            { const unsigned h = cvt_pk_bf16(x1[0], x1[1]); hw[2] = h; lw[2] = cvt_pk_bf16(x1[0] - __uint_as_float(h << 16), x1[1] - __uint_as_float(h & 0xffff0000u)); }
            { const unsigned h = cvt_pk_bf16(x1[2], x1[3]); hw[3] = h; lw[3] = cvt_pk_bf16(x1[2] - __uint_as_float(h << 16), x1[3] - __uint_as_float(h & 0xffff0000u)); }
            const bf16x8 xh = __builtin_bit_cast(bf16x8, hw), xl = __builtin_bit_cast(bf16x8, lw);
            const bf16x8 ah = *(const bf16x8*)(whi + 16 * s), al = *(const bf16x8*)(wlo + 16 * s);
            c = __builtin_amdgcn_mfma_f32_32x32x16_bf16(ah, xh, c, 0, 0, 0);
            if (!H1_BF16) c = __builtin_amdgcn_mfma_f32_32x32x16_bf16(ah, xl, c, 0, 0, 0);
            c = __builtin_amdgcn_mfma_f32_32x32x16_bf16(al, xh, c, 0, 0, 0);
        }
#pragma unroll
        for (int r = 0; r < 16; ++r) red[(w * 18 + r) * 64 + lane] = c[r];
        red[(w * 18 + 16) * 64 + lane] = ss; red[(w * 18 + 17) * 64 + lane] = fmaxf(fmaxf(am[0], am[1]), fmaxf(am[2], am[3]));
        __syncthreads();
        int idx[4]; unsigned lpos[4]; float pw[4]; float rstd = 0.f;
        if (kq == 0) {
            float lg[16], pl[16]; float ssum = 0.f, amax = 0.f;
#pragma unroll
            for (int r = 0; r < 16; ++r) lg[r] = 0.f;
#pragma unroll
            for (int q = 0; q < 4; ++q) {
#pragma unroll
                for (int r = 0; r < 16; ++r) lg[r] += red[((w + 2 * q) * 18 + r) * 64 + lane];
                ssum += red[((w + 2 * q) * 18 + 16) * 64 + lane]; amax = fmaxf(amax, red[((w + 2 * q) * 18 + 17) * 64 + lane]); }
            ssum += __shfl_xor(ssum, 32); amax = fmaxf(fmaxf(amax, __shfl_xor(amax, 32)), 1e-30f);
            rstd = 1.f / sqrtf(ssum * (1.f / D) + EPS);
            if (hi == 0) rowinfo[gI * 32 + r32] = (f32x2){127.f / amax, MOE_I8 ? rstd * amax * (1.f / 127.f) : rstd};
#pragma unroll
            for (int r = 0; r < 16; ++r) { lg[r] = lg[r] * rstd + P.b_router[(r & 3) + 8 * (r >> 2) + 4 * hi]; pl[r] = __shfl_xor(lg[r], 32); }
            float v[32];
#pragma unroll
            for (int e = 0; e < 32; ++e) { const int half = (e >> 2) & 1, r = (e & 3) + 4 * (e >> 3); v[e] = (half == hi) ? lg[r] : pl[r]; }
            float val[4];
#pragma unroll
            for (int k = 0; k < 4; ++k) { int best = 0; float bv = -INFINITY;
#pragma unroll
                for (int e = 0; e < 32; ++e) if (v[e] > bv) { bv = v[e]; best = e; }
#pragma unroll
                for (int e = 0; e < 32; ++e) if (e == best) v[e] = -INFINITY;
                idx[k] = best; val[k] = bv; }
            float den = 0.f;
#pragma unroll
            for (int k = 0; k < 4; ++k) { pw[k] = __expf(val[k] - val[0]); den += pw[k]; }
            const float rden = 1.f / den;
#pragma unroll
            for (int k = 0; k < 4; ++k) { pw[k] *= rden; lpos[k] = 0u; if (hi == 0) lpos[k] = atomicAdd((unsigned*)&lcnt[idx[k]], 1u); }
        }
        __syncthreads();
        if (F.tid < NE) ((unsigned*)(ws + WS_HIST))[grp * NE + F.tid] = lcnt[F.tid];
        if (kq == 0 && hi == 0) {
            unsigned* slot = (unsigned*)(ws + WS_TOKSLOT); float* tw = (float*)(ws + WS_TOKW);
#pragma unroll
            for (int k = 0; k < 4; ++k) { slot[tok * 4 + k] = (unsigned)idx[k] | (lpos[k] << 8); tw[tok * 4 + k] = pw[k]; }
            ((float*)(ws + WS_RSTD2))[tok] = MOE_I8 ? rowinfo[gI * 32 + r32].y : rstd;
        }
#if MOE_I8
        { const float qs = rowinfo[gI * 32 + r32].x; unsigned char* qrow = ws + WS_H1Q + (size_t)tok * D + kq * 256 + 8 * hi; LAS unsigned char* qst = F.lds + 49152 + w * (32 * 272);
#pragma unroll 4
          for (int s = 0; s < 16; ++s) {
#if H1_BF16
              const u32x4 xraw = *(const u32x4*)(xb + 16 * s);
              const f32x4 x0 = (f32x4){bf2f(xraw[0] & 0xffffu), bf2f(xraw[0] >> 16), bf2f(xraw[1] & 0xffffu), bf2f(xraw[1] >> 16)}, x1 = (f32x4){bf2f(xraw[2] & 0xffffu), bf2f(xraw[2] >> 16), bf2f(xraw[3] & 0xffffu), bf2f(xraw[3] >> 16)};
#else
              const f32x4 x0 = *(const f32x4*)(xr + 16 * s), x1 = *(const f32x4*)(xr + 16 * s + 4);
#endif
              u32x2 w;
              w.x = ((unsigned)(int)__builtin_rintf(x0[0] * qs) & 0xffu) | (((unsigned)(int)__builtin_rintf(x0[1] * qs) & 0xffu) << 8) | (((unsigned)(int)__builtin_rintf(x0[2] * qs) & 0xffu) << 16) | ((unsigned)(int)__builtin_rintf(x0[3] * qs) << 24);
              w.y = ((unsigned)(int)__builtin_rintf(x1[0] * qs) & 0xffu) | (((unsigned)(int)__builtin_rintf(x1[1] * qs) & 0xffu) << 8) | (((unsigned)(int)__builtin_rintf(x1[2] * qs) & 0xffu) << 16) | ((unsigned)(int)__builtin_rintf(x1[3] * qs) << 24);
              *(LAS u32x2*)(qst + r32 * 272 + 16 * s + 8 * hi) = w; (void)qrow; }
          asm volatile("s_waitcnt lgkmcnt(0)" ::: "memory");
#pragma unroll
          for (int j = 0; j < 8; ++j) { const int idx = lane + 64 * j, tk = idx >> 4, ch = idx & 15; const u32x4 v = *(const LAS u32x4*)(qst + tk * 272 + 16 * ch);
              *(u32x4*)(ws + WS_H1Q + (size_t)(grp * 64 + gI * 32 + tk) * D + kq * 256 + 16 * ch) = v; } }
#endif
        __syncthreads();
    }
}
__device__ __forceinline__ void p5b_lists(Frame& F, const Ptrs& P) {
    unsigned char* ws = P.ws; unsigned* ctl = (unsigned*)(ws + WS_CTL); const unsigned* hist = (const unsigned*)(ws + WS_HIST);
    LAS unsigned* part = (LAS unsigned*)F.lds;
    LAS unsigned* lbase = part + 512;
    for (int grp = blockIdx.x; grp < T / 64; grp += F.G) {
        { const int e = F.tid & 31, pt = F.tid >> 5; unsigned s = 0u;
#pragma unroll
          for (int i = 0; i < 16; ++i) { const int g2 = pt * 16 + i; const unsigned v = hist[g2 * NE + e]; s += (g2 < grp) ? v : 0u; }
          part[pt * 32 + e] = s; }
        __syncthreads();
        if (F.tid < NE) { unsigned s = 0u;
#pragma unroll
            for (int i = 0; i < 16; ++i) s += part[i * 32 + F.tid];
            lbase[F.tid] = s;
            if (grp == T / 64 - 1) ctl[CW_CNT + 64 * F.tid] = s + hist[grp * NE + F.tid]; }
        __syncthreads();
        if (F.tid < 256) { const int tok = grp * 64 + (F.tid >> 2); unsigned* slot = (unsigned*)(ws + WS_TOKSLOT) + tok * 4 + (F.tid & 3);
            const unsigned sv = *slot; const unsigned e = sv & 0xffu, pos = lbase[e] + (sv >> 8);
            *slot = e | (pos << 8); ((int*)(ws + WS_LIST))[(size_t)e * T + pos] = tok; ((float*)(ws + WS_RLIST))[(size_t)e * T + pos] = ((const float*)(ws + WS_RSTD2))[tok]; }
        __syncthreads();
    }
}
__device__ __forceinline__ void p8_combine(Frame& F, const Ptrs& P) {
    unsigned char* ws = P.ws; const LAS int* tbase = (const LAS int*)(F.lds + LX_TBASE);
    const int gw = F.vcu * NWAVES + F.wave, NGW = F.G * NWAVES, lane = F.lane;
    const bf16* Y = (const bf16*)(ws + WS_Y); const unsigned* slot = (const unsigned*)(ws + WS_TOKSLOT); const float* tw = (const float*)(ws + WS_TOKW);
    f32x4 gg[4];
#pragma unroll
    for (int j = 0; j < 2; ++j) { gg[2 * j] = *(const f32x4*)(P.fin_g + 8 * lane + 512 * j); gg[2 * j + 1] = *(const f32x4*)(P.fin_g + 8 * lane + 512 * j + 4); }
    for (int tok = gw; tok < T; tok += NGW) {
        const float* hr = (const float*)(ws + WS_H1) + (size_t)tok * D + 8 * lane; f32x4 v[4];
#pragma unroll
#if H1_BF16
        for (int j = 0; j < 2; ++j) { const u32x4 hb = *(const u32x4*)((const bf16*)(ws + WS_H1B) + (size_t)tok * D + 8 * lane + 512 * j);
            v[2 * j] = (f32x4){bf2f(hb[0] & 0xffffu), bf2f(hb[0] >> 16), bf2f(hb[1] & 0xffffu), bf2f(hb[1] >> 16)}; v[2 * j + 1] = (f32x4){bf2f(hb[2] & 0xffffu), bf2f(hb[2] >> 16), bf2f(hb[3] & 0xffffu), bf2f(hb[3] >> 16)}; }
        (void)hr;
#else
        for (int j = 0; j < 2; ++j) { v[2 * j] = *(const f32x4*)(hr + 512 * j); v[2 * j + 1] = *(const f32x4*)(hr + 512 * j + 4); }
#endif
        const u32x4 sl = *(const u32x4*)(slot + tok * 4); const f32x4 wv = *(const f32x4*)(tw + tok * 4);
#if Y_F8
        u32x2 y8[4][2];
#pragma unroll
        for (int k = 0; k < 4; ++k) { const int e = sl[k] & 0xff, pos = sl[k] >> 8; const unsigned char* yr = (const unsigned char*)Y + (size_t)(tbase[e] * 256 + pos) * D + 8 * lane; y8[k][0] = *(const u32x2*)yr; y8[k][1] = *(const u32x2*)(yr + 512); }
#pragma unroll
        for (int k = 0; k < 4; ++k)
#pragma unroll
            for (int j = 0; j < 2; ++j) { const u32x2 q = y8[k][j]; const float wk = wv[k];
                const f32x2 a = __builtin_amdgcn_cvt_pk_f32_fp8(q.x, false), b = __builtin_amdgcn_cvt_pk_f32_fp8(q.x, true), c = __builtin_amdgcn_cvt_pk_f32_fp8(q.y, false), d = __builtin_amdgcn_cvt_pk_f32_fp8(q.y, true);
                v[2 * j][0] += wk * a[0]; v[2 * j][1] += wk * a[1]; v[2 * j][2] += wk * b[0]; v[2 * j][3] += wk * b[1];
                v[2 * j + 1][0] += wk * c[0]; v[2 * j + 1][1] += wk * c[1]; v[2 * j + 1][2] += wk * d[0]; v[2 * j + 1][3] += wk * d[1]; }
#endif
        u32x4 y[4][2];
#pragma unroll
        for (int k = 0; k < 4; ++k) { if (Y_F8) break; const int e = sl[k] & 0xff, pos = sl[k] >> 8; const bf16* yr = Y + (size_t)(tbase[e] * 256 + pos) * D + 8 * lane; y[k][0] = *(const u32x4*)yr; y[k][1] = *(const u32x4*)(yr + 512); }
#pragma unroll
        for (int k = 0; k < 4; ++k)
#pragma unroll
            for (int j = 0; j < 2; ++j) { if (Y_F8) break; const u32x4 q = y[k][j]; const float wk = wv[k];
                v[2 * j][0] += wk * bf2f(q.x & 0xffffu); v[2 * j][1] += wk * bf2f(q.x >> 16); v[2 * j][2] += wk * bf2f(q.y & 0xffffu); v[2 * j][3] += wk * bf2f(q.y >> 16);
                v[2 * j + 1][0] += wk * bf2f(q.z & 0xffffu); v[2 * j + 1][1] += wk * bf2f(q.z >> 16); v[2 * j + 1][2] += wk * bf2f(q.w & 0xffffu); v[2 * j + 1][3] += wk * bf2f(q.w >> 16); }
        float s = 0.f;
#pragma unroll
        for (int j = 0; j < 4; ++j) s += (v[j][0] * v[j][0] + v[j][1] * v[j][1]) + (v[j][2] * v[j][2] + v[j][3] * v[j][3]);
        const float rstd = 1.f / sqrtf(wave_sum(s) * (1.f / D) + EPS);
        float* orow = P.out + (size_t)tok * D + 8 * lane;
#pragma unroll
        for (int j = 0; j < 2; ++j) { *(f32x4*)(orow + 512 * j) = v[2 * j] * rstd * gg[2 * j]; *(f32x4*)(orow + 512 * j + 4) = v[2 * j + 1] * rstd * gg[2 * j + 1]; }
    }
}

constexpr int SGU_PITCH = 136;
__device__ __forceinline__ void sgu_unit(Frame& F, const Ptrs& P, int hu) {
    unsigned char* ws = P.ws; const int b = hu >> 6, c = (hu >> 1) & 31, gh = hu & 1, tok0 = b * SEQ + c * 128;
    const bf16* VV = (const bf16*)(ws + WS_VV); const bf16* U = (const bf16*)(ws + WS_U); bf16* SG = (bf16*)(ws + WS_SG);
    LAS bf16* vnT = (LAS bf16*)F.lds;
    int tid = F.tid; asm volatile("" : "+v"(tid));
    const int w = __builtin_amdgcn_readfirstlane(tid >> 6), lane = tid & 63;
    const int gl = w >> 1, th = w & 1, g = 4 * gh + gl, r32 = lane & 31, hi = lane >> 5;
    u32x4 rs[16], ru[8];
#pragma unroll
    for (int i = 0; i < 16; ++i) rs[i] = *((const u32x4*)(VV + (size_t)(tok0 + 16 * w + i) * SW) + lane);
#pragma unroll
    for (int j = 0; j < 8; ++j) { const int idx = lane + 64 * j; ru[j] = *(const u32x4*)(U + (size_t)(tok0 + 64 * th + (idx >> 3)) * SW + g * 64 + 8 * (idx & 7)); }
    const int chunk = lane & 31; const bool mine = (lane >> 5) == gh;
    const f32x4 g0 = *(const f32x4*)(P.ln_g + 8 * lane), g1 = *(const f32x4*)(P.ln_g + 8 * lane + 4), b0 = *(const f32x4*)(P.ln_b + 8 * lane), b1 = *(const f32x4*)(P.ln_b + 8 * lane + 4);
#pragma unroll
    for (int i = 0; i < 16; ++i) { float v[8]; float s1 = 0.f, s2 = 0.f;
#pragma unroll
        for (int e = 0; e < 4; ++e) { v[2 * e] = bf2f(rs[i][e] & 0xffffu); v[2 * e + 1] = bf2f(rs[i][e] >> 16); s1 += v[2 * e] + v[2 * e + 1]; s2 += v[2 * e] * v[2 * e] + v[2 * e + 1] * v[2 * e + 1]; }
#pragma unroll
        for (int o = 1; o < 64; o <<= 1) { s1 += __shfl_xor(s1, o); s2 += __shfl_xor(s2, o); }
        const float mu = s1 * (1.f / SW), rstd = 1.f / sqrtf(fmaxf(s2 * (1.f / SW) - mu * mu, 0.f) + EPS);
        if (mine) { const int sp = (16 * w + i) ^ ((chunk & 15) << 3);
#pragma unroll
            for (int e = 0; e < 8; ++e) { const float gg = e < 4 ? g0[e] : g1[e - 4], bb = e < 4 ? b0[e] : b1[e - 4]; vnT[(8 * chunk + e) * SGU_PITCH + sp] = (bf16)f2bf((v[e] - mu) * rstd * gg + bb); } } }
    const bf16* Wg = (const bf16*)(ws + WS_WSP) + (size_t)g * 128 * 128;
    const int nst = 4 * th + 4;
    bf16x8 wf[2][8];
#pragma unroll
    for (int tt = 0; tt < 2; ++tt)
#pragma unroll
        for (int ks = 0; ks < 8; ++ks) { const int t = 64 * th + 32 * tt + r32, s0 = 16 * ks + 8 * hi; wf[tt][ks] = *(const bf16x8*)(Wg + (size_t)t * 128 + s0); }
    const float bias0 = P.b_sp[g * 128 + 64 * th + r32], bias1 = P.b_sp[g * 128 + 64 * th + 32 + r32];
    LDS_BARRIER();
    f32x16 acc[2][2];
#pragma unroll
    for (int dt = 0; dt < 2; ++dt)
#pragma unroll
        for (int tt = 0; tt < 2; ++tt) acc[dt][tt] = f32x16{};
#pragma unroll
    for (int ks = 0; ks < 8; ++ks) { if (ks < nst) {
        const int s0 = 16 * ks + 8 * hi; bf16x8 af[2];
#pragma unroll
        for (int dt = 0; dt < 2; ++dt) { const int cc = 64 * gl + 32 * dt + r32; af[dt] = *(const LAS bf16x8*)(vnT + cc * SGU_PITCH + (s0 ^ (((cc >> 3) & 15) << 3))); }
#pragma unroll
        for (int tt = 0; tt < 2; ++tt) {
#pragma unroll
            for (int dt = 0; dt < 2; ++dt) acc[dt][tt] = __builtin_amdgcn_mfma_f32_32x32x16_bf16(af[dt], wf[tt][ks], acc[dt][tt], 0, 0, 0); } } }
    LDS_BARRIER();
    LAS bf16* ost = (LAS bf16*)(F.lds + w * (64 * 72 * 2));
#pragma unroll
    for (int tt = 0; tt < 2; ++tt) { const float bias = tt ? bias1 : bias0;
#pragma unroll
        for (int dt = 0; dt < 2; ++dt)
#pragma unroll
            for (int q = 0; q < 4; ++q) { u32x2 ov; ov.x = cvt_pk_bf16(acc[dt][tt][4 * q] + bias, acc[dt][tt][4 * q + 1] + bias); ov.y = cvt_pk_bf16(acc[dt][tt][4 * q + 2] + bias, acc[dt][tt][4 * q + 3] + bias);
                *(LAS u32x2*)(ost + (32 * tt + r32) * 72 + 32 * dt + 8 * q + 4 * hi) = ov; } }
    asm volatile("s_waitcnt lgkmcnt(0)" ::: "memory");
#pragma unroll
    for (int j = 0; j < 8; ++j) { const int idx = lane + 64 * j, row = idx >> 3, ch = idx & 7; const u32x4 m = *(const LAS u32x4*)(ost + row * 72 + 8 * ch); const u32x4 uu = ru[j]; u32x4 o;
#pragma unroll
        for (int e = 0; e < 4; ++e) o[e] = cvt_pk_bf16(bf2f(uu[e] & 0xffffu) * bf2f(m[e] & 0xffffu), bf2f(uu[e] >> 16) * bf2f(m[e] >> 16));
        const size_t tok = (size_t)(tok0 + 64 * th + row); const int cch = g * 64 + 8 * ch;
        *(u32x4*)(P3_FUSED ? (bf16*)(ws + WS_O) + tok * 1024 + 512 + cch : SG + tok * SW + cch) = o; }
    LDS_BARRIER();
}
__device__ __forceinline__ void p2_mixer(Frame& F, const Ptrs& P, char* lds_generic, int nrep) {
    unsigned char* ws = P.ws;
    const attn_body::bf16* Q = (const attn_body::bf16*)(ws + WS_Q); const attn_body::bf16* K = (const attn_body::bf16*)(ws + WS_K); const attn_body::bf16* V = (const attn_body::bf16*)(ws + WS_V);
    const float* KM = (const float*)(ws + WS_CTL) + CW_KM; attn_body::bf16* O = (attn_body::bf16*)(ws + WS_O);
    SUBSTAMP(14);
    for (int p = F.vcu; p < NBATCH * NH * 8; p += F.G) { const int bh = p >> 3, s = p & 7;
        for (int r = 0; r < 2 * nrep; ++r)
            attn_body::attn_unit<8>(bh / NH, bh % NH, (r & 1) ? 15 - s : s, Q, K, V, KM, O, lds_generic); }
    SUBSTAMP(12);
    for (int hu = F.vcu; hu < NBATCH * 32 * 2; hu += F.G) for (int r = 0; r < SGU_REP; ++r) sgu_unit(F, P, hu);
    SUBSTAMP(13);
}

struct Args { Ptrs P; int ph_lo, ph_hi, li, pad; };
__global__ void __launch_bounds__(NWAVES * 64, 2) fwd(Args args) {
    extern __shared__ __attribute__((aligned(16))) unsigned char lds_raw[];
    Frame F; F.lds = (LAS unsigned char*)lds_raw; F.tid = threadIdx.x; F.lane = F.tid & 63; F.wave = __builtin_amdgcn_readfirstlane(F.tid >> 6);
    F.G = gridDim.x; { const int bx = blockIdx.x; F.vcu = (F.G % 8 == 0) ? (bx % 8) * (F.G / 8) + bx / 8 : bx; }
    const Ptrs& P = args.P; unsigned char* ws = P.ws; unsigned* ctl = (unsigned*)(ws + WS_CTL);
    if (F.tid < 4) ((LAS unsigned*)(F.lds + LX_BAR))[F.tid] = 0u;
    __syncthreads();
    XcdBarrier bar = xcd_barrier_post(ctl + CW_BAR + args.li * XCD_BAR_WORDS, (volatile LAS unsigned*)(F.lds + LX_BAR));
    const int lo = args.ph_lo, hi = args.ph_hi;
#define IN(k) (lo <= (k) && (k) < hi)
#define STAMP(i) do { if (PROBE_K >= 0 && blockIdx.x == 0 && F.tid == 0) { ((LAS unsigned long long*)(F.lds + LX_MISC))[i] = __builtin_amdgcn_s_memrealtime(); } } while (0)
#ifndef REP_PHASE
#define REP_PHASE -1
#endif
#define REPS(k) (((k) == REP_PHASE) ? 2 : 1)
#define SEAM(k) do { if (IN(k) && IN((k) + 1)) { STAMP(20 + (k)); xcd_barrier(bar); } } while (0)

    STAMP(0);
    if (IN(0)) _Pragma("unroll") for (int rep_ = 0; rep_ < REPS(0); ++rep_) { p0_prologue(F, P); if (rep_ + 1 < REPS(0)) xcd_barrier(bar); else SEAM(0); }
    STAMP(1);
    if (IN(1)) _Pragma("unroll") for (int rep_ = 0; rep_ < REPS(1); ++rep_) {
        DenseSched S{(const char*)(ws + WS_XN), (const char*)(ws + WS_WIN), D, D, T / 256, IN_I8 ? IN_BF_TILES : NIN / 256, F.G, (int)blockIdx.x, WGM_IN};
        EpiIn E{ws, (float*)(ws + WS_CTL) + CW_KM};
        pg8::gemm_phase<EpiIn, DenseSched, true>(F.lds, D, D, S, E);
#if IN_I8
        BalSched S2{(const char*)(ws + WS_XNQ), (const char*)(ws + WS_WINQ), D / 2, D / 2, T / 256, NIN / 256 - IN_BF_TILES, F.G, (int)blockIdx.x, (T / 256) * IN_BF_TILES};
        EpiInQ E2{ws, (const float*)(ws + WS_SXN), (const float*)(ws + WS_SBIN), (float*)(ws + WS_CTL) + CW_KM, F.lds};
        pg8::gemm_phase<EpiInQ, BalSched, true>(F.lds, D / 2, D / 2, S2, E2);
#endif
        if (rep_ + 1 < REPS(1)) xcd_barrier(bar); else SEAM(1);
    }
    STAMP(2);
    if (IN(2)) _Pragma("unroll") for (int rep_ = 0; rep_ < REPS(2); ++rep_) { p2_mixer(F, P, (char*)lds_raw, args.pad); if (rep_ + 1 < REPS(2)) xcd_barrier(bar); else SEAM(2); }
    STAMP(3);
    if (IN(3)) _Pragma("unroll") for (int rep_ = 0; rep_ < REPS(3); ++rep_) {
#if P3_FUSED
        DenseSched S{(const char*)(ws + WS_O), (const char*)(ws + WS_WA), D, D, T / 256, D / 256, F.G, (int)blockIdx.x, WGM_MID};
        EpiMergeF E{ws};
        pg8::gemm_phase<EpiMergeF, DenseSched, true>(F.lds, D, D, S, E);
#else
        MergeSched S{(const char*)(ws + WS_O), (const char*)(ws + WS_WA), F.G, (int)blockIdx.x};
        EpiMerge E{ws};
        pg8::gemm_phase<EpiMerge, MergeSched, true>(F.lds, AW, AW, S, E);
#endif
        if (rep_ + 1 < REPS(3)) xcd_barrier(bar); else SEAM(3);
    }
    STAMP(4);
    if (IN(4)) _Pragma("unroll") for (int rep_ = 0; rep_ < REPS(4); ++rep_) {
        DenseSched S{(const char*)(ws + WS_MG), (const char*)(ws + WS_WM), D, D, T / 256, D / 256, F.G, (int)blockIdx.x, WGM_MID};
        EpiH1 E{P.x, (float*)(ws + WS_H1), (bf16*)(ws + WS_H1B)};
        pg8::gemm_phase<EpiH1, DenseSched, true>(F.lds, D, D, S, E);
        if (rep_ + 1 < REPS(4)) xcd_barrier(bar); else SEAM(4);
    }
    STAMP(5);
    if (IN(5)) { p5_router(F, P); xcd_barrier(bar); p5b_lists(F, P); SEAM(5); }
    STAMP(6);
    if (IN(6)) _Pragma("unroll") for (int rep_ = 0; rep_ < REPS(6); ++rep_) {
        moe_tables(F, ctl);
#if MOE_I8
        MoeSched<true> S{(const char*)(ws + WS_H1Q), (const char*)(ws + WS_WGU), (const int*)(ws + WS_LIST), (const LAS int*)(F.lds + LX_TBASE), (const LAS int*)(F.lds + LX_TILEE), ctl, 8, F.G, (int)blockIdx.x, D / 2};
        EpiGuQ E{(const float*)(ws + WS_RLIST), (const float*)(ws + WS_SB), P.b_gu, (bf16*)(ws + WS_HID), F.lds};
        pg8::gemm_phase<EpiGuQ, MoeSched<true>, true>(F.lds, D / 2, D / 2, S, E);
#else
        MoeSched<true> S{(const char*)(ws + WS_H1B), (const char*)(ws + WS_WGU), (const int*)(ws + WS_LIST), (const LAS int*)(F.lds + LX_TBASE), (const LAS int*)(F.lds + LX_TILEE), ctl, 8, F.G, (int)blockIdx.x, D};
        EpiGu E{(const float*)(ws + WS_RLIST), P.b_gu, (bf16*)(ws + WS_HID)};
        pg8::gemm_phase<EpiGu, MoeSched<true>, true>(F.lds, D, D, S, E);
#endif
        if (rep_ + 1 < REPS(6)) xcd_barrier(bar); else SEAM(6);
    }
    STAMP(7);
    if (IN(7)) _Pragma("unroll") for (int rep_ = 0; rep_ < REPS(7); ++rep_) {
        if (!IN(6)) moe_tables(F, ctl);
        MoeSched<false> S{(const char*)(ws + WS_HID), (const char*)(ws + WS_WD), nullptr, (const LAS int*)(F.lds + LX_TBASE), (const LAS int*)(F.lds + LX_TILEE), ctl, 4, F.G, (int)blockIdx.x, MOE_F8 ? DE / 2 : DE};
        EpiDown E{P.b_down, (bf16*)(ws + WS_Y), F.lds};
        pg8::gemm_phase<EpiDown, MoeSched<false>, true>(F.lds, MOE_F8 ? DE / 2 : DE, MOE_F8 ? DE / 2 : DE, S, E);
        if (rep_ + 1 < REPS(7)) xcd_barrier(bar); else SEAM(7);
    }
    STAMP(8);
    if (IN(8)) _Pragma("unroll") for (int rep_ = 0; rep_ < REPS(8); ++rep_) { if (!IN(6)) moe_tables(F, ctl); p8_combine(F, P); if (rep_ + 1 < REPS(8)) xcd_barrier(bar); }
    STAMP(9);
    if (PROBE_K >= 0 && blockIdx.x == 0 && F.tid == 0) { const LAS unsigned long long* ts = (const LAS unsigned long long*)(F.lds + LX_MISC); const unsigned long long d = (PROBE_K == 9) ? ts[9] - ts[0] : (PROBE_K == 40) ? (ts[1] - ts[20]) + (ts[2] - ts[21]) + (ts[3] - ts[22]) + (ts[4] - ts[23]) + (ts[5] - ts[24]) + (ts[6] - ts[25]) + (ts[7] - ts[26]) + (ts[8] - ts[27]) : (PROBE_K == 24) ? ts[12] - ts[14] : (PROBE_K == 23) ? ts[13] - ts[12] : (PROBE_K == 20) ? ts[10] - ts[0] : (PROBE_K == 21) ? ts[11] - ts[10] : (PROBE_K == 22) ? ts[1] - ts[11] : ts[(PROBE_K + 1) % 10] - ts[PROBE_K % 10], t0 = __builtin_amdgcn_s_memrealtime();
        while (__builtin_amdgcn_s_memrealtime() - t0 < d) __builtin_amdgcn_s_sleep(8); }
#undef IN
#undef SEAM
}

#ifndef ATTN_REP
#define ATTN_REP 1
#endif
#ifndef REDO_MASK
#define REDO_MASK 0x000
#endif
#ifndef OPT_MASK
#define OPT_MASK 0x1FF
#endif
static void naive_phase(int k, const Ptrs& P, hipStream_t stream) {
    unsigned char* ws = P.ws;
    switch (k) {
    case 0:
        n_cvtT<<<dim3(NIN / 32, D / 32, 1), 256, 0, stream>>>(P.w_in, (bf16*)(ws + WS_WIN), D, NIN, nullptr);
        n_cvtT<<<dim3(D / 32, AW / 32, 1), 256, 0, stream>>>(P.w_attn_out, (bf16*)(ws + WS_WA), AW, D, nullptr);
        n_cvtT<<<dim3(D / 32, SW / 32, 1), 256, 0, stream>>>(P.w_sgu_out, (bf16*)(ws + WS_WS), SW, D, nullptr);
        n_cvtT<<<dim3(D / 32, D / 32, 1), 256, 0, stream>>>(P.w_mix_out, (bf16*)(ws + WS_WM), D, D, nullptr);
        n_cvtT<<<dim3(2 * DE / 32, D / 32, NE), 256, 0, stream>>>(P.w_gu, (bf16*)(ws + WS_WGU), D, 2 * DE, P.ffn_g);
        n_cvtT<<<dim3(D / 32, DE / 32, NE), 256, 0, stream>>>(P.w_down, (bf16*)(ws + WS_WD), DE, D, nullptr);
        n_cvt_router<<<NE * D / 256, 256, 0, stream>>>(P.w_router, P.ffn_g, (bf16*)(ws + WS_WR), (bf16*)(ws + WS_WR) + NE * D);
        n_rmsnorm<<<T / 4, 256, 0, stream>>>(P.x, P.mix_g, (bf16*)(ws + WS_XN));
        break;
    case 1:
        n_gemm<EPI_IN><<<dim3(NIN / 128, T / 128), 256, 0, stream>>>((const bf16*)(ws + WS_XN), D, (const bf16*)(ws + WS_WIN), D, D, P);
        n_kmean<<<NBATCH * NBLK * AW / 256, 256, 0, stream>>>((const bf16*)(ws + WS_K), (float*)(ws + WS_CTL) + CW_KM);
        break;
    case 2:
        n_attn<<<T * NH / 4, 256, 0, stream>>>((const bf16*)(ws + WS_Q), (const bf16*)(ws + WS_K), (const bf16*)(ws + WS_V), (const float*)(ws + WS_CTL) + CW_KM, (bf16*)(ws + WS_O));
        n_sgu_stats<<<T / 4, 256, 0, stream>>>((const bf16*)(ws + WS_VV), (float*)(ws + WS_STATS));
        n_sgu<<<T * SW / 256, 256, 0, stream>>>((const bf16*)(ws + WS_U), (const bf16*)(ws + WS_VV), (const float*)(ws + WS_STATS), P, (bf16*)(ws + WS_SG));
        break;
    case 3:
        n_gemm<EPI_MG1><<<dim3(D / 128, T / 128), 256, 0, stream>>>((const bf16*)(ws + WS_O), AW, (const bf16*)(ws + WS_WA), AW, AW, P);
        n_gemm<EPI_MG2><<<dim3(D / 128, T / 128), 256, 0, stream>>>((const bf16*)(ws + WS_SG), SW, (const bf16*)(ws + WS_WS), SW, SW, P);
        break;
    case 4: n_gemm<EPI_H1><<<dim3(D / 128, T / 128), 256, 0, stream>>>((const bf16*)(ws + WS_MG), D, (const bf16*)(ws + WS_WM), D, D, P); break;
    case 5: n_router<<<T / 4, 256, 0, stream>>>(P); break;
    case 6: n_moe_gu<<<dim3(DE / 128, NROWS_PAD / 128), 256, 0, stream>>>(P); break;
    case 7: n_moe_down<<<dim3(D / 128, NROWS_PAD / 128), 256, 0, stream>>>(P); break;
    default: n_combine<<<T / 4, 256, 0, stream>>>(P); break;
    }
}
extern "C" void kernel_launch(void* const* d_in, const int* in_sizes, int n_in, void* d_out, int out_size, void* d_ws, size_t ws_size, hipStream_t stream) {
    static int grid = 0;
    if (grid == 0) {
        if (n_in != 18 || in_sizes[0] != T * D || out_size != T * D || ws_size < WS_END) { fprintf(stderr, "kernel_launch: unexpected shapes (n_in %d, in0 %d, out %d, ws %zu)\n", n_in, n_in > 0 ? in_sizes[0] : -1, out_size, ws_size); grid = -1; return; }
        int dev = 0, cus = 0, per_cu = 0;
        if (hipGetDevice(&dev) != hipSuccess || hipDeviceGetAttribute(&cus, hipDeviceAttributeMultiprocessorCount, dev) != hipSuccess) { grid = -1; return; }
        if (hipFuncSetAttribute((const void*)fwd, hipFuncAttributeMaxDynamicSharedMemorySize, LDS_BYTES) != hipSuccess) { fprintf(stderr, "kernel_launch: hipFuncSetAttribute failed\n"); grid = -1; return; }
        if (hipOccupancyMaxActiveBlocksPerMultiprocessor(&per_cu, (const void*)fwd, NWAVES * 64, LDS_BYTES) != hipSuccess || per_cu < 1) fprintf(stderr, "kernel_launch: occupancy query says %d\n", per_cu);
        (void)hipGetLastError();
        grid = cus;
    }
    if (grid < 0) return;
    Ptrs P{};
    const float** pf = (const float**)&P;
    for (int i = 0; i < 18; ++i) pf[i] = (const float*)d_in[i];
    P.out = (float*)d_out; P.ws = (unsigned char*)d_ws;
    (void)hipMemsetAsync((unsigned char*)d_ws + WS_CTL, 0, CTL_ZERO_BYTES, stream);
    int li = 0;
    for (int k = 0; k < 9;) {
        if (!((OPT_MASK >> k) & 1)) { naive_phase(k, P, stream); ++k; continue; }
        int hi = k; while (hi < 9 && ((OPT_MASK >> hi) & 1)) ++hi;
        Args a{}; a.P = P; a.ph_lo = k; a.ph_hi = hi; a.li = li++; a.pad = ATTN_REP;
        hipLaunchKernelGGL(fwd, dim3(grid), dim3(NWAVES * 64), LDS_BYTES, stream, a);
        for (int q = k; q < hi; ++q) if ((REDO_MASK >> q) & 1) naive_phase(q, P, stream);
        k = hi;
    }
}
```

```cpp
#include <hip/hip_runtime.h>
#include <hip/hip_bf16.h>
#include <cstdio>
#include <cstdint>
#ifndef SGU_REP
#define SGU_REP 1
#ifndef EPI_PROBE
#define EPI_PROBE 0
#endif
#define EPI_PREF 1
#define WIDE_EPI 1
#define P1_DEAL 1
#define XB_RES 1
#define ZERO_PAD 1
#define ROUTER_ROWCOPY 1
#define DPP_REDUCE 1
#define GATE_IMAGE 1
#define KV_IMAGE 1
#endif
#ifndef Y_F8
#define Y_F8 1
#endif
#ifndef GATE_U8
#define GATE_U8 1
#endif
#ifndef H1_BF16
#define H1_BF16 1
#endif
#ifndef WGM_IN
#define WGM_IN 2
#endif
#ifndef WGM_MID
#define WGM_MID 2
#endif
#ifndef WGM_GU
#define WGM_GU 2
#endif
#ifndef WGM_DN
#define WGM_DN 2
#endif
#ifndef P3_FUSED
#define P3_FUSED 1
#endif
#ifndef IN_I8
#define IN_I8 1
#endif
#define IN_BF_TILES 2
#ifndef MOE_F8
#define MOE_F8 1
#endif
#ifndef MOE_I8
#define MOE_I8 1
#endif
#ifndef PROBE_K
#define PROBE_K -1
#endif

typedef unsigned short bf16;
typedef short bf16x8 __attribute__((ext_vector_type(8)));
typedef float f32x4 __attribute__((ext_vector_type(4)));
typedef unsigned u32x4 __attribute__((ext_vector_type(4)));
typedef unsigned u32x2 __attribute__((ext_vector_type(2)));
typedef int i32x4 __attribute__((ext_vector_type(4)));
typedef int i32x8 __attribute__((ext_vector_type(8)));
typedef int i32x8a __attribute__((ext_vector_type(8), aligned(16)));

constexpr int T = 16384, D = 1024, SEQ = 4096, NBATCH = 4, NH = 8, HD = 64, AW = 512, SW = 512, NIN = 4608;
constexpr int NE = 32, TOPK = 4, DE = 1024, MB = 256  , NBLK = SEQ / MB  ;
constexpr int NROWS_PAD = 73728;
constexpr float EPS = 1e-5f;
constexpr float C2 = 0.125f * 1.4426950408889634f;
constexpr float LOG2E = 1.4426950408889634f;

constexpr size_t MiB = 1u << 20;
constexpr size_t WS_CTL = 0, CTL_ZERO_BYTES = 160 * 1024;
constexpr size_t WS_WIN = 2 * MiB, WS_WA = 12 * MiB, WS_WS = 13 * MiB, WS_WM = 14 * MiB, WS_WR = 16 * MiB;
constexpr size_t WS_WGU = 32 * MiB, WS_WD = 160 * MiB, WS_XN = 224 * MiB;
constexpr size_t WS_Q = 256 * MiB, WS_K = 272 * MiB, WS_V = 288 * MiB, WS_U = 304 * MiB, WS_VV = 320 * MiB, WS_O = 336 * MiB, WS_SG = 352 * MiB;
constexpr size_t WS_GA = 368 * MiB, WS_GS = 400 * MiB, WS_MG = 432 * MiB, WS_H1 = 464 * MiB, WS_H1B = 528 * MiB;
constexpr size_t WS_LIST = 560 * MiB, WS_TOKSLOT = 562 * MiB, WS_TOKW = 563 * MiB, WS_RSTD2 = 564 * MiB, WS_STATS = 565 * MiB, WS_RLIST = 566 * MiB, WS_HIST = 568 * MiB;
constexpr size_t WS_HID = 576 * MiB, WS_Y = 720 * MiB, WS_H1Q = 864 * MiB  , WS_SB = 569 * MiB  ,
    WS_SBIN = WS_SB + 256 * 1024  , WS_SXN = WS_SB + 320 * 1024  , WS_WSP = WS_SB + 384 * 1024  , WS_XNQ = 880 * MiB  , WS_WINQ = 896 * MiB  , WS_ZROW = 900 * MiB  , WS_END = 901 * MiB;
constexpr int CW_TMO = 0, CW_CODE = 1, CW_BAR = 4096  , CW_CNT = 32768  , CW_KM = 65536  ;

struct Ptrs {
    const float *x, *mix_g, *w_in, *w_attn_out, *ln_g, *ln_b, *w_sp, *b_sp, *w_sgu_out, *w_mix_out, *ffn_g, *w_router, *b_router, *w_gu, *b_gu, *w_down, *b_down, *fin_g;
    float* out; unsigned char* ws;
};

__device__ __forceinline__ unsigned f2bf(float f) { unsigned u = __builtin_bit_cast(unsigned, f); return (u + 0x7fffu + ((u >> 16) & 1u)) >> 16; }
__device__ __forceinline__ float bf2f(unsigned h) { return __builtin_bit_cast(float, (h & 0xffffu) << 16); }
__device__ __forceinline__ float xor32f(float v, int hi) { const auto r_ = __builtin_amdgcn_permlane32_swap(__builtin_bit_cast(unsigned, v), __builtin_bit_cast(unsigned, v), false, false);
    return __builtin_bit_cast(float, hi ? r_[0] : r_[1]); }
#define DPP_F(old_, v_, ctrl, rmask) __builtin_bit_cast(float, __builtin_amdgcn_update_dpp(__builtin_bit_cast(int, (float)(old_)), __builtin_bit_cast(int, (float)(v_)), (ctrl), (rmask), 0xf, false))
__device__ __forceinline__ float row16_sum(float v) {
    v += DPP_F(0.f, v, 0xB1, 0xf); v += DPP_F(0.f, v, 0x4E, 0xf); v += DPP_F(0.f, v, 0x141, 0xf); v += DPP_F(0.f, v, 0x140, 0xf); return v; }
__device__ __forceinline__ float wave_sum(float v) {
#if DPP_REDUCE
    v = row16_sum(v); v += DPP_F(0.f, v, 0x142, 0xa); v += DPP_F(0.f, v, 0x143, 0xc);
    return __builtin_bit_cast(float, __builtin_amdgcn_readlane(__builtin_bit_cast(int, v), 63));
#else
#pragma unroll
    for (int o = 1; o < 64; o <<= 1) v += __shfl_xor(v, o);
    return v;
#endif
}
__device__ __forceinline__ float wave_max(float v) {
#if DPP_REDUCE
    v = fmaxf(v, DPP_F(v, v, 0xB1, 0xf)); v = fmaxf(v, DPP_F(v, v, 0x4E, 0xf)); v = fmaxf(v, DPP_F(v, v, 0x141, 0xf)); v = fmaxf(v, DPP_F(v, v, 0x140, 0xf));
    v = fmaxf(v, DPP_F(v, v, 0x142, 0xa)); v = fmaxf(v, DPP_F(v, v, 0x143, 0xc));
    return __builtin_bit_cast(float, __builtin_amdgcn_readlane(__builtin_bit_cast(int, v), 63));
#endif
#pragma unroll
    for (int o = 1; o < 64; o <<= 1) v = fmaxf(v, __shfl_xor(v, o));
    return v;
}
__device__ __forceinline__ float gelu_erf(float v) { return 0.5f * v * (1.f + erff(v * 0.70710678118654752f)); }
__device__ __forceinline__ float sigmoidf(float v) { return 1.f / (1.f + __expf(-v)); }
__device__ __forceinline__ float swiglu(float g, float u) {
    g = fminf(g, 7.f); u = fminf(fmaxf(u, -7.f), 7.f);
    return g * (1.f / (1.f + __expf(-1.702f * g))) * (u + 1.f);
}

__global__ __launch_bounds__(256) void n_cvtT(const float* W, bf16* WT, int K, int N, const float* kscale) {
    __shared__ float t[32][33];
    const size_t boff = (size_t)blockIdx.z * K * N; W += boff; WT += boff;
    const int k0 = blockIdx.y * 32, n0 = blockIdx.x * 32, tx = threadIdx.x & 31, ty = threadIdx.x >> 5;
    for (int i = ty; i < 32; i += 8) t[i][tx] = W[(size_t)(k0 + i) * N + n0 + tx] * (kscale ? kscale[k0 + i] : 1.f);
    __syncthreads();
    for (int i = ty; i < 32; i += 8) WT[(size_t)(n0 + i) * K + k0 + tx] = (bf16)f2bf(t[tx][i]);
}
__global__ void n_cvt_router(const float* w, const float* g, bf16* hi, bf16* lo) {
    const int i = blockIdx.x * blockDim.x + threadIdx.x; if (i >= NE * D) return;
    const int e = i / D, k = i % D; const float v = w[(size_t)k * NE + e] * g[k];
    const unsigned h = f2bf(v); hi[i] = (bf16)h; lo[i] = (bf16)f2bf(v - bf2f(h));
}
__global__ __launch_bounds__(256) void n_rmsnorm(const float* x, const float* g, bf16* xn) {
    const int row = blockIdx.x * 4 + (threadIdx.x >> 6), lane = threadIdx.x & 63;
    const f32x4* xr = (const f32x4*)(x + (size_t)row * D) + lane; f32x4 v[4]; float s = 0.f;
#pragma unroll
    for (int j = 0; j < 4; ++j) { v[j] = xr[64 * j]; s += v[j].x * v[j].x + v[j].y * v[j].y + v[j].z * v[j].z + v[j].w * v[j].w; }
    const float rstd = 1.f / sqrtf(wave_sum(s) * (1.f / D) + EPS);
#pragma unroll
    for (int j = 0; j < 4; ++j) { const f32x4 gg = ((const f32x4*)g)[lane + 64 * j];
        u32x2 o; o.x = f2bf(v[j].x * rstd * gg.x) | (f2bf(v[j].y * rstd * gg.y) << 16); o.y = f2bf(v[j].z * rstd * gg.z) | (f2bf(v[j].w * rstd * gg.w) << 16);
        *((u32x2*)(xn + (size_t)row * D) + lane + 64 * j) = o; }
}

__device__ __forceinline__ void wave_gemm64(const bf16* a0, const bf16* a1, const bf16* a2, const bf16* a3, const bf16* b0, const bf16* b1, const bf16* b2, const bf16* b3, int K, f32x4 (&acc)[4][4]) {
    for (int k = 0; k < K; k += 32) {
        bf16x8 a[4], b[4];
        a[0] = *(const bf16x8*)(a0 + k); a[1] = *(const bf16x8*)(a1 + k); a[2] = *(const bf16x8*)(a2 + k); a[3] = *(const bf16x8*)(a3 + k);
        b[0] = *(const bf16x8*)(b0 + k); b[1] = *(const bf16x8*)(b1 + k); b[2] = *(const bf16x8*)(b2 + k); b[3] = *(const bf16x8*)(b3 + k);
#pragma unroll
        for (int mi = 0; mi < 4; ++mi)
#pragma unroll
            for (int ni = 0; ni < 4; ++ni) acc[mi][ni] = __builtin_amdgcn_mfma_f32_16x16x32_bf16(a[mi], b[ni], acc[mi][ni], 0, 0, 0);
    }
}
#define ZERO_ACC(acc) _Pragma("unroll") for (int _a = 0; _a < 4; ++_a) _Pragma("unroll") for (int _b = 0; _b < 4; ++_b) acc[_a][_b] = (f32x4){0.f, 0.f, 0.f, 0.f}

enum { EPI_IN = 0, EPI_MG1 = 1, EPI_MG2 = 2, EPI_H1 = 3 };
template <int MODE>
__global__ __launch_bounds__(256) void n_gemm(const bf16* A, int lda, const bf16* Bt, int ldb, int K, Ptrs P) {
    const int lane = threadIdx.x & 63, w = threadIdx.x >> 6, wy = w >> 1, wx = w & 1;
    const int row0 = blockIdx.y * 128 + wy * 64, col0 = blockIdx.x * 128 + wx * 64;
    const int lr = lane & 15, lq = lane >> 4;
    const bf16* ap = A + (size_t)(row0 + lr) * lda + 8 * lq; const bf16* bp = Bt + (size_t)(col0 + lr) * ldb + 8 * lq;
    f32x4 acc[4][4]; ZERO_ACC(acc);
    wave_gemm64(ap, ap + 16 * (size_t)lda, ap + 32 * (size_t)lda, ap + 48 * (size_t)lda, bp, bp + 16 * (size_t)ldb, bp + 32 * (size_t)ldb, bp + 48 * (size_t)ldb, K, acc);
    unsigned char* ws = P.ws;
#pragma unroll
    for (int mi = 0; mi < 4; ++mi)
#pragma unroll
        for (int ni = 0; ni < 4; ++ni)
#pragma unroll
            for (int j = 0; j < 4; ++j) {
                const int row = row0 + 16 * mi + lq * 4 + j, col = col0 + 16 * ni + lr; const float v = acc[mi][ni][j];
                if (MODE == EPI_IN) {
                    if (col < 512) ((bf16*)(ws + WS_Q))[(size_t)row * 512 + col] = (bf16)f2bf(v * C2);
                    else if (col < 1024) ((bf16*)(ws + WS_K))[(size_t)row * 512 + col - 512] = (bf16)f2bf(v);
                    else if (col < 1536) ((bf16*)(ws + WS_V))[(size_t)row * 512 + col - 1024] = (bf16)f2bf(v);
                    else if (col < 2048) ((bf16*)(ws + WS_U))[(size_t)row * 512 + col - 1536] = (bf16)f2bf(gelu_erf(v));
                    else if (col < 2560) ((bf16*)(ws + WS_VV))[(size_t)row * 512 + col - 2048] = (bf16)f2bf(gelu_erf(v));
                    else if (col < 3584) ((bf16*)(ws + WS_GA))[(size_t)row * 1024 + col - 2560] = (bf16)f2bf(sigmoidf(v));
                    else ((bf16*)(ws + WS_GS))[(size_t)row * 1024 + col - 3584] = (bf16)f2bf(sigmoidf(v));
                } else if (MODE == EPI_MG1) {
                    const size_t o = (size_t)row * 1024 + col; ((bf16*)(ws + WS_MG))[o] = (bf16)f2bf(v * bf2f(((const bf16*)(ws + WS_GA))[o]));
                } else if (MODE == EPI_MG2) {
                    const size_t o = (size_t)row * 1024 + col; bf16* mg = (bf16*)(ws + WS_MG); mg[o] = (bf16)f2bf(bf2f(mg[o]) + v * bf2f(((const bf16*)(ws + WS_GS))[o]));
                } else {
                    const size_t o = (size_t)row * 1024 + col; const float h = P.x[o] + v; ((float*)(ws + WS_H1))[o] = h; ((bf16*)(ws + WS_H1B))[o] = (bf16)f2bf(h);
                }
            }
}
__global__ void n_kmean(const bf16* Kb, float* KM) {
    const int i = blockIdx.x * blockDim.x + threadIdx.x; if (i >= NBATCH * NBLK * AW) return;
    const int c = i % AW, bb = i / AW; float s = 0.f;
    for (int r = 0; r < MB; ++r) s += bf2f(Kb[(size_t)(bb * MB + r) * AW + c]);
    KM[i] = s * (1.f / MB);
}
__global__ __launch_bounds__(256) void n_attn(const bf16* Q, const bf16* Kb, const bf16* Vb, const float* KM, bf16* O) {
    __shared__ float qs[4][64];
    const int lane = threadIdx.x & 63, w = threadIdx.x >> 6, gw = blockIdx.x * 4 + w, tok = gw >> 3, h = gw & 7;
    const int b = tok / SEQ, t = tok % SEQ, blk = t / MB;
    const float qd = bf2f(Q[(size_t)tok * AW + h * HD + lane]);
    qs[w][lane] = qd; __syncthreads();
    float g[16];
#pragma unroll
    for (int j = 0; j < 16; ++j) { float p = (j < blk) ? qd * KM[(size_t)(b * NBLK + j) * AW + h * HD + lane] : 0.f; p = wave_sum(p); g[j] = (j < blk) ? p : -INFINITY; }
    int sel[4];
#pragma unroll
    for (int s = 0; s < 3; ++s) { int best = -1; float bv = -INFINITY;
#pragma unroll
        for (int j = 0; j < 16; ++j) if (g[j] > bv) { bv = g[j]; best = j; }
#pragma unroll
        for (int j = 0; j < 16; ++j) if (j == best) g[j] = -INFINITY;
        sel[s] = best; }
    sel[3] = blk;
    const float slope2 = exp2f(-(float)(h + 1)) * LOG2E;
    float sc[16];
#pragma unroll
    for (int s = 0; s < 4; ++s) {
        const int kb = sel[s];
#pragma unroll
        for (int c = 0; c < 4; ++c) {
            float v = -INFINITY;
            if (kb >= 0) { const int key = kb * MB + c * 64 + lane;
                if (key <= t) { const bf16* kr = Kb + (size_t)(b * SEQ + key) * AW + h * HD; float a = 0.f;
                    for (int d8 = 0; d8 < 8; ++d8) { const u32x4 kk = *(const u32x4*)(kr + d8 * 8);
#pragma unroll
                        for (int e = 0; e < 4; ++e) { a += qs[w][d8 * 8 + 2 * e] * bf2f(kk[e] & 0xffffu) + qs[w][d8 * 8 + 2 * e + 1] * bf2f(kk[e] >> 16); } }
                    v = a + slope2 * (float)(key - t); } }
            sc[s * 4 + c] = v; }
    }
    float m = sc[0];
#pragma unroll
    for (int i = 1; i < 16; ++i) m = fmaxf(m, sc[i]);
    m = wave_max(m); float l = 0.f;
#pragma unroll
    for (int i = 0; i < 16; ++i) { sc[i] = (sc[i] == -INFINITY) ? 0.f : exp2f(sc[i] - m); l += sc[i]; }
    l = wave_sum(l); float o = 0.f;
#pragma unroll
    for (int s = 0; s < 4; ++s) { const int kb = sel[s]; if (kb < 0) continue;
#pragma unroll
        for (int c = 0; c < 4; ++c) { const int key0 = kb * MB + c * 64; if (key0 > t) continue;
            const bf16* vr = Vb + (size_t)(b * SEQ + key0) * AW + h * HD + lane;
            for (int kl = 0; kl < 64; ++kl) { const float p = __shfl(sc[s * 4 + c], kl); o += p * bf2f(vr[(size_t)kl * AW]); } } }
    O[(size_t)tok * AW + h * HD + lane] = (bf16)f2bf(o / l);
}
__global__ __launch_bounds__(256) void n_sgu_stats(const bf16* VV, float* stats) {
    const int row = blockIdx.x * 4 + (threadIdx.x >> 6), lane = threadIdx.x & 63;
    const u32x4 r = *((const u32x4*)(VV + (size_t)row * SW) + lane); float v[8];
#pragma unroll
    for (int e = 0; e < 4; ++e) { v[2 * e] = bf2f(r[e] & 0xffffu); v[2 * e + 1] = bf2f(r[e] >> 16); }
    float s = 0.f;
#pragma unroll
    for (int e = 0; e < 8; ++e) s += v[e];
    const float mu = wave_sum(s) * (1.f / SW); float q = 0.f;
#pragma unroll
    for (int e = 0; e < 8; ++e) q += (v[e] - mu) * (v[e] - mu);
    const float rstd = 1.f / sqrtf(wave_sum(q) * (1.f / SW) + EPS);
    if (lane == 0) { stats[2 * row] = mu; stats[2 * row + 1] = rstd; }
}
__global__ __launch_bounds__(256) void n_sgu(const bf16* U, const bf16* VV, const float* stats, Ptrs P, bf16* SG) {
    const int i = blockIdx.x * 256 + threadIdx.x, tok = i / SW, c = i % SW, g = c / 64, tl = tok % 128, s0 = tok - tl;
    const float lg = P.ln_g[c], lb = P.ln_b[c]; const float* wr = P.w_sp + ((size_t)g * 128 + tl) * 128; float a = 0.f;
    for (int s = 0; s <= tl; ++s) { const float vn = (bf2f(VV[(size_t)(s0 + s) * SW + c]) - stats[2 * (s0 + s)]) * stats[2 * (s0 + s) + 1] * lg + lb; a += wr[s] * vn; }
    SG[i] = (bf16)f2bf(bf2f(U[i]) * (a + P.b_sp[g * 128 + tl]));
}
__global__ __launch_bounds__(256) void n_router(Ptrs P) {
    unsigned char* ws = P.ws; const int tok = blockIdx.x * 4 + (threadIdx.x >> 6), lane = threadIdx.x & 63;
    const f32x4* hr = (const f32x4*)((const float*)(ws + WS_H1) + (size_t)tok * D) + lane; f32x4 v[4]; float s = 0.f;
#pragma unroll
    for (int j = 0; j < 4; ++j) { v[j] = hr[64 * j]; s += v[j].x * v[j].x + v[j].y * v[j].y + v[j].z * v[j].z + v[j].w * v[j].w; }
    const float rstd = 1.f / sqrtf(wave_sum(s) * (1.f / D) + EPS);
#pragma unroll
    for (int j = 0; j < 4; ++j) { const f32x4 gg = ((const f32x4*)P.ffn_g)[lane + 64 * j]; v[j] = v[j] * gg; }
    float lg[32];
#pragma unroll
    for (int e = 0; e < 32; ++e) { float a = 0.f;
#pragma unroll
        for (int j = 0; j < 4; ++j) { const float* wr = P.w_router + (size_t)(4 * lane + 256 * j) * NE + e; a += v[j].x * wr[0] + v[j].y * wr[NE] + v[j].z * wr[2 * NE] + v[j].w * wr[3 * NE]; }
        lg[e] = wave_sum(a) * rstd + P.b_router[e]; }
    int idx[4]; float val[4];
#pragma unroll
    for (int k = 0; k < 4; ++k) { int best = 0; float bv = -INFINITY;
#pragma unroll
        for (int e = 0; e < 32; ++e) if (lg[e] > bv) { bv = lg[e]; best = e; }
#pragma unroll
        for (int e = 0; e < 32; ++e) if (e == best) lg[e] = -INFINITY;
        idx[k] = best; val[k] = bv; }
    float den = 0.f, pw[4];
#pragma unroll
    for (int k = 0; k < 4; ++k) { pw[k] = __expf(val[k] - val[0]); den += pw[k]; }
    if (lane == 0) {
        unsigned* ctl = (unsigned*)(ws + WS_CTL); int* list = (int*)(ws + WS_LIST); unsigned* slot = (unsigned*)(ws + WS_TOKSLOT); float* tw = (float*)(ws + WS_TOKW);
#pragma unroll
        for (int k = 0; k < 4; ++k) { const unsigned pos = atomicAdd(ctl + CW_CNT + 64 * idx[k], 1u); list[(size_t)idx[k] * T + pos] = tok;
            slot[tok * 4 + k] = (unsigned)idx[k] | (pos << 8); tw[tok * 4 + k] = pw[k] / den; }
        ((float*)(ws + WS_RSTD2))[tok] = rstd;
        for (int k = 0; k < 4; ++k) { const unsigned s2 = slot[tok * 4 + k]; ((float*)(ws + WS_RLIST))[(size_t)(s2 & 0xff) * T + (s2 >> 8)] = rstd; }
    }
}
__device__ __forceinline__ bool tile_lookup(const unsigned* ctl, int mt, int& e, int& lt, int& cnt) {
    int base = 0;
    for (int i = 0; i < NE; ++i) { const int c = (int)ctl[CW_CNT + 64 * i], nt = (c + 255) >> 8; if (mt < base + nt) { e = i; lt = mt - base; cnt = c; return true; } base += nt; }
    return false;
}
__device__ __forceinline__ int expert_rowbase(const unsigned* ctl, int e) { int base = 0; for (int i = 0; i < e; ++i) base += ((int)ctl[CW_CNT + 64 * i] + 255) >> 8; return base * 256; }
__global__ __launch_bounds__(256) void n_moe_gu(Ptrs P) {
    unsigned char* ws = P.ws; const unsigned* ctl = (const unsigned*)(ws + WS_CTL);
    const int lane = threadIdx.x & 63, w = threadIdx.x >> 6, wy = w >> 1, wx = w & 1, lr = lane & 15, lq = lane >> 4;
    const int mt = blockIdx.y >> 1; int e, lt, cnt; if (!tile_lookup(ctl, mt, e, lt, cnt)) return;
    const int* list = (const int*)(ws + WS_LIST) + (size_t)e * T; const bf16* A = (const bf16*)(ws + WS_H1B); const bf16* Bt = (const bf16*)(ws + WS_WGU) + (size_t)e * 2048 * D;
    const int prow0 = lt * 256 + (blockIdx.y & 1) * 128 + wy * 64;
    const int j0 = blockIdx.x * 128 + wx * 64;
    const bf16* ap[4];
#pragma unroll
    for (int i = 0; i < 4; ++i) { const int pos = prow0 + 16 * i + lr; const int tok = list[pos < cnt ? pos : lt * 256]; ap[i] = A + (size_t)tok * D + 8 * lq; }
    const bf16* bg = Bt + (size_t)(2 * (j0 + lr)) * D + 8 * lq; const bf16* bu = bg + D;
    f32x4 accg[4][4], accu[4][4]; ZERO_ACC(accg); ZERO_ACC(accu);
    wave_gemm64(ap[0], ap[1], ap[2], ap[3], bg, bg + 32 * (size_t)D, bg + 64 * (size_t)D, bg + 96 * (size_t)D, D, accg);
    wave_gemm64(ap[0], ap[1], ap[2], ap[3], bu, bu + 32 * (size_t)D, bu + 64 * (size_t)D, bu + 96 * (size_t)D, D, accu);
    const float* rs = (const float*)(ws + WS_RSTD2); const float* bgu = P.b_gu + (size_t)e * 2048; bf16* HID = (bf16*)(ws + WS_HID);
#pragma unroll
    for (int mi = 0; mi < 4; ++mi)
#pragma unroll
        for (int j = 0; j < 4; ++j) { const int pos = prow0 + 16 * mi + lq * 4 + j; const int tok = list[pos < cnt ? pos : lt * 256]; const float r = rs[tok];
            const size_t orow = (size_t)mt * 256 + (blockIdx.y & 1) * 128 + wy * 64 + 16 * mi + lq * 4 + j;
#pragma unroll
            for (int ni = 0; ni < 4; ++ni) { const int jc = j0 + 16 * ni + lr; HID[orow * DE + jc] = (bf16)f2bf(swiglu(accg[mi][ni][j] * r + bgu[2 * jc], accu[mi][ni][j] * r + bgu[2 * jc + 1])); } }
}
__global__ __launch_bounds__(256) void n_moe_down(Ptrs P) {
    unsigned char* ws = P.ws; const unsigned* ctl = (const unsigned*)(ws + WS_CTL);
    const int lane = threadIdx.x & 63, w = threadIdx.x >> 6, wy = w >> 1, wx = w & 1, lr = lane & 15, lq = lane >> 4;
    const int mt = blockIdx.y >> 1; int e, lt, cnt; if (!tile_lookup(ctl, mt, e, lt, cnt)) return;
    const int row0 = blockIdx.y * 128 + wy * 64, col0 = blockIdx.x * 128 + wx * 64;
    const bf16* ap = (const bf16*)(ws + WS_HID) + (size_t)(row0 + lr) * DE + 8 * lq; const bf16* bp = (const bf16*)(ws + WS_WD) + ((size_t)e * D + col0 + lr) * DE + 8 * lq;
    f32x4 acc[4][4]; ZERO_ACC(acc);
    wave_gemm64(ap, ap + 16 * (size_t)DE, ap + 32 * (size_t)DE, ap + 48 * (size_t)DE, bp, bp + 16 * (size_t)DE, bp + 32 * (size_t)DE, bp + 48 * (size_t)DE, DE, acc);
    bf16* Y = (bf16*)(ws + WS_Y); const float* bd = P.b_down + (size_t)e * D;
#pragma unroll
    for (int mi = 0; mi < 4; ++mi)
#pragma unroll
        for (int ni = 0; ni < 4; ++ni)
#pragma unroll
            for (int j = 0; j < 4; ++j) { const int row = row0 + 16 * mi + lq * 4 + j, col = col0 + 16 * ni + lr; Y[(size_t)row * D + col] = (bf16)f2bf(acc[mi][ni][j] + bd[col]); }
}
__global__ __launch_bounds__(256) void n_combine(Ptrs P) {
    unsigned char* ws = P.ws; const unsigned* ctl = (const unsigned*)(ws + WS_CTL);
    const int tok = blockIdx.x * 4 + (threadIdx.x >> 6), lane = threadIdx.x & 63;
    const f32x4* hr = (const f32x4*)((const float*)(ws + WS_H1) + (size_t)tok * D) + lane; f32x4 v[4];
#pragma unroll
    for (int j = 0; j < 4; ++j) v[j] = hr[64 * j];
    const unsigned* slot = (const unsigned*)(ws + WS_TOKSLOT) + tok * 4; const float* tw = (const float*)(ws + WS_TOKW) + tok * 4; const bf16* Y = (const bf16*)(ws + WS_Y);
    for (int k = 0; k < 4; ++k) { const unsigned s = slot[k]; const int e = s & 0xff, pos = s >> 8; const float wgt = tw[k];
        const bf16* yr = Y + (size_t)(expert_rowbase(ctl, e) + pos) * D;
#pragma unroll
        for (int j = 0; j < 4; ++j) { const u32x2 y = *((const u32x2*)yr + lane + 64 * j);
            v[j].x += wgt * bf2f(y.x & 0xffffu); v[j].y += wgt * bf2f(y.x >> 16); v[j].z += wgt * bf2f(y.y & 0xffffu); v[j].w += wgt * bf2f(y.y >> 16); } }
    float s = 0.f;
#pragma unroll
    for (int j = 0; j < 4; ++j) s += v[j].x * v[j].x + v[j].y * v[j].y + v[j].z * v[j].z + v[j].w * v[j].w;
    const float rstd = 1.f / sqrtf(wave_sum(s) * (1.f / D) + EPS);
#pragma unroll
    for (int j = 0; j < 4; ++j) { const f32x4 gg = ((const f32x4*)P.fin_g)[lane + 64 * j]; *((f32x4*)(P.out + (size_t)tok * D) + lane + 64 * j) = v[j] * rstd * gg; }
}

#define GAS __attribute__((address_space(1)))
#define LAS __attribute__((address_space(3)))
typedef float f32x2 __attribute__((ext_vector_type(2)));
typedef float f32x16 __attribute__((ext_vector_type(16)));
constexpr int NWAVES = 8;
constexpr int RING_BYTES = 131072;
constexpr int LX_BAR = RING_BYTES, LX_TBASE = RING_BYTES + 64, LX_TILEE = RING_BYTES + 256, LX_ROWBASE = RING_BYTES + 2048, LX_MISC = RING_BYTES + 4096;
constexpr int LDS_BYTES = 147456;
constexpr size_t WS_RSTDX = 564 * MiB + 512 * 1024;
constexpr int LX_EPI = RING_BYTES + 8192;

typedef __bf16 bf16x2_t __attribute__((ext_vector_type(2)));
__device__ __forceinline__ unsigned cvt_pk_bf16(float lo, float hi) { const f32x2 v = {lo, hi}; const bf16x2_t b = __builtin_convertvector(v, bf16x2_t); return __builtin_bit_cast(unsigned, b); }
__device__ __forceinline__ f32x2 gelu_pk(f32x2 v) {
    const f32x2 av = __builtin_elementwise_abs(v), d = av * 0.2316418882f + 1.0f;
    f32x2 t; t.x = __builtin_amdgcn_rcpf(d.x); t.y = __builtin_amdgcn_rcpf(d.y);
    f32x2 q = t * 0.5307027145f + (-0.7265760135f); q = q * t + 0.7107068705f; q = q * t + (-0.142248368f); q = q * t + 0.127414796f; q = q * t;
    const f32x2 s = (v * v) * (-0.72134752044f);
    f32x2 e; e.x = __builtin_amdgcn_exp2f(s.x); e.y = __builtin_amdgcn_exp2f(s.y);
    const f32x2 m = v * (q * e), r = v - m;
    f32x2 o; o.x = v.x < 0.f ? m.x : r.x; o.y = v.y < 0.f ? m.y : r.y; return o;
}
__device__ __forceinline__ float fast_sigmoid(float v) { return __builtin_amdgcn_rcpf(1.f + __builtin_amdgcn_exp2f(-LOG2E * v)); }
__device__ __forceinline__ float fast_swiglu(float g, float u) {
    g = fminf(g, 7.f); u = fminf(fmaxf(u, -7.f), 7.f);
    return g * __builtin_amdgcn_rcpf(1.f + __builtin_amdgcn_exp2f(-1.702f * LOG2E * g)) * (u + 1.f);
}

__device__ __forceinline__ float folded_swiglu(float t, float w) {
    constexpr float CC = -1.702f * LOG2E;
    t = __builtin_fmaxf(t, 7.f * CC); w = __builtin_amdgcn_fmed3f(w, 8.f / CC, -6.f / CC);
    return t * __builtin_amdgcn_rcpf(1.f + __builtin_amdgcn_exp2f(t)) * w;
}

#define XB_TMO      128
#define XB_XCNT(j)  (256  + 64 * (j))
#define XB_XSUB(j)  (1280 + 64 * (j))
#define XB_XGEN(j)  (2304 + 64 * (j))
#define XB_TOP      3328
#define XB_TOPGEN   3392
#define XCD_BAR_WORDS 3456
#define XB_SPIN_CAP (1u << 18)
__device__ __forceinline__ unsigned xb_ld(unsigned* p)              { return __hip_atomic_load(p, __ATOMIC_RELAXED, __HIP_MEMORY_SCOPE_AGENT); }
__device__ __forceinline__ unsigned xb_add(unsigned* p, unsigned v) { return __hip_atomic_fetch_add(p, v, __ATOMIC_RELAXED, __HIP_MEMORY_SCOPE_AGENT); }
__device__ __forceinline__ unsigned xb_xcc_id() { return (unsigned)__builtin_amdgcn_s_getreg((3 << 11) | 20) & 0xFu; }
#define XB_SPIN(cond, bar) do { unsigned _sp = 0; while (cond) { __builtin_amdgcn_s_sleep(1); \
    if ((++_sp & 255u) == 0u) { if (xb_ld(&(bar)[XB_TMO])) break; if (_sp > XB_SPIN_CAP) { atomicAdd(&(bar)[XB_TMO], 1u); break; } } } } while (0)
struct XcdBarrier { unsigned* bar; unsigned x; volatile LAS unsigned* st; };
__device__ __forceinline__ XcdBarrier xcd_barrier_post(unsigned* bar, volatile LAS unsigned* st) {
    XcdBarrier b; b.bar = bar; b.x = xb_xcc_id(); b.st = st;
    if (threadIdx.x == 0) (void)xb_add(&bar[XB_XCNT(b.x)], 1u);
    return b;
}
__device__ __forceinline__ void xcd_barrier_complete(unsigned* bar, unsigned x, unsigned& nloc, unsigned& nx) {
    const unsigned G = gridDim.x * gridDim.y * gridDim.z;
    unsigned sum, cnt, mine, sp = 0u;
    for (;;) {
        sum = 0u; cnt = 0u; mine = 0u;
#pragma unroll
        for (unsigned j = 0; j < 16; ++j) { const unsigned c = xb_ld(&bar[XB_XCNT(j)]); sum += c; cnt += (c > 0u) ? 1u : 0u; mine = (j == x) ? c : mine; }
        if (sum == G) break;
        __builtin_amdgcn_s_sleep(1);
        if ((++sp & 255u) == 0u) { if (xb_ld(&bar[XB_TMO])) break; if (sp > XB_SPIN_CAP) { atomicAdd(&bar[XB_TMO], 1u); break; } }
    }
    nloc = mine > 0u ? mine : 1u; nx = cnt > 0u ? cnt : 1u;
}
__device__ __forceinline__ void xcd_barrier(const XcdBarrier& b) {
    asm volatile("s_waitcnt vmcnt(0)" ::: "memory");
    __syncthreads();
    if (threadIdx.x == 0) {
        unsigned* bar = b.bar;
        __builtin_amdgcn_s_waitcnt(0);
        unsigned nloc = b.st[0], nx = b.st[1];
        if (nloc == 0u) { xcd_barrier_complete(bar, b.x, nloc, nx); b.st[0] = nloc; b.st[1] = nx; }
        const unsigned old = xb_add(&bar[XB_XSUB(b.x)], 1u);
        const unsigned gen = old / nloc;
        if (old + 1u == (gen + 1u) * nloc) {
            __builtin_amdgcn_fence(__ATOMIC_RELEASE, "agent");
            asm volatile("s_waitcnt vmcnt(0)" ::: "memory");
            const unsigned og = xb_add(&bar[XB_TOP], 1u);
            const unsigned tg = og / nx;
            if (og + 1u == (tg + 1u) * nx) xb_add(&bar[XB_TOPGEN], 1u);
            else XB_SPIN(xb_ld(&bar[XB_TOPGEN]) == tg, bar);
            __builtin_amdgcn_fence(__ATOMIC_ACQUIRE, "agent");
            xb_add(&bar[XB_XGEN(b.x)], 1u);
            asm volatile("s_waitcnt vmcnt(0)" ::: "memory");
        } else {
            XB_SPIN(xb_ld(&bar[XB_XGEN(b.x)]) == gen, bar);
            __builtin_amdgcn_fence(__ATOMIC_ACQUIRE, "agent");
            asm volatile("s_waitcnt vmcnt(0)" ::: "memory");
        }
    }
    __syncthreads();
}

namespace pg8 {
constexpr int BM = 256, BK = 64, HALF = 128, HTB = HALF * BK * 2, STAGE_BYTES = 8 * HTB, NXCD = 8;
__host__ __device__ __forceinline__ int lds_byte(int r, int c) { const int st = (r >> 4) * 2 + (c >> 5), rr = r & 15, cc = c & 31, ob = rr * 64 + cc * 2; return st * 1024 + (ob ^ (((ob >> 9) & 1) << 5)); }
__host__ __device__ __forceinline__ void stage_rc(int b, int& R, int& C) { const int st = b / 1024, sb = b % 1024, swz = sb ^ (((sb >> 9) & 1) << 5); R = (st >> 1) * 16 + swz / 64; C = (st & 1) * 32 + (swz % 64) / 2; }
__host__ __device__ __forceinline__ int perm32(int rho) { const int n = rho >> 4, i = rho & 15; return 8 * (i >> 2) + 4 * n + (i & 3); }

struct Unit { int pm, pn, e, lt, cnt, par; };

__device__ __forceinline__ void order_map(int L, int nM, int nN, int& pm, int& pn, int WGM) {
    const int nwg = nM * nN; int wgid = L; { const int q = nwg / NXCD, r = nwg % NXCD, xcd = wgid % NXCD, off = wgid / NXCD; wgid = (xcd < r ? xcd * (q + 1) : r * (q + 1) + (xcd - r) * q) + off; }
    const int nig = WGM * nN, gid = wgid / nig, fm = gid * WGM, gsz = (nM - fm) < WGM ? (nM - fm) : WGM;
    pm = fm + ((wgid % nig) % gsz); pn = (wgid % nig) / gsz;
}

template <class Epi, class Sched, bool ALIGN_EPI>
__device__ __forceinline__ void gemm_phase(LAS unsigned char* lds, const int K, const unsigned ldb, const Sched& S, const Epi& E) {
    const int tid = threadIdx.x, wid = __builtin_amdgcn_readfirstlane(tid >> 6), lane = tid & 63, wr = wid >> 2, wc = wid & 3, fr = lane & 15, fq = lane >> 4;
    const int nt = K / BK;
    int R[2], C[2]; unsigned voffB[2];
#pragma unroll
    for (int i = 0; i < 2; ++i) { stage_rc(tid * 16 + i * 8192, R[i], C[i]); const int Rb = (R[i] & ~31) + perm32(R[i] & 31); voffB[i] = (unsigned)(Rb * (int)ldb + C[i]) * 2u; }
    const unsigned kstep = (unsigned)(BK * 2);
    const size_t hstepB = (size_t)HALF * ldb * 2;
    const unsigned ldsw = (unsigned)wid * 1024u;
    constexpr int MODE = Epi::MODE; constexpr int KST = 1024;
    const int c8 = fq * 8;
    const int aoff = lds_byte(wr * 64 + fr, c8), boff = lds_byte(wc * 32 + fr, c8);
#define PG8_SA(b, h) (((b) * 2 + (h)) * HTB)
#define PG8_SB(b, h) ((4 + (b) * 2 + (h)) * HTB)
#define PG8_STAGE(bufoff, gbase, voff) do { _Pragma("unroll") for (int _i = 0; _i < 2; ++_i) \
        __builtin_amdgcn_global_load_lds((const unsigned*)((const char*)(gbase) + (voff)[_i]), (LAS unsigned*)(lds + (bufoff) + ldsw + _i * 8192), 16, 0, 0); } while (0)
#define PG8_LD32(p) __builtin_shufflevector(*(const LAS i32x4*)(p), *(const LAS i32x4*)((p) + KST), 0, 1, 2, 3, 4, 5, 6, 7)
#define PG8_LDA(dst, b, h) do { if constexpr (MODE == 2) { _Pragma("unroll") for (int m = 0; m < 4; ++m) dst##8[m] = PG8_LD32(lds + PG8_SA(b, h) + aoff + m * 2048); } \
        else { _Pragma("unroll") for (int m = 0; m < 4; ++m) _Pragma("unroll") for (int k = 0; k < 2; ++k) dst[m][k] = *(const LAS bf16x8*)(lds + PG8_SA(b, h) + aoff + m * 2048 + k * KST); } } while (0)
#define PG8_LDB(dst, b, h) do { if constexpr (MODE == 2) { _Pragma("unroll") for (int n = 0; n < 2; ++n) dst##8[n] = PG8_LD32(lds + PG8_SB(b, h) + boff + n * 2048); } \
        else { _Pragma("unroll") for (int n = 0; n < 2; ++n) _Pragma("unroll") for (int k = 0; k < 2; ++k) dst[n][k] = *(const LAS bf16x8*)(lds + PG8_SB(b, h) + boff + n * 2048 + k * KST); } } while (0)
#define PG8_CAT(x) __builtin_shufflevector(__builtin_bit_cast(i32x4, x[0]), __builtin_bit_cast(i32x4, x[1]), 0, 1, 2, 3, 4, 5, 6, 7)
#define PG8_MMA(ai, bj, At, Bt) do { __builtin_amdgcn_s_setprio(1); _Pragma("unroll") for (int m = 0; m < 4; ++m) _Pragma("unroll") for (int n = 0; n < 2; ++n) { \
        if constexpr (MODE == 2) asm volatile("v_mfma_scale_f32_16x16x128_f8f6f4 %0, %1, %2, %0, %3, %3 op_sel_hi:[0,0,0]" : "+v"(acc[ai][bj][m][n]) : "v"(Bt##8[n]), "v"(At##8[m]), "v"(one_scale)); \
        else { _Pragma("unroll") for (int k = 0; k < 2; ++k) { if constexpr (MODE == 1) acc[ai][bj][m][n] = __builtin_amdgcn_mfma_i32_16x16x64_i8(__builtin_bit_cast(i32x4, Bt[n][k]), __builtin_bit_cast(i32x4, At[m][k]), acc[ai][bj][m][n], 0, 0, 0); \
          else acc[ai][bj][m][n] = __builtin_amdgcn_mfma_f32_16x16x32_bf16(Bt[n][k], At[m][k], acc[ai][bj][m][n], 0, 0, 0); } } } __builtin_amdgcn_s_setprio(0); } while (0)
#define PG8_WAIT_V(n) asm volatile("s_waitcnt vmcnt(" #n ")" ::: "memory")
#define PG8_WAIT_L(n) asm volatile("s_waitcnt lgkmcnt(" #n ")" ::: "memory")
#define PG8_BAR __builtin_amdgcn_s_barrier()
#define PG8_SCHED __builtin_amdgcn_sched_barrier(0)
#define PG8_PIN4(v) asm volatile("" : "+v"(v[0][0]), "+v"(v[0][1]), "+v"(v[1][0]), "+v"(v[1][1]))
    Unit cur, nxt; int ui = 0;
    if (!S.next(0, cur)) return;
    typedef typename Epi::acc_t acc_t;
    acc_t acc[2][2][4][2];
#pragma unroll
    for (int a = 0; a < 2; ++a)
#pragma unroll
        for (int b = 0; b < 2; ++b)
#pragma unroll
            for (int m = 0; m < 4; ++m)
#pragma unroll
                for (int n = 0; n < 2; ++n) acc[a][b][m][n] = acc_t{};
    bf16x8 At[4][2], B0[2][2], B1[2][2]; i32x8 At8[4], B08[2], B18[2];
    unsigned one_scale = 0x7f7f7f7fu; if constexpr (MODE == 2) asm volatile("" : "+v"(one_scale));
    unsigned cvo[2][2], nvo[2][2];
    const char* const Ab = S.a_base();
    const char* cA = Ab;
    if constexpr (Sched::GATHER) { S.a_off(cur, R, C, cvo); PG8_PIN4(cvo); } else { S.lane_off(R, C, cvo); cA = Ab + S.a_ubase(cur); }
    const char* cB = S.b_ptr(cur);
    cur.par = 0;
    if constexpr (Epi::PREF) { if (wid == 0) E.pref(lds + LX_EPI, cur, lane); }
    PG8_STAGE(PG8_SB(0, 0), cB, voffB); PG8_STAGE(PG8_SB(0, 1), cB + hstepB, voffB); PG8_STAGE(PG8_SA(0, 0), cA, cvo[0]); PG8_STAGE(PG8_SA(0, 1), cA, cvo[1]);
    if (wr == 1) PG8_BAR;
    PG8_WAIT_V(2); PG8_BAR;
    PG8_STAGE(PG8_SB(1, 0), cB + kstep, voffB); PG8_STAGE(PG8_SA(1, 0), cA + kstep, cvo[0]); PG8_STAGE(PG8_SB(1, 1), cB + hstepB + kstep, voffB);
    PG8_WAIT_V(6); PG8_BAR;
    for (;;) {
        const bool has_next = S.next(ui + 1, nxt);
        const char* nA = cA;
        if constexpr (Sched::GATHER) {
            if (has_next) { S.a_off(nxt, R, C, nvo); } else { nvo[0][0] = cvo[0][0]; nvo[0][1] = cvo[0][1]; nvo[1][0] = cvo[1][0]; nvo[1][1] = cvo[1][1]; }
            PG8_PIN4(nvo);
        } else { if (has_next) nA = Ab + S.a_ubase(nxt); }
        const char* nB = has_next ? S.b_ptr(nxt) : cB;
        if constexpr (Epi::PREF) { if (ui > 0 && wid == 0) E.pref(lds + LX_EPI + cur.par * 3072, cur, lane); }
#pragma nounroll
        for (int t = 0; t < nt; t += 2) {
            const bool last = (t == nt - 2);
            if constexpr (Epi::MIDK) { if (t == nt / 2) E.mid(acc, cur, wr, wc, fr, fq); }
            const char* a1 = cA + (size_t)(t + 1) * kstep;
            const char* a2 = last ? nA : cA + (size_t)(t + 2) * kstep; const char* b2 = last ? nB : cB + (size_t)(t + 2) * kstep;
            const char* a3 = a2 + kstep; const char* b3 = b2 + kstep;
            unsigned v2[2][2];
#pragma unroll
            for (int h = 0; h < 2; ++h)
#pragma unroll
                for (int i = 0; i < 2; ++i) v2[h][i] = (Sched::GATHER && last) ? nvo[h][i] : cvo[h][i];
            PG8_LDB(B0, 0, 0); PG8_LDB(B1, 0, 1); PG8_SCHED; PG8_LDA(At, 0, 0); PG8_STAGE(PG8_SA(1, 1), a1, cvo[1]);
            PG8_WAIT_V(8); PG8_WAIT_L(0); PG8_BAR; PG8_MMA(0, 0, At, B0); PG8_MMA(0, 1, At, B1); PG8_BAR; PG8_SCHED;
            PG8_LDA(At, 0, 1); PG8_STAGE(PG8_SB(0, 0), b2, voffB); PG8_STAGE(PG8_SB(0, 1), b2 + hstepB, voffB); PG8_STAGE(PG8_SA(0, 0), a2, v2[0]);
            PG8_WAIT_V(8); PG8_WAIT_L(0); PG8_BAR; PG8_MMA(1, 0, At, B0); PG8_MMA(1, 1, At, B1); PG8_BAR; PG8_SCHED;
            PG8_LDB(B0, 1, 0); PG8_LDB(B1, 1, 1); PG8_SCHED; PG8_LDA(At, 1, 0); PG8_STAGE(PG8_SA(0, 1), a2, v2[1]);
            PG8_WAIT_V(8); PG8_WAIT_L(0); PG8_BAR; PG8_MMA(0, 0, At, B0); PG8_MMA(0, 1, At, B1); PG8_BAR; PG8_SCHED;
            PG8_LDA(At, 1, 1); PG8_STAGE(PG8_SB(1, 0), b3, voffB); PG8_STAGE(PG8_SB(1, 1), b3 + hstepB, voffB); PG8_STAGE(PG8_SA(1, 0), a3, v2[0]);
            PG8_WAIT_V(8); PG8_WAIT_L(0); PG8_BAR; PG8_MMA(1, 0, At, B0); PG8_MMA(1, 1, At, B1); PG8_BAR; PG8_SCHED;
        }
        if constexpr (ALIGN_EPI) { if (wr == 0) PG8_BAR; }
        if constexpr (MODE == 2) asm volatile("s_nop 15\n\ts_nop 15" ::: "memory");
        E(acc, cur, wr, wc, fr, fq);
        if constexpr (EPI_PROBE == 6 && Epi::MODE == 1 && Sched::GATHER) { asm volatile("" ::: "memory"); E(acc, cur, wr, wc, fr, fq); }
        if constexpr (EPI_PROBE == 7 && Epi::MODE == 2) { asm volatile("" ::: "memory"); E(acc, cur, wr, wc, fr, fq); }
        if (!has_next) break;
#pragma unroll
        for (int a = 0; a < 2; ++a)
#pragma unroll
            for (int b = 0; b < 2; ++b)
#pragma unroll
                for (int m = 0; m < 4; ++m)
#pragma unroll
                    for (int n = 0; n < 2; ++n) acc[a][b][m][n] = acc_t{};
        cur = nxt; cB = nB; cA = nA; ++ui; cur.par = ui & 1;
        if constexpr (Sched::GATHER) {
#pragma unroll
        for (int h = 0; h < 2; ++h)
#pragma unroll
            for (int i = 0; i < 2; ++i) cvo[h][i] = nvo[h][i]; }
        if constexpr (ALIGN_EPI) { if (wr == 1) PG8_BAR; }
    }
    PG8_WAIT_V(0);
    if constexpr (!ALIGN_EPI) { if (wr == 0) PG8_BAR; }
    PG8_BAR;
#undef PG8_SA
#undef PG8_SB
#undef PG8_STAGE
#undef PG8_LDA
#undef PG8_LD32
#undef PG8_LDB
#undef PG8_MMA
#undef PG8_CAT
#undef PG8_WAIT_V
#undef PG8_WAIT_L
#undef PG8_BAR
#undef PG8_SCHED
#undef PG8_PIN4
}
}

struct DenseSched {
    static constexpr bool GATHER = false;
    const char* A; const char* Bt; int lda, ldb, nM, nN, G, c, wgm;
    __device__ __forceinline__ bool next(int i, pg8::Unit& u) const { const int L = i * G + c; if (L >= nM * nN) return false; pg8::order_map(L, nM, nN, u.pm, u.pn, wgm); u.e = 0; u.lt = 0; u.cnt = 0; return true; }
    __device__ __forceinline__ void a_off(const pg8::Unit& u, const int (&R)[2], const int (&C)[2], unsigned (&vo)[2][2]) const {
#pragma unroll
        for (int h = 0; h < 2; ++h)
#pragma unroll
            for (int i = 0; i < 2; ++i) vo[h][i] = (unsigned)((u.pm * 256 + 128 * h + R[i]) * lda + C[i]) * 2u; }
    __device__ __forceinline__ void lane_off(const int (&R)[2], const int (&C)[2], unsigned (&vo)[2][2]) const {
#pragma unroll
        for (int h = 0; h < 2; ++h)
#pragma unroll
            for (int i = 0; i < 2; ++i) vo[h][i] = (unsigned)((128 * h + R[i]) * lda + C[i]) * 2u; }
    __device__ __forceinline__ size_t a_ubase(const pg8::Unit& u) const { return (size_t)u.pm * 256 * lda * 2; }
    __device__ __forceinline__ const char* a_base() const { return A; }
    __device__ __forceinline__ const char* b_ptr(const pg8::Unit& u) const { return Bt + (size_t)u.pn * 256 * ldb * 2; }
};
struct BalSched {
    static constexpr bool GATHER = false;
    const char* A; const char* Bt; int lda, ldb, nM, nN, G, c, nbf;
    __device__ __forceinline__ bool next(int i, pg8::Unit& u) const {
        int L;
        if (P1_DEAL && G == 256 && nbf == 128 && nM == 64 && nN == 16) {
            const int x = c & 7, j = (c < 128 ? c : c - 128) >> 3, uu = j + 16 * i, sel = uu >> 3;
            if (c < 128) { if (i >= 3) return false; u.pn = sel < 4 ? 4 + sel : sel - 4; } else { if (i >= 5) return false; u.pn = sel < 2 ? 2 + sel : 6 + sel; }
            u.pm = 8 * x + (uu & 7); u.e = 0; u.lt = 0; u.cnt = 0; return true; }
        if (G == 256 && nbf == 128 && nM * nN == 1024) { if (c < 128) { if (i >= 3) return false; L = 128 * i + c; } else { if (i >= 5) return false; L = 384 + 128 * i + (c - 128); } }
        else { L = i * G + c; if (L >= nM * nN) return false; }
        pg8::order_map(L, nM, nN, u.pm, u.pn, WGM_IN); u.e = 0; u.lt = 0; u.cnt = 0; return true; }
    __device__ __forceinline__ void a_off(const pg8::Unit&, const int (&)[2], const int (&)[2], unsigned (&)[2][2]) const {}
    __device__ __forceinline__ void lane_off(const int (&R)[2], const int (&C)[2], unsigned (&vo)[2][2]) const {
#pragma unroll
        for (int h = 0; h < 2; ++h)
#pragma unroll
            for (int i = 0; i < 2; ++i) vo[h][i] = (unsigned)((128 * h + R[i]) * lda + C[i]) * 2u; }
    __device__ __forceinline__ size_t a_ubase(const pg8::Unit& u) const { return (size_t)u.pm * 256 * lda * 2; }
    __device__ __forceinline__ const char* a_base() const { return A; }
    __device__ __forceinline__ const char* b_ptr(const pg8::Unit& u) const { return Bt + (size_t)u.pn * 256 * ldb * 2; }
};
struct MergeSched {
    static constexpr bool GATHER = false;
    const char* A; const char* Bt; int G, c;
    __device__ __forceinline__ bool next(int i, pg8::Unit& u) const { const int v = i & 1, L = (i >> 1) * G + c; if (L >= 256 || i >= 2 * ((256 + G - 1) / G)) return false; pg8::order_map(L, 64, 4, u.pm, u.pn, WGM_MID); u.e = v; u.lt = 0; u.cnt = 0; return true; }
    __device__ __forceinline__ void a_off(const pg8::Unit& u, const int (&R)[2], const int (&C)[2], unsigned (&vo)[2][2]) const {
#pragma unroll
        for (int h = 0; h < 2; ++h)
#pragma unroll
            for (int i = 0; i < 2; ++i) vo[h][i] = (unsigned)u.e * (unsigned)(WS_SG - WS_O) + (unsigned)((u.pm * 256 + 128 * h + R[i]) * 512 + C[i]) * 2u; }
    __device__ __forceinline__ void lane_off(const int (&R)[2], const int (&C)[2], unsigned (&vo)[2][2]) const {
#pragma unroll
        for (int h = 0; h < 2; ++h)
#pragma unroll
            for (int i = 0; i < 2; ++i) vo[h][i] = (unsigned)((128 * h + R[i]) * 512 + C[i]) * 2u; }
    __device__ __forceinline__ size_t a_ubase(const pg8::Unit& u) const { return (size_t)u.e * (WS_SG - WS_O) + (size_t)u.pm * 256 * 512 * 2; }
    __device__ __forceinline__ const char* a_base() const { return A; }
    __device__ __forceinline__ const char* b_ptr(const pg8::Unit& u) const { return Bt + (size_t)u.e * (WS_WS - WS_WA) + (size_t)u.pn * 256 * 512 * 2; }
};
template <bool GU>
struct MoeSched {
    static constexpr bool GATHER = GU;
    const char* A; const char* Bt; const int* list; const LAS int* tbase; const LAS int* tile_e; const unsigned* cnt; int nN, G, c, ldk;
    __device__ __forceinline__ bool next(int i, pg8::Unit& u) const {
        const int nM = tbase[NE]; const int L = i * G + c; if (L >= nM * nN) return false;
        pg8::order_map(L, nM, nN, u.pm, u.pn, GU ? WGM_GU : WGM_DN); u.e = tile_e[u.pm]; u.lt = u.pm - tbase[u.e]; u.cnt = (int)cnt[CW_CNT + 64 * u.e]; return true; }
    __device__ __forceinline__ void a_off(const pg8::Unit& u, const int (&R)[2], const int (&C)[2], unsigned (&vo)[2][2]) const {
#pragma unroll
        for (int h = 0; h < 2; ++h)
#pragma unroll
            for (int i = 0; i < 2; ++i) {
                if (GU) { const int pos = u.lt * 256 + 128 * h + R[i]; const int tk = list[(size_t)u.e * T + (pos < u.cnt ? pos : u.lt * 256)];
                    const int tok = (ZERO_PAD && MOE_I8 && pos >= u.cnt) ? (int)((WS_ZROW - WS_H1Q) / D) : tk; vo[h][i] = (unsigned)(tok * ldk + C[i]) * 2u; }
                else vo[h][i] = (unsigned)((u.pm * 256 + 128 * h + R[i]) * ldk + C[i]) * 2u; } }
    __device__ __forceinline__ void lane_off(const int (&R)[2], const int (&C)[2], unsigned (&vo)[2][2]) const {
#pragma unroll
        for (int h = 0; h < 2; ++h)
#pragma unroll
            for (int i = 0; i < 2; ++i) vo[h][i] = (unsigned)((128 * h + R[i]) * ldk + C[i]) * 2u; }
    __device__ __forceinline__ size_t a_ubase(const pg8::Unit& u) const { return (size_t)u.pm * 256 * ldk * 2; }
    __device__ __forceinline__ const char* a_base() const { return A; }
    __device__ __forceinline__ const char* b_ptr(const pg8::Unit& u) const { return Bt + ((size_t)u.e * nN + u.pn) * 256 * ldk * 2; }
};

#ifndef KM_ATOMICS
#define KM_ATOMICS 1
#endif
struct EpiIn {
    typedef f32x4 acc_t; static constexpr int MODE = 0;
    static constexpr bool MIDK = false; static constexpr bool PREF = false;
    unsigned char* ws; float* km;
    template <int ACT>
    __device__ __forceinline__ void store(const f32x4 (&acc)[2][2][4][2], bf16* base, int ldc, int row0, int col0, float sc0) const {
        float rsc[2][4];
#pragma unroll
        for (int ai = 0; ai < 2; ++ai)
#pragma unroll
            for (int m = 0; m < 4; ++m) rsc[ai][m] = XB_RES ? sc0 * ((const float*)(ws + WS_RSTDX))[row0 + ai * 128 + m * 16] : sc0;
#pragma unroll
        for (int ai = 0; ai < 2; ++ai)
#pragma unroll
            for (int m = 0; m < 4; ++m) { bf16* rowp = base + (size_t)(row0 + ai * 128 + m * 16) * ldc + col0; const float sc = rsc[ai][m];
#pragma unroll
                for (int bj = 0; bj < 2; ++bj) { f32x4 v0 = acc[ai][bj][m][0], v1 = acc[ai][bj][m][1];
                    if (ACT == 0) { v0 = v0 * sc; v1 = v1 * sc; }
                    if (ACT == 1) { const f32x2 a = gelu_pk((f32x2){v0[0], v0[1]}), b = gelu_pk((f32x2){v0[2], v0[3]}), c = gelu_pk((f32x2){v1[0], v1[1]}), d = gelu_pk((f32x2){v1[2], v1[3]});
                        v0 = (f32x4){a.x, a.y, b.x, b.y}; v1 = (f32x4){c.x, c.y, d.x, d.y}; }
                    if (ACT == 2) {
#pragma unroll
                        for (int j = 0; j < 4; ++j) { v0[j] = fast_sigmoid(v0[j]); v1[j] = fast_sigmoid(v1[j]); } }
                    u32x4 w; w.x = cvt_pk_bf16(v0[0], v0[1]); w.y = cvt_pk_bf16(v0[2], v0[3]); w.z = cvt_pk_bf16(v1[0], v1[1]); w.w = cvt_pk_bf16(v1[2], v1[3]);
                    *(u32x4*)(rowp + bj * 128) = w; } }
    }
    __device__ __forceinline__ void operator()(const f32x4 (&acc)[2][2][4][2], const pg8::Unit& u, int wr, int wc, int fr, int fq) const {
        const int pn = u.pn, row0 = u.pm * 256 + wr * 64 + fr;
        if (pn < 10) {
            const int kind = pn >> 1, col0 = (pn & 1) * 256 + wc * 32 + 8 * fq; bf16* base = (bf16*)(ws + WS_Q + (size_t)kind * 16 * MiB);
            if (kind == 0) store<0>(acc, base, 512, row0, col0, C2);
            else if (kind < 3) store<0>(acc, base, 512, row0, col0, 1.f);
            else store<1>(acc, base, 512, row0, col0, 1.f);
            if (KM_ATOMICS && kind == 1) {
#pragma unroll
                for (int bj = 0; bj < 2; ++bj)
#pragma unroll
                    for (int n = 0; n < 2; ++n) { f32x4 s = (f32x4){0.f, 0.f, 0.f, 0.f};
#pragma unroll
                        for (int ai = 0; ai < 2; ++ai)
#pragma unroll
                            for (int m = 0; m < 4; ++m) s = s + acc[ai][bj][m][n];
#pragma unroll
                        for (int j = 0; j < 4; ++j) { float t = s[j]; if (DPP_REDUCE) t = row16_sum(t); else { t += __shfl_xor(t, 1); t += __shfl_xor(t, 2); t += __shfl_xor(t, 4); t += __shfl_xor(t, 8); } s[j] = t; }
                        if (fr == 0) { float* dst = km + (size_t)u.pm * 512 + col0 + bj * 128 + 4 * n;
#pragma unroll
                            for (int j = 0; j < 4; ++j) unsafeAtomicAdd(dst + j, s[j] * (1.f / 256.f)); } }
            }
        } else {
            const int gsel = (pn - 10) >> 2, col0 = ((pn - 10) & 3) * 256 + wc * 32 + 8 * fq; bf16* base = (bf16*)(ws + (gsel ? WS_GS : WS_GA));
            store<2>(acc, base, 1024, row0, col0, 1.f);
        }
    }
};
struct EpiInQ {
    typedef i32x4 acc_t; static constexpr int MODE = 1;
    static constexpr bool MIDK = false; static constexpr bool PREF = EPI_PREF != 0;
    unsigned char* ws; const float* sxn; const float* sbin; float* km; LAS unsigned char* lds;
    __device__ __forceinline__ void pref(LAS unsigned char* buf, const pg8::Unit& u, int lane) const {
        __builtin_amdgcn_global_load_lds((const unsigned*)(sbin + u.pn * 256 + 4 * lane), (LAS unsigned*)buf, 16, 0, 0);
        __builtin_amdgcn_global_load_lds((const unsigned*)(sxn + u.pm * 256 + 4 * lane), (LAS unsigned*)(buf + 1024), 16, 0, 0);
    }
    __device__ __forceinline__ f32x4 ldsc(const float* sbp, const LAS float* esb, int off) const { if constexpr (PREF) return *(const LAS f32x4*)(esb + off); else return *(const f32x4*)(sbp + off); }
    __device__ __forceinline__ float ldsr(int row, const LAS float* esr, int off) const { if constexpr (PREF) return esr[off]; else return sxn[row]; }
    template <int ACT, int LAY = 0>
    __device__ __forceinline__ void store(const i32x4 (&acc)[2][2][4][2], bf16* base, int ldc, int row0, int col0, const float* sbp, const LAS float* esb, const LAS float* esr) const {
        f32x4 s0[2], s1[2];
#pragma unroll
        for (int bj = 0; bj < 2; ++bj) { s0[bj] = ldsc(sbp, esb, bj * 128); s1[bj] = ldsc(sbp, esb, bj * 128 + 4); }
#pragma unroll
        for (int ai = 0; ai < 2; ++ai)
#pragma unroll
            for (int m = 0; m < 4; ++m) { const int row = row0 + ai * 128 + m * 16; const float sa = ldsr(row, esr, ai * 128 + m * 16); bf16* rowp = base + (size_t)row * ldc + col0;
#pragma unroll
                for (int bj = 0; bj < 2; ++bj) { f32x4 v0 = __builtin_convertvector(acc[ai][bj][m][0], f32x4) * (s0[bj] * sa), v1 = __builtin_convertvector(acc[ai][bj][m][1], f32x4) * (s1[bj] * sa);
                    if (ACT == 1) { const f32x2 a = gelu_pk((f32x2){v0[0], v0[1]}), b = gelu_pk((f32x2){v0[2], v0[3]}), c = gelu_pk((f32x2){v1[0], v1[1]}), d = gelu_pk((f32x2){v1[2], v1[3]});
                        v0 = (f32x4){a.x, a.y, b.x, b.y}; v1 = (f32x4){c.x, c.y, d.x, d.y}; }
                    if (ACT == 2) {
#pragma unroll
                        for (int j = 0; j < 4; ++j) { v0[j] = fast_sigmoid(v0[j]); v1[j] = fast_sigmoid(v1[j]); } }
                    u32x4 w; w.x = cvt_pk_bf16(v0[0], v0[1]); w.y = cvt_pk_bf16(v0[2], v0[3]); w.z = cvt_pk_bf16(v1[0], v1[1]); w.w = cvt_pk_bf16(v1[2], v1[3]);
                    if constexpr (LAY == 0) *(u32x4*)(rowp + bj * 128) = w;
                    else { const int col = col0 + bj * 128, hh = col >> 6, d0 = col & 63, r = row & 63, tb = row >> 6;
                        const size_t tile = (size_t)((tb >> 6) * NH + hh) * 64 + (tb & 63);
                        const int in = LAY == 1 ? (d0 >> 3) * 512 + r * 8 : (((d0 >> 5) << 2) + (r >> 4)) * 512 + (((r & 15) << 2) + ((d0 & 31) >> 3)) * 8;
                        *(u32x4*)(base + tile * 4096 + in) = w; } } }
    }
    __device__ __forceinline__ void operator()(const i32x4 (&acc)[2][2][4][2], const pg8::Unit& u, int wr, int wc, int fr, int fq) const {
        const int pn = u.pn + IN_BF_TILES, row0 = u.pm * 256 + wr * 64 + fr; const float* sbp = sbin + u.pn * 256 + wc * 32 + 8 * fq;
        const LAS float* esb = (const LAS float*)(lds + LX_EPI + u.par * 3072) + wc * 32 + 8 * fq; const LAS float* esr = (const LAS float*)(lds + LX_EPI + u.par * 3072) + 256 + wr * 64 + fr;
        if (pn < 10) { const int kind = pn >> 1, col0 = (pn & 1) * 256 + wc * 32 + 8 * fq; bf16* base = (bf16*)(ws + WS_Q + (size_t)kind * 16 * MiB);
            if (KV_IMAGE && kind == 1) store<0, 1>(acc, base, 512, row0, col0, sbp, esb, esr); else if (KV_IMAGE && kind == 2) store<0, 2>(acc, base, 512, row0, col0, sbp, esb, esr);
            else if (kind <= 2) store<0>(acc, base, 512, row0, col0, sbp, esb, esr); else store<1>(acc, base, 512, row0, col0, sbp, esb, esr);
            if (KM_ATOMICS && kind == 1) {
                float sa[2][4];
#pragma unroll
                for (int ai = 0; ai < 2; ++ai)
#pragma unroll
                    for (int m = 0; m < 4; ++m) sa[ai][m] = ldsr(row0 + ai * 128 + m * 16, esr, ai * 128 + m * 16);
#pragma unroll
                for (int bj = 0; bj < 2; ++bj)
#pragma unroll
                    for (int n = 0; n < 2; ++n) { f32x4 s = (f32x4){0.f, 0.f, 0.f, 0.f};
#pragma unroll
                        for (int ai = 0; ai < 2; ++ai)
#pragma unroll
                            for (int m = 0; m < 4; ++m) s = s + __builtin_convertvector(acc[ai][bj][m][n], f32x4) * sa[ai][m];
                        s = s * ldsc(sbp, esb, bj * 128 + 4 * n);
#pragma unroll
                        for (int j = 0; j < 4; ++j) { float t = s[j]; if (DPP_REDUCE) t = row16_sum(t); else { t += __shfl_xor(t, 1); t += __shfl_xor(t, 2); t += __shfl_xor(t, 4); t += __shfl_xor(t, 8); } s[j] = t; }
                        if (fr == 0) { float* dst = km + (size_t)u.pm * 512 + col0 + bj * 128 + 4 * n;
#pragma unroll
                            for (int j = 0; j < 4; ++j) unsafeAtomicAdd(dst + j, s[j] * (1.f / 256.f)); } }
            }
        } else { const int gsel = (pn - 10) >> 2, col0 = ((pn - 10) & 3) * 256 + wc * 32 + 8 * fq; bf16* base = (bf16*)(ws + (gsel ? WS_GS : WS_GA));
#if GATE_U8
            { f32x4 s0[2], s1[2];
#pragma unroll
              for (int bj = 0; bj < 2; ++bj) { s0[bj] = ldsc(sbp, esb, bj * 128) * -LOG2E; s1[bj] = ldsc(sbp, esb, bj * 128 + 4) * -LOG2E; }
              u32x2 gprev[2]; gprev[0] = (u32x2){0u, 0u}; gprev[1] = gprev[0];
#pragma unroll
              for (int ai = 0; ai < 2; ++ai)
#pragma unroll
                for (int m = 0; m < 4; ++m) { const int row = row0 + ai * 128 + m * 16; const float sa = ldsr(row, esr, ai * 128 + m * 16);
                    unsigned char* rowp = GATE_IMAGE ? (unsigned char*)base + ((size_t)((u.pm * 4 + ((pn - 10) & 3)) * 8 + ai * 4 + (m >> 1) * 2) * 8 + (wr * 4 + wc)) * 1024 + (fq * 16 + fr) * 16
                                                     : (unsigned char*)base + (size_t)row * 1024 + col0;
#pragma unroll
                    for (int bj = 0; bj < 2; ++bj) { const f32x4 v0 = __builtin_convertvector(acc[ai][bj][m][0], f32x4) * (s0[bj] * sa), v1 = __builtin_convertvector(acc[ai][bj][m][1], f32x4) * (s1[bj] * sa); unsigned q[8];
#pragma unroll
                        for (int j = 0; j < 4; ++j) { q[j] = __float_as_uint(__builtin_fmaxf(__builtin_amdgcn_rcpf(__builtin_fmaf(__builtin_amdgcn_exp2f(v0[j]), 1.f / 255.f, 1.f / 255.f)), 1.f) + 8388608.f);
                            q[4 + j] = __float_as_uint(__builtin_fmaxf(__builtin_amdgcn_rcpf(__builtin_fmaf(__builtin_amdgcn_exp2f(v1[j]), 1.f / 255.f, 1.f / 255.f)), 1.f) + 8388608.f); }
                        u32x2 w;
                        w.x = __builtin_amdgcn_perm(q[1], q[0], 0x0c0c0400u) | __builtin_amdgcn_perm(q[3], q[2], 0x04000c0cu); w.y = __builtin_amdgcn_perm(q[5], q[4], 0x0c0c0400u) | __builtin_amdgcn_perm(q[7], q[6], 0x04000c0cu);
                        if (GATE_IMAGE) { if (m & 1) *(u32x4*)(rowp + bj * 8192) = (u32x4){gprev[bj].x, gprev[bj].y, w.x, w.y}; else gprev[bj] = w; }
                        else *(u32x2*)(rowp + bj * 128) = w; } } }
#else
            store<2>(acc, base, 1024, row0, col0, sbp, esb, esr);
#endif
        }
    }
};
struct EpiMerge {
    typedef f32x4 acc_t; static constexpr int MODE = 0;
    static constexpr bool MIDK = false; static constexpr bool PREF = false;
    unsigned char* ws;
    __device__ __forceinline__ void operator()(const f32x4 (&acc)[2][2][4][2], const pg8::Unit& u, int wr, int wc, int fr, int fq) const {
        const int row0 = u.pm * 256 + wr * 64 + fr, col0 = u.pn * 256 + wc * 32 + 8 * fq;
        const bf16* gate = (const bf16*)(ws + (u.e ? WS_GS : WS_GA)); bf16* mg = (bf16*)(ws + WS_MG);
#pragma unroll
        for (int ai = 0; ai < 2; ++ai)
#pragma unroll
            for (int m = 0; m < 4; ++m) { const size_t ro = (size_t)(row0 + ai * 128 + m * 16) * 1024 + col0;
#pragma unroll
                for (int bj = 0; bj < 2; ++bj) { const u32x4 g = *(const u32x4*)(gate + ro + bj * 128); f32x4 v0 = acc[ai][bj][m][0], v1 = acc[ai][bj][m][1];
                    v0[0] *= bf2f(g.x & 0xffffu); v0[1] *= bf2f(g.x >> 16); v0[2] *= bf2f(g.y & 0xffffu); v0[3] *= bf2f(g.y >> 16);
                    v1[0] *= bf2f(g.z & 0xffffu); v1[1] *= bf2f(g.z >> 16); v1[2] *= bf2f(g.w & 0xffffu); v1[3] *= bf2f(g.w >> 16);
                    if (u.e) { const u32x4 p = *(const u32x4*)(mg + ro + bj * 128);
                        v0[0] += bf2f(p.x & 0xffffu); v0[1] += bf2f(p.x >> 16); v0[2] += bf2f(p.y & 0xffffu); v0[3] += bf2f(p.y >> 16);
                        v1[0] += bf2f(p.z & 0xffffu); v1[1] += bf2f(p.z >> 16); v1[2] += bf2f(p.w & 0xffffu); v1[3] += bf2f(p.w >> 16); }
                    u32x4 w; w.x = cvt_pk_bf16(v0[0], v0[1]); w.y = cvt_pk_bf16(v0[2], v0[3]); w.z = cvt_pk_bf16(v1[0], v1[1]); w.w = cvt_pk_bf16(v1[2], v1[3]);
                    *(u32x4*)(mg + ro + bj * 128) = w; } }
    }
};
struct EpiMergeF {
    typedef f32x4 acc_t; static constexpr int MODE = 0; static constexpr bool MIDK = true; static constexpr bool PREF = false;
    unsigned char* ws;
    __device__ __forceinline__ void mid(f32x4 (&acc)[2][2][4][2], const pg8::Unit& u, int wr, int wc, int fr, int fq) const {
        asm volatile("" : "+v"(fr), "+v"(fq));
        const int row0 = u.pm * 256 + wr * 64 + fr, col0 = u.pn * 256 + wc * 32 + 8 * fq; const bf16* ga = (const bf16*)(ws + WS_GA); const bf16* gs = (const bf16*)(ws + WS_GS);
        u32x4 ga4[2], gs4[2]; ga4[0] = ga4[1] = gs4[0] = gs4[1] = (u32x4){0u, 0u, 0u, 0u}; (void)ga4; (void)gs4;
#pragma unroll
        for (int ai = 0; ai < 2; ++ai)
#pragma unroll
            for (int m = 0; m < 4; ++m) { const size_t ro = (size_t)(row0 + ai * 128 + m * 16) * 1024 + col0; (void)ro;
#pragma unroll
                for (int bj = 0; bj < 2; ++bj) {
#if GATE_U8
#if GATE_IMAGE
                    if ((m & 1) == 0) { const size_t go = ((size_t)((u.pm * 4 + u.pn) * 8 + ai * 4 + (m >> 1) * 2 + bj) * 8 + (wr * 4 + wc)) * 1024 + (fq * 16 + fr) * 16;
                        ga4[bj] = *(const u32x4*)((const unsigned char*)ga + go); gs4[bj] = *(const u32x4*)((const unsigned char*)gs + go); }
                    const u32x2 a = (m & 1) ? (u32x2){ga4[bj].z, ga4[bj].w} : (u32x2){ga4[bj].x, ga4[bj].y}, b = (m & 1) ? (u32x2){gs4[bj].z, gs4[bj].w} : (u32x2){gs4[bj].x, gs4[bj].y};
#else
                    const size_t go = ro + bj * 128;
                    const u32x2 a = *(const u32x2*)((const unsigned char*)ga + go), b = *(const u32x2*)((const unsigned char*)gs + go);
#endif
#pragma unroll
                    for (int j = 0; j < 8; ++j) { const float r = (float)((a[j >> 2] >> (8 * (j & 3))) & 0xffu) * __builtin_amdgcn_rcpf((float)((b[j >> 2] >> (8 * (j & 3))) & 0xffu)); acc[ai][bj][m][j >> 2][j & 3] *= r; }
#else
                    const u32x4 a = *(const u32x4*)(ga + ro + bj * 128), b = *(const u32x4*)(gs + ro + bj * 128);
#pragma unroll
                    for (int j = 0; j < 4; ++j) { const float rl = bf2f(a[j] & 0xffffu) * __builtin_amdgcn_rcpf(bf2f(b[j] & 0xffffu)), rh = bf2f(a[j] >> 16) * __builtin_amdgcn_rcpf(bf2f(b[j] >> 16));
                        acc[ai][bj][m][j >> 1][2 * (j & 1)] *= rl; acc[ai][bj][m][j >> 1][2 * (j & 1) + 1] *= rh; }
#endif
                }
                if (m == 3) asm volatile("" ::: "memory"); }
    }
    __device__ __forceinline__ void operator()(const f32x4 (&acc)[2][2][4][2], const pg8::Unit& u, int wr, int wc, int fr, int fq) const {
        const int row0 = u.pm * 256 + wr * 64 + fr, col0 = u.pn * 256 + wc * 32 + 8 * fq; const bf16* gs = (const bf16*)(ws + WS_GS); bf16* mg = (bf16*)(ws + WS_MG);
#if GATE_U8
        u32x2 gq[2][4][2];
#pragma unroll
        for (int ai = 0; ai < 2; ++ai)
#pragma unroll
            for (int m = 0; m < 4; ++m)
#pragma unroll
                for (int bj = 0; bj < 2; ++bj) {
                    if (GATE_IMAGE) { if ((m & 1) == 0) { const u32x4 g4 = *(const u32x4*)((const unsigned char*)gs + ((size_t)((u.pm * 4 + u.pn) * 8 + ai * 4 + (m >> 1) * 2 + bj) * 8 + (wr * 4 + wc)) * 1024 + (fq * 16 + fr) * 16);
                            gq[ai][m][bj] = (u32x2){g4.x, g4.y}; gq[ai][m + 1][bj] = (u32x2){g4.z, g4.w}; } }
                    else gq[ai][m][bj] = *(const u32x2*)((const unsigned char*)gs + (size_t)(row0 + ai * 128 + m * 16) * 1024 + col0 + bj * 128); }
#endif
#pragma unroll
        for (int ai = 0; ai < 2; ++ai)
#pragma unroll
            for (int m = 0; m < 4; ++m) { const size_t ro = (size_t)(row0 + ai * 128 + m * 16) * 1024 + col0;
#pragma unroll
                for (int bj = 0; bj < 2; ++bj) { f32x4 v0 = acc[ai][bj][m][0], v1 = acc[ai][bj][m][1];
#if GATE_U8
                    const u32x2 g = gq[ai][m][bj];
#pragma unroll
                    for (int j = 0; j < 4; ++j) { v0[j] *= (float)((g.x >> (8 * j)) & 0xffu) * (1.f / 255.f); v1[j] *= (float)((g.y >> (8 * j)) & 0xffu) * (1.f / 255.f); }
#else
                    const u32x4 g = *(const u32x4*)(gs + ro + bj * 128);
                    v0[0] *= bf2f(g.x & 0xffffu); v0[1] *= bf2f(g.x >> 16); v0[2] *= bf2f(g.y & 0xffffu); v0[3] *= bf2f(g.y >> 16);
                    v1[0] *= bf2f(g.z & 0xffffu); v1[1] *= bf2f(g.z >> 16); v1[2] *= bf2f(g.w & 0xffffu); v1[3] *= bf2f(g.w >> 16);
#endif
                    u32x4 w; w.x = cvt_pk_bf16(v0[0], v0[1]); w.y = cvt_pk_bf16(v0[2], v0[3]); w.z = cvt_pk_bf16(v1[0], v1[1]); w.w = cvt_pk_bf16(v1[2], v1[3]);
                    *(u32x4*)(mg + ro + bj * 128) = w; } }
    }
};
struct EpiH1 {
    typedef f32x4 acc_t; static constexpr int MODE = 0;
    static constexpr bool MIDK = false; static constexpr bool PREF = false;
    const float* x; float* h1; bf16* h1b; const bf16* xb;
    __device__ __forceinline__ void operator()(const f32x4 (&acc)[2][2][4][2], const pg8::Unit& u, int wr, int wc, int fr, int fq) const {
        const int row0 = u.pm * 256 + wr * 64 + fr, col0 = u.pn * 256 + wc * 32 + 8 * fq; (void)xb;
#if XB_RES
        u32x4 xq[4][2];
#pragma unroll
        for (int g = 0; g < 4; ++g)
#pragma unroll
            for (int bj = 0; bj < 2; ++bj) xq[g][bj] = *(const u32x4*)(xb + (size_t)(row0 + (g >> 2) * 128 + (g & 3) * 16) * 1024 + col0 + bj * 128);
#else
        f32x4 xq[4][2][2];
#pragma unroll
        for (int g = 0; g < 4; ++g)
#pragma unroll
            for (int bj = 0; bj < 2; ++bj) { const size_t ro = (size_t)(row0 + (g >> 2) * 128 + (g & 3) * 16) * 1024 + col0;
                xq[g][bj][0] = __builtin_nontemporal_load((const f32x4*)(x + ro + bj * 128)); xq[g][bj][1] = __builtin_nontemporal_load((const f32x4*)(x + ro + bj * 128 + 4)); }
#endif
#pragma unroll
        for (int ai = 0; ai < 2; ++ai)
#pragma unroll
            for (int m = 0; m < 4; ++m) { const size_t ro = (size_t)(row0 + ai * 128 + m * 16) * 1024 + col0; const int g = ai * 4 + m;
                f32x4 xc[2][2];
#if XB_RES
#pragma unroll
                for (int bj = 0; bj < 2; ++bj) { const u32x4 w = xq[g & 3][bj];
                    xc[bj][0] = (f32x4){bf2f(w.x & 0xffffu), bf2f(w.x >> 16), bf2f(w.y & 0xffffu), bf2f(w.y >> 16)}; xc[bj][1] = (f32x4){bf2f(w.z & 0xffffu), bf2f(w.z >> 16), bf2f(w.w & 0xffffu), bf2f(w.w >> 16)}; }
                if (g + 4 < 8) {
#pragma unroll
                    for (int bj = 0; bj < 2; ++bj) xq[g & 3][bj] = *(const u32x4*)(xb + (size_t)(row0 + ((g + 4) >> 2) * 128 + ((g + 4) & 3) * 16) * 1024 + col0 + bj * 128); }
#else
#pragma unroll
                for (int bj = 0; bj < 2; ++bj) { xc[bj][0] = xq[g & 3][bj][0]; xc[bj][1] = xq[g & 3][bj][1]; }
                if (g + 4 < 8) {
#pragma unroll
                    for (int bj = 0; bj < 2; ++bj) { const size_t rn = (size_t)(row0 + ((g + 4) >> 2) * 128 + ((g + 4) & 3) * 16) * 1024 + col0;
                        xq[g & 3][bj][0] = __builtin_nontemporal_load((const f32x4*)(x + rn + bj * 128)); xq[g & 3][bj][1] = __builtin_nontemporal_load((const f32x4*)(x + rn + bj * 128 + 4)); } }
#endif
#pragma unroll
                for (int bj = 0; bj < 2; ++bj) { const f32x4 x0 = xc[bj][0], x1 = xc[bj][1];
                    const f32x4 v0 = acc[ai][bj][m][0] + x0, v1 = acc[ai][bj][m][1] + x1;
                    if (!H1_BF16) { *(f32x4*)(h1 + ro + bj * 128) = v0; *(f32x4*)(h1 + ro + bj * 128 + 4) = v1; }
                    if (!MOE_I8 || H1_BF16) { u32x4 w; w.x = cvt_pk_bf16(v0[0], v0[1]); w.y = cvt_pk_bf16(v0[2], v0[3]); w.z = cvt_pk_bf16(v1[0], v1[1]); w.w = cvt_pk_bf16(v1[2], v1[3]);
                        *(u32x4*)(h1b + ro + bj * 128) = w; } } }
    }
};
struct EpiGu {
    typedef f32x4 acc_t; static constexpr int MODE = 0;
    static constexpr bool MIDK = false; static constexpr bool PREF = false;
    const float* rlist; const float* bgu; bf16* hid;
    __device__ __forceinline__ void operator()(const f32x4 (&acc)[2][2][4][2], const pg8::Unit& u, int wr, int wc, int fr, int fq) const {
        const int lrow0 = wr * 64 + fr, col0 = u.pn * 256 + wc * 32 + 8 * fq; const float* bb = bgu + (size_t)u.e * 2048 + col0;
        f32x4 b0[2], b1[2];
#pragma unroll
        for (int bj = 0; bj < 2; ++bj) { b0[bj] = *(const f32x4*)(bb + bj * 128); b1[bj] = *(const f32x4*)(bb + bj * 128 + 4); }
#pragma unroll
        for (int ai = 0; ai < 2; ++ai)
#pragma unroll
            for (int m = 0; m < 4; ++m) { const int lr = lrow0 + ai * 128 + m * 16, pos = u.lt * 256 + lr; const float r = pos < u.cnt ? rlist[(size_t)u.e * T + pos] : 0.f;
                bf16* rowp = hid + (size_t)(u.pm * 256 + lr) * DE + (col0 >> 1);
#pragma unroll
                for (int bj = 0; bj < 2; ++bj) { const f32x4 v0 = acc[ai][bj][m][0] * r + b0[bj], v1 = acc[ai][bj][m][1] * r + b1[bj];
                    u32x2 w; w.x = cvt_pk_bf16(fast_swiglu(v0[0], v0[1]), fast_swiglu(v0[2], v0[3])); w.y = cvt_pk_bf16(fast_swiglu(v1[0], v1[1]), fast_swiglu(v1[2], v1[3]));
                    *(u32x2*)(rowp + bj * 64) = w; } }
    }
};
struct EpiGuQ {
    typedef i32x4 acc_t; static constexpr int MODE = 1;
    static constexpr bool MIDK = false; static constexpr bool PREF = EPI_PREF != 0;
    const float* rlist; const float* sb; const float* bgu; bf16* hid; LAS unsigned char* lds;
    __device__ __forceinline__ void pref(LAS unsigned char* buf, const pg8::Unit& u, int lane) const {
        __builtin_amdgcn_global_load_lds((const unsigned*)(bgu + (size_t)u.e * 2048 + u.pn * 256 + 4 * lane), (LAS unsigned*)buf, 16, 0, 0);
        __builtin_amdgcn_global_load_lds((const unsigned*)(sb + (size_t)u.e * 2048 + u.pn * 256 + 4 * lane), (LAS unsigned*)(buf + 1024), 16, 0, 0);
        __builtin_amdgcn_global_load_lds((const unsigned*)(rlist + (size_t)u.e * T + u.lt * 256 + 4 * lane), (LAS unsigned*)(buf + 2048), 16, 0, 0);
    }
    __device__ __forceinline__ void operator()(const i32x4 (&acc)[2][2][4][2], const pg8::Unit& u, int wr, int wc, int fr, int fq) const {
        const int lrow0 = wr * 64 + fr, col0 = u.pn * 256 + wc * 32 + 8 * fq; const float* bb = bgu + (size_t)u.e * 2048 + col0; const float* ss = sb + (size_t)u.e * 2048 + col0;
        const LAS float* eb = (const LAS float*)(lds + LX_EPI + u.par * 3072) + wc * 32 + 8 * fq; (void)eb;
        f32x4 b0[2], b1[2], s0[2], s1[2];
#pragma unroll
        for (int bj = 0; bj < 2; ++bj) {
            if constexpr (PREF) { b0[bj] = *(const LAS f32x4*)(eb + bj * 128); b1[bj] = *(const LAS f32x4*)(eb + bj * 128 + 4); s0[bj] = *(const LAS f32x4*)(eb + 256 + bj * 128); s1[bj] = *(const LAS f32x4*)(eb + 256 + bj * 128 + 4); }
            else { b0[bj] = *(const f32x4*)(bb + bj * 128); b1[bj] = *(const f32x4*)(bb + bj * 128 + 4); s0[bj] = *(const f32x4*)(ss + bj * 128); s1[bj] = *(const f32x4*)(ss + bj * 128 + 4); } }
        const LAS float* er = (const LAS float*)(lds + LX_EPI + u.par * 3072) + 512; (void)er;
#if MOE_F8
        { constexpr float CC = -1.702f * LOG2E, IC = 1.f / CC; const f32x4 cm = (f32x4){CC, IC, CC, IC}, ca = (f32x4){0.f, IC, 0.f, IC};
#pragma unroll
          for (int bj = 0; bj < 2; ++bj) { s0[bj] = s0[bj] * cm; s1[bj] = s1[bj] * cm; b0[bj] = b0[bj] * cm + ca; b1[bj] = b1[bj] * cm + ca; } }
#endif
#pragma unroll
        for (int ai = 0; ai < 2; ++ai) {
#if MOE_F8 && WIDE_EPI
          unsigned wq[4][2];
#endif
#pragma unroll
            for (int m = 0; m < 4; ++m) { const int lr = lrow0 + ai * 128 + m * 16, pos = u.lt * 256 + lr; float r;
                if constexpr (PREF) { const float rv = er[lr]; r = pos < u.cnt ? rv : 0.f; } else r = pos < u.cnt ? rlist[(size_t)u.e * T + pos] : 0.f;
                bf16* rowp = hid + (size_t)(u.pm * 256 + lr) * DE + (col0 >> 1);
#pragma unroll
                for (int bj = 0; bj < 2; ++bj) { const f32x4 v0 = __builtin_convertvector(acc[ai][bj][m][0], f32x4) * (s0[bj] * r) + b0[bj], v1 = __builtin_convertvector(acc[ai][bj][m][1], f32x4) * (s1[bj] * r) + b1[bj];
#if MOE_F8
                    unsigned w = 0u; w = __builtin_amdgcn_cvt_pk_fp8_f32(folded_swiglu(v0[0], v0[1]), folded_swiglu(v0[2], v0[3]), w, false); w = __builtin_amdgcn_cvt_pk_fp8_f32(folded_swiglu(v1[0], v1[1]), folded_swiglu(v1[2], v1[3]), w, true);
#if WIDE_EPI
                    wq[m][bj] = (ZERO_PAD && pos >= u.cnt) ? 0u : w; (void)rowp;
#else
                    *(unsigned*)((unsigned char*)hid + (size_t)(u.pm * 256 + lr) * DE + (col0 >> 1) + bj * 64) = w; (void)rowp;
#endif
#else
                    u32x2 w; w.x = cvt_pk_bf16(fast_swiglu(v0[0], v0[1]), fast_swiglu(v0[2], v0[3])); w.y = cvt_pk_bf16(fast_swiglu(v1[0], v1[1]), fast_swiglu(v1[2], v1[3]));
                    *(u32x2*)(rowp + bj * 64) = w;
#endif
                } }
#if MOE_F8 && WIDE_EPI
#pragma unroll
            for (int bj = 0; bj < 2; ++bj) { unsigned r0 = wq[0][bj], r1 = wq[1][bj], r2 = wq[2][bj], r3 = wq[3][bj];
                { auto t = __builtin_amdgcn_permlane32_swap(r0, r2, false, false); r0 = t[0]; r2 = t[1]; }
                { auto t = __builtin_amdgcn_permlane32_swap(r1, r3, false, false); r1 = t[0]; r3 = t[1]; }
                { auto t = __builtin_amdgcn_permlane16_swap(r0, r1, false, false); r0 = t[0]; r1 = t[1]; }
                { auto t = __builtin_amdgcn_permlane16_swap(r2, r3, false, false); r2 = t[0]; r3 = t[1]; }
                *(u32x4*)((unsigned char*)hid + (size_t)(u.pm * 256 + lrow0 + ai * 128 + fq * 16) * DE + u.pn * 128 + wc * 16 + bj * 64) = (u32x4){r0, r1, r2, r3}; }
#endif
        }
    }
};
struct EpiDown {
    typedef f32x4 acc_t; static constexpr int MODE = MOE_F8 ? 2 : 0;
    static constexpr bool MIDK = false; static constexpr bool PREF = EPI_PREF != 0;
    const float* bd; bf16* y; LAS unsigned char* lds;
    __device__ __forceinline__ void pref(LAS unsigned char* buf, const pg8::Unit& u, int lane) const {
        __builtin_amdgcn_global_load_lds((const unsigned*)(bd + (size_t)u.e * D + u.pn * 256 + 4 * lane), (LAS unsigned*)buf, 16, 0, 0);
    }
    __device__ __forceinline__ void operator()(const f32x4 (&acc)[2][2][4][2], const pg8::Unit& u, int wr, int wc, int fr, int fq) const {
        const int lrow0 = wr * 64 + fr, col0 = u.pn * 256 + wc * 32 + 8 * fq; const float* bb = bd + (size_t)u.e * D + col0;
        const LAS float* eb = (const LAS float*)(lds + LX_EPI + u.par * 3072) + wc * 32 + 8 * fq; (void)eb;
        f32x4 b0[2], b1[2];
#pragma unroll
        for (int bj = 0; bj < 2; ++bj) {
            if constexpr (PREF) { b0[bj] = *(const LAS f32x4*)(eb + bj * 128); b1[bj] = *(const LAS f32x4*)(eb + bj * 128 + 4); }
            else { b0[bj] = *(const f32x4*)(bb + bj * 128); b1[bj] = *(const f32x4*)(bb + bj * 128 + 4); } }
        u32x2 wprev[2]; wprev[0] = (u32x2){0u, 0u}; wprev[1] = wprev[0]; (void)wprev;
#pragma unroll
        for (int ai = 0; ai < 2; ++ai)
#pragma unroll
            for (int m = 0; m < 4; ++m) { bf16* rowp = y + (size_t)(u.pm * 256 + lrow0 + ai * 128 + m * 16) * D + col0;
#pragma unroll
                for (int bj = 0; bj < 2; ++bj) { constexpr float ws_ = MOE_F8 ? (1.f / 32.f) : 1.f; const f32x4 v0 = acc[ai][bj][m][0] * ws_ + b0[bj], v1 = acc[ai][bj][m][1] * ws_ + b1[bj];
#if Y_F8
                    u32x2 w; unsigned t = 0u; t = __builtin_amdgcn_cvt_pk_fp8_f32(v0[0], v0[1], t, false); t = __builtin_amdgcn_cvt_pk_fp8_f32(v0[2], v0[3], t, true); w.x = t;
                    t = 0u; t = __builtin_amdgcn_cvt_pk_fp8_f32(v1[0], v1[1], t, false); t = __builtin_amdgcn_cvt_pk_fp8_f32(v1[2], v1[3], t, true); w.y = t;
#if WIDE_EPI
                    if (m & 1) { u32x2 a = wprev[bj], b = w;
                        { auto q = __builtin_amdgcn_permlane16_swap(a.x, b.x, false, false); a.x = q[0]; b.x = q[1]; }
                        { auto q = __builtin_amdgcn_permlane16_swap(a.y, b.y, false, false); a.y = q[0]; b.y = q[1]; }
                        *(u32x4*)((unsigned char*)y + (size_t)(u.pm * 256 + lrow0 + ai * 128 + (m - 1 + (fq & 1)) * 16) * D + u.pn * 256 + wc * 32 + bj * 128 + (fq >> 1) * 16) = (u32x4){a.x, a.y, b.x, b.y}; }
                    else wprev[bj] = w;
                    (void)rowp;
#else
                    *(u32x2*)((unsigned char*)y + (size_t)(u.pm * 256 + lrow0 + ai * 128 + m * 16) * D + col0 + bj * 128) = w; (void)rowp;
#endif
#else
                    u32x4 w; w.x = cvt_pk_bf16(v0[0], v0[1]); w.y = cvt_pk_bf16(v0[2], v0[3]); w.z = cvt_pk_bf16(v1[0], v1[1]); w.w = cvt_pk_bf16(v1[2], v1[3]);
                    *(u32x4*)(rowp + bj * 128) = w;
#endif
                } }
    }
};

namespace attn_body {
using bf16=__hip_bfloat16;
using bf16x8=__attribute__((ext_vector_type(8)))short;
using s16x4=__attribute__((ext_vector_type(4)))short;
using f32x16=__attribute__((ext_vector_type(16)))float;
using u32x4=__attribute__((ext_vector_type(4)))unsigned;
constexpr int BATCH=4,NHEAD=8,SEQ=4096,D=64,DM=NHEAD*D;
constexpr int NW=8,QBLK=32,QB=QBLK*NW,KVBLK=64,NQB=SEQ/QB;
__device__ __forceinline__ int crow(int r,int hi){return (r&3)+8*(r>>2)+4*hi;}
#define SBAR() __builtin_amdgcn_sched_barrier(0)
__device__ __forceinline__ void cmask(f32x16&p0,f32x16&p1,int jb,int qrel,int hi){
  const float NEG=-INFINITY; int kb=64*jb+4*hi;
  #pragma unroll
  for(int r=0;r<16;++r){int kv=kb+(r&3)+8*(r>>2); if(kv>qrel)p0[r]=NEG; if(kv+32>qrel)p1[r]=NEG;}
}
constexpr int NSLOT=3, SLOTB=8192;
constexpr int LDS_K=0, LDS_V=NSLOT*SLOTB, LDS_WS=2*NSLOT*SLOTB, LDS_OST=LDS_WS+NW*64*4, LDS_BYTES=LDS_OST+NW*4096;
constexpr int LDS_GATE=LDS_OST;
__device__ __forceinline__ void glds16(const void*gsrc,unsigned lds_dst){unsigned keep;
  asm volatile("s_mov_b32 %0, m0\n\ts_mov_b32 m0, %2\n\ts_nop 0\n\tglobal_load_lds_dwordx4 %1, off\n\ts_mov_b32 m0, %0":"=&s"(keep):"v"(gsrc),"s"(lds_dst):"memory");}
typedef float f32x2_t __attribute__((ext_vector_type(2))); typedef __bf16 bf16x2_t __attribute__((ext_vector_type(2)));
__device__ __forceinline__ unsigned cvtpk_s(float lo,float hi){f32x2_t v={lo,hi};bf16x2_t b=__builtin_convertvector(v,bf16x2_t);return __builtin_bit_cast(unsigned,b);}
#define WAIT_BAR(N) asm volatile("s_waitcnt vmcnt(" #N ") lgkmcnt(0)\n\ts_barrier":::"memory")
__device__ __forceinline__ float max3f(float a,float b,float c){return __builtin_fmaxf(__builtin_fmaxf(a,b),c);}
typedef __attribute__((address_space(3))) const char* lds_cptr;
typedef short v4i16_t __attribute__((ext_vector_type(4)));
__device__ __forceinline__ void kload8(bf16x8*kf,lds_cptr kp){
  kf[0]=*(const __attribute__((address_space(3))) bf16x8*)(kp);      kf[1]=*(const __attribute__((address_space(3))) bf16x8*)(kp+512);
  kf[2]=*(const __attribute__((address_space(3))) bf16x8*)(kp+2048); kf[3]=*(const __attribute__((address_space(3))) bf16x8*)(kp+2560);
  kf[4]=*(const __attribute__((address_space(3))) bf16x8*)(kp+4096); kf[5]=*(const __attribute__((address_space(3))) bf16x8*)(kp+4608);
  kf[6]=*(const __attribute__((address_space(3))) bf16x8*)(kp+6144); kf[7]=*(const __attribute__((address_space(3))) bf16x8*)(kp+6656);
}
__device__ __forceinline__ void kload2(bf16x8*kf,lds_cptr kp,int j){ kf[2*j]=*(const __attribute__((address_space(3))) bf16x8*)(kp+j*2048); kf[2*j+1]=*(const __attribute__((address_space(3))) bf16x8*)(kp+j*2048+512); }
__device__ __forceinline__ s16x4 vtr(lds_cptr p){ return __builtin_bit_cast(s16x4,__builtin_amdgcn_ds_read_tr16_b64_v4i16((__attribute__((address_space(3))) v4i16_t*)p)); }
__device__ __forceinline__ float rowmax(const f32x16&p0,const f32x16&p1){
  float a=max3f(p0[0],p0[1],p1[0]),b=max3f(p0[2],p0[3],p1[1]);a=max3f(a,p1[2],p1[3]);
  #pragma unroll
  for(int r=4;r<16;r+=4){a=max3f(a,p0[r],p0[r+1]);b=max3f(b,p0[r+2],p0[r+3]);a=max3f(a,p1[r],p1[r+1]);b=max3f(b,p1[r+2],p1[r+3]);}
  const float m=__builtin_fmaxf(a,b);
  auto rr=__builtin_amdgcn_permlane32_swap(__float_as_uint(m),__float_as_uint(m),false,false);
  return __builtin_fmaxf(__uint_as_float(rr[0]),__uint_as_float(rr[1]));
}
__device__ __forceinline__ void pv(f32x16*o,int vb,bf16x8 pa0,bf16x8 pa1,bf16x8 pa2,bf16x8 pa3){
  #pragma unroll
  for(int d0=0;d0<2;++d0){s16x4 lo[4],hi[4];
    #pragma unroll
    for(int ks=0;ks<4;++ks){
      asm volatile("ds_read_b64_tr_b16 %0,%1 offset:%c2":"=&v"(lo[ks]):"v"(vb),"i"(d0*4096+ks*1024):"memory");
      asm volatile("ds_read_b64_tr_b16 %0,%1 offset:%c2":"=&v"(hi[ks]):"v"(vb),"i"(d0*4096+ks*1024+512):"memory");}
    asm volatile("s_waitcnt lgkmcnt(0)":::"memory");SBAR();
    #define PK(k) (bf16x8){lo[k][0],lo[k][1],lo[k][2],lo[k][3],hi[k][0],hi[k][1],hi[k][2],hi[k][3]}
    o[d0]=__builtin_amdgcn_mfma_f32_32x32x16_bf16(pa0,PK(0),o[d0],0,0,0);
    o[d0]=__builtin_amdgcn_mfma_f32_32x32x16_bf16(pa1,PK(1),o[d0],0,0,0);
    o[d0]=__builtin_amdgcn_mfma_f32_32x32x16_bf16(pa2,PK(2),o[d0],0,0,0);
    o[d0]=__builtin_amdgcn_mfma_f32_32x32x16_bf16(pa3,PK(3),o[d0],0,0,0);
    #undef PK
  }
}
constexpr float MASKED=-1.0e30f, LOWREF=-1000.f;
template<int THRL> __device__ __forceinline__ void attn_unit(int b,int h,int qb,const bf16*Q,const bf16*__restrict__ K,const bf16*__restrict__ V,const float*__restrict__ KM,bf16*O,char*shm){
  int tid=threadIdx.x; asm volatile("":"+v"(tid));
  const int lane=tid&63,r32=lane&31,hi=lane>>5; const int wid=__builtin_amdgcn_readfirstlane(tid>>6);
  const long rowbase=(long)b*SEQ; const int q0=qb*QB;
  const bf16*Qw=Q+(rowbase+q0+wid*QBLK)*DM+h*D;
  const bf16*Kh=K+rowbase*DM+h*D,*Vh=V+rowbase*DM+h*D;
  const unsigned lds0=(unsigned)(uintptr_t)shm;
  __attribute__((address_space(3))) float*wsf=(__attribute__((address_space(3))) float*)((__attribute__((address_space(3))) char*)shm+LDS_WS)+wid*64;
#if KV_IMAGE
  (void)Kh; (void)Vh;
  const bf16*ksrc=K+(long)((b*NHEAD+h)*(SEQ/KVBLK))*(KVBLK*D)+wid*512+lane*8;
  const bf16*vsrc=V+(long)((b*NHEAD+h)*(SEQ/KVBLK))*(KVBLK*D)+wid*512+lane*8;
  const unsigned kdst=lds0+LDS_K+wid*1024, vdst=lds0+LDS_V+wid*1024;
  #define TAU(t) (NT-1-(t))
  #define DMA_K(t,slot) glds16(ksrc+(long)TAU(t)*(KVBLK*D),(unsigned)__builtin_amdgcn_readfirstlane(kdst+(slot)))
  #define DMA_V(t,slot) glds16(vsrc+(long)TAU(t)*(KVBLK*D),(unsigned)__builtin_amdgcn_readfirstlane(vdst+(slot)))
#else
  const bf16*ksrc=Kh+(long)lane*DM+wid*8;
  const bf16*vsrc=Vh+(long)(16*(wid&3)+(lane>>2))*DM+(wid>>2)*32+(lane&3)*8;
  const unsigned kdst=lds0+LDS_K+wid*1024, vdst=lds0+LDS_V+wid*1024;
  #define DMA_K(t,slot) glds16(ksrc+(long)(t)*KVBLK*DM,(unsigned)__builtin_amdgcn_readfirstlane(kdst+(slot)))
  #define DMA_V(t,slot) glds16(vsrc+(long)(t)*KVBLK*DM,(unsigned)__builtin_amdgcn_readfirstlane(vdst+(slot)))
#endif
  const int vb0=(int)(lds0+LDS_V)+((lane>>4)&1)*32+(lane&3)*8+(4*hi+((lane&15)>>2))*64;
  bf16x8 kf[8];
  const lds_cptr shm3=(lds_cptr)shm; const lds_cptr kp0=shm3+LDS_K+hi*1024+r32*16; const lds_cptr vp0=shm3+LDS_V+((lane>>4)&1)*32+(lane&3)*8+(4*hi+((lane&15)>>2))*64;
  const int NT=(q0+QB)/KVBLK;
  DMA_K(0,0);DMA_V(0,0);DMA_K(1,SLOTB);
  bf16x8 qr[4];
  #pragma unroll
  for(int d0=0;d0<4;++d0)qr[d0]=*reinterpret_cast<const bf16x8*>(&Qw[(long)r32*DM+d0*16+hi*8]);
  { const int row=tid>>4, dg=tid&15, j=row&15; f32x4 m4=(f32x4){0.f,0.f,0.f,0.f};
    if(j<qb) m4=*(const f32x4*)(KM+((long)(b*NQB+j))*DM+h*D+4*dg);
    unsigned w0,w1; { const unsigned h0=cvtpk_s(m4[0],m4[1]),h1=cvtpk_s(m4[2],m4[3]);
      if(row<16){w0=h0;w1=h1;} else { w0=cvtpk_s(m4[0]-__uint_as_float(h0<<16),m4[1]-__uint_as_float(h0&0xffff0000u)); w1=cvtpk_s(m4[2]-__uint_as_float(h1<<16),m4[3]-__uint_as_float(h1&0xffff0000u)); } }
    typedef unsigned u32x2_t __attribute__((ext_vector_type(2)));
    *(__attribute__((address_space(3))) u32x2_t*)(shm3+LDS_GATE+(dg>>1)*512+row*16+(dg&1)*8)=(u32x2_t){w0,w1}; }
  float mhat=0.f,l_reg=0.f;
  const int qrel=wid*QBLK+r32;
  const float sl2=exp2f(-(float)(h+1))*1.4426950408889634f;
  const float cb0=sl2*(float)(4*hi-(q0+qrel));
  #define CMASK(P0,P1,t) do{int jb_=3-(t); if(jb_>=0)cmask(P0,P1,jb_,qrel,hi);}while(0)
  #define CINIT(C0,C1,t) do{ const bool s_=((selmask>>(TAU(t)>>2))&1u)!=0u; const float bt_=s_?(cb0+sl2*(float)(64*TAU(t))-mhat):MASKED; \
      _Pragma("unroll") for(int r=0;r<16;++r){ const float kc_=(float)((r&3)+8*(r>>2)); C0[r]=__builtin_fmaf(sl2,kc_,bt_); C1[r]=__builtin_fmaf(sl2,kc_+32.f,bt_);} }while(0)
  bool resc=false;
  #define START(P0,P1) do{ const float rm=rowmax(P0,P1); resc=false; \
    { const float dl=__builtin_fmaxf(rm,LOWREF); mhat+=dl; \
      _Pragma("unroll") for(int r=0;r<16;++r){P0[r]-=dl;P1[r]-=dl;} } \
    _Pragma("unroll") for(int r=0;r<16;++r)P0[r]=__builtin_amdgcn_exp2f(P0[r]); }while(0)
  #define RESC() do{ if(resc){ asm volatile("s_waitcnt lgkmcnt(0)":::"memory"); \
      _Pragma("unroll") for(int d_=0;d_<2;++d_) _Pragma("unroll") for(int r=0;r<16;++r)o[d_][r]*=wsf[crow(r,hi)]; } }while(0)
  f32x16 pA0,pA1,pB0,pB1;
  int sl_prev=0,sl_cur=0,sl_next=SLOTB;
  #define ROT() do{sl_prev=sl_cur;sl_cur=sl_next;sl_next=(sl_next==(NSLOT-1)*SLOTB)?0:sl_next+SLOTB;}while(0)
  DMA_K(2,2*SLOTB);
  WAIT_BAR(3);
  unsigned selmask=1u<<qb;
  if(qb>0){
    f32x16 g=f32x16{};
    #pragma unroll
    for(int d0=0;d0<4;++d0){ const bf16x8 a=*(const __attribute__((address_space(3))) bf16x8*)(shm3+LDS_GATE+(2*d0+hi)*512+r32*16); g=__builtin_amdgcn_mfma_f32_32x32x16_bf16(a,qr[d0],g,0,0,0); }
    float gl[8],gp[8];
    #pragma unroll
    for(int i=0;i<4;++i){ gl[i]=g[i]+g[8+i]; gl[4+i]=g[4+i]+g[12+i]; }
    #pragma unroll
    for(int i=0;i<8;++i) gp[i]=DPP_REDUCE?xor32f(gl[i],hi):__shfl_xor(gl[i],32);
    float gv[16];
    #pragma unroll
    for(int j=0;j<16;++j){ const int half=(j>>2)&1, i=(j&3)+4*(j>>3); const float v=(half==hi)?gl[i]:gp[i]; gv[j]=(j<qb)?v:-INFINITY; }
    #pragma unroll
    for(int s=0;s<3;++s){ int best=-1; float bv=-INFINITY;
      #pragma unroll
      for(int j=0;j<16;++j) if(gv[j]>bv){bv=gv[j];best=j;}
      #pragma unroll
      for(int j=0;j<16;++j) if(j==best) gv[j]=-INFINITY;
      if(best>=0) selmask|=1u<<best; }
  }
  f32x16 o[2];o[0]=f32x16{};o[1]=f32x16{}; asm volatile("":"+v"(o[0]),"+v"(o[1]));
  { const lds_cptr kp=kp0; kload8(kf,kp); }
  CINIT(pA0,pA1,0);
  #pragma unroll
  for(int d0=0;d0<4;++d0){ pA0=__builtin_amdgcn_mfma_f32_32x32x16_bf16(kf[2*d0],qr[d0],pA0,0,0,0); pA1=__builtin_amdgcn_mfma_f32_32x32x16_bf16(kf[2*d0+1],qr[d0],pA1,0,0,0); }
  CMASK(pA0,pA1,0);
  START(pA0,pA1);
  _Pragma("unroll") for(int r=0;r<16;++r)pA1[r]=__builtin_amdgcn_exp2f(pA1[r]);
  WAIT_BAR(0);
  DMA_K(3,0);DMA_V(1,SLOTB);
  ROT();
  kload8(kf,kp0+sl_cur);
  WAIT_BAR(2);
  s16x4 vlo[8],vhi[8]; u32x4 pw0,pw1,pw2,pw3;
  #define PKW(P,B) cvtpk_s(P[B],P[B+1])
  #define PAF(k) __builtin_bit_cast(bf16x8,pw##k)
  #define VFR(i) (bf16x8){vlo[i][0],vlo[i][1],vlo[i][2],vlo[i][3],vhi[i][0],vhi[i][1],vhi[i][2],vhi[i][3]}
  #define PIN(x) asm volatile("":"+v"(x))
  #define MX3(a,b,c) __builtin_fmaxf(__builtin_fmaxf((a),(b)),(c))
  #define GAPA(MF,A0,A1,A2,A3,W0,W1,PW) do{ MF; sacc+=A0; sacc+=A1; sacc+=A2; sacc+=A3; PIN(sacc); W0; W1; PIN(PW); SBAR(); }while(0)
  #define EX(v) __builtin_amdgcn_exp2f(v)
  #define KCF(r) ((float)(((r)&3)+8*((r)>>2)))
  #define GAPB(MF,X,B,N0,N1,R) do{ MF; X[B]=EX(X[B]); X[B+1]=EX(X[B+1]); X[B+2]=EX(X[B+2]); X[B+3]=EX(X[B+3]); PIN(X); \
    N0[R]=__builtin_fmaf(sl2,KCF(R),btn_); N0[R+1]=__builtin_fmaf(sl2,KCF(R+1),btn_); N1[R]=__builtin_fmaf(sl2,KCF(R)+32.f,btn_); N1[R+1]=__builtin_fmaf(sl2,KCF(R+1)+32.f,btn_); SBAR(); }while(0)
  #define VRD(i) do{ vlo[i]=vtr(vp_+(((i)>>2)*4096+((i)&3)*1024)); vhi[i]=vtr(vp_+(((i)>>2)*4096+((i)&3)*1024+512)); }while(0)
  #define KRD(G,j) do{ if(G){ kload2(kf,kp0+sl_next,j); SBAR(); } }while(0)
  #define STEP(C0,C1,P0,P1,t,GK,GV,GL) do{ SBAR(); \
    const lds_cptr vp_=vp0+sl_prev; \
    VRD(0); SBAR(); float sacc=(P0[0]+P0[1]); \
    GAPA(C0=__builtin_amdgcn_mfma_f32_32x32x16_bf16(kf[0],qr[0],C0,0,0,0), P0[2],P0[3],P0[4],P0[5],     pw0[0]=PKW(P0,0), pw0[1]=PKW(P0,2), pw0); \
    VRD(4); SBAR(); GAPA(C1=__builtin_amdgcn_mfma_f32_32x32x16_bf16(kf[1],qr[0],C1,0,0,0), P0[6],P0[7],P0[8],P0[9],     pw0[2]=PKW(P0,4), pw0[3]=PKW(P0,6), pw0); \
    VRD(1); SBAR(); GAPA(C0=__builtin_amdgcn_mfma_f32_32x32x16_bf16(kf[2],qr[1],C0,0,0,0),   P0[10],P0[11],P0[12],P0[13], pw1[0]=PKW(P0,8), pw1[1]=PKW(P0,10), pw1); \
    VRD(5); SBAR(); GAPA(C1=__builtin_amdgcn_mfma_f32_32x32x16_bf16(kf[3],qr[1],C1,0,0,0),   P0[14],P0[15],P1[0],P1[1],   pw1[2]=PKW(P0,12),pw1[3]=PKW(P0,14), pw1); \
    VRD(2); SBAR(); GAPA(C0=__builtin_amdgcn_mfma_f32_32x32x16_bf16(kf[4],qr[2],C0,0,0,0),   P1[2],P1[3],P1[4],P1[5],     pw2[0]=PKW(P1,0), pw2[1]=PKW(P1,2), pw2); \
    VRD(6); SBAR(); GAPA(C1=__builtin_amdgcn_mfma_f32_32x32x16_bf16(kf[5],qr[2],C1,0,0,0),   P1[6],P1[7],P1[8],P1[9],     pw2[2]=PKW(P1,4), pw2[3]=PKW(P1,6), pw2); \
    VRD(3); SBAR(); GAPA(C0=__builtin_amdgcn_mfma_f32_32x32x16_bf16(kf[6],qr[3],C0,0,0,0),   P1[10],P1[11],P1[12],P1[13], pw3[0]=PKW(P1,8), pw3[1]=PKW(P1,10), pw3); \
    VRD(7); SBAR(); GAPA(C1=__builtin_amdgcn_mfma_f32_32x32x16_bf16(kf[7],qr[3],C1,0,0,0),   P1[14],P1[15],0.f,0.f,       pw3[2]=PKW(P1,12),pw3[3]=PKW(P1,14), pw3); \
    l_reg+=sacc; \
    if(GK){DMA_K((t)+3,sl_cur);} if(GV){DMA_V((t)+1,sl_next);} \
    CMASK(C0,C1,t); \
    { float a=MX3(C0[0],C0[1],C1[0]),b=MX3(C0[2],C0[3],C1[1]); a=MX3(a,C1[2],C1[3]); \
      _Pragma("unroll") for(int r=4;r<16;r+=4){a=MX3(a,C0[r],C0[r+1]);b=MX3(b,C0[r+2],C0[r+3]);a=MX3(a,C1[r],C1[r+1]);b=MX3(b,C1[r+2],C1[r+3]);} \
      float rm=__builtin_fmaxf(a,b); { auto rr=__builtin_amdgcn_permlane32_swap(__float_as_uint(rm),__float_as_uint(rm),false,false); rm=__builtin_fmaxf(__uint_as_float(rr[0]),__uint_as_float(rr[1])); } \
      resc=false; \
      if(__builtin_expect(__any(rm>(float)THRL),0)){ const float dl=__builtin_fmaxf(rm,0.f); mhat+=dl; \
        _Pragma("unroll") for(int r=0;r<16;++r){C0[r]-=dl;C1[r]-=dl;} \
        const float f=__builtin_amdgcn_exp2f(-dl); l_reg*=f; if(hi==0)wsf[r32]=f; resc=true; } } \
    const float btn_=(TAU((t)+1)>=0&&((selmask>>(TAU((t)+1)>>2))&1u)!=0u)?(cb0+sl2*(float)(64*TAU((t)+1))-mhat):MASKED; \
    SBAR(); \
    GAPB(o[0]=__builtin_amdgcn_mfma_f32_32x32x16_bf16(PAF(0),VFR(0),o[0],0,0,0), C0,0, P0,P1,0); \
    GAPB(o[1]=__builtin_amdgcn_mfma_f32_32x32x16_bf16(PAF(0),VFR(4),o[1],0,0,0), C0,4, P0,P1,2); \
    KRD(GL,0); GAPB(o[0]=__builtin_amdgcn_mfma_f32_32x32x16_bf16(PAF(1),VFR(1),o[0],0,0,0), C0,8, P0,P1,4); \
    KRD(GL,1); GAPB(o[1]=__builtin_amdgcn_mfma_f32_32x32x16_bf16(PAF(1),VFR(5),o[1],0,0,0), C0,12, P0,P1,6); \
    KRD(GL,2); GAPB(o[0]=__builtin_amdgcn_mfma_f32_32x32x16_bf16(PAF(2),VFR(2),o[0],0,0,0), C1,0, P0,P1,8); \
    KRD(GL,3); GAPB(o[1]=__builtin_amdgcn_mfma_f32_32x32x16_bf16(PAF(2),VFR(6),o[1],0,0,0), C1,4, P0,P1,10); \
    GAPB(o[0]=__builtin_amdgcn_mfma_f32_32x32x16_bf16(PAF(3),VFR(3),o[0],0,0,0), C1,8, P0,P1,12); \
    GAPB(o[1]=__builtin_amdgcn_mfma_f32_32x32x16_bf16(PAF(3),VFR(7),o[1],0,0,0), C1,12, P0,P1,14); \
    }while(0)
  CINIT(pB0,pB1,1);
  int t=1;
  #undef CMASK
  #define CMASK(P0,P1,t) do{int jb_=3-(t); if(jb_>=0)cmask(P0,P1,jb_,qrel,hi);}while(0)
  for(int it_=0;it_<2&&t+5<NT;++it_,t+=2){
    STEP(pB0,pB1,pA0,pA1,t,true,true,true);     WAIT_BAR(2); RESC(); ROT();
    STEP(pA0,pA1,pB0,pB1,t+1,true,true,true);   WAIT_BAR(2); RESC(); ROT();
  }
  #undef CMASK
  #define CMASK(P0,P1,t) do{}while(0)
  for(;t+5<NT;t+=2){
    STEP(pB0,pB1,pA0,pA1,t,true,true,true);     WAIT_BAR(2); RESC(); ROT();
    STEP(pA0,pA1,pB0,pB1,t+1,true,true,true);   WAIT_BAR(2); RESC(); ROT();
  }
  #undef CMASK
  #define CMASK(P0,P1,t) do{int jb_=3-(t); if(jb_>=0)cmask(P0,P1,jb_,qrel,hi);}while(0)
  #define ENDW(tt) do{ if((tt)+3<NT){WAIT_BAR(2);} else if((tt)+2<NT){WAIT_BAR(1);} else {WAIT_BAR(0);} }while(0)
  for(;t+1<NT;t+=2){
    STEP(pB0,pB1,pA0,pA1,t,(t+3<NT),(t+1<NT),(t+1<NT));       ENDW(t);   RESC(); ROT();
    STEP(pA0,pA1,pB0,pB1,t+1,(t+4<NT),(t+2<NT),(t+2<NT));     ENDW(t+1); RESC(); ROT();
  }
  STEP(pB0,pB1,pA0,pA1,NT-1,false,false,false); RESC();
  { float sacc=pB0[0]+pB0[1]; _Pragma("unroll") for(int r=2;r<16;++r)sacc+=pB0[r]; _Pragma("unroll") for(int r=0;r<16;++r)sacc+=pB1[r]; l_reg+=sacc;
    pw0=(u32x4){PKW(pB0,0),PKW(pB0,2),PKW(pB0,4),PKW(pB0,6)};pw1=(u32x4){PKW(pB0,8),PKW(pB0,10),PKW(pB0,12),PKW(pB0,14)};pw2=(u32x4){PKW(pB1,0),PKW(pB1,2),PKW(pB1,4),PKW(pB1,6)};pw3=(u32x4){PKW(pB1,8),PKW(pB1,10),PKW(pB1,12),PKW(pB1,14)};
    SBAR(); pv(o,vb0+sl_cur,PAF(0),PAF(1),PAF(2),PAF(3)); }
  #undef PKW
  #undef PAF
  #undef VFR
  #undef PIN
  #undef MX3
  #undef GAPA
  #undef GAPB
  #undef KCF
  #undef EX
  #undef VRD
  #undef KRD
  #undef STEP
  #undef ENDW
  {auto rr=__builtin_amdgcn_permlane32_swap(__float_as_uint(l_reg),__float_as_uint(l_reg),false,false);l_reg=__uint_as_float(rr[0])+__uint_as_float(rr[1]);}
  if(hi==0)wsf[32+r32]=l_reg;asm volatile("s_waitcnt lgkmcnt(0)":::"memory");
  float rli[16];
  #pragma unroll
  for(int r=0;r<16;++r)rli[r]=__builtin_amdgcn_rcpf(wsf[32+crow(r,hi)]);
  int lane2=lane; asm volatile("":"+v"(lane2));
  constexpr int OP=P3_FUSED?2*DM:DM;
  bf16*Ow=O+(rowbase+q0+wid*QBLK)*OP+h*D;
  { __attribute__((address_space(3))) unsigned short*stg=(__attribute__((address_space(3))) unsigned short*)((__attribute__((address_space(3))) char*)shm+LDS_OST)+wid*2048;
    #pragma unroll
    for(int r=0;r<16;++r){const int orow=crow(r,hi);
      #pragma unroll
      for(int d0=0;d0<2;++d0)stg[orow*64+d0*32+r32]=(unsigned short)(cvtpk_s(o[d0][r]*rli[r],0.f)&0xffffu);}
    asm volatile("s_waitcnt lgkmcnt(0)":::"memory");
    #pragma unroll
    for(int i=0;i<4;++i){const int row=i*8+(lane2>>3),ch=lane2&7; const u32x4 v=*(const __attribute__((address_space(3))) u32x4*)(stg+row*64+ch*8); *(u32x4*)(Ow+(long)row*OP+ch*8)=v;} }
  asm volatile("s_waitcnt lgkmcnt(0)\n\ts_barrier":::"memory");
  #undef DMA_K
  #undef DMA_V
  #undef CMASK
  #undef CINIT
  #undef START
  #undef RESC
  #undef ROT
}
constexpr int ATTN_LDS_BYTES=LDS_BYTES;
#undef SBAR
#undef WAIT_BAR
}

struct Frame { LAS unsigned char* lds; int tid, lane, wave, vcu, G; };
#define LDS_WAIT() asm volatile("s_waitcnt lgkmcnt(0)" ::: "memory")

struct P0Item { const float* W; bf16* WT; const float* ks; int K, N, k0, n0, f8, nblk, pitch; };
__device__ __forceinline__ P0Item p0_decode(const Ptrs& P, int it) {
    constexpr int I_IN = (D / 64) * ((IN_I8 ? 256 * IN_BF_TILES : NIN) / 32), I_A = (AW / 64) * (D / 32), I_M = (D / 64) * (D / 32), I_GU = (D / 64) * (2 * DE / 32), I_D = (DE / 64) * (D / 32);
    unsigned char* ws = P.ws; P0Item q; int r = it; q.f8 = 0; q.nblk = 0; q.pitch = 0;
    if (r < I_IN) { q.W = P.w_in; q.WT = (bf16*)(ws + WS_WIN); q.ks = XB_RES ? P.mix_g : nullptr; q.K = D; q.N = NIN; q.nblk = (IN_I8 ? 256 * IN_BF_TILES : NIN) / 32; }
    else if ((r -= I_IN) < I_A) { q.W = P.w_attn_out; q.WT = (bf16*)(ws + WS_WA); q.ks = nullptr; q.K = AW; q.N = D; q.pitch = P3_FUSED ? 1024 : 0; }
    else if ((r -= I_A) < I_A) { q.W = P.w_sgu_out; q.WT = P3_FUSED ? (bf16*)(ws + WS_WA) + 512 : (bf16*)(ws + WS_WS); q.ks = nullptr; q.K = SW; q.N = D; q.pitch = P3_FUSED ? 1024 : 0; }
    else if ((r -= I_A) < I_M) { q.W = P.w_mix_out; q.WT = (bf16*)(ws + WS_WM); q.ks = nullptr; q.K = D; q.N = D; }
    else if (!MOE_I8 && (r -= I_M) < NE * I_GU) { const int e = r / I_GU; r -= e * I_GU; q.W = P.w_gu + (size_t)e * D * 2 * DE; q.WT = (bf16*)(ws + WS_WGU) + (size_t)e * D * 2 * DE; q.ks = P.ffn_g; q.K = D; q.N = 2 * DE; }
    else { r -= MOE_I8 ? I_M : NE * I_GU; const int e = r / I_D; r -= e * I_D; q.W = P.w_down + (size_t)e * DE * D; q.WT = MOE_F8 ? (bf16*)(ws + WS_WD + (size_t)e * DE * D) : (bf16*)(ws + WS_WD) + (size_t)e * DE * D; q.ks = nullptr; q.K = DE; q.N = D; q.f8 = MOE_F8; }
    const int nblk = q.nblk ? q.nblk : q.N / 32; q.k0 = 64 * (r / nblk); q.n0 = 32 * (r % nblk); return q;
}
__device__ __forceinline__ void p0_load(const P0Item& q, int lane, f32x4 (&buf)[8]) {
    const float* src = q.W + (size_t)(q.k0 + (lane >> 3)) * q.N + q.n0 + 4 * (lane & 7);
#pragma unroll
    for (int i = 0; i < 8; ++i) buf[i] = __builtin_nontemporal_load((const GAS f32x4*)(src + (size_t)(8 * i) * q.N));
}
__device__ __forceinline__ void p0_store(const P0Item& q, int lane, const f32x4 (&buf)[8], LAS float* scr) {
#pragma unroll
    for (int i = 0; i < 8; ++i) { const int kk = (lane >> 3) + 8 * i; const float sc = q.ks ? q.ks[q.k0 + kk] : 1.f; LAS float* d = scr + kk * 33 + 4 * (lane & 7);
        d[0] = buf[i][0] * sc; d[1] = buf[i][1] * sc; d[2] = buf[i][2] * sc; d[3] = buf[i][3] * sc; }
    LDS_WAIT(); asm volatile("" ::: "memory");
    const int c = lane & 7;
#pragma unroll
    for (int j = 0; j < 4; ++j) { const int n = (lane >> 3) + 8 * j; const LAS float* s = scr + (8 * c) * 33 + n;
        if (q.f8) { u32x2 o; unsigned w = 0u; w = __builtin_amdgcn_cvt_pk_fp8_f32(s[0 * 33] * 32.f, s[1 * 33] * 32.f, w, false); w = __builtin_amdgcn_cvt_pk_fp8_f32(s[2 * 33] * 32.f, s[3 * 33] * 32.f, w, true); o.x = w;
            w = 0u; w = __builtin_amdgcn_cvt_pk_fp8_f32(s[4 * 33] * 32.f, s[5 * 33] * 32.f, w, false); w = __builtin_amdgcn_cvt_pk_fp8_f32(s[6 * 33] * 32.f, s[7 * 33] * 32.f, w, true); o.y = w;
            *(GAS u32x2*)((unsigned char*)q.WT + (size_t)(q.n0 + n) * q.K + q.k0 + 8 * c) = o; }
        else { u32x4 o; o.x = cvt_pk_bf16(s[0 * 33], s[1 * 33]); o.y = cvt_pk_bf16(s[2 * 33], s[3 * 33]); o.z = cvt_pk_bf16(s[4 * 33], s[5 * 33]); o.w = cvt_pk_bf16(s[6 * 33], s[7 * 33]);
            *(GAS u32x4*)(q.WT + (size_t)(q.n0 + n) * (q.pitch ? q.pitch : q.K) + q.k0 + 8 * c) = o; } }
    LDS_WAIT(); asm volatile("" ::: "memory");
}
__device__ __forceinline__ void p0_gu_load(const Ptrs& P, int s, int t, f32x4 (&v)[16]) {
    const bool gu = s < NE * 64; const int e = s >> 6, n0 = (s & 63) * 32; const size_t ld = gu ? (size_t)2 * DE : (size_t)NIN;
    const float* src = (gu ? P.w_gu + (size_t)e * D * 2 * DE + n0 : P.w_in + 256 * IN_BF_TILES + 32 * (s - NE * 64)) + 4 * (t & 7) + (size_t)(4 * (t >> 3)) * ld;
#pragma unroll
    for (int i = 0; i < 4; ++i)
#pragma unroll
        for (int j = 0; j < 4; ++j) v[4 * i + j] = __builtin_nontemporal_load((const GAS f32x4*)(src + (size_t)(256 * i + j) * ld));
}
#define LDS_BARRIER() asm volatile("s_waitcnt lgkmcnt(0)\n\ts_barrier" ::: "memory")
__device__ __forceinline__ void p0_gu_process(Frame& F, const Ptrs& P, int s, f32x4 (&va)[16], const f32x4 (&gk)[4]) {
    unsigned char* ws = P.ws; LAS unsigned char* tile = F.lds; LAS unsigned* lmax = (LAS unsigned*)(F.lds + 40960);
    const int t = F.tid, n4 = 4 * (t & 7), kq = t >> 3; const bool gu = s < NE * 64;
    unsigned char* qdst = gu ? ws + WS_WGU + (size_t)(s * 32) * 1024 : ws + WS_WINQ + (size_t)((s - NE * 64) * 32) * 1024;
    float* sdst = gu ? (float*)(ws + WS_SB) + s * 32 : (float*)(ws + WS_SBIN) + (s - NE * 64) * 32;
    if (t < 32) lmax[t] = 0u;
    f32x4 m = (f32x4){0.f, 0.f, 0.f, 0.f};
#pragma unroll
    for (int i = 0; i < 4; ++i)
#pragma unroll
        for (int j = 0; j < 4; ++j) { va[4 * i + j] = va[4 * i + j] * (gu ? gk[i][j] : 1.f); m = __builtin_elementwise_max(m, __builtin_elementwise_abs(va[4 * i + j])); }
    LDS_BARRIER();
#pragma unroll
    for (int c = 0; c < 4; ++c) __hip_atomic_fetch_max(lmax + n4 + c, __float_as_uint(m[c]), __ATOMIC_RELAXED, __HIP_MEMORY_SCOPE_WORKGROUP);
    LDS_BARRIER();
    f32x4 inv;
#pragma unroll
    for (int c = 0; c < 4; ++c) inv[c] = 127.f / fmaxf(__uint_as_float(lmax[n4 + c]), 1e-30f);
#pragma unroll
    for (int i = 0; i < 4; ++i)
#pragma unroll
        for (int c = 0; c < 4; ++c) { unsigned w = 0u;
#pragma unroll
            for (int j = 0; j < 4; ++j) { const int q = (int)__builtin_rintf(va[4 * i + j][c] * inv[c]); w |= ((unsigned)q & 0xffu) << (8 * j); }
            *(LAS unsigned*)(tile + (n4 + c) * 1040 + 4 * kq + 256 * i) = w; }
    LDS_BARRIER();
#pragma unroll
    for (int j = 0; j < 4; ++j) { const int ch = t + 512 * j, n = ch >> 6, kc = ch & 63; const u32x4 w = *(const LAS u32x4*)(tile + n * 1040 + 16 * kc);
        *(GAS u32x4*)(qdst + (size_t)n * 1024 + 16 * kc) = w; }
    if (t < 32) sdst[t] = __uint_as_float(lmax[t]) * (1.f / 127.f);
    LDS_BARRIER();
}
__device__ __forceinline__ void p0_gu_strips(Frame& F, const Ptrs& P) {
    const int t = F.tid, kq = t >> 3; constexpr int NS = NE * 64 + (IN_I8 ? (NIN - 256 * IN_BF_TILES) / 32 : 0);
    const int sb = (int)(((long)F.vcu * NS) / F.G), se = (int)(((long)(F.vcu + 1) * NS) / F.G);
    if (sb >= se) return;
    f32x4 va[16], vb[16]; p0_gu_load(P, sb, t, va);
    f32x4 gk[4];
#pragma unroll
    for (int i = 0; i < 4; ++i) gk[i] = *(const f32x4*)(P.ffn_g + 4 * kq + 256 * i);
    for (int s0 = sb;;) {
        const int s1 = s0 + 1; const bool has1 = s1 < se;
        p0_gu_load(P, has1 ? s1 : NS - 1, t, vb);
        p0_gu_process(F, P, s0, va, gk);
        if (!has1) break;
        s0 = s1 + 1; const bool has0 = s0 < se;
        p0_gu_load(P, has0 ? s0 : NS - 1, t, va);
        p0_gu_process(F, P, s1, vb, gk);
        if (!has0) break;
    }
}
#define SUBSTAMP(i) do { if (PROBE_K >= 0 && blockIdx.x == 0 && F.tid == 0) { ((LAS unsigned long long*)(F.lds + LX_MISC))[i] = __builtin_amdgcn_s_memrealtime(); } } while (0)
__device__ __forceinline__ void p0_prologue(Frame& F, const Ptrs& P) {
    unsigned char* ws = P.ws;
    const bool strips_first = (F.vcu & 1) == 0;
#if MOE_I8
    if (strips_first) p0_gu_strips(F, P);
#endif
    SUBSTAMP(10);
    LAS float* scr = (LAS float*)(F.lds + F.wave * 16384);
    const int gw = F.vcu * NWAVES + F.wave, NGW = F.G * NWAVES;
    constexpr int I_IN = (D / 64) * ((IN_I8 ? 256 * IN_BF_TILES : NIN) / 32), I_A = (AW / 64) * (D / 32), I_M = (D / 64) * (D / 32), I_GU = (D / 64) * (2 * DE / 32), I_D = (DE / 64) * (D / 32);
    constexpr int NITEMS = I_IN + 2 * I_A + I_M + (MOE_I8 ? 0 : NE * I_GU) + NE * I_D;
    if (gw < NITEMS) {
        P0Item cur = p0_decode(P, gw), nxt = cur; f32x4 bufA[8], bufB[8]; p0_load(cur, F.lane, bufA);
        for (int it = gw;;) {
            int nit = it + NGW; bool has = nit < NITEMS;
            nxt = p0_decode(P, has ? nit : NITEMS - 1); p0_load(nxt, F.lane, bufB);
            p0_store(cur, F.lane, bufA, scr);
            if (!has) break;
            it = nit + NGW; has = it < NITEMS;
            cur = p0_decode(P, has ? it : NITEMS - 1); p0_load(cur, F.lane, bufA);
            p0_store(nxt, F.lane, bufB, scr);
            if (!has) break;
        }
    }
    SUBSTAMP(11);
    if (ZERO_PAD && blockIdx.x == 0 && F.tid < 64) ((u32x4*)(ws + WS_ZROW))[F.tid] = (u32x4){0u, 0u, 0u, 0u};
    for (int i = (F.vcu * NWAVES + F.wave) * 64 + F.lane; i < NBATCH * 16 * 512; i += NGW * 64) ((float*)(ws + WS_CTL))[CW_KM + i] = 0.f;
    for (int i = (F.vcu * NWAVES + F.wave) * 64 + F.lane; i < 8 * 128 * 128 / 2; i += NGW * 64) { const int e0 = 2 * i, t = (e0 >> 7) & 127, s0 = e0 & 127; const f32x2 wv = *(const f32x2*)(P.w_sp + e0);
        ((unsigned*)(ws + WS_WSP))[i] = cvt_pk_bf16(s0 <= t ? wv.x : 0.f, s0 + 1 <= t ? wv.y : 0.f); }
    for (int i = (F.vcu * NWAVES + F.wave) * 64 + F.lane; i < NE * D; i += NGW * 64) { const int e = i / D, k = i % D; const float v = P.w_router[(size_t)k * NE + e] * P.ffn_g[k];
        const int wi = (((k >> 8) * 16 + ((k >> 4) & 15)) * 64 + ((k >> 3) & 1) * 32 + e) * 8 + (k & 7);
        const unsigned h = f2bf(v); ((bf16*)(ws + WS_WR))[wi] = (bf16)h; ((bf16*)(ws + WS_WR))[NE * D + wi] = (bf16)f2bf(v - bf2f(h)); }
    f32x4 gg[4];
#pragma unroll
    for (int j = 0; j < 4; ++j) gg[j] = ((const f32x4*)P.mix_g)[F.lane + 64 * j];
    int rb, re_;
    if (MOE_I8 && IN_I8 && F.G == 256 && T == 16384) { const int h = F.vcu >> 1; rb = h * 128 + ((F.vcu & 1) ? 75 : 0); re_ = rb + ((F.vcu & 1) ? 53 : 75); }
    else { const int per = (T + F.G - 1) / F.G; rb = F.vcu * per; re_ = rb + per < T ? rb + per : T; }
    for (int row = rb + F.wave; row < re_; row += 2 * NWAVES) {
        const int row2 = row + NWAVES; const bool two = row2 < re_;
        const GAS f32x4* xr = (const GAS f32x4*)(P.x + (size_t)row * D) + F.lane; const GAS f32x4* xr2 = (const GAS f32x4*)(P.x + (size_t)(two ? row2 : row) * D) + F.lane;
        f32x4 v[4], u[4]; float s = 0.f, s2 = 0.f;
#pragma unroll
        for (int j = 0; j < 4; ++j) { v[j] = __builtin_nontemporal_load(xr + 64 * j); u[j] = __builtin_nontemporal_load(xr2 + 64 * j); }
#pragma unroll
        for (int j = 0; j < 4; ++j) { s += (v[j].x * v[j].x + v[j].y * v[j].y) + (v[j].z * v[j].z + v[j].w * v[j].w); s2 += (u[j].x * u[j].x + u[j].y * u[j].y) + (u[j].z * u[j].z + u[j].w * u[j].w); }
        const float rstd = 1.f / sqrtf(wave_sum(s) * (1.f / D) + EPS), rstd2 = 1.f / sqrtf(wave_sum(s2) * (1.f / D) + EPS);
#if !XB_RES
#pragma unroll
        for (int j = 0; j < 4; ++j) { v[j] = v[j] * rstd * gg[j]; u[j] = u[j] * rstd2 * gg[j]; }
#endif
#pragma unroll
        for (int j = 0; j < 4; ++j) { u32x2 o; o.x = cvt_pk_bf16(v[j].x, v[j].y); o.y = cvt_pk_bf16(v[j].z, v[j].w);
            *((GAS u32x2*)(ws + WS_XN + (size_t)row * D * 2) + F.lane + 64 * j) = o; }
        if (two) {
#pragma unroll
            for (int j = 0; j < 4; ++j) { u32x2 o; o.x = cvt_pk_bf16(u[j].x, u[j].y); o.y = cvt_pk_bf16(u[j].z, u[j].w);
                *((GAS u32x2*)(ws + WS_XN + (size_t)row2 * D * 2) + F.lane + 64 * j) = o; } }
#if XB_RES
        if (F.lane == 0) { ((float*)(ws + WS_RSTDX))[row] = rstd; if (two) ((float*)(ws + WS_RSTDX))[row2] = rstd2; }
#pragma unroll
        for (int j = 0; j < 4; ++j) { v[j] = v[j] * rstd * gg[j]; u[j] = u[j] * rstd2 * gg[j]; }
#endif
#if IN_I8
        { float a1 = 0.f, a2 = 0.f;
#pragma unroll
          for (int j = 0; j < 4; ++j) { const f32x4 av = __builtin_elementwise_abs(v[j]), au = __builtin_elementwise_abs(u[j]); a1 = fmaxf(a1, fmaxf(fmaxf(av.x, av.y), fmaxf(av.z, av.w))); a2 = fmaxf(a2, fmaxf(fmaxf(au.x, au.y), fmaxf(au.z, au.w))); }
          a1 = fmaxf(wave_max(a1), 1e-30f); a2 = fmaxf(wave_max(a2), 1e-30f); const float q1 = 127.f / a1, q2 = 127.f / a2;
#pragma unroll
          for (int j = 0; j < 4; ++j) { const unsigned w = ((unsigned)(int)__builtin_rintf(v[j].x * q1) & 0xffu) | (((unsigned)(int)__builtin_rintf(v[j].y * q1) & 0xffu) << 8) | (((unsigned)(int)__builtin_rintf(v[j].z * q1) & 0xffu) << 16) | ((unsigned)(int)__builtin_rintf(v[j].w * q1) << 24);
              *((GAS unsigned*)(ws + WS_XNQ + (size_t)row * D) + F.lane + 64 * j) = w; }
          if (F.lane == 0) ((float*)(ws + WS_SXN))[row] = a1 * (1.f / 127.f);
          if (two) {
#pragma unroll
              for (int j = 0; j < 4; ++j) { const unsigned w = ((unsigned)(int)__builtin_rintf(u[j].x * q2) & 0xffu) | (((unsigned)(int)__builtin_rintf(u[j].y * q2) & 0xffu) << 8) | (((unsigned)(int)__builtin_rintf(u[j].z * q2) & 0xffu) << 16) | ((unsigned)(int)__builtin_rintf(u[j].w * q2) << 24);
                  *((GAS unsigned*)(ws + WS_XNQ + (size_t)row2 * D) + F.lane + 64 * j) = w; }
              if (F.lane == 0) ((float*)(ws + WS_SXN))[row2] = a2 * (1.f / 127.f); } }
#endif
    }
#if MOE_I8
    if (!strips_first) { __syncthreads(); p0_gu_strips(F, P); }
#endif
}
__device__ __forceinline__ void moe_tables(Frame& F, const unsigned* ctl) {
    LAS int* tbase = (LAS int*)(F.lds + LX_TBASE); LAS int* tile_e = (LAS int*)(F.lds + LX_TILEE);
    if (F.tid < 64) { const int c = F.tid < NE ? (int)ctl[CW_CNT + 64 * F.tid] : 0; const int n = (c + 255) >> 8; int incl = n;
#pragma unroll
        for (int o = 1; o < 64; o <<= 1) { const int t = __shfl_up(incl, o); if (F.lane >= o) incl += t; }
        if (F.tid <= NE) tbase[F.tid] = incl - n;
    }
    __syncthreads();
    for (int mt = F.tid; mt < NROWS_PAD / 256; mt += NWAVES * 64) { int e = 0;
        for (int i = 0; i < NE; ++i) if (mt >= tbase[i + 1]) e = i + 1;
        tile_e[mt] = e < NE ? e : NE - 1; }
    __syncthreads();
}


__device__ __forceinline__ void p5_router(Frame& F, const Ptrs& P) {
    unsigned char* ws = P.ws; unsigned* ctl = (unsigned*)(ws + WS_CTL);
    LAS float* red = (LAS float*)F.lds;
    LAS unsigned* lcnt = (LAS unsigned*)(F.lds + 40960);
    LAS f32x2* rowinfo = (LAS f32x2*)(F.lds + 41472);
    LAS unsigned* lbase = lcnt + 32;
    const int w = F.wave, lane = F.lane, gI = w & 1, kq = w >> 1, r32 = lane & 31, hi = lane >> 5;
    const bf16* WR = (const bf16*)(ws + WS_WR);
    for (int grp = blockIdx.x; grp < T / 64; grp += F.G) {
        if (F.tid < 64) lcnt[F.tid] = 0u;
        const int tok = grp * 64 + gI * 32 + r32;
        const float* xr = (const float*)(ws + WS_H1) + (size_t)tok * D + kq * 256 + 8 * hi;
        const bf16* xb = (const bf16*)(ws + WS_H1B) + (size_t)tok * D + kq * 256 + 8 * hi; (void)xb; (void)xr;
        const bf16* whi = WR + (size_t)(kq * 16 * 64 + lane) * 8 - 16 * 0; const bf16* wlo = whi + NE * D;
        f32x16 c = {}; float ss = 0.f; f32x4 am = (f32x4){0.f, 0.f, 0.f, 0.f};
#pragma unroll 4
        for (int s = 0; s < 16; ++s) {
#if H1_BF16
            const u32x4 xraw = *(const u32x4*)(xb + 16 * s);
            const f32x4 x0 = (f32x4){bf2f(xraw[0] & 0xffffu), bf2f(xraw[0] >> 16), bf2f(xraw[1] & 0xffffu), bf2f(xraw[1] >> 16)}, x1 = (f32x4){bf2f(xraw[2] & 0xffffu), bf2f(xraw[2] >> 16), bf2f(xraw[3] & 0xffffu), bf2f(xraw[3] >> 16)};
#else
            const f32x4 x0 = *(const f32x4*)(xr + 16 * s), x1 = *(const f32x4*)(xr + 16 * s + 4);
#endif
            am = __builtin_elementwise_max(am, __builtin_elementwise_max(__builtin_elementwise_abs(x0), __builtin_elementwise_abs(x1)));
            ss += (x0[0] * x0[0] + x0[1] * x0[1]) + (x0[2] * x0[2] + x0[3] * x0[3]) + (x1[0] * x1[0] + x1[1] * x1[1]) + (x1[2] * x1[2] + x1[3] * x1[3]);
            u32x4 hw, lw;
            { const unsigned h = cvt_pk_bf16(x0[0], x0[1]); hw[0] = h; lw[0] = cvt_pk_bf16(x0[0] - __uint_as_float(h << 16), x0[1] - __uint_as_float(h & 0xffff0000u)); }
            { const unsigned h = cvt_pk_bf16(x0[2], x0[3]); hw[1] = h; lw[1] = cvt_pk_bf16(x0[2] - __uint_as_float(h << 16), x0[3] - __uint_as_float(h & 0xffff0000u)); }
            { const unsigned h = cvt_pk_bf16(x1[0], x1[1]); hw[2] = h; lw[2] = cvt_pk_bf16(x1[0] - __uint_as_float(h << 16), x1[1] - __uint_as_float(h & 0xffff0000u)); }
            { const unsigned h = cvt_pk_bf16(x1[2], x1[3]); hw[3] = h; lw[3] = cvt_pk_bf16(x1[2] - __uint_as_float(h << 16), x1[3] - __uint_as_float(h & 0xffff0000u)); }
            const bf16x8 xh = __builtin_bit_cast(bf16x8, hw), xl = __builtin_bit_cast(bf16x8, lw);
            const bf16x8 ah = *(const bf16x8*)(whi + 512 * s), al = *(const bf16x8*)(wlo + 512 * s);
            c = __builtin_amdgcn_mfma_f32_32x32x16_bf16(ah, xh, c, 0, 0, 0);
            if (!H1_BF16) c = __builtin_amdgcn_mfma_f32_32x32x16_bf16(ah, xl, c, 0, 0, 0);
            c = __builtin_amdgcn_mfma_f32_32x32x16_bf16(al, xh, c, 0, 0, 0);
        }
#pragma unroll
        for (int r = 0; r < 16; ++r) red[(w * 18 + r) * 64 + lane] = c[r];
        red[(w * 18 + 16) * 64 + lane] = ss; red[(w * 18 + 17) * 64 + lane] = fmaxf(fmaxf(am[0], am[1]), fmaxf(am[2], am[3]));
        __syncthreads();
        int idx[4]; unsigned lpos[4]; float pw[4]; float rstd = 0.f;
        if (kq == 0) {
            float lg[16], pl[16]; float ssum = 0.f, amax = 0.f;
#pragma unroll
            for (int r = 0; r < 16; ++r) lg[r] = 0.f;
#pragma unroll
            for (int q = 0; q < 4; ++q) {
#pragma unroll
                for (int r = 0; r < 16; ++r) lg[r] += red[((w + 2 * q) * 18 + r) * 64 + lane];
                ssum += red[((w + 2 * q) * 18 + 16) * 64 + lane]; amax = fmaxf(amax, red[((w + 2 * q) * 18 + 17) * 64 + lane]); }
            ssum += DPP_REDUCE ? xor32f(ssum, hi) : __shfl_xor(ssum, 32); amax = fmaxf(fmaxf(amax, DPP_REDUCE ? xor32f(amax, hi) : __shfl_xor(amax, 32)), 1e-30f);
            rstd = 1.f / sqrtf(ssum * (1.f / D) + EPS);
            if (hi == 0) rowinfo[gI * 32 + r32] = (f32x2){127.f / amax, MOE_I8 ? rstd * amax * (1.f / 127.f) : rstd};
#pragma unroll
            for (int r = 0; r < 16; ++r) { lg[r] = lg[r] * rstd + P.b_router[(r & 3) + 8 * (r >> 2) + 4 * hi]; pl[r] = DPP_REDUCE ? xor32f(lg[r], hi) : __shfl_xor(lg[r], 32); }
            float v[32];
#pragma unroll
            for (int e = 0; e < 32; ++e) { const int half = (e >> 2) & 1, r = (e & 3) + 4 * (e >> 3); v[e] = (half == hi) ? lg[r] : pl[r]; }
            float val[4];
#pragma unroll
            for (int k = 0; k < 4; ++k) { int best = 0; float bv = -INFINITY;
#pragma unroll
                for (int e = 0; e < 32; ++e) if (v[e] > bv) { bv = v[e]; best = e; }
#pragma unroll
                for (int e = 0; e < 32; ++e) if (e == best) v[e] = -INFINITY;
                idx[k] = best; val[k] = bv; }
            float den = 0.f;
#pragma unroll
            for (int k = 0; k < 4; ++k) { pw[k] = __expf(val[k] - val[0]); den += pw[k]; }
            const float rden = 1.f / den;
#pragma unroll
            for (int k = 0; k < 4; ++k) { pw[k] *= rden; lpos[k] = 0u; if (hi == 0) lpos[k] = atomicAdd((unsigned*)&lcnt[idx[k]], 1u); }
        }
        __syncthreads();
        if (F.tid < NE) ((unsigned*)(ws + WS_HIST))[grp * NE + F.tid] = lcnt[F.tid];
        if (kq == 0 && hi == 0) {
            unsigned* slot = (unsigned*)(ws + WS_TOKSLOT); float* tw = (float*)(ws + WS_TOKW);
#pragma unroll
            for (int k = 0; k < 4; ++k) { slot[tok * 4 + k] = (unsigned)idx[k] | (lpos[k] << 8); tw[tok * 4 + k] = pw[k]; }
            ((float*)(ws + WS_RSTD2))[tok] = MOE_I8 ? rowinfo[gI * 32 + r32].y : rstd;
        }
#if MOE_I8
#if H1_BF16 && ROUTER_ROWCOPY
        { const bf16* xg = (const bf16*)(ws + WS_H1B) + (size_t)(grp * 64 + 8 * w) * D + 8 * lane; u32x4 xa[8][2];
#pragma unroll
          for (int t = 0; t < 8; ++t)
#pragma unroll
              for (int j = 0; j < 2; ++j) xa[t][j] = *(const u32x4*)(xg + (size_t)t * D + 512 * j);
#pragma unroll
          for (int t = 0; t < 8; ++t) { const float qs = rowinfo[8 * w + t].x;
#pragma unroll
              for (int j = 0; j < 2; ++j) { const u32x4 xraw = xa[t][j];
                  const f32x4 x0 = (f32x4){bf2f(xraw[0] & 0xffffu), bf2f(xraw[0] >> 16), bf2f(xraw[1] & 0xffffu), bf2f(xraw[1] >> 16)}, x1 = (f32x4){bf2f(xraw[2] & 0xffffu), bf2f(xraw[2] >> 16), bf2f(xraw[3] & 0xffffu), bf2f(xraw[3] >> 16)};
                  u32x2 q;
                  q.x = ((unsigned)(int)__builtin_rintf(x0[0] * qs) & 0xffu) | (((unsigned)(int)__builtin_rintf(x0[1] * qs) & 0xffu) << 8) | (((unsigned)(int)__builtin_rintf(x0[2] * qs) & 0xffu) << 16) | ((unsigned)(int)__builtin_rintf(x0[3] * qs) << 24);
                  q.y = ((unsigned)(int)__builtin_rintf(x1[0] * qs) & 0xffu) | (((unsigned)(int)__builtin_rintf(x1[1] * qs) & 0xffu) << 8) | (((unsigned)(int)__builtin_rintf(x1[2] * qs) & 0xffu) << 16) | ((unsigned)(int)__builtin_rintf(x1[3] * qs) << 24);
                  *(u32x2*)(ws + WS_H1Q + (size_t)(grp * 64 + 8 * w + t) * D + 8 * lane + 512 * j) = q; } } }
#else
        { const float qs = rowinfo[gI * 32 + r32].x; unsigned char* qrow = ws + WS_H1Q + (size_t)tok * D + kq * 256 + 8 * hi; LAS unsigned char* qst = F.lds + 49152 + w * (32 * 272);
#pragma unroll 4
          for (int s = 0; s < 16; ++s) {
#if H1_BF16
              const u32x4 xraw = *(const u32x4*)(xb + 16 * s);
              const f32x4 x0 = (f32x4){bf2f(xraw[0] & 0xffffu), bf2f(xraw[0] >> 16), bf2f(xraw[1] & 0xffffu), bf2f(xraw[1] >> 16)}, x1 = (f32x4){bf2f(xraw[2] & 0xffffu), bf2f(xraw[2] >> 16), bf2f(xraw[3] & 0xffffu), bf2f(xraw[3] >> 16)};
#else
              const f32x4 x0 = *(const f32x4*)(xr + 16 * s), x1 = *(const f32x4*)(xr + 16 * s + 4);
#endif
              u32x2 w;
              w.x = ((unsigned)(int)__builtin_rintf(x0[0] * qs) & 0xffu) | (((unsigned)(int)__builtin_rintf(x0[1] * qs) & 0xffu) << 8) | (((unsigned)(int)__builtin_rintf(x0[2] * qs) & 0xffu) << 16) | ((unsigned)(int)__builtin_rintf(x0[3] * qs) << 24);
              w.y = ((unsigned)(int)__builtin_rintf(x1[0] * qs) & 0xffu) | (((unsigned)(int)__builtin_rintf(x1[1] * qs) & 0xffu) << 8) | (((unsigned)(int)__builtin_rintf(x1[2] * qs) & 0xffu) << 16) | ((unsigned)(int)__builtin_rintf(x1[3] * qs) << 24);
              *(LAS u32x2*)(qst + r32 * 272 + 16 * s + 8 * hi) = w; (void)qrow; }
          asm volatile("s_waitcnt lgkmcnt(0)" ::: "memory");
#pragma unroll
          for (int j = 0; j < 8; ++j) { const int idx = lane + 64 * j, tk = idx >> 4, ch = idx & 15; const u32x4 v = *(const LAS u32x4*)(qst + tk * 272 + 16 * ch);
              *(u32x4*)(ws + WS_H1Q + (size_t)(grp * 64 + gI * 32 + tk) * D + kq * 256 + 16 * ch) = v; } }
#endif
#endif
        __syncthreads();
    }
}
__device__ __forceinline__ void p5b_lists(Frame& F, const Ptrs& P) {
    unsigned char* ws = P.ws; unsigned* ctl = (unsigned*)(ws + WS_CTL); const unsigned* hist = (const unsigned*)(ws + WS_HIST);
    LAS unsigned* part = (LAS unsigned*)F.lds;
    LAS unsigned* lbase = part + 512;
    for (int grp = blockIdx.x; grp < T / 64; grp += F.G) {
        { const int e = F.tid & 31, pt = F.tid >> 5; unsigned s = 0u;
#pragma unroll
          for (int i = 0; i < 16; ++i) { const int g2 = pt * 16 + i; const unsigned v = hist[g2 * NE + e]; s += (g2 < grp) ? v : 0u; }
          part[pt * 32 + e] = s; }
        __syncthreads();
        if (F.tid < NE) { unsigned s = 0u;
#pragma unroll
            for (int i = 0; i < 16; ++i) s += part[i * 32 + F.tid];
            lbase[F.tid] = s;
            if (grp == T / 64 - 1) ctl[CW_CNT + 64 * F.tid] = s + hist[grp * NE + F.tid]; }
        __syncthreads();
        if (F.tid < 256) { const int tok = grp * 64 + (F.tid >> 2); unsigned* slot = (unsigned*)(ws + WS_TOKSLOT) + tok * 4 + (F.tid & 3);
            const unsigned sv = *slot; const unsigned e = sv & 0xffu, pos = lbase[e] + (sv >> 8);
            *slot = e | (pos << 8); ((int*)(ws + WS_LIST))[(size_t)e * T + pos] = tok; ((float*)(ws + WS_RLIST))[(size_t)e * T + pos] = ((const float*)(ws + WS_RSTD2))[tok]; }
        __syncthreads();
    }
}
__device__ __forceinline__ void p8_combine(Frame& F, const Ptrs& P) {
    unsigned char* ws = P.ws; const LAS int* tbase = (const LAS int*)(F.lds + LX_TBASE);
    const int gw = F.vcu * NWAVES + F.wave, NGW = F.G * NWAVES, lane = F.lane;
    const bf16* Y = (const bf16*)(ws + WS_Y); const unsigned* slot = (const unsigned*)(ws + WS_TOKSLOT); const float* tw = (const float*)(ws + WS_TOKW);
    f32x4 gg[4];
#pragma unroll
    for (int j = 0; j < 2; ++j) { gg[2 * j] = *(const f32x4*)(P.fin_g + 8 * lane + 512 * j); gg[2 * j + 1] = *(const f32x4*)(P.fin_g + 8 * lane + 512 * j + 4); }
    for (int tok = gw; tok < T; tok += NGW) {
        const float* hr = (const float*)(ws + WS_H1) + (size_t)tok * D + 8 * lane; f32x4 v[4];
#pragma unroll
#if H1_BF16
        for (int j = 0; j < 2; ++j) { const u32x4 hb = *(const u32x4*)((const bf16*)(ws + WS_H1B) + (size_t)tok * D + 8 * lane + 512 * j);
            v[2 * j] = (f32x4){bf2f(hb[0] & 0xffffu), bf2f(hb[0] >> 16), bf2f(hb[1] & 0xffffu), bf2f(hb[1] >> 16)}; v[2 * j + 1] = (f32x4){bf2f(hb[2] & 0xffffu), bf2f(hb[2] >> 16), bf2f(hb[3] & 0xffffu), bf2f(hb[3] >> 16)}; }
        (void)hr;
#else
        for (int j = 0; j < 2; ++j) { v[2 * j] = *(const f32x4*)(hr + 512 * j); v[2 * j + 1] = *(const f32x4*)(hr + 512 * j + 4); }
#endif
        const u32x4 sl = *(const u32x4*)(slot + tok * 4); const f32x4 wv = *(const f32x4*)(tw + tok * 4);
#if Y_F8
        u32x2 y8[4][2];
#pragma unroll
        for (int k = 0; k < 4; ++k) { const int e = sl[k] & 0xff, pos = sl[k] >> 8; const unsigned char* yr = (const unsigned char*)Y + (size_t)(tbase[e] * 256 + pos) * D + 8 * lane; y8[k][0] = *(const u32x2*)yr; y8[k][1] = *(const u32x2*)(yr + 512); }
#pragma unroll
        for (int k = 0; k < 4; ++k)
#pragma unroll
            for (int j = 0; j < 2; ++j) { const u32x2 q = y8[k][j]; const float wk = wv[k];
                const f32x2 a = __builtin_amdgcn_cvt_pk_f32_fp8(q.x, false), b = __builtin_amdgcn_cvt_pk_f32_fp8(q.x, true), c = __builtin_amdgcn_cvt_pk_f32_fp8(q.y, false), d = __builtin_amdgcn_cvt_pk_f32_fp8(q.y, true);
                v[2 * j][0] += wk * a[0]; v[2 * j][1] += wk * a[1]; v[2 * j][2] += wk * b[0]; v[2 * j][3] += wk * b[1];
                v[2 * j + 1][0] += wk * c[0]; v[2 * j + 1][1] += wk * c[1]; v[2 * j + 1][2] += wk * d[0]; v[2 * j + 1][3] += wk * d[1]; }
#endif
        u32x4 y[4][2];
#pragma unroll
        for (int k = 0; k < 4; ++k) { if (Y_F8) break; const int e = sl[k] & 0xff, pos = sl[k] >> 8; const bf16* yr = Y + (size_t)(tbase[e] * 256 + pos) * D + 8 * lane; y[k][0] = *(const u32x4*)yr; y[k][1] = *(const u32x4*)(yr + 512); }
#pragma unroll
        for (int k = 0; k < 4; ++k)
#pragma unroll
            for (int j = 0; j < 2; ++j) { if (Y_F8) break; const u32x4 q = y[k][j]; const float wk = wv[k];
                v[2 * j][0] += wk * bf2f(q.x & 0xffffu); v[2 * j][1] += wk * bf2f(q.x >> 16); v[2 * j][2] += wk * bf2f(q.y & 0xffffu); v[2 * j][3] += wk * bf2f(q.y >> 16);
                v[2 * j + 1][0] += wk * bf2f(q.z & 0xffffu); v[2 * j + 1][1] += wk * bf2f(q.z >> 16); v[2 * j + 1][2] += wk * bf2f(q.w & 0xffffu); v[2 * j + 1][3] += wk * bf2f(q.w >> 16); }
        float s = 0.f;
#pragma unroll
        for (int j = 0; j < 4; ++j) s += (v[j][0] * v[j][0] + v[j][1] * v[j][1]) + (v[j][2] * v[j][2] + v[j][3] * v[j][3]);
        const float rstd = __builtin_amdgcn_rsqf(wave_sum(s) * (1.f / D) + EPS);
        float* orow = P.out + (size_t)tok * D + 8 * lane;
#pragma unroll
        for (int j = 0; j < 2; ++j) { *(f32x4*)(orow + 512 * j) = v[2 * j] * rstd * gg[2 * j]; *(f32x4*)(orow + 512 * j + 4) = v[2 * j + 1] * rstd * gg[2 * j + 1]; }
    }
}

constexpr int SGU_PITCH = 136;
__device__ __forceinline__ void sgu_unit(Frame& F, const Ptrs& P, int hu) {
    unsigned char* ws = P.ws; const int b = hu >> 6, c = (hu >> 1) & 31, gh = hu & 1, tok0 = b * SEQ + c * 128;
    const bf16* VV = (const bf16*)(ws + WS_VV); const bf16* U = (const bf16*)(ws + WS_U); bf16* SG = (bf16*)(ws + WS_SG);
    LAS bf16* vnT = (LAS bf16*)F.lds;
    int tid = F.tid; asm volatile("" : "+v"(tid));
    const int w = __builtin_amdgcn_readfirstlane(tid >> 6), lane = tid & 63;
    const int gl = w >> 1, th = w & 1, g = 4 * gh + gl, r32 = lane & 31, hi = lane >> 5;
    u32x4 rs[16], ru[8];
#pragma unroll
    for (int i = 0; i < 16; ++i) rs[i] = *((const u32x4*)(VV + (size_t)(tok0 + 16 * w + i) * SW) + lane);
#pragma unroll
    for (int j = 0; j < 8; ++j) { const int idx = lane + 64 * j; ru[j] = *(const u32x4*)(U + (size_t)(tok0 + 64 * th + (idx >> 3)) * SW + g * 64 + 8 * (idx & 7)); }
    const int chunk = lane & 31; const bool mine = (lane >> 5) == gh;
    const f32x4 g0 = *(const f32x4*)(P.ln_g + 8 * lane), g1 = *(const f32x4*)(P.ln_g + 8 * lane + 4), b0 = *(const f32x4*)(P.ln_b + 8 * lane), b1 = *(const f32x4*)(P.ln_b + 8 * lane + 4);
#pragma unroll
    for (int i = 0; i < 16; i += 2) { float v[2][8], mu[2], rstd[2];
#pragma unroll
        for (int t = 0; t < 2; ++t) { float s1 = 0.f, s2 = 0.f;
#pragma unroll
            for (int e = 0; e < 4; ++e) { v[t][2 * e] = bf2f(rs[i + t][e] & 0xffffu); v[t][2 * e + 1] = bf2f(rs[i + t][e] >> 16); s1 += v[t][2 * e] + v[t][2 * e + 1]; s2 += v[t][2 * e] * v[t][2 * e] + v[t][2 * e + 1] * v[t][2 * e + 1]; }
            s1 = wave_sum(s1); s2 = wave_sum(s2);
            mu[t] = s1 * (1.f / SW); rstd[t] = __builtin_amdgcn_rsqf(fmaxf(s2 * (1.f / SW) - mu[t] * mu[t], 0.f) + EPS); }
        if (mine) { const int sp = (16 * w + i) ^ ((chunk & 15) << 3);
#pragma unroll
            for (int e = 0; e < 8; ++e) { const float gg = e < 4 ? g0[e] : g1[e - 4], bb = e < 4 ? b0[e] : b1[e - 4];
                *(LAS unsigned*)(vnT + (8 * chunk + e) * SGU_PITCH + sp) = cvt_pk_bf16((v[0][e] - mu[0]) * rstd[0] * gg + bb, (v[1][e] - mu[1]) * rstd[1] * gg + bb); } } }
    const bf16* Wg = (const bf16*)(ws + WS_WSP) + (size_t)g * 128 * 128;
    const int nst = 4 * th + 4;
    bf16x8 wf[2][8];
#pragma unroll
    for (int tt = 0; tt < 2; ++tt)
#pragma unroll
        for (int ks = 0; ks < 8; ++ks) { const int t = 64 * th + 32 * tt + r32, s0 = 16 * ks + 8 * hi; wf[tt][ks] = *(const bf16x8*)(Wg + (size_t)t * 128 + s0); }
    const float bias0 = P.b_sp[g * 128 + 64 * th + r32], bias1 = P.b_sp[g * 128 + 64 * th + 32 + r32];
    LDS_BARRIER();
    f32x16 acc[2][2];
#pragma unroll
    for (int dt = 0; dt < 2; ++dt)
#pragma unroll
        for (int tt = 0; tt < 2; ++tt) acc[dt][tt] = f32x16{};
#pragma unroll
    for (int ks = 0; ks < 8; ++ks) { if (ks < nst) {
        const int s0 = 16 * ks + 8 * hi; bf16x8 af[2];
#pragma unroll
        for (int dt = 0; dt < 2; ++dt) { const int cc = 64 * gl + 32 * dt + r32; af[dt] = *(const LAS bf16x8*)(vnT + cc * SGU_PITCH + (s0 ^ (((cc >> 3) & 15) << 3))); }
#pragma unroll
        for (int tt = 0; tt < 2; ++tt) {
#pragma unroll
            for (int dt = 0; dt < 2; ++dt) acc[dt][tt] = __builtin_amdgcn_mfma_f32_32x32x16_bf16(af[dt], wf[tt][ks], acc[dt][tt], 0, 0, 0); } } }
    LDS_BARRIER();
    LAS bf16* ost = (LAS bf16*)(F.lds + w * (64 * 72 * 2));
#pragma unroll
    for (int tt = 0; tt < 2; ++tt) { const float bias = tt ? bias1 : bias0;
#pragma unroll
        for (int dt = 0; dt < 2; ++dt)
#pragma unroll
            for (int q = 0; q < 4; ++q) { u32x2 ov; ov.x = cvt_pk_bf16(acc[dt][tt][4 * q] + bias, acc[dt][tt][4 * q + 1] + bias); ov.y = cvt_pk_bf16(acc[dt][tt][4 * q + 2] + bias, acc[dt][tt][4 * q + 3] + bias);
                *(LAS u32x2*)(ost + (32 * tt + r32) * 72 + 32 * dt + 8 * q + 4 * hi) = ov; } }
    asm volatile("s_waitcnt lgkmcnt(0)" ::: "memory");
#pragma unroll
    for (int j = 0; j < 8; ++j) { const int idx = lane + 64 * j, row = idx >> 3, ch = idx & 7; const u32x4 m = *(const LAS u32x4*)(ost + row * 72 + 8 * ch); const u32x4 uu = ru[j]; u32x4 o;
#pragma unroll
        for (int e = 0; e < 4; ++e) o[e] = cvt_pk_bf16(bf2f(uu[e] & 0xffffu) * bf2f(m[e] & 0xffffu), bf2f(uu[e] >> 16) * bf2f(m[e] >> 16));
        const size_t tok = (size_t)(tok0 + 64 * th + row); const int cch = g * 64 + 8 * ch;
        *(u32x4*)(P3_FUSED ? (bf16*)(ws + WS_O) + tok * 1024 + 512 + cch : SG + tok * SW + cch) = o; }
    LDS_BARRIER();
}
__device__ __forceinline__ void p2_mixer(Frame& F, const Ptrs& P, char* lds_generic, int nrep) {
    unsigned char* ws = P.ws;
    const attn_body::bf16* Q = (const attn_body::bf16*)(ws + WS_Q); const attn_body::bf16* K = (const attn_body::bf16*)(ws + WS_K); const attn_body::bf16* V = (const attn_body::bf16*)(ws + WS_V);
    const float* KM = (const float*)(ws + WS_CTL) + CW_KM; attn_body::bf16* O = (attn_body::bf16*)(ws + WS_O);
    SUBSTAMP(14);
    for (int p = F.vcu; p < NBATCH * NH * 8; p += F.G) { const int bh = p >> 3, s = p & 7;
        for (int r = 0; r < 2 * nrep; ++r)
            attn_body::attn_unit<48>(bh / NH, bh % NH, (r & 1) ? 15 - s : s, Q, K, V, KM, O, lds_generic); }
    SUBSTAMP(12);
    for (int hu = F.vcu; hu < NBATCH * 32 * 2; hu += F.G) for (int r = 0; r < SGU_REP; ++r) sgu_unit(F, P, hu);
    SUBSTAMP(13);
}

struct Args { Ptrs P; int ph_lo, ph_hi, li, pad; };
__global__ void __launch_bounds__(NWAVES * 64, 2) fwd(Args args) {
    extern __shared__ __attribute__((aligned(16))) unsigned char lds_raw[];
    Frame F; F.lds = (LAS unsigned char*)lds_raw; F.tid = threadIdx.x; F.lane = F.tid & 63; F.wave = __builtin_amdgcn_readfirstlane(F.tid >> 6);
    F.G = gridDim.x; { const int bx = blockIdx.x; F.vcu = (F.G % 8 == 0) ? (bx % 8) * (F.G / 8) + bx / 8 : bx; }
    const Ptrs& P = args.P; unsigned char* ws = P.ws; unsigned* ctl = (unsigned*)(ws + WS_CTL);
    if (F.tid < 4) ((LAS unsigned*)(F.lds + LX_BAR))[F.tid] = 0u;
    __syncthreads();
    XcdBarrier bar = xcd_barrier_post(ctl + CW_BAR + args.li * XCD_BAR_WORDS, (volatile LAS unsigned*)(F.lds + LX_BAR));
    const int lo = args.ph_lo, hi = args.ph_hi;
#define IN(k) (lo <= (k) && (k) < hi)
#define STAMP(i) do { if (PROBE_K >= 0 && blockIdx.x == 0 && F.tid == 0) { ((LAS unsigned long long*)(F.lds + LX_MISC))[i] = __builtin_amdgcn_s_memrealtime(); } } while (0)
#ifndef REP_PHASE
#define REP_PHASE -1
#endif
#define REPS(k) (((k) == REP_PHASE) ? 2 : 1)
#define SEAM(k) do { if (IN(k) && IN((k) + 1)) { STAMP(20 + (k)); xcd_barrier(bar); } } while (0)

    STAMP(0);
    if (IN(0)) _Pragma("unroll") for (int rep_ = 0; rep_ < REPS(0); ++rep_) { p0_prologue(F, P); if (rep_ + 1 < REPS(0)) xcd_barrier(bar); else SEAM(0); }
    STAMP(1);
    if (IN(1)) _Pragma("unroll") for (int rep_ = 0; rep_ < REPS(1); ++rep_) {
        DenseSched S{(const char*)(ws + WS_XN), (const char*)(ws + WS_WIN), D, D, T / 256, IN_I8 ? IN_BF_TILES : NIN / 256, F.G, (int)blockIdx.x, WGM_IN};
        EpiIn E{ws, (float*)(ws + WS_CTL) + CW_KM};
        pg8::gemm_phase<EpiIn, DenseSched, true>(F.lds, D, D, S, E);
#if IN_I8
        BalSched S2{(const char*)(ws + WS_XNQ), (const char*)(ws + WS_WINQ), D / 2, D / 2, T / 256, NIN / 256 - IN_BF_TILES, F.G, (int)blockIdx.x, (T / 256) * IN_BF_TILES};
        EpiInQ E2{ws, (const float*)(ws + WS_SXN), (const float*)(ws + WS_SBIN), (float*)(ws + WS_CTL) + CW_KM, F.lds};
        pg8::gemm_phase<EpiInQ, BalSched, true>(F.lds, D / 2, D / 2, S2, E2);
#endif
        if (rep_ + 1 < REPS(1)) xcd_barrier(bar); else SEAM(1);
    }
    STAMP(2);
    if (IN(2)) _Pragma("unroll") for (int rep_ = 0; rep_ < REPS(2); ++rep_) { p2_mixer(F, P, (char*)lds_raw, args.pad); if (rep_ + 1 < REPS(2)) xcd_barrier(bar); else SEAM(2); }
    STAMP(3);
    if (IN(3)) _Pragma("unroll") for (int rep_ = 0; rep_ < REPS(3); ++rep_) {
#if P3_FUSED
        DenseSched S{(const char*)(ws + WS_O), (const char*)(ws + WS_WA), D, D, T / 256, D / 256, F.G, (int)blockIdx.x, WGM_MID};
        EpiMergeF E{ws};
        pg8::gemm_phase<EpiMergeF, DenseSched, true>(F.lds, D, D, S, E);
#else
        MergeSched S{(const char*)(ws + WS_O), (const char*)(ws + WS_WA), F.G, (int)blockIdx.x};
        EpiMerge E{ws};
        pg8::gemm_phase<EpiMerge, MergeSched, true>(F.lds, AW, AW, S, E);
#endif
        if (rep_ + 1 < REPS(3)) xcd_barrier(bar); else SEAM(3);
    }
    STAMP(4);
    if (IN(4)) _Pragma("unroll") for (int rep_ = 0; rep_ < REPS(4); ++rep_) {
        DenseSched S{(const char*)(ws + WS_MG), (const char*)(ws + WS_WM), D, D, T / 256, D / 256, F.G, (int)blockIdx.x, WGM_MID};
        EpiH1 E{P.x, (float*)(ws + WS_H1), (bf16*)(ws + WS_H1B), (const bf16*)(ws + WS_XN)};
        pg8::gemm_phase<EpiH1, DenseSched, true>(F.lds, D, D, S, E);
        if (rep_ + 1 < REPS(4)) xcd_barrier(bar); else SEAM(4);
    }
    STAMP(5);
    if (IN(5)) { p5_router(F, P); xcd_barrier(bar); p5b_lists(F, P); SEAM(5); }
    STAMP(6);
    if (IN(6)) _Pragma("unroll") for (int rep_ = 0; rep_ < REPS(6); ++rep_) {
        moe_tables(F, ctl);
#if MOE_I8
        MoeSched<true> S{(const char*)(ws + WS_H1Q), (const char*)(ws + WS_WGU), (const int*)(ws + WS_LIST), (const LAS int*)(F.lds + LX_TBASE), (const LAS int*)(F.lds + LX_TILEE), ctl, 8, F.G, (int)blockIdx.x, D / 2};
        EpiGuQ E{(const float*)(ws + WS_RLIST), (const float*)(ws + WS_SB), P.b_gu, (bf16*)(ws + WS_HID), F.lds};
        pg8::gemm_phase<EpiGuQ, MoeSched<true>, true>(F.lds, D / 2, D / 2, S, E);
#else
        MoeSched<true> S{(const char*)(ws + WS_H1B), (const char*)(ws + WS_WGU), (const int*)(ws + WS_LIST), (const LAS int*)(F.lds + LX_TBASE), (const LAS int*)(F.lds + LX_TILEE), ctl, 8, F.G, (int)blockIdx.x, D};
        EpiGu E{(const float*)(ws + WS_RLIST), P.b_gu, (bf16*)(ws + WS_HID)};
        pg8::gemm_phase<EpiGu, MoeSched<true>, true>(F.lds, D, D, S, E);
#endif
        if (rep_ + 1 < REPS(6)) xcd_barrier(bar); else SEAM(6);
    }
    STAMP(7);
    if (IN(7)) _Pragma("unroll") for (int rep_ = 0; rep_ < REPS(7); ++rep_) {
        if (!IN(6)) moe_tables(F, ctl);
        MoeSched<false> S{(const char*)(ws + WS_HID), (const char*)(ws + WS_WD), nullptr, (const LAS int*)(F.lds + LX_TBASE), (const LAS int*)(F.lds + LX_TILEE), ctl, 4, F.G, (int)blockIdx.x, MOE_F8 ? DE / 2 : DE};
        EpiDown E{P.b_down, (bf16*)(ws + WS_Y), F.lds};
        pg8::gemm_phase<EpiDown, MoeSched<false>, true>(F.lds, MOE_F8 ? DE / 2 : DE, MOE_F8 ? DE / 2 : DE, S, E);
        if (rep_ + 1 < REPS(7)) xcd_barrier(bar); else SEAM(7);
    }
    STAMP(8);
    if (IN(8)) _Pragma("unroll") for (int rep_ = 0; rep_ < REPS(8); ++rep_) { if (!IN(6)) moe_tables(F, ctl); p8_combine(F, P); if (rep_ + 1 < REPS(8)) xcd_barrier(bar); }
    STAMP(9);
    if (PROBE_K >= 0 && blockIdx.x == 0 && F.tid == 0) { const LAS unsigned long long* ts = (const LAS unsigned long long*)(F.lds + LX_MISC); const unsigned long long d = (PROBE_K == 9) ? ts[9] - ts[0] : (PROBE_K == 40) ? (ts[1] - ts[20]) + (ts[2] - ts[21]) + (ts[3] - ts[22]) + (ts[4] - ts[23]) + (ts[5] - ts[24]) + (ts[6] - ts[25]) + (ts[7] - ts[26]) + (ts[8] - ts[27]) : (PROBE_K == 24) ? ts[12] - ts[14] : (PROBE_K == 23) ? ts[13] - ts[12] : (PROBE_K == 20) ? ts[10] - ts[0] : (PROBE_K == 21) ? ts[11] - ts[10] : (PROBE_K == 22) ? ts[1] - ts[11] : ts[(PROBE_K + 1) % 10] - ts[PROBE_K % 10], t0 = __builtin_amdgcn_s_memrealtime();
        while (__builtin_amdgcn_s_memrealtime() - t0 < d) __builtin_amdgcn_s_sleep(8); }
#undef IN
#undef SEAM
}

#ifndef ATTN_REP
#define ATTN_REP 1
#endif
#ifndef REDO_MASK
#define REDO_MASK 0x000
#endif
#ifndef OPT_MASK
#define OPT_MASK 0x1FF
#endif
static void naive_phase(int k, const Ptrs& P, hipStream_t stream) {
    unsigned char* ws = P.ws;
    switch (k) {
    case 0:
        n_cvtT<<<dim3(NIN / 32, D / 32, 1), 256, 0, stream>>>(P.w_in, (bf16*)(ws + WS_WIN), D, NIN, nullptr);
        n_cvtT<<<dim3(D / 32, AW / 32, 1), 256, 0, stream>>>(P.w_attn_out, (bf16*)(ws + WS_WA), AW, D, nullptr);
        n_cvtT<<<dim3(D / 32, SW / 32, 1), 256, 0, stream>>>(P.w_sgu_out, (bf16*)(ws + WS_WS), SW, D, nullptr);
        n_cvtT<<<dim3(D / 32, D / 32, 1), 256, 0, stream>>>(P.w_mix_out, (bf16*)(ws + WS_WM), D, D, nullptr);
        n_cvtT<<<dim3(2 * DE / 32, D / 32, NE), 256, 0, stream>>>(P.w_gu, (bf16*)(ws + WS_WGU), D, 2 * DE, P.ffn_g);
        n_cvtT<<<dim3(D / 32, DE / 32, NE), 256, 0, stream>>>(P.w_down, (bf16*)(ws + WS_WD), DE, D, nullptr);
        n_cvt_router<<<NE * D / 256, 256, 0, stream>>>(P.w_router, P.ffn_g, (bf16*)(ws + WS_WR), (bf16*)(ws + WS_WR) + NE * D);
        n_rmsnorm<<<T / 4, 256, 0, stream>>>(P.x, P.mix_g, (bf16*)(ws + WS_XN));
        break;
    case 1:
        n_gemm<EPI_IN><<<dim3(NIN / 128, T / 128), 256, 0, stream>>>((const bf16*)(ws + WS_XN), D, (const bf16*)(ws + WS_WIN), D, D, P);
        n_kmean<<<NBATCH * NBLK * AW / 256, 256, 0, stream>>>((const bf16*)(ws + WS_K), (float*)(ws + WS_CTL) + CW_KM);
        break;
    case 2:
        n_attn<<<T * NH / 4, 256, 0, stream>>>((const bf16*)(ws + WS_Q), (const bf16*)(ws + WS_K), (const bf16*)(ws + WS_V), (const float*)(ws + WS_CTL) + CW_KM, (bf16*)(ws + WS_O));
        n_sgu_stats<<<T / 4, 256, 0, stream>>>((const bf16*)(ws + WS_VV), (float*)(ws + WS_STATS));
        n_sgu<<<T * SW / 256, 256, 0, stream>>>((const bf16*)(ws + WS_U), (const bf16*)(ws + WS_VV), (const float*)(ws + WS_STATS), P, (bf16*)(ws + WS_SG));
        break;
    case 3:
        n_gemm<EPI_MG1><<<dim3(D / 128, T / 128), 256, 0, stream>>>((const bf16*)(ws + WS_O), AW, (const bf16*)(ws + WS_WA), AW, AW, P);
        n_gemm<EPI_MG2><<<dim3(D / 128, T / 128), 256, 0, stream>>>((const bf16*)(ws + WS_SG), SW, (const bf16*)(ws + WS_WS), SW, SW, P);
        break;
    case 4: n_gemm<EPI_H1><<<dim3(D / 128, T / 128), 256, 0, stream>>>((const bf16*)(ws + WS_MG), D, (const bf16*)(ws + WS_WM), D, D, P); break;
    case 5: n_router<<<T / 4, 256, 0, stream>>>(P); break;
    case 6: n_moe_gu<<<dim3(DE / 128, NROWS_PAD / 128), 256, 0, stream>>>(P); break;
    case 7: n_moe_down<<<dim3(D / 128, NROWS_PAD / 128), 256, 0, stream>>>(P); break;
    default: n_combine<<<T / 4, 256, 0, stream>>>(P); break;
    }
}
extern "C" void kernel_launch(void* const* d_in, const int* in_sizes, int n_in, void* d_out, int out_size, void* d_ws, size_t ws_size, hipStream_t stream) {
    static int grid = 0;
    if (grid == 0) {
        if (n_in != 18 || in_sizes[0] != T * D || out_size != T * D || ws_size < WS_END) { fprintf(stderr, "kernel_launch: unexpected shapes (n_in %d, in0 %d, out %d, ws %zu)\n", n_in, n_in > 0 ? in_sizes[0] : -1, out_size, ws_size); grid = -1; return; }
        int dev = 0, cus = 0, per_cu = 0;
        if (hipGetDevice(&dev) != hipSuccess || hipDeviceGetAttribute(&cus, hipDeviceAttributeMultiprocessorCount, dev) != hipSuccess) { grid = -1; return; }
        if (hipFuncSetAttribute((const void*)fwd, hipFuncAttributeMaxDynamicSharedMemorySize, LDS_BYTES) != hipSuccess) { fprintf(stderr, "kernel_launch: hipFuncSetAttribute failed\n"); grid = -1; return; }
        if (hipOccupancyMaxActiveBlocksPerMultiprocessor(&per_cu, (const void*)fwd, NWAVES * 64, LDS_BYTES) != hipSuccess || per_cu < 1) fprintf(stderr, "kernel_launch: occupancy query says %d\n", per_cu);
        (void)hipGetLastError();
        grid = cus;
    }
    if (grid < 0) return;
    Ptrs P{};
    const float** pf = (const float**)&P;
    for (int i = 0; i < 18; ++i) pf[i] = (const float*)d_in[i];
    P.out = (float*)d_out; P.ws = (unsigned char*)d_ws;
    (void)hipMemsetAsync((unsigned char*)d_ws + WS_CTL, 0, CTL_ZERO_BYTES, stream);
    int li = 0;
    for (int k = 0; k < 9;) {
        if (!((OPT_MASK >> k) & 1)) { naive_phase(k, P, stream); ++k; continue; }
        int hi = k; while (hi < 9 && ((OPT_MASK >> hi) & 1)) ++hi;
        Args a{}; a.P = P; a.ph_lo = k; a.ph_hi = hi; a.li = li++; a.pad = ATTN_REP;
        hipLaunchKernelGGL(fwd, dim3(grid), dim3(NWAVES * 64), LDS_BYTES, stream, a);
        for (int q = k; q < hi; ++q) if ((REDO_MASK >> q) & 1) naive_phase(q, P, stream);
        k = hi;
    }
}
```
